# Optimizing an MI355X kernel written in HIP

```python
import math
import numpy as np
import jax
import jax.numpy as jnp
from jax import lax

D_MODEL = 1024
BATCH = 2
SEQ = 16384
DEPTH = 2

GRID_W = 64
CTX_LEN = 256
EPS = 1e-6
Q_BLOCK = 128
ROPE_THETA = 10000.0

HEAD_DIM = 64
AXIS_DIM = HEAD_DIM // 2

A_HEADS = 8
A_KV_HEADS = 2
A_GROUP = A_HEADS // A_KV_HEADS

DN_HEADS = 8
DN_DK = 64
DN_DV = 64
DN_CHUNK = 64
DN_CONV = 3

DF_HEADS = 4
DF_HD = 64
DF_VD = 2 * DF_HD

N_EXPERTS = 64
TOP_K = 6
N_GROUPS = 8
TOPK_GROUPS = 4
MOE_FF = 256
ROUTED_SCALE = 2.5
MOE_BLOCK = 128

A_QW = A_HEADS * HEAD_DIM
A_KVW = A_KV_HEADS * HEAD_DIM
DN_QKVW = DN_HEADS * (2 * DN_DK + DN_DV)
DN_ZW = DN_HEADS * DN_DV
DN_GW = 2 * DN_HEADS
DF_QKW = DF_HEADS * 2 * DF_HD
DF_VW = DF_HEADS * DF_VD
GATE_W = 3 * D_MODEL
PROJ_SPLITS = (A_QW, A_KVW, A_KVW, DN_QKVW, DN_ZW, DN_GW, DN_GW, DF_QKW, DF_QKW, DF_VW, GATE_W)
IN_W = A_QW + 2 * A_KVW + DN_QKVW + DN_ZW + 2 * DN_GW + 2 * DF_QKW + DF_VW + GATE_W
BR_W = 512

kernel_name = "hybrid_gqa_deltanet_diffattn_moe_dit"


def _rmsnorm(x, g):
    xf = x.astype(jnp.float32)
    y = xf * lax.rsqrt(jnp.mean(xf * xf, axis=-1, keepdims=True) + EPS)
    return (y * g.astype(jnp.float32)).astype(x.dtype)


def _l2norm(x):
    xf = x.astype(jnp.float32)
    return (xf * lax.rsqrt(jnp.sum(xf * xf, axis=-1, keepdims=True) + EPS)).astype(x.dtype)


def _axial_rope(n_tokens, dtype):
    rows = n_tokens // GRID_W
    row = jnp.repeat(jnp.arange(rows, dtype=jnp.float32), GRID_W)
    col = (jnp.arange(n_tokens) % GRID_W).astype(jnp.float32)
    inv = 1.0 / (ROPE_THETA ** (jnp.arange(0, AXIS_DIM, 2, dtype=jnp.float32) / AXIS_DIM))
    ang = jnp.concatenate([row[:, None] * inv, col[:, None] * inv], axis=-1)
    ang = jnp.concatenate([ang, ang], axis=-1)
    return jnp.cos(ang).astype(dtype), jnp.sin(ang).astype(dtype)


def _apply_rope(x, cos, sin):
    shape = (1, x.shape[1]) + (1,) * (x.ndim - 3) + (x.shape[-1],)
    cos = cos.reshape(shape)
    sin = sin.reshape(shape)
    x1, x2 = jnp.split(x, 2, axis=-1)
    return x * cos + jnp.concatenate([-x2, x1], axis=-1) * sin


def _sweep_query_blocks(fn, q):
    B, T = q.shape[:2]
    nb = T // Q_BLOCK
    qb = jnp.moveaxis(q.reshape((B, nb, Q_BLOCK) + q.shape[2:]), 1, 0)
    ob = lax.map(fn, qb)
    return jnp.moveaxis(ob, 0, 1).reshape((B, T) + ob.shape[3:])


def _gqa_attend(q, k, v):
    s = jnp.einsum("bqhgd,bkhd->bhgqk", q, k, preferred_element_type=jnp.float32) * (HEAD_DIM ** -0.5)
    p = jax.nn.softmax(s, axis=-1).astype(v.dtype)
    return jnp.einsum("bhgqk,bkhd->bqhgd", p, v)


def _diff_attend(q, k, v, lam):
    s = jnp.einsum("bqhcd,bkhcd->bhcqk", q, k, preferred_element_type=jnp.float32) * (DF_HD ** -0.5)
    p = jax.nn.softmax(s, axis=-1)
    a = (p[:, :, 0] - lam * p[:, :, 1]).astype(v.dtype)
    return jnp.einsum("bhqk,bkhe->bqhe", a, v)


def _short_conv(x, w):
    T = x.shape[1]
    pad = DN_CONV // 2
    xp = jnp.pad(x, ((0, 0), (pad, DN_CONV - 1 - pad), (0, 0)))
    out = xp[:, 0:T] * w[0]
    for j in range(1, DN_CONV):
        out = out + xp[:, j:j + T] * w[j]
    return out


def _gated_delta_rule(q, k, v, g, beta, s0):
    out_dtype = v.dtype
    B, T, H, dk = q.shape
    dv = v.shape[-1]
    n = T // DN_CHUNK
    f32 = jnp.float32

    def chunks(t):
        t = t.astype(f32).reshape((B, n, DN_CHUNK, H) + t.shape[3:])
        return jnp.moveaxis(t, 3, 1)

    q = chunks(q) * (dk ** -0.5)
    k = chunks(k)
    v = chunks(v)
    g = jnp.cumsum(chunks(g), axis=-1)
    beta = chunks(beta)
    kb = k * beta[..., None]
    vb = v * beta[..., None]
    causal = jnp.tril(jnp.ones((DN_CHUNK, DN_CHUNK), bool))
    strict = jnp.tril(jnp.ones((DN_CHUNK, DN_CHUNK), bool), -1)
    decay = jnp.exp(jnp.where(causal, g[..., :, None] - g[..., None, :], -jnp.inf))
    lower = jnp.where(strict, jnp.einsum("bhncd,bhnsd->bhncs", kb, k) * decay, 0.0)
    eye = jnp.eye(DN_CHUNK, dtype=f32)
    tinv = lax.linalg.triangular_solve(lower + eye, jnp.broadcast_to(eye, lower.shape),
                                       left_side=True, lower=True, unit_diagonal=True)
    vals = tinv @ vb
    wk = tinv @ (kb * jnp.exp(g)[..., None])
    qk = jnp.einsum("bhncd,bhnsd->bhncs", q, k) * decay
    q_dec = q * jnp.exp(g)[..., None]
    k_dec = k * jnp.exp(g[..., -1:] - g)[..., None]
    g_last = jnp.exp(g[..., -1])
    xs = tuple(jnp.moveaxis(t, 2, 0) for t in (q_dec, k_dec, vals, wk, qk, g_last))

    def step(S, inp):
        q_i, k_i, u_i, w_i, qk_i, gl_i = inp
        v_new = u_i - w_i @ S
        o_i = q_i @ S + qk_i @ v_new
        S = S * gl_i[..., None, None] + jnp.swapaxes(k_i, -1, -2) @ v_new
        return S, o_i

    S, o = lax.scan(step, s0, xs)
    o = jnp.moveaxis(jnp.moveaxis(o, 0, 2), 1, 3).reshape(B, T, H, dv)
    return o.astype(out_dtype), S


def _split_proj(p):
    idx = np.cumsum(PROJ_SPLITS)[:-1].tolist()
    return jnp.split(p, idx, axis=-1)


def _mixer_gqa(q_c, k_c, v_c, q_l, k_l, v_l, cos, sin, g_q, g_k, with_ctx):
    B, S = q_l.shape[:2]
    n_c = k_c.shape[1]
    q_l = _apply_rope(_rmsnorm(q_l.reshape(B, S, A_KV_HEADS, A_GROUP, HEAD_DIM), g_q), cos, sin)
    k_l = _apply_rope(_rmsnorm(k_l.reshape(B, S, A_KV_HEADS, HEAD_DIM), g_k), cos, sin)
    v_l = v_l.reshape(B, S, A_KV_HEADS, HEAD_DIM)
    k_c = _rmsnorm(k_c.reshape(B, n_c, A_KV_HEADS, HEAD_DIM), g_k)
    v_c = v_c.reshape(B, n_c, A_KV_HEADS, HEAD_DIM)
    k_all = jnp.concatenate([k_c, k_l], axis=1)
    v_all = jnp.concatenate([v_c, v_l], axis=1)
    o_l = _sweep_query_blocks(lambda qb: _gqa_attend(qb, k_all, v_all), q_l).reshape(B, S, A_QW)
    if not with_ctx:
        return None, o_l
    q_c = _rmsnorm(q_c.reshape(B, n_c, A_KV_HEADS, A_GROUP, HEAD_DIM), g_q)
    return _gqa_attend(q_c, k_c, v_c).reshape(B, n_c, A_QW), o_l


def _dn_prepare(qkv, a, b, w_conv, a_log, dt_bias):
    B, T = qkv.shape[:2]
    qkv = jax.nn.silu(_short_conv(qkv, w_conv))
    q, k, v = jnp.split(qkv, [DN_HEADS * DN_DK, 2 * DN_HEADS * DN_DK], axis=-1)
    q = _l2norm(q.reshape(B, T, DN_HEADS, DN_DK))
    k = _l2norm(k.reshape(B, T, DN_HEADS, DN_DK))
    v = v.reshape(B, T, DN_HEADS, DN_DV)
    a = a.astype(jnp.float32).reshape(B, T, 2, DN_HEADS)
    b = b.astype(jnp.float32).reshape(B, T, 2, DN_HEADS)
    g = -jnp.exp(a_log.astype(jnp.float32)) * jax.nn.softplus(a + dt_bias.astype(jnp.float32))
    return q, k, v, g, jax.nn.sigmoid(b)


def _flip(t):
    return jnp.flip(t, axis=1)


def _mixer_deltanet(qkv_c, z_c, a_c, b_c, qkv_l, z_l, a_l, b_l, w_conv, a_log, dt_bias, g_out, with_ctx):
    qc, kc, vc, gc, bc = _dn_prepare(qkv_c, a_c, b_c, w_conv, a_log, dt_bias)
    ql, kl, vl, gl, bl = _dn_prepare(qkv_l, a_l, b_l, w_conv, a_log, dt_bias)
    s0 = jnp.zeros((qc.shape[0], DN_HEADS, DN_DK, DN_DV), jnp.float32)
    oc_f, s_f = _gated_delta_rule(qc, kc, vc, gc[:, :, 0], bc[:, :, 0], s0)
    ol_f, _ = _gated_delta_rule(ql, kl, vl, gl[:, :, 0], bl[:, :, 0], s_f)
    oc_b, s_b = _gated_delta_rule(_flip(qc), _flip(kc), _flip(vc), _flip(gc[:, :, 1]), _flip(bc[:, :, 1]), s0)
    ol_b, _ = _gated_delta_rule(_flip(ql), _flip(kl), _flip(vl), _flip(gl[:, :, 1]), _flip(bl[:, :, 1]), s_b)

    def gated_out(o, z):
        B, T = o.shape[:2]
        zz = z.reshape(B, T, DN_HEADS, DN_DV)
        return (_rmsnorm(o, g_out) * jax.nn.silu(zz)).reshape(B, T, DN_ZW)

    o_l = gated_out(ol_f + _flip(ol_b), z_l)
    if not with_ctx:
        return None, o_l
    return gated_out(oc_f + _flip(oc_b), z_c), o_l


def _mixer_diff(q_c, k_c, v_c, q_l, k_l, v_l, cos, sin, lam_qk, g_subln, lambda_init, with_ctx):
    B, S = q_l.shape[:2]
    n_c = k_c.shape[1]
    lq = lam_qk.astype(jnp.float32)
    lam = jnp.exp(jnp.sum(lq[0] * lq[1])) - jnp.exp(jnp.sum(lq[2] * lq[3])) + lambda_init
    q_l = _apply_rope(q_l.reshape(B, S, DF_HEADS, 2, DF_HD), cos, sin)
    k_l = _apply_rope(k_l.reshape(B, S, DF_HEADS, 2, DF_HD), cos, sin)
    v_l = v_l.reshape(B, S, DF_HEADS, DF_VD)
    k_c = k_c.reshape(B, n_c, DF_HEADS, 2, DF_HD)
    v_c = v_c.reshape(B, n_c, DF_HEADS, DF_VD)
    k_all = jnp.concatenate([k_c, k_l], axis=1)
    v_all = jnp.concatenate([v_c, v_l], axis=1)

    def finish(o):
        return (_rmsnorm(o, g_subln) * (1.0 - lambda_init)).reshape(o.shape[:2] + (DF_VW,))

    o_l = finish(_sweep_query_blocks(lambda qb: _diff_attend(qb, k_all, v_all, lam), q_l))
    if not with_ctx:
        return None, o_l
    q_c = q_c.reshape(B, n_c, DF_HEADS, 2, DF_HD)
    return finish(_diff_attend(q_c, k_c, v_c, lam)), o_l


def _merge(br_a, br_b, br_c, gates, w_branch, w_out):
    g_a, g_b, g_c = jnp.split(gates, 3, axis=-1)
    m = (jax.nn.sigmoid(g_a) * (br_a @ w_branch[0])
         + jax.nn.sigmoid(g_b) * (br_b @ w_branch[1])
         + jax.nn.sigmoid(g_c) * (br_c @ w_branch[2]))
    return m @ w_out


def _moe(u, w_router, b_router, w_e_gate, w_e_up, w_e_down, w_s_gate, w_s_up, w_s_down):
    N, D = u.shape
    scores = jax.nn.sigmoid(jnp.dot(u, w_router, preferred_element_type=jnp.float32))
    sel = scores + b_router.astype(jnp.float32)
    grouped = sel.reshape(N, N_GROUPS, N_EXPERTS // N_GROUPS)
    group_score = jnp.sum(lax.top_k(grouped, 2)[0], axis=-1)
    gidx = lax.top_k(group_score, TOPK_GROUPS)[1]
    gmask = jnp.sum(jax.nn.one_hot(gidx, N_GROUPS, dtype=jnp.float32), axis=1) > 0
    emask = jnp.repeat(gmask, N_EXPERTS // N_GROUPS, axis=1)
    eidx = lax.top_k(jnp.where(emask, sel, -jnp.inf), TOP_K)[1]
    wts = jnp.take_along_axis(scores, eidx, axis=1)
    wts = wts / (jnp.sum(wts, axis=-1, keepdims=True) + 1e-20) * ROUTED_SCALE
    combine = jnp.sum(jax.nn.one_hot(eidx, N_EXPERTS, dtype=jnp.float32) * wts[..., None], axis=1)
    nb = N // MOE_BLOCK
    ub = u.reshape(nb, MOE_BLOCK, D)
    cb = combine.astype(u.dtype).reshape(nb, MOE_BLOCK, N_EXPERTS)

    def blk(args):
        xb, gb = args
        h = jax.nn.silu(jnp.einsum("nd,edf->nef", xb, w_e_gate)) * jnp.einsum("nd,edf->nef", xb, w_e_up)
        return jnp.einsum("nef,efd->nd", h * gb[..., None], w_e_down)

    routed = lax.map(blk, (ub, cb)).reshape(N, D)
    shared = (jax.nn.silu(u @ w_s_gate) * (u @ w_s_up)) @ w_s_down
    return routed + shared


def _layer(h_ctx, h_lat, cond_ctx, cond_lat, cos, sin, layer_idx, update_ctx,
           w_mod, b_mod, g_norm1, g_norm2, w_in, g_qnorm, g_knorm, w_conv, a_log, dt_bias,
           g_dn_out, lam_qk, g_subln, w_branch, w_out, w_router, b_router,
           w_e_gate, w_e_up, w_e_down, w_s_gate, w_s_up, w_s_down):
    D = h_lat.shape[-1]
    lambda_init = 0.8 - 0.6 * math.exp(-0.3 * layer_idx)
    mod_l = (cond_lat @ w_mod + b_mod)[:, None, :]
    mod_c = cond_ctx @ w_mod + b_mod
    sh1_l, sc1_l, gt1_l, sh2_l, sc2_l, gt2_l = jnp.split(mod_l, 6, axis=-1)
    sh1_c, sc1_c, gt1_c, sh2_c, sc2_c, gt2_c = jnp.split(mod_c, 6, axis=-1)

    u_l = _rmsnorm(h_lat, g_norm1) * (1 + sc1_l) + sh1_l
    u_c = _rmsnorm(h_ctx, g_norm1) * (1 + sc1_c) + sh1_c
    (aq_l, ak_l, av_l, bqkv_l, bz_l, ba_l, bb_l, cq_l, ck_l, cv_l, gate_l) = _split_proj(u_l @ w_in)
    (aq_c, ak_c, av_c, bqkv_c, bz_c, ba_c, bb_c, cq_c, ck_c, cv_c, gate_c) = _split_proj(u_c @ w_in)
    a_c, a_l = _mixer_gqa(aq_c, ak_c, av_c, aq_l, ak_l, av_l, cos, sin, g_qnorm, g_knorm, update_ctx)
    b_c, b_l = _mixer_deltanet(bqkv_c, bz_c, ba_c, bb_c, bqkv_l, bz_l, ba_l, bb_l,
                               w_conv, a_log, dt_bias, g_dn_out, update_ctx)
    c_c, c_l = _mixer_diff(cq_c, ck_c, cv_c, cq_l, ck_l, cv_l, cos, sin, lam_qk, g_subln,
                           lambda_init, update_ctx)
    h_lat = h_lat + gt1_l * _merge(a_l, b_l, c_l, gate_l, w_branch, w_out)
    v_l = _rmsnorm(h_lat, g_norm2) * (1 + sc2_l) + sh2_l

    moe_args = (w_router, b_router, w_e_gate, w_e_up, w_e_down, w_s_gate, w_s_up, w_s_down)
    if update_ctx:
        h_ctx = h_ctx + gt1_c * _merge(a_c, b_c, c_c, gate_c, w_branch, w_out)
        v_c = _rmsnorm(h_ctx, g_norm2) * (1 + sc2_c) + sh2_c
        n_c = v_c.shape[0] * v_c.shape[1]
        f = _moe(jnp.concatenate([v_c.reshape(-1, D), v_l.reshape(-1, D)], axis=0), *moe_args)
        h_ctx = h_ctx + gt2_c * f[:n_c].reshape(h_ctx.shape)
        h_lat = h_lat + gt2_l * f[n_c:].reshape(h_lat.shape)
    else:
        h_lat = h_lat + gt2_l * _moe(v_l.reshape(-1, D), *moe_args).reshape(h_lat.shape)
    return h_ctx, h_lat


def setup_inputs(seed: int = 0) -> dict:
    key = jax.random.key(seed)
    ks = jax.random.split(key, 32)
    L, D, E, F = DEPTH, D_MODEL, N_EXPERTS, MOE_FF

    def nrm(k, shape, scale):
        return jax.random.normal(k, shape, jnp.float32) * scale

    return {
        "x": nrm(ks[0], (BATCH, SEQ, D), 1.0),
        "c": nrm(ks[1], (BATCH, D), 1.0),
        "ctx": nrm(ks[2], (BATCH, CTX_LEN, D), 1.0),
        "c_ctx": nrm(ks[3], (D,), 1.0),
        "w_mod": nrm(ks[4], (L, D, 6 * D), 0.5 * D ** -0.5),
        "b_mod": nrm(ks[5], (L, 6 * D), 0.02),
        "g_norm1": 1.0 + nrm(ks[6], (L, D), 0.02),
        "g_norm2": 1.0 + nrm(ks[7], (L, D), 0.02),
        "w_in": nrm(ks[8], (L, D, IN_W), D ** -0.5),
        "g_qnorm": 1.0 + nrm(ks[9], (L, HEAD_DIM), 0.02),
        "g_knorm": 1.0 + nrm(ks[10], (L, HEAD_DIM), 0.02),
        "w_conv": nrm(ks[11], (L, DN_CONV, DN_QKVW), DN_CONV ** -0.5),
        "a_log": jnp.log(jax.random.uniform(ks[12], (L, 2, DN_HEADS), jnp.float32, 1.0, 16.0)),
        "dt_bias": 1.0 + nrm(ks[13], (L, 2, DN_HEADS), 0.1),
        "g_dn_out": 1.0 + nrm(ks[14], (L, DN_DV), 0.02),
        "lam_qk": nrm(ks[15], (L, 4, DF_HD), 0.1),
        "g_subln": 1.0 + nrm(ks[16], (L, DF_VD), 0.02),
        "w_branch": nrm(ks[17], (L, 3, BR_W, D), BR_W ** -0.5),
        "w_out": nrm(ks[18], (L, D, D), D ** -0.5),
        "w_router": nrm(ks[19], (L, D, E), D ** -0.5),
        "b_router": nrm(ks[20], (L, E), 0.01),
        "w_e_gate": nrm(ks[21], (L, E, D, F), D ** -0.5),
        "w_e_up": nrm(ks[22], (L, E, D, F), D ** -0.5),
        "w_e_down": nrm(ks[23], (L, E, F, D), F ** -0.5),
        "w_s_gate": nrm(ks[24], (L, D, F), D ** -0.5),
        "w_s_up": nrm(ks[25], (L, D, F), D ** -0.5),
        "w_s_down": nrm(ks[26], (L, F, D), F ** -0.5),
        "g_final": 1.0 + nrm(ks[27], (D,), 0.02),
    }


def reference(x, c, ctx, c_ctx, w_mod, b_mod, g_norm1, g_norm2, w_in, g_qnorm, g_knorm, w_conv,
              a_log, dt_bias, g_dn_out, lam_qk, g_subln, w_branch, w_out, w_router, b_router,
              w_e_gate, w_e_up, w_e_down, w_s_gate, w_s_up, w_s_down, g_final):
    cos, sin = _axial_rope(x.shape[1], x.dtype)
    cond_lat = jax.nn.silu(c)
    cond_ctx = jax.nn.silu(c_ctx)
    h_ctx, h_lat = ctx, x
    for l in range(DEPTH):
        h_ctx, h_lat = _layer(
            h_ctx, h_lat, cond_ctx, cond_lat, cos, sin, l, l < DEPTH - 1,
            w_mod[l], b_mod[l], g_norm1[l], g_norm2[l], w_in[l], g_qnorm[l], g_knorm[l],
            w_conv[l], a_log[l], dt_bias[l], g_dn_out[l], lam_qk[l], g_subln[l],
            w_branch[l], w_out[l], w_router[l], b_router[l],
            w_e_gate[l], w_e_up[l], w_e_down[l], w_s_gate[l], w_s_up[l], w_s_down[l])
    return _rmsnorm(h_lat, g_final)
```

```cpp
#include <hip/hip_runtime.h>
#include <hip/hip_bf16.h>
#include <cstdio>
#include <cstdint>
#include <cmath>

constexpr int DM = 1024, NB = 2, SEQ = 16384, CTXL = 256, TT = SEQ + CTXL  , MROWS = NB * TT  ;
constexpr int NLAYER = 2, GRIDW = 64;
constexpr int P1W = 4608;
constexpr int GW = 3072;
constexpr int INW = 7456;
constexpr int C_AQ = 0, C_AK = 512, C_AV = 640, C_BQKV = 768, C_BZ = 2304, C_BA = 2816, C_BB = 2832, C_CQ = 2848, C_CK = 3360, C_CV = 3872, C_GATE = 4384;
constexpr int NEXP = 64, NEXP1 = 65  , TOPK = 6, FF = 256;
constexpr int HROWS = TT * 7 + NEXP1 * 255;
constexpr int HROWS_PAD = 133120;
constexpr float EPS = 1e-6f;
constexpr float QSCALE = 0.125f * 1.4426950408889634f;

constexpr size_t MiB = 1u << 20;
constexpr size_t WS_CTL = 0, CTL_ZERO_BYTES = 1 * MiB;
constexpr size_t WS_MODV = 1 * MiB;
constexpr size_t WS_HCTX = 2 * MiB;
constexpr size_t WS_TOPE = 4 * MiB;
constexpr size_t WS_TOPW = WS_TOPE + (size_t)MROWS * 32;
constexpr size_t WS_TOPS = WS_TOPW + (size_t)MROWS * 32;
constexpr size_t WS_RTOK = WS_TOPS + (size_t)MROWS * 32;
constexpr size_t WS_RW = WS_RTOK + (size_t)2 * HROWS_PAD * 4;
constexpr size_t WS_SMALL_END = WS_RW + (size_t)2 * HROWS_PAD * 4;
constexpr size_t WS_WB1 = 10 * MiB;
constexpr size_t WS_WB2 = WS_WB1 + (size_t)P1W * DM * 2;
constexpr size_t WS_WBR = WS_WB2 + (size_t)GW * DM * 2;
constexpr size_t WS_WOT = WS_WBR + (size_t)3 * DM * 512 * 2;
constexpr size_t WS_A = 30 * MiB;
constexpr size_t SZ_A = (size_t)MROWS * P1W * 2;
constexpr size_t WS_B = WS_A + SZ_A;
constexpr size_t SZ_B = (size_t)MROWS * 1536 * 2;
constexpr size_t WS_C = WS_B + SZ_B;
constexpr size_t SZ_C = (size_t)MROWS * DM * 2;
constexpr size_t WS_D = WS_C + SZ_C;
constexpr size_t SZ_D = (size_t)MROWS * 2048 * 2;
constexpr size_t WS_RING = WS_D + SZ_D;
constexpr int RING_SLOT = 40960;
constexpr size_t SZ_RING = (size_t)32 * 12 * RING_SLOT;
constexpr size_t WS_END = WS_RING + SZ_RING;
static_assert(WS_SMALL_END <= WS_WB1 && WS_WOT + (size_t)DM * DM * 2 <= WS_A, "ws map");
static_assert((size_t)MROWS * GW * 2 + (size_t)MROWS * DM * 2 <= SZ_A && (size_t)HROWS_PAD * DM * 2 <= SZ_A, "region A overlays");
static_assert((size_t)NEXP1 * 3 * DM * FF * 2 <= SZ_B && (size_t)HROWS_PAD * FF * 2 <= SZ_D, "region B/D overlays");
constexpr int CW_TMO = 0;
constexpr int CW_BAR = 4096;
constexpr int CW_QUEUE = 16384;
constexpr int CW_ECNT = 32768;

constexpr int RING_OFF = 0, RING_BYTES = 139264;
constexpr int MISC_OFF = RING_BYTES;
constexpr int LDS_BYTES = 147456;
constexpr int NWAVES = 8, NTHREADS = 512;

#define GAS __attribute__((address_space(1)))
#define LAS __attribute__((address_space(3)))
typedef unsigned short bf16_t;
typedef unsigned v4u __attribute__((ext_vector_type(4)));
typedef unsigned v2u __attribute__((ext_vector_type(2)));
typedef float f32x4 __attribute__((ext_vector_type(4)));
typedef float f32x2 __attribute__((ext_vector_type(2)));
typedef float f32x16 __attribute__((ext_vector_type(16)));
typedef short bf16x8 __attribute__((ext_vector_type(8)));
typedef short s16x4 __attribute__((ext_vector_type(4)));
typedef GAS unsigned gu32;
#define RLX_AGENT __ATOMIC_RELAXED, __HIP_MEMORY_SCOPE_AGENT
#define LDS_WAIT() asm volatile("s_waitcnt lgkmcnt(0)" ::: "memory")
#define VM_WAIT() asm volatile("s_waitcnt vmcnt(0)" ::: "memory")
__device__ __forceinline__ unsigned f2bf(float f) { unsigned u = __builtin_bit_cast(unsigned, f); return (u + 0x7fffu + ((u >> 16) & 1u)) >> 16; }
__device__ __forceinline__ unsigned pk2(float lo, float hi) { return f2bf(lo) | (f2bf(hi) << 16); }
__device__ __forceinline__ float bf2f(unsigned short b) { return __builtin_bit_cast(float, (unsigned)b << 16); }
__device__ __forceinline__ float bflo(unsigned w) { return __builtin_bit_cast(float, w << 16); }
__device__ __forceinline__ float bfhi(unsigned w) { return __builtin_bit_cast(float, w & 0xffff0000u); }
typedef __bf16 bf16x2_t_ __attribute__((ext_vector_type(2)));
__device__ __forceinline__ unsigned cvt_pk_bf16(float lo, float hi) { unsigned r; asm volatile("v_cvt_pk_bf16_f32 %0, %1, %2" : "=v"(r) : "v"(lo), "v"(hi)); return r; }
__device__ __forceinline__ unsigned cvt_pk_bf16_safe(float lo, float hi) { f32x2 v = {lo, hi}; bf16x2_t_ b = __builtin_convertvector(v, bf16x2_t_); return __builtin_bit_cast(unsigned, b); }
__device__ __forceinline__ float wave_sum(float v) {
#pragma unroll
    for (int o = 1; o < 64; o <<= 1) v += __shfl_xor(v, o);
    return v;
}
__device__ __forceinline__ float sigmoidf_(float x) { return 1.f / (1.f + __expf(-x)); }
__device__ __forceinline__ float siluf_(float x) { return x / (1.f + __expf(-x)); }
__device__ __forceinline__ int hw_lane() { int l; asm volatile("v_mbcnt_lo_u32_b32 %0, -1, 0\n\tv_mbcnt_hi_u32_b32 %0, -1, %0" : "=v"(l)); return l; }
#define XB_TMO      128
#define XB_XCNT(j)  (256  + 64 * (j))
#define XB_XSUB(j)  (1280 + 64 * (j))
#define XB_XGEN(j)  (2304 + 64 * (j))
#define XB_TOP      3328
#define XB_TOPGEN   3392
#define XCD_BAR_WORDS 3456
#define XB_SPIN_CAP (1u << 18)

__device__ __forceinline__ unsigned xb_ld(unsigned* p)              { return __hip_atomic_load(p, __ATOMIC_RELAXED, __HIP_MEMORY_SCOPE_AGENT); }
__device__ __forceinline__ unsigned xb_add(unsigned* p, unsigned v) { return __hip_atomic_fetch_add(p, v, __ATOMIC_RELAXED, __HIP_MEMORY_SCOPE_AGENT); }
__device__ __forceinline__ unsigned xb_xcc_id() { return (unsigned)__builtin_amdgcn_s_getreg((3 << 11) | 20) & 0xFu; }
#define XB_SPIN(cond, bar) do { unsigned _sp = 0; while (cond) { __builtin_amdgcn_s_sleep(1); \
    if ((++_sp & 255u) == 0u) { if (xb_ld(&(bar)[XB_TMO])) break; if (_sp > XB_SPIN_CAP) { atomicAdd(&(bar)[XB_TMO], 1u); break; } } } } while (0)

struct XcdBarrier {
    unsigned* bar; unsigned x;
    volatile LAS unsigned* st;
};

__device__ __forceinline__ XcdBarrier xcd_barrier_post(unsigned* bar, volatile LAS unsigned* st, bool is_t0) {
    XcdBarrier b; b.bar = bar; b.x = xb_xcc_id(); b.st = st;
    if (is_t0) (void)xb_add(&bar[XB_XCNT(b.x)], 1u);
    return b;
}
__device__ __forceinline__ void xcd_barrier_complete(unsigned* bar, unsigned x, unsigned& nloc, unsigned& nx) {
    const unsigned G = gridDim.x * gridDim.y * gridDim.z;
    unsigned sum, cnt, mine, sp = 0u;
    for (;;) {
        sum = 0u; cnt = 0u; mine = 0u;
#pragma unroll
        for (unsigned j = 0; j < 16; ++j) { const unsigned c = xb_ld(&bar[XB_XCNT(j)]); sum += c; cnt += (c > 0u) ? 1u : 0u; mine = (j == x) ? c : mine; }
        if (sum == G) break;
        __builtin_amdgcn_s_sleep(1);
        if ((++sp & 255u) == 0u) { if (xb_ld(&bar[XB_TMO])) break; if (sp > XB_SPIN_CAP) { atomicAdd(&bar[XB_TMO], 1u); break; } }
    }
    nloc = mine > 0u ? mine : 1u; nx = cnt > 0u ? cnt : 1u;
}

__device__ __forceinline__ void xcd_barrier(const XcdBarrier& b, bool is_t0) {
    asm volatile("s_waitcnt vmcnt(0)" ::: "memory");
    __syncthreads();
    if (is_t0) {
        unsigned* bar = b.bar;
        __builtin_amdgcn_s_waitcnt(0);
        unsigned nloc = b.st[0], nx = b.st[1];
        if (nloc == 0u) { xcd_barrier_complete(bar, b.x, nloc, nx); b.st[0] = nloc; b.st[1] = nx; }
        const unsigned old = xb_add(&bar[XB_XSUB(b.x)], 1u);
        const unsigned gen = old / nloc;
        if (old + 1u == (gen + 1u) * nloc) {
            __builtin_amdgcn_fence(__ATOMIC_RELEASE, "agent");
            asm volatile("s_waitcnt vmcnt(0)" ::: "memory");
            const unsigned og = xb_add(&bar[XB_TOP], 1u);
            const unsigned tg = og / nx;
            if (og + 1u == (tg + 1u) * nx) xb_add(&bar[XB_TOPGEN], 1u);
            else XB_SPIN(xb_ld(&bar[XB_TOPGEN]) == tg, bar);
            __builtin_amdgcn_fence(__ATOMIC_ACQUIRE, "agent");
            xb_add(&bar[XB_XGEN(b.x)], 1u);
            asm volatile("s_waitcnt vmcnt(0)" ::: "memory");
        } else {
            XB_SPIN(xb_ld(&bar[XB_XGEN(b.x)]) == gen, bar);
            __builtin_amdgcn_fence(__ATOMIC_ACQUIRE, "agent");
            asm volatile("s_waitcnt vmcnt(0)" ::: "memory");
        }
    }
    __syncthreads();
}
namespace pg8 {
constexpr int BM = 256, BK = 64, HALF = 128, HTB = HALF * BK * 2  , STAGE_BYTES = 8 * HTB, NXCD = 8, WGM = 8;
__host__ __device__ __forceinline__ int lds_byte(int r, int c) { const int st = (r >> 4) * 2 + (c >> 5), rr = r & 15, cc = c & 31, ob = rr * 64 + cc * 2; return st * 1024 + (ob ^ (((ob >> 9) & 1) << 5)); }
__host__ __device__ __forceinline__ void stage_rc(int b, int& R, int& C) { const int st = b / 1024, sb = b % 1024, swz = sb ^ (((sb >> 9) & 1) << 5); R = (st >> 1) * 16 + swz / 64; C = (st & 1) * 32 + (swz % 64) / 2; }
__host__ __device__ __forceinline__ int perm32(int rho) { const int n = rho >> 4, i = rho & 15; return 8 * (i >> 2) + 4 * n + (i & 3); }

struct Unit { int pm, pn, em, en, ex; };
struct Gemm { const bf16_t* A; const bf16_t* Bt; int lda, ldb, K; const int* rowlist; };

struct DenseOrder {
    int nM, nN, nwg, G, c;
    __device__ void init(int nM_, int nN_, int G_, int c_) { nM = nM_; nN = nN_; nwg = nM * nN; G = G_; c = c_; }
    __device__ bool next(int i, Unit& u) const {
        const int L = i * G + c; if (L >= nwg) return false;
        int wgid = L; { const int q = nwg / NXCD, r = nwg % NXCD, xcd = wgid % NXCD, off = wgid / NXCD; wgid = (xcd < r ? xcd * (q + 1) : r * (q + 1) + (xcd - r) * q) + off; }
        const int nig = WGM * nN, gid = wgid / nig, fm = gid * WGM, gsz = (nM - fm) < WGM ? (nM - fm) : WGM;
        u.pm = fm + ((wgid % nig) % gsz); u.pn = (wgid % nig) / gsz; u.em = u.pm; u.en = u.pn; u.ex = 0; return true;
    }
};
struct MoeOrder {
    const LAS int* tstart; const LAS int* texp; int nN, G, c;
    __device__ bool next(int i, Unit& u) const {
        const int L = i * G + c; const int total = tstart[NEXP1];
        if (L >= total * nN) return false;
        const int rt = L / nN, pn = L - rt * nN;
        const int e = texp[rt];
        u.pm = rt; u.pn = e * nN + pn; u.em = rt; u.en = pn; u.ex = e; return true;
    }
};

template <int ACT  > struct EpiBf16 {
    static constexpr bool PERM = true;
    bf16_t* O; int ldc;
    __device__ __forceinline__ void operator()(const f32x4 (&acc)[2][2][4][2], const Unit& u, int wr, int wc, int fr, int fq) const {
        const int row0 = u.em * BM + wr * 64 + fr; const int col0 = u.en * BM + wc * 32 + 8 * fq;
#pragma unroll
        for (int ai = 0; ai < 2; ++ai)
#pragma unroll
            for (int m = 0; m < 4; ++m) { bf16_t* rowp = O + (size_t)(row0 + ai * HALF + m * 16) * ldc + col0;
#pragma unroll
                for (int bj = 0; bj < 2; ++bj) { f32x4 v0 = acc[ai][bj][m][0], v1 = acc[ai][bj][m][1];
                    if (ACT == 1) {
#pragma unroll
                        for (int j = 0; j < 4; ++j) { v0[j] = sigmoidf_(v0[j]); v1[j] = sigmoidf_(v1[j]); } }
                    v4u w; w.x = cvt_pk_bf16(v0[0], v0[1]); w.y = cvt_pk_bf16(v0[2], v0[3]); w.z = cvt_pk_bf16(v1[0], v1[1]); w.w = cvt_pk_bf16(v1[2], v1[3]);
                    *(v4u*)(rowp + bj * HALF) = w; } }
    }
};
struct EpiMerge {
    static constexpr bool PERM = true;
    bf16_t* Mo; const bf16_t* G; int goff; int first;
    __device__ __forceinline__ void operator()(const f32x4 (&acc)[2][2][4][2], const Unit& u, int wr, int wc, int fr, int fq) const {
        const int row0 = u.em * BM + wr * 64 + fr; const int col0 = u.en * BM + wc * 32 + 8 * fq;
#pragma unroll
        for (int ai = 0; ai < 2; ++ai)
#pragma unroll
            for (int m = 0; m < 4; ++m) { const size_t r = (size_t)(row0 + ai * HALF + m * 16);
#pragma unroll
                for (int bj = 0; bj < 2; ++bj) { const f32x4 v0 = acc[ai][bj][m][0], v1 = acc[ai][bj][m][1];
                    const v4u gw = *(const v4u*)(G + r * GW + goff + col0 + bj * HALF);
                    bf16_t* mp = Mo + r * DM + col0 + bj * HALF;
                    float o[8];
                    o[0] = bflo(gw.x) * v0[0]; o[1] = bfhi(gw.x) * v0[1]; o[2] = bflo(gw.y) * v0[2]; o[3] = bfhi(gw.y) * v0[3];
                    o[4] = bflo(gw.z) * v1[0]; o[5] = bfhi(gw.z) * v1[1]; o[6] = bflo(gw.w) * v1[2]; o[7] = bfhi(gw.w) * v1[3];
                    if (!first) { const v4u pw = *(const v4u*)mp;
                        o[0] += bflo(pw.x); o[1] += bfhi(pw.x); o[2] += bflo(pw.y); o[3] += bfhi(pw.y); o[4] += bflo(pw.z); o[5] += bfhi(pw.z); o[6] += bflo(pw.w); o[7] += bfhi(pw.w); }
                    v4u w; w.x = cvt_pk_bf16(o[0], o[1]); w.y = cvt_pk_bf16(o[2], o[3]); w.z = cvt_pk_bf16(o[4], o[5]); w.w = cvt_pk_bf16(o[6], o[7]);
                    *(v4u*)mp = w; } }
    }
};
struct EpiResid {
    static constexpr bool PERM = false;
    const float* in_lat; const float* in_ctx; float* out_lat; float* out_ctx; const float* modv; int gsel;
    __device__ __forceinline__ void operator()(const f32x4 (&acc)[2][2][4][2], const Unit& u, int wr, int wc, int fr, int fq) const {
        const int b = u.em / 65, j = u.em % 65; const bool isctx = (j == 0);
        const float* ib = isctx ? in_ctx + (size_t)b * CTXL * DM : in_lat + ((size_t)b * SEQ + (size_t)(j - 1) * 256) * DM;
        float* ob = isctx ? out_ctx + (size_t)b * CTXL * DM : out_lat + ((size_t)b * SEQ + (size_t)(j - 1) * 256) * DM;
        const float* gt = modv + (isctx ? 2 : b) * 6144 + gsel * DM;
        const int col0 = u.en * BM + wc * 32 + 4 * fq;
        f32x4 gv[2][2];
#pragma unroll
        for (int bj = 0; bj < 2; ++bj)
#pragma unroll
            for (int n = 0; n < 2; ++n) gv[bj][n] = *(const f32x4*)(gt + col0 + bj * HALF + n * 16);
#pragma unroll
        for (int ai = 0; ai < 2; ++ai)
#pragma unroll
            for (int m = 0; m < 4; ++m) { const size_t off = (size_t)(ai * HALF + wr * 64 + m * 16 + fr) * DM + col0;
#pragma unroll
                for (int bj = 0; bj < 2; ++bj)
#pragma unroll
                    for (int n = 0; n < 2; ++n) { const f32x4 bs = *(const f32x4*)(ib + off + bj * HALF + n * 16);
                        *(f32x4*)(ob + off + bj * HALF + n * 16) = bs + gv[bj][n] * acc[ai][bj][m][n]; } }
    }
};
struct EpiMoe1 {
    static constexpr bool PERM = true;
    bf16_t* Hs; const float* roww;
    __device__ __forceinline__ void operator()(const f32x4 (&acc)[2][2][4][2], const Unit& u, int wr, int wc, int fr, int fq) const {
        const int row0 = u.em * BM + wr * 64 + fr; const int col0 = u.en * HALF + wc * 32 + 8 * fq;
#pragma unroll
        for (int ai = 0; ai < 2; ++ai)
#pragma unroll
            for (int m = 0; m < 4; ++m) { const int r = row0 + ai * HALF + m * 16; const float w = roww[r];
                float o[8];
#pragma unroll
                for (int n = 0; n < 2; ++n)
#pragma unroll
                    for (int j = 0; j < 4; ++j) { const float g = acc[ai][0][m][n][j], up = acc[ai][1][m][n][j]; o[n * 4 + j] = siluf_(g) * up * w; }
                v4u pw; pw.x = cvt_pk_bf16(o[0], o[1]); pw.y = cvt_pk_bf16(o[2], o[3]); pw.z = cvt_pk_bf16(o[4], o[5]); pw.w = cvt_pk_bf16(o[6], o[7]);
                *(v4u*)(Hs + (size_t)r * FF + col0) = pw; }
    }
};

template <class Epi, class Sched, bool GATHER>
__device__ __forceinline__ void gemm_phase(LAS unsigned char* lds, const Gemm g, const Sched& S, const Epi& E, int wave) {
    const int lane = hw_lane(), wid = wave, tid = wave * 64 + lane;
    const int wr = wid >> 2, wc = wid & 3, fr = lane & 15, fq = lane >> 4;
    const int K = g.K, nt = K / BK;
    int Rr[2], Cc[2];
    unsigned voffB[2], voffA[2];
#pragma unroll
    for (int i = 0; i < 2; ++i) { int R, C; stage_rc(tid * 16 + i * 8192, R, C); const int Rb = Epi::PERM ? ((R & ~31) + perm32(R & 31)) : R; Rr[i] = R; Cc[i] = C;
        voffB[i] = (unsigned)(Rb * g.ldb + C) * 2u; voffA[i] = (unsigned)(R * g.lda + C) * 2u; }
    const size_t kstep = (size_t)(BK * 2);
    const size_t hstepB = (size_t)HALF * g.ldb * 2, hstepA = (size_t)HALF * g.lda * 2;
    const size_t tstepA = (size_t)BM * g.lda * 2, tstepB = (size_t)BM * g.ldb * 2;
    const unsigned ldsw = (unsigned)wid * 1024u;
    const int aoff = lds_byte(wr * 64 + fr, fq * 8), boff = lds_byte(wc * 32 + fr, fq * 8);
#define PG8_SA(b, h) (((b) * 2 + (h)) * HTB)
#define PG8_SB(b, h) ((4 + (b) * 2 + (h)) * HTB)
#define PG8_STAGE(bufoff, gbase, voff) do { _Pragma("unroll") for (int _i = 0; _i < 2; ++_i) \
        __builtin_amdgcn_global_load_lds((const unsigned*)((const char*)(gbase) + (voff)[_i]), (LAS unsigned*)(lds + (bufoff) + ldsw + _i * 8192), 16, 0, 0); } while (0)
#define PG8_LDA(dst, b, h) do { _Pragma("unroll") for (int m = 0; m < 4; ++m) _Pragma("unroll") for (int k = 0; k < 2; ++k) dst[m][k] = *(const LAS bf16x8*)(lds + PG8_SA(b, h) + aoff + m * 2048 + k * 1024); } while (0)
#define PG8_LDB(dst, b, h) do { _Pragma("unroll") for (int n = 0; n < 2; ++n) _Pragma("unroll") for (int k = 0; k < 2; ++k) dst[n][k] = *(const LAS bf16x8*)(lds + PG8_SB(b, h) + boff + n * 2048 + k * 1024); } while (0)
#define PG8_MMA(ai, bj, At, Bt) do { __builtin_amdgcn_s_setprio(1); _Pragma("unroll") for (int m = 0; m < 4; ++m) _Pragma("unroll") for (int n = 0; n < 2; ++n) _Pragma("unroll") for (int k = 0; k < 2; ++k) \
        acc[ai][bj][m][n] = __builtin_amdgcn_mfma_f32_16x16x32_bf16(Bt[n][k], At[m][k], acc[ai][bj][m][n], 0, 0, 0); __builtin_amdgcn_s_setprio(0); } while (0)
#define PG8_WAIT_V(n) asm volatile("s_waitcnt vmcnt(" #n ")" ::: "memory")
#define PG8_WAIT_L(n) asm volatile("s_waitcnt lgkmcnt(" #n ")" ::: "memory")
#define PG8_BAR __builtin_amdgcn_s_barrier()
#define PG8_SCHED __builtin_amdgcn_sched_barrier(0)
#define PG8_AOFFS(dst, unit) do { if constexpr (GATHER) { _Pragma("unroll") for (int _h = 0; _h < 2; ++_h) _Pragma("unroll") for (int _i = 0; _i < 2; ++_i) { \
        const int _row = g.rowlist[(size_t)(unit).pm * BM + _h * HALF + Rr[_i]]; dst[_h][_i] = (unsigned)((size_t)_row * g.lda + Cc[_i]) * 2u; } \
        asm volatile("s_waitcnt vmcnt(0)" ::: "memory"); } } while (0)
#define PG8_STAGE_A(bufoff, base, h, vset) do { if constexpr (GATHER) { PG8_STAGE(bufoff, base, vset[h]); } else { PG8_STAGE(bufoff, (base) + (h) * hstepA, voffA); } } while (0)
    Unit cur, nxt; int ui = 0;
    if (!S.next(0, cur)) return;
    f32x4 acc[2][2][4][2];
#pragma unroll
    for (int a = 0; a < 2; ++a)
#pragma unroll
        for (int b = 0; b < 2; ++b)
#pragma unroll
            for (int m = 0; m < 4; ++m)
#pragma unroll
                for (int n = 0; n < 2; ++n) acc[a][b][m][n] = (f32x4){0.f, 0.f, 0.f, 0.f};
    bf16x8 At[4][2], B0[2][2], B1[2][2];
    unsigned vc[2][2], vn[2][2];
    PG8_AOFFS(vc, cur);
    const char* cA = GATHER ? (const char*)g.A : (const char*)g.A + (size_t)cur.pm * tstepA; const char* cB = (const char*)g.Bt + (size_t)cur.pn * tstepB;
    PG8_STAGE(PG8_SB(0, 0), cB, voffB); PG8_STAGE(PG8_SB(0, 1), cB + hstepB, voffB); PG8_STAGE_A(PG8_SA(0, 0), cA, 0, vc); PG8_STAGE_A(PG8_SA(0, 1), cA, 1, vc);
    if (wr == 1) PG8_BAR;
    PG8_WAIT_V(2); PG8_BAR;
    PG8_STAGE(PG8_SB(1, 0), cB + kstep, voffB); PG8_STAGE_A(PG8_SA(1, 0), cA + kstep, 0, vc); PG8_STAGE(PG8_SB(1, 1), cB + hstepB + kstep, voffB);
    PG8_WAIT_V(6); PG8_BAR;
    for (;;) {
        const bool has_next = S.next(ui + 1, nxt);
        if constexpr (GATHER) { if (has_next) { PG8_AOFFS(vn, nxt); } else { vn[0][0] = vc[0][0]; vn[0][1] = vc[0][1]; vn[1][0] = vc[1][0]; vn[1][1] = vc[1][1]; } }
        const char* nA = has_next ? (GATHER ? (const char*)g.A : (const char*)g.A + (size_t)nxt.pm * tstepA) : cA; const char* nB = has_next ? (const char*)g.Bt + (size_t)nxt.pn * tstepB : cB;
        for (int t = 0; t < nt; t += 2) {
            const bool last = (t == nt - 2);
            const char* a1 = cA + (size_t)(t + 1) * kstep;
            const char* a2 = last ? nA : cA + (size_t)(t + 2) * kstep; const char* b2 = last ? nB : cB + (size_t)(t + 2) * kstep;
            const char* a3 = a2 + kstep; const char* b3 = b2 + kstep;
            unsigned v2[2][2];
            if constexpr (GATHER) { v2[0][0] = last ? vn[0][0] : vc[0][0]; v2[0][1] = last ? vn[0][1] : vc[0][1]; v2[1][0] = last ? vn[1][0] : vc[1][0]; v2[1][1] = last ? vn[1][1] : vc[1][1]; }
            PG8_LDB(B0, 0, 0); PG8_LDB(B1, 0, 1); PG8_SCHED; PG8_LDA(At, 0, 0); PG8_STAGE_A(PG8_SA(1, 1), a1, 1, vc);
            PG8_WAIT_V(8); PG8_WAIT_L(0); PG8_BAR; PG8_MMA(0, 0, At, B0); PG8_MMA(0, 1, At, B1); PG8_BAR; PG8_SCHED;
            PG8_LDA(At, 0, 1); PG8_STAGE(PG8_SB(0, 0), b2, voffB); PG8_STAGE(PG8_SB(0, 1), b2 + hstepB, voffB); PG8_STAGE_A(PG8_SA(0, 0), a2, 0, v2);
            PG8_WAIT_V(8); PG8_WAIT_L(0); PG8_BAR; PG8_MMA(1, 0, At, B0); PG8_MMA(1, 1, At, B1); PG8_BAR; PG8_SCHED;
            PG8_LDB(B0, 1, 0); PG8_LDB(B1, 1, 1); PG8_SCHED; PG8_LDA(At, 1, 0); PG8_STAGE_A(PG8_SA(0, 1), a2, 1, v2);
            PG8_WAIT_V(8); PG8_WAIT_L(0); PG8_BAR; PG8_MMA(0, 0, At, B0); PG8_MMA(0, 1, At, B1); PG8_BAR; PG8_SCHED;
            PG8_LDA(At, 1, 1); PG8_STAGE(PG8_SB(1, 0), b3, voffB); PG8_STAGE(PG8_SB(1, 1), b3 + hstepB, voffB); PG8_STAGE_A(PG8_SA(1, 0), a3, 0, v2);
            PG8_WAIT_V(8); PG8_WAIT_L(0); PG8_BAR; PG8_MMA(1, 0, At, B0); PG8_MMA(1, 1, At, B1); PG8_BAR; PG8_SCHED;
        }
        if (wr == 0) PG8_BAR;
        { const int l2 = hw_lane(); E(acc, cur, wr, wc, l2 & 15, l2 >> 4); }
        if (!has_next) break;
#pragma unroll
        for (int a = 0; a < 2; ++a)
#pragma unroll
            for (int b = 0; b < 2; ++b)
#pragma unroll
                for (int m = 0; m < 4; ++m)
#pragma unroll
                    for (int n = 0; n < 2; ++n) acc[a][b][m][n] = (f32x4){0.f, 0.f, 0.f, 0.f};
        cur = nxt; cA = nA; cB = nB; ++ui;
        if constexpr (GATHER) { vc[0][0] = vn[0][0]; vc[0][1] = vn[0][1]; vc[1][0] = vn[1][0]; vc[1][1] = vn[1][1]; }
        if (wr == 1) PG8_BAR;
    }
    PG8_WAIT_V(0);
    PG8_BAR;
#undef PG8_SA
#undef PG8_SB
#undef PG8_STAGE
#undef PG8_LDA
#undef PG8_LDB
#undef PG8_MMA
#undef PG8_WAIT_V
#undef PG8_WAIT_L
#undef PG8_BAR
#undef PG8_SCHED
#undef PG8_AOFFS
#undef PG8_STAGE_A
}
}
namespace attn_body {
using bf16=__hip_bfloat16;
using bf16x8=__attribute__((ext_vector_type(8)))short;
using s16x4=__attribute__((ext_vector_type(4)))short;
using f32x16=__attribute__((ext_vector_type(16)))float;
using u32x4=__attribute__((ext_vector_type(4)))unsigned;
constexpr int D=64;
constexpr int NW=8,QBLK=32,QB=QBLK*NW,KVBLK=64;
constexpr int ATTN_UNIT_ROWS=QB;
__device__ __forceinline__ int crow(int r,int hi){return (r&3)+8*(r>>2)+4*hi;}
#define SBAR() __builtin_amdgcn_sched_barrier(0)
constexpr int NSLOT=3, SLOTB=8192;
constexpr int LDS_K=0, LDS_V=NSLOT*SLOTB, LDS_WS=2*NSLOT*SLOTB, LDS_OST=LDS_WS+NW*64*4, LDS_BYTES=LDS_OST+NW*4096;
constexpr float C2=0.125f*1.4426950408889634f;
__device__ __forceinline__ void glds16(const void*gsrc,unsigned lds_dst){unsigned keep;
  asm volatile("s_mov_b32 %0, m0\n\ts_mov_b32 m0, %2\n\ts_nop 0\n\tglobal_load_lds_dwordx4 %1, off\n\ts_mov_b32 m0, %0":"=&s"(keep):"v"(gsrc),"s"(lds_dst):"memory");}
__device__ __forceinline__ float max3f(float a,float b,float c){float r;asm("v_max3_f32 %0, %1, %2, %3":"=v"(r):"v"(a),"v"(b),"v"(c));return r;}
__device__ __forceinline__ float max2f(float a,float b){float r;asm("v_max_f32_e32 %0, %1, %2":"=v"(r):"v"(a),"v"(b));return r;}
__device__ __forceinline__ float fadd_s(float a,float b){float r;asm("v_add_f32_e32 %0, %1, %2":"=v"(r):"v"(a),"v"(b));return r;}
__device__ __forceinline__ float fsub_s(float a,float b){float r;asm("v_sub_f32_e32 %0, %1, %2":"=v"(r):"v"(a),"v"(b));return r;}
typedef float f32x2_t __attribute__((ext_vector_type(2))); typedef __bf16 bf16x2_t __attribute__((ext_vector_type(2)));
__device__ __forceinline__ unsigned cvtpk_s(float lo,float hi){f32x2_t v={lo,hi};bf16x2_t b=__builtin_convertvector(v,bf16x2_t);return __builtin_bit_cast(unsigned,b);}
#define WAIT_BAR(N) asm volatile("s_waitcnt vmcnt(" #N ") lgkmcnt(0)\n\ts_barrier":::"memory")

__device__ __forceinline__ void qkt(f32x16&p0,f32x16&p1,const char*Kslot,const bf16x8*qr,const f32x16&negm,int r32,int hi){
  const char*kb=Kslot+hi*1024+r32*16;
  #pragma unroll
  for(int d0=0;d0<4;++d0){
    const bf16x8 b0=*reinterpret_cast<const bf16x8*>(kb+d0*2048);
    const bf16x8 b1=*reinterpret_cast<const bf16x8*>(kb+d0*2048+512);
    if(d0==0){p0=__builtin_amdgcn_mfma_f32_32x32x16_bf16(b0,qr[0],negm,0,0,0);p1=__builtin_amdgcn_mfma_f32_32x32x16_bf16(b1,qr[0],negm,0,0,0);}
    else{p0=__builtin_amdgcn_mfma_f32_32x32x16_bf16(b0,qr[d0],p0,0,0,0);p1=__builtin_amdgcn_mfma_f32_32x32x16_bf16(b1,qr[d0],p1,0,0,0);}}
}
typedef __attribute__((address_space(3))) const char* lds_cptr;
typedef short v4i16_t __attribute__((ext_vector_type(4)));
__device__ __forceinline__ void kload8(bf16x8*kf,lds_cptr kp){
  kf[0]=*(const __attribute__((address_space(3))) bf16x8*)(kp);      kf[1]=*(const __attribute__((address_space(3))) bf16x8*)(kp+512);
  kf[2]=*(const __attribute__((address_space(3))) bf16x8*)(kp+2048); kf[3]=*(const __attribute__((address_space(3))) bf16x8*)(kp+2560);
  kf[4]=*(const __attribute__((address_space(3))) bf16x8*)(kp+4096); kf[5]=*(const __attribute__((address_space(3))) bf16x8*)(kp+4608);
  kf[6]=*(const __attribute__((address_space(3))) bf16x8*)(kp+6144); kf[7]=*(const __attribute__((address_space(3))) bf16x8*)(kp+6656);
}
__device__ __forceinline__ void kload2(bf16x8*kf,lds_cptr kp,int j){ kf[2*j]=*(const __attribute__((address_space(3))) bf16x8*)(kp+j*2048); kf[2*j+1]=*(const __attribute__((address_space(3))) bf16x8*)(kp+j*2048+512); }
__device__ __forceinline__ s16x4 vtr(lds_cptr p){ return __builtin_bit_cast(s16x4,__builtin_amdgcn_ds_read_tr16_b64_v4i16((__attribute__((address_space(3))) v4i16_t*)p)); }
__device__ __forceinline__ float rowmax(const f32x16&p0,const f32x16&p1){
  float a=max3f(p0[0],p0[1],p1[0]),b=max3f(p0[2],p0[3],p1[1]);a=max3f(a,p1[2],p1[3]);
  #pragma unroll
  for(int r=4;r<16;r+=4){a=max3f(a,p0[r],p0[r+1]);b=max3f(b,p0[r+2],p0[r+3]);a=max3f(a,p1[r],p1[r+1]);b=max3f(b,p1[r+2],p1[r+3]);}
  const float m=max2f(a,b);
  auto rr=__builtin_amdgcn_permlane32_swap(__float_as_uint(m),__float_as_uint(m),false,false);
  return max2f(__uint_as_float(rr[0]),__uint_as_float(rr[1]));
}
__device__ __forceinline__ void pv(f32x16*o,int vb,bf16x8 pa0,bf16x8 pa1,bf16x8 pa2,bf16x8 pa3){
  #pragma unroll
  for(int d0=0;d0<2;++d0){s16x4 lo[4],hi[4];
    #pragma unroll
    for(int ks=0;ks<4;++ks){
      asm volatile("ds_read_b64_tr_b16 %0,%1 offset:%c2":"=&v"(lo[ks]):"v"(vb),"i"(d0*4096+ks*1024):"memory");
      asm volatile("ds_read_b64_tr_b16 %0,%1 offset:%c2":"=&v"(hi[ks]):"v"(vb),"i"(d0*4096+ks*1024+512):"memory");}
    asm volatile("s_waitcnt lgkmcnt(0)":::"memory");SBAR();
    #define PK(k) (bf16x8){lo[k][0],lo[k][1],lo[k][2],lo[k][3],hi[k][0],hi[k][1],hi[k][2],hi[k][3]}
    o[d0]=__builtin_amdgcn_mfma_f32_32x32x16_bf16(pa0,PK(0),o[d0],0,0,0);
    o[d0]=__builtin_amdgcn_mfma_f32_32x32x16_bf16(pa1,PK(1),o[d0],0,0,0);
    o[d0]=__builtin_amdgcn_mfma_f32_32x32x16_bf16(pa2,PK(2),o[d0],0,0,0);
    o[d0]=__builtin_amdgcn_mfma_f32_32x32x16_bf16(pa3,PK(3),o[d0],0,0,0);
    #undef PK
  }
}

#ifndef ATTN_STORE16
#define ATTN_STORE16(p,v) (*(u32x4*)(p)=(v))
#endif
template<int THRL> __device__ __forceinline__ void attn_unit(const bf16*Qb,int QP,const bf16*__restrict__ Kh,int KP,const bf16*__restrict__ Vh,int VP,bf16*Ob,int OP,int NT,char*shm,int wave){
  const int lane=hw_lane(),r32=lane&31,hi=lane>>5; const int wid=wave;
  const bf16*Qw=Qb+(long)(wid*QBLK)*QP;
  const unsigned lds0=(unsigned)(uintptr_t)shm;
  float*wsf=(float*)(shm+LDS_WS)+wid*64;
  const bf16*ksrc=Kh+(long)lane*KP+wid*8;
  const bf16*vsrc=Vh+(long)(16*(wid&3)+(lane>>2))*VP+(wid>>2)*32+(lane&3)*8;
  const unsigned kdst=lds0+LDS_K+wid*1024, vdst=lds0+LDS_V+wid*1024;
  #define DMA_K(t,slot) glds16(ksrc+(long)(t)*KVBLK*KP,(unsigned)__builtin_amdgcn_readfirstlane(kdst+(slot)))
  #define DMA_V(t,slot) glds16(vsrc+(long)(t)*KVBLK*VP,(unsigned)__builtin_amdgcn_readfirstlane(vdst+(slot)))
  const int vb0=(int)(lds0+LDS_V)+((lane>>4)&1)*32+(lane&3)*8+(4*hi+((lane&15)>>2))*64;
  const char*Kbase=shm+LDS_K; bf16x8 kf[8];
  const lds_cptr shm3=(lds_cptr)shm; const lds_cptr kp0=shm3+LDS_K+hi*1024+r32*16; const lds_cptr vp0=shm3+LDS_V+((lane>>4)&1)*32+(lane&3)*8+(4*hi+((lane&15)>>2))*64;
  DMA_K(0,0);DMA_V(0,0);DMA_K(1,SLOTB);
  bf16x8 qr[4];
  #pragma unroll
  for(int d0=0;d0<4;++d0)qr[d0]=*reinterpret_cast<const bf16x8*>(&Qw[(long)r32*QP+d0*16+hi*8]);
  float mhat=0.f,l_reg=0.f;f32x16 o[2];o[0]=f32x16{};o[1]=f32x16{};f32x16 negm=f32x16{};asm volatile("":"+v"(negm));
  #define CMASK(P0,P1,t) do{}while(0)
  bool resc=false;
  #define START(P0,P1) do{ const float rm=rowmax(P0,P1); resc=false; \
    { const float dl=rm; mhat=fadd_s(mhat,dl); \
      _Pragma("unroll") for(int r=0;r<16;++r){P0[r]=fsub_s(P0[r],dl);P1[r]=fsub_s(P1[r],dl);} \
      _Pragma("unroll") for(int r=0;r<16;++r)negm[r]=-mhat; asm volatile("":"+v"(negm)); } \
    _Pragma("unroll") for(int r=0;r<16;++r)P0[r]=__builtin_amdgcn_exp2f(P0[r]); }while(0)
  #define RESC() do{ if(resc){ asm volatile("s_waitcnt lgkmcnt(0)":::"memory"); \
      _Pragma("unroll") for(int d_=0;d_<2;++d_) _Pragma("unroll") for(int r=0;r<16;++r)o[d_][r]*=wsf[crow(r,hi)]; } }while(0)
  f32x16 pA0,pA1,pB0,pB1;
  int sl_prev=0,sl_cur=0,sl_next=SLOTB;
  #define ROT() do{sl_prev=sl_cur;sl_cur=sl_next;sl_next=(sl_next==(NSLOT-1)*SLOTB)?0:sl_next+SLOTB;}while(0)
  DMA_K(2,2*SLOTB);
  WAIT_BAR(3);
  qkt(pA0,pA1,Kbase,qr,negm,r32,hi);asm volatile("s_nop 15\n\ts_nop 7":"+v"(pA0),"+v"(pA1));CMASK(pA0,pA1,0);
  START(pA0,pA1);
  _Pragma("unroll") for(int r=0;r<16;++r)pA1[r]=__builtin_amdgcn_exp2f(pA1[r]);
  WAIT_BAR(0);
  DMA_K(3,0);DMA_V(1,SLOTB);
  ROT();
  kload8(kf,kp0+sl_cur);
  WAIT_BAR(2);
  s16x4 vlo[8],vhi[8]; u32x4 pw0,pw1,pw2,pw3;
  #define PKW(P,B) cvtpk_s(P[B],P[B+1])
  #define PAF(k) __builtin_bit_cast(bf16x8,pw##k)
  #define VFR(i) (bf16x8){vlo[i][0],vlo[i][1],vlo[i][2],vlo[i][3],vhi[i][0],vhi[i][1],vhi[i][2],vhi[i][3]}
  #define PIN(x) asm volatile("":"+v"(x))
  #define MX3(a,b,c) __builtin_fmaxf(__builtin_fmaxf((a),(b)),(c))
  #define GAPA(MF,A0,A1,A2,A3,W0,W1,PW) do{ MF; sacc+=A0; sacc+=A1; sacc+=A2; sacc+=A3; PIN(sacc); W0; W1; PIN(PW); SBAR(); }while(0)
  #define EX(v) __builtin_amdgcn_exp2f(v)
  #define GAPB(MF,X,B) do{ MF; X[B]=EX(X[B]); X[B+1]=EX(X[B+1]); X[B+2]=EX(X[B+2]); X[B+3]=EX(X[B+3]); PIN(X); SBAR(); }while(0)
  #define VRD(i) do{ vlo[i]=vtr(vp_+(((i)>>2)*4096+((i)&3)*1024)); vhi[i]=vtr(vp_+(((i)>>2)*4096+((i)&3)*1024+512)); }while(0)
  #define KRD(G,j) do{ if(G){ kload2(kf,kp0+sl_next,j); SBAR(); } }while(0)
  #define STEP(C0,C1,P0,P1,t,GK,GV,GL) do{ SBAR(); \
    const lds_cptr vp_=vp0+sl_prev; \
    VRD(0); SBAR(); float sacc=(P0[0]+P0[1]); \
    GAPA(C0=__builtin_amdgcn_mfma_f32_32x32x16_bf16(kf[0],qr[0],negm,0,0,0), P0[2],P0[3],P0[4],P0[5],     pw0[0]=PKW(P0,0), pw0[1]=PKW(P0,2), pw0); \
    VRD(4); SBAR(); GAPA(C1=__builtin_amdgcn_mfma_f32_32x32x16_bf16(kf[1],qr[0],negm,0,0,0), P0[6],P0[7],P0[8],P0[9],     pw0[2]=PKW(P0,4), pw0[3]=PKW(P0,6), pw0); \
    VRD(1); SBAR(); GAPA(C0=__builtin_amdgcn_mfma_f32_32x32x16_bf16(kf[2],qr[1],C0,0,0,0),   P0[10],P0[11],P0[12],P0[13], pw1[0]=PKW(P0,8), pw1[1]=PKW(P0,10), pw1); \
    VRD(5); SBAR(); GAPA(C1=__builtin_amdgcn_mfma_f32_32x32x16_bf16(kf[3],qr[1],C1,0,0,0),   P0[14],P0[15],P1[0],P1[1],   pw1[2]=PKW(P0,12),pw1[3]=PKW(P0,14), pw1); \
    VRD(2); SBAR(); GAPA(C0=__builtin_amdgcn_mfma_f32_32x32x16_bf16(kf[4],qr[2],C0,0,0,0),   P1[2],P1[3],P1[4],P1[5],     pw2[0]=PKW(P1,0), pw2[1]=PKW(P1,2), pw2); \
    VRD(6); SBAR(); GAPA(C1=__builtin_amdgcn_mfma_f32_32x32x16_bf16(kf[5],qr[2],C1,0,0,0),   P1[6],P1[7],P1[8],P1[9],     pw2[2]=PKW(P1,4), pw2[3]=PKW(P1,6), pw2); \
    VRD(3); SBAR(); GAPA(C0=__builtin_amdgcn_mfma_f32_32x32x16_bf16(kf[6],qr[3],C0,0,0,0),   P1[10],P1[11],P1[12],P1[13], pw3[0]=PKW(P1,8), pw3[1]=PKW(P1,10), pw3); \
    VRD(7); SBAR(); GAPA(C1=__builtin_amdgcn_mfma_f32_32x32x16_bf16(kf[7],qr[3],C1,0,0,0),   P1[14],P1[15],0.f,0.f,       pw3[2]=PKW(P1,12),pw3[3]=PKW(P1,14), pw3); \
    l_reg+=sacc; \
    if(GK){DMA_K((t)+3,sl_cur);} if(GV){DMA_V((t)+1,sl_next);} \
    CMASK(C0,C1,t); \
    { float a=MX3(C0[0],C0[1],C1[0]),b=MX3(C0[2],C0[3],C1[1]); a=MX3(a,C1[2],C1[3]); \
      _Pragma("unroll") for(int r=4;r<16;r+=4){a=MX3(a,C0[r],C0[r+1]);b=MX3(b,C0[r+2],C0[r+3]);a=MX3(a,C1[r],C1[r+1]);b=MX3(b,C1[r+2],C1[r+3]);} \
      float rm=__builtin_fmaxf(a,b); { auto rr=__builtin_amdgcn_permlane32_swap(__float_as_uint(rm),__float_as_uint(rm),false,false); rm=__builtin_fmaxf(__uint_as_float(rr[0]),__uint_as_float(rr[1])); } \
      resc=false; \
      if(__builtin_expect(__any(rm>(float)THRL),0)){ const float dl=__builtin_fmaxf(rm,0.f); mhat+=dl; \
        _Pragma("unroll") for(int r=0;r<16;++r){C0[r]-=dl;C1[r]-=dl;} \
        _Pragma("unroll") for(int r=0;r<16;++r)negm[r]=-mhat; asm volatile("":"+v"(negm)); \
        const float f=__builtin_amdgcn_exp2f(-dl); l_reg*=f; if(hi==0)wsf[r32]=f; resc=true; } } \
    SBAR(); \
    GAPB(o[0]=__builtin_amdgcn_mfma_f32_32x32x16_bf16(PAF(0),VFR(0),o[0],0,0,0), C0,0); \
    GAPB(o[1]=__builtin_amdgcn_mfma_f32_32x32x16_bf16(PAF(0),VFR(4),o[1],0,0,0), C0,4); \
    KRD(GL,0); GAPB(o[0]=__builtin_amdgcn_mfma_f32_32x32x16_bf16(PAF(1),VFR(1),o[0],0,0,0), C0,8); \
    KRD(GL,1); GAPB(o[1]=__builtin_amdgcn_mfma_f32_32x32x16_bf16(PAF(1),VFR(5),o[1],0,0,0), C0,12); \
    KRD(GL,2); GAPB(o[0]=__builtin_amdgcn_mfma_f32_32x32x16_bf16(PAF(2),VFR(2),o[0],0,0,0), C1,0); \
    KRD(GL,3); GAPB(o[1]=__builtin_amdgcn_mfma_f32_32x32x16_bf16(PAF(2),VFR(6),o[1],0,0,0), C1,4); \
    GAPB(o[0]=__builtin_amdgcn_mfma_f32_32x32x16_bf16(PAF(3),VFR(3),o[0],0,0,0), C1,8); \
    GAPB(o[1]=__builtin_amdgcn_mfma_f32_32x32x16_bf16(PAF(3),VFR(7),o[1],0,0,0), C1,12); \
    }while(0)
  int t=1;
  #undef CMASK
  #define CMASK(P0,P1,t) do{}while(0)
  for(;t+5<NT;t+=2){
    STEP(pB0,pB1,pA0,pA1,t,true,true,true);     WAIT_BAR(2); RESC(); ROT();
    STEP(pA0,pA1,pB0,pB1,t+1,true,true,true);   WAIT_BAR(2); RESC(); ROT();
  }
  #undef CMASK
  #define CMASK(P0,P1,t) do{}while(0)
  #define ENDW(tt) do{ if((tt)+3<NT){WAIT_BAR(2);} else if((tt)+2<NT){WAIT_BAR(1);} else {WAIT_BAR(0);} }while(0)
  for(;t+1<NT;t+=2){
    STEP(pB0,pB1,pA0,pA1,t,(t+3<NT),(t+1<NT),(t+1<NT));       ENDW(t);   RESC(); ROT();
    STEP(pA0,pA1,pB0,pB1,t+1,(t+4<NT),(t+2<NT),(t+2<NT));     ENDW(t+1); RESC(); ROT();
  }
  STEP(pB0,pB1,pA0,pA1,NT-1,false,false,false); RESC();
  { float sacc=pB0[0]+pB0[1]; _Pragma("unroll") for(int r=2;r<16;++r)sacc+=pB0[r]; _Pragma("unroll") for(int r=0;r<16;++r)sacc+=pB1[r]; l_reg+=sacc;
    pw0=(u32x4){PKW(pB0,0),PKW(pB0,2),PKW(pB0,4),PKW(pB0,6)};pw1=(u32x4){PKW(pB0,8),PKW(pB0,10),PKW(pB0,12),PKW(pB0,14)};pw2=(u32x4){PKW(pB1,0),PKW(pB1,2),PKW(pB1,4),PKW(pB1,6)};pw3=(u32x4){PKW(pB1,8),PKW(pB1,10),PKW(pB1,12),PKW(pB1,14)};
    SBAR(); pv(o,vb0+sl_cur,PAF(0),PAF(1),PAF(2),PAF(3)); }
  #undef PKW
  #undef PAF
  #undef VFR
  #undef PIN
  #undef MX3
  #undef GAPA
  #undef GAPB
  #undef EX
  #undef VRD
  #undef KRD
  #undef STEP
  #undef ENDW
  {auto rr=__builtin_amdgcn_permlane32_swap(__float_as_uint(l_reg),__float_as_uint(l_reg),false,false);l_reg=__uint_as_float(rr[0])+__uint_as_float(rr[1]);}
  if(hi==0)wsf[32+r32]=l_reg;asm volatile("s_waitcnt lgkmcnt(0)":::"memory");
  float rli[16];
  #pragma unroll
  for(int r=0;r<16;++r)rli[r]=__builtin_amdgcn_rcpf(wsf[32+crow(r,hi)]);
  bf16*Ow=Ob+(long)(wid*QBLK)*OP;
  { bf16*stg=(bf16*)(shm+LDS_OST)+wid*2048;
    #pragma unroll
    for(int r=0;r<16;++r){const int orow=crow(r,hi);
      #pragma unroll
      for(int d0=0;d0<2;++d0)stg[orow*64+d0*32+r32]=__float2bfloat16(o[d0][r]*rli[r]);}
    asm volatile("s_waitcnt lgkmcnt(0)":::"memory");
    #pragma unroll
    for(int i=0;i<4;++i){const int row=i*8+(lane>>3),ch=lane&7; const u32x4 v=*(const u32x4*)(stg+row*64+ch*8); ATTN_STORE16(Ow+(long)row*OP+ch*8,v);} }
  asm volatile("s_waitcnt lgkmcnt(0)\n\ts_barrier":::"memory");
  #undef DMA_K
  #undef DMA_V
  #undef CMASK
  #undef START
  #undef RESC
  #undef ROT
}
constexpr int ATTN_LDS_BYTES=LDS_BYTES;
#undef SBAR
#undef WAIT_BAR
}
namespace dn {
constexpr int NCHUNK = 260, GROUP = 6, WREG = 17408  , TP = 72  ;
constexpr int F_WT = 0, F_QKT = 8, F_QD = 14, F_KD = 22, F_U = 30, F_GL = 38;
__device__ __forceinline__ int crow(int r, int hi) { return (r & 3) + 8 * (r >> 2) + 4 * hi; }
__device__ __forceinline__ bf16x8 pack8(const f32x16& x, int s) {
    v4u w; w.x = cvt_pk_bf16(x[8 * s + 0], x[8 * s + 1]); w.y = cvt_pk_bf16(x[8 * s + 2], x[8 * s + 3]); w.z = cvt_pk_bf16(x[8 * s + 4], x[8 * s + 5]); w.w = cvt_pk_bf16(x[8 * s + 6], x[8 * s + 7]);
    return __builtin_bit_cast(bf16x8, w);
}
#define DN_MFMA(a, b, c) __builtin_amdgcn_mfma_f32_32x32x16_bf16(a, b, c, 0, 0, 0)

struct Chain {
    const bf16_t* P1b;
    bf16_t* Ob;
    int h, dir;
    float Aexp, dtb;
    unsigned char* ring;
    unsigned* dbg;
};
__device__ __forceinline__ int chunk_of(int ci, int dir) { return dir == 0 ? ci : (ci < 4 ? 3 - ci : 263 - ci); }

__device__ __forceinline__ void produce(const Chain& ch, int ci, LAS unsigned char* wl, const LAS float* wct, unsigned char* slot, int lane_in) {
    int lane = lane_in; asm volatile("" : "+v"(lane));
    const int r = lane & 31, hh = lane >> 5;
    const int c = chunk_of(ci, ch.dir), t0 = 64 * c, seg_lo = (c < 4) ? 0 : CTXL, seg_hi = (c < 4) ? CTXL : TT;
    LAS float* Lm = (LAS float*)wl; LAS bf16_t* Tm = (LAS bf16_t*)wl; LAS float* gcT = (LAS float*)(wl + 16384); LAS float* btT = gcT + 64;
    {
        const int tok = ch.dir ? t0 + 63 - lane : t0 + lane;
        const bf16_t* row = ch.P1b + (size_t)tok * P1W;
        const float a = bf2f(row[C_BA + ch.dir * 8 + ch.h]), bb = bf2f(row[C_BB + ch.dir * 8 + ch.h]);
        const float x = a + ch.dtb; const float sp = x > 20.f ? x : log1pf(__expf(x));
        float g = -ch.Aexp * sp;
#pragma unroll
        for (int o = 1; o < 64; o <<= 1) { const float t = __shfl_up(g, o); if (lane >= o) g += t; }
        gcT[lane] = g; btT[lane] = sigmoidf_(bb);
    }
    LDS_WAIT();
    const float gl = gcT[63];
    bf16x8 kA[2][4], qA[2][4], vA[2][4];
#pragma unroll
    for (int x = 0; x < 3; ++x) {
        const int colb = C_BQKV + (x == 0 ? 512 : (x == 1 ? 0 : 1024)) + ch.h * 64; const int wcb = x * 64;
#pragma unroll
        for (int rt = 0; rt < 2; ++rt) {
            const int p = 32 * rt + r; const int tok = ch.dir ? t0 + 63 - p : t0 + p;
            const bool hasm = (tok - 1 >= seg_lo), hasp = (tok + 1 < seg_hi);
            const bf16_t* rowc = ch.P1b + (size_t)tok * P1W + colb + 4 * hh;
            const bf16_t* rowm = hasm ? rowc - P1W : rowc; const bf16_t* rowp = hasp ? rowc + P1W : rowc;
            v2u rawc[8], rawm[8], rawp[8];
#pragma unroll
            for (int e = 0; e < 8; ++e) { rawc[e] = *(const v2u*)(rowc + 8 * e); rawm[e] = *(const v2u*)(rowm + 8 * e); rawp[e] = *(const v2u*)(rowp + 8 * e); }
            __builtin_amdgcn_sched_barrier(0);
            float f[4][8]; float ss = 0.f;
#pragma unroll
            for (int e = 0; e < 8; ++e) {
                const int d0 = 8 * e + 4 * hh;
                const f32x4 w0 = *(const LAS f32x4*)(wct + 0 * 192 + wcb + d0), w1 = *(const LAS f32x4*)(wct + 1 * 192 + wcb + d0), w2 = *(const LAS f32x4*)(wct + 2 * 192 + wcb + d0);
                const v2u wc_ = rawc[e]; v2u wm = rawm[e], wp = rawp[e];
                if (!hasm) wm = (v2u){0u, 0u};
                if (!hasp) wp = (v2u){0u, 0u};
                float y[4];
                y[0] = bflo(wm.x) * w0[0] + bflo(wc_.x) * w1[0] + bflo(wp.x) * w2[0];
                y[1] = bfhi(wm.x) * w0[1] + bfhi(wc_.x) * w1[1] + bfhi(wp.x) * w2[1];
                y[2] = bflo(wm.y) * w0[2] + bflo(wc_.y) * w1[2] + bflo(wp.y) * w2[2];
                y[3] = bfhi(wm.y) * w0[3] + bfhi(wc_.y) * w1[3] + bfhi(wp.y) * w2[3];
#pragma unroll
                for (int j = 0; j < 4; ++j) { const float v = siluf_(y[j]); f[e >> 1][(e & 1) * 4 + j] = v; ss += v * v; }
            }
            float sc = 1.f;
            if (x < 2) { ss += __shfl_xor(ss, 32); sc = rsqrtf(ss + EPS); if (x == 1) sc *= 0.125f; }
#pragma unroll
            for (int s = 0; s < 4; ++s) {
                v4u w; w.x = cvt_pk_bf16(f[s][0] * sc, f[s][1] * sc); w.y = cvt_pk_bf16(f[s][2] * sc, f[s][3] * sc); w.z = cvt_pk_bf16(f[s][4] * sc, f[s][5] * sc); w.w = cvt_pk_bf16(f[s][6] * sc, f[s][7] * sc);
                const bf16x8 fr_ = __builtin_bit_cast(bf16x8, w);
                if (x == 0) kA[rt][s] = fr_; else if (x == 1) qA[rt][s] = fr_; else vA[rt][s] = fr_;
            }
            __builtin_amdgcn_sched_barrier(0);
        }
    }
    v4u* sl = (v4u*)slot;
    const float gcc0 = gcT[r], gcc1 = gcT[32 + r];
#pragma unroll
    for (int tix = 0; tix < 3; ++tix) {
        const int it = (tix == 0) ? 0 : 1, jt = (tix == 2) ? 1 : 0;
        f32x16 acc = {};
#pragma unroll
        for (int s = 0; s < 4; ++s) acc = DN_MFMA(kA[it][s], kA[jt][s], acc);
        const float gcj = jt ? gcc1 : gcc0; const int j = 32 * jt + r;
#pragma unroll
        for (int rg = 0; rg < 16; ++rg) { const int i = 32 * it + crow(rg, hh); const float gi = gcT[i], bi = btT[i];
            const float v = (i > j) ? bi * acc[rg] * __expf(fminf(gi - gcj, 0.f)) : 0.f; Lm[i * 64 + j] = v; }
    }
#pragma unroll
    for (int tix = 0; tix < 3; ++tix) {
        const int jt = (tix == 2) ? 1 : 0, it = (tix == 0) ? 0 : 1;
        f32x16 acc = {};
#pragma unroll
        for (int s = 0; s < 4; ++s) acc = DN_MFMA(kA[jt][s], qA[it][s], acc);
        const float gci = it ? gcc1 : gcc0; const int i = 32 * it + r;
#pragma unroll
        for (int rg = 0; rg < 16; ++rg) { const int j = 32 * jt + crow(rg, hh); const float gj = gcT[j];
            acc[rg] = (i >= j) ? acc[rg] * __expf(fminf(gci - gj, 0.f)) : 0.f; }
        sl[(F_QKT + tix * 2 + 0) * 64 + lane] = __builtin_bit_cast(v4u, pack8(acc, 0));
        sl[(F_QKT + tix * 2 + 1) * 64 + lane] = __builtin_bit_cast(v4u, pack8(acc, 1));
    }
#pragma unroll
    for (int rt = 0; rt < 2; ++rt) { const float e = __expf(rt ? gcc1 : gcc0);
#pragma unroll
        for (int s = 0; s < 4; ++s) { const v4u w = __builtin_bit_cast(v4u, qA[rt][s]); v4u o;
            o.x = cvt_pk_bf16(bflo(w.x) * e, bfhi(w.x) * e); o.y = cvt_pk_bf16(bflo(w.y) * e, bfhi(w.y) * e); o.z = cvt_pk_bf16(bflo(w.z) * e, bfhi(w.z) * e); o.w = cvt_pk_bf16(bflo(w.w) * e, bfhi(w.w) * e);
            sl[(F_QD + rt * 4 + s) * 64 + lane] = o; } }
    LDS_WAIT();
#if MK_DEBUG == 3
    { unsigned bad = 0u;
      for (int i = 0; i < 64; ++i) { const float lv = Lm[i * 64 + lane]; if (lane < i && !(fabsf(lv) <= 1.5f)) bad |= 1u; }
      if (!(fabsf(gcT[lane]) < 1.0e30f)) bad |= 2u; if (!(btT[lane] >= 0.f && btT[lane] <= 1.f)) bad |= 4u;
      if (bad) atomicOr(ch.dbg, bad); }
#endif
    float T[64];
#pragma unroll
    for (int i = 0; i < 64; ++i) {
        float a = (lane == i) ? 1.f : 0.f;
#pragma unroll
        for (int q = 0; q < (i + 3) / 4; ++q) { const f32x4 l4 = *(const LAS f32x4*)(Lm + i * 64 + 4 * q);
#pragma unroll
            for (int e = 0; e < 4; ++e) if (4 * q + e < i) a -= l4[e] * T[4 * q + e]; }
        T[i] = a;
        if ((i & 3) == 3) __builtin_amdgcn_sched_barrier(0);
    }
    LDS_WAIT();
#pragma unroll
    for (int i = 0; i < 64; ++i) Tm[i * TP + lane] = (bf16_t)f2bf(T[i]);
    LDS_WAIT();
    bf16x8 Tf[3][2];
#pragma unroll
    for (int tix = 0; tix < 3; ++tix) { const int it = (tix == 0) ? 0 : 1, jt = (tix == 2) ? 1 : 0;
#pragma unroll
        for (int s = 0; s < 2; ++s) { const LAS bf16_t* p = Tm + (32 * it + r) * TP + 32 * jt + 16 * s + 4 * hh;
            const v2u a = *(const LAS v2u*)p, b = *(const LAS v2u*)(p + 8); v4u w; w.x = a.x; w.y = a.y; w.z = b.x; w.w = b.y; Tf[tix][s] = __builtin_bit_cast(bf16x8, w); } }
#if MK_DEBUG == 4
    { unsigned bad = 0u;
      _Pragma("unroll") for (int t_ = 0; t_ < 3; ++t_) _Pragma("unroll") for (int s_ = 0; s_ < 2; ++s_) { const v4u w = __builtin_bit_cast(v4u, Tf[t_][s_]);
        const unsigned ws_[4] = {w.x, w.y, w.z, w.w};
        _Pragma("unroll") for (int q_ = 0; q_ < 4; ++q_) { const float lo_ = bflo(ws_[q_]), hi_ = bfhi(ws_[q_]);
          if (!(fabsf(lo_) < 3.0e38f) || !(fabsf(hi_) < 3.0e38f)) bad |= 1u; else if (fabsf(lo_) > 1.0e3f || fabsf(hi_) > 1.0e3f) bad |= 2u; } }
      if (bad) atomicOr(ch.dbg, bad); }
#endif
    bf16x8 If[2];
#pragma unroll
    for (int sp = 0; sp < 2; ++sp) { bf16x8 f_;
#pragma unroll
        for (int jj = 0; jj < 8; ++jj) f_[jj] = ((16 * sp + 8 * (jj >> 2) + 4 * hh + (jj & 3)) == r) ? (short)0x3F80 : (short)0;
        If[sp] = f_; }
    {
        bf16x8 kbg[2][2][2];
#pragma unroll
        for (int jt = 0; jt < 2; ++jt)
#pragma unroll
            for (int dt = 0; dt < 2; ++dt) {
                f32x16 kc = {};
                kc = DN_MFMA(kA[jt][2 * dt + 0], If[0], kc); kc = DN_MFMA(kA[jt][2 * dt + 1], If[1], kc);
                f32x16 kd, kb;
#pragma unroll
                for (int rg = 0; rg < 16; ++rg) { const int j = 32 * jt + crow(rg, hh); const float gj = gcT[j], bj = btT[j];
                    kd[rg] = kc[rg] * __expf(gl - gj); kb[rg] = kc[rg] * bj * __expf(gj); }
                sl[(F_KD + (jt * 2 + dt) * 2 + 0) * 64 + lane] = __builtin_bit_cast(v4u, pack8(kd, 0));
                sl[(F_KD + (jt * 2 + dt) * 2 + 1) * 64 + lane] = __builtin_bit_cast(v4u, pack8(kd, 1));
                kbg[jt][dt][0] = pack8(kb, 0); kbg[jt][dt][1] = pack8(kb, 1);
#if MK_DEBUG == 4
                { bool b_ = false; _Pragma("unroll") for (int rg = 0; rg < 16; ++rg) if (!(fabsf(kb[rg]) < 3.0e38f)) b_ = true; if (b_) atomicOr(ch.dbg, 4u); }
#endif
            }
#pragma unroll
        for (int dt = 0; dt < 2; ++dt)
#pragma unroll
            for (int it = 0; it < 2; ++it) {
                f32x16 wt = {};
#pragma unroll
                for (int s = 0; s < 2; ++s) {
                    if (it == 0) wt = DN_MFMA(kbg[0][dt][s], Tf[0][s], wt);
                    else { wt = DN_MFMA(kbg[0][dt][s], Tf[1][s], wt); wt = DN_MFMA(kbg[1][dt][s], Tf[2][s], wt); }
                }
                asm volatile("s_nop 15\n\ts_nop 7" : "+v"(wt));
                sl[(F_WT + (dt * 2 + it) * 2 + 0) * 64 + lane] = __builtin_bit_cast(v4u, pack8(wt, 0));
                sl[(F_WT + (dt * 2 + it) * 2 + 1) * 64 + lane] = __builtin_bit_cast(v4u, pack8(wt, 1));
            }
    }
    {
        bf16x8 vb[2][2][2];
#pragma unroll
        for (int jt = 0; jt < 2; ++jt)
#pragma unroll
            for (int dvt = 0; dvt < 2; ++dvt) {
                f32x16 vc = {};
                vc = DN_MFMA(vA[jt][2 * dvt + 0], If[0], vc); vc = DN_MFMA(vA[jt][2 * dvt + 1], If[1], vc);
#pragma unroll
                for (int rg = 0; rg < 16; ++rg) { const int j = 32 * jt + crow(rg, hh); vc[rg] *= btT[j]; }
                vb[jt][dvt][0] = pack8(vc, 0); vb[jt][dvt][1] = pack8(vc, 1);
#if MK_DEBUG == 4
                { bool b_ = false; _Pragma("unroll") for (int rg = 0; rg < 16; ++rg) if (!(fabsf(vc[rg]) < 3.0e38f)) b_ = true; if (b_) atomicOr(ch.dbg, 8u); }
#endif
            }
#pragma unroll
        for (int it = 0; it < 2; ++it)
#pragma unroll
            for (int dvt = 0; dvt < 2; ++dvt) {
                f32x16 u = {};
#pragma unroll
                for (int s = 0; s < 2; ++s) {
                    if (it == 0) u = DN_MFMA(Tf[0][s], vb[0][dvt][s], u);
                    else { u = DN_MFMA(Tf[1][s], vb[0][dvt][s], u); u = DN_MFMA(Tf[2][s], vb[1][dvt][s], u); }
                }
                asm volatile("s_nop 15\n\ts_nop 7" : "+v"(u));
                sl[(F_U + (it * 2 + dvt) * 2 + 0) * 64 + lane] = __builtin_bit_cast(v4u, pack8(u, 0));
                sl[(F_U + (it * 2 + dvt) * 2 + 1) * 64 + lane] = __builtin_bit_cast(v4u, pack8(u, 1));
            }
    }
    { v4u gw; gw.x = __float_as_uint(__expf(gl)); gw.y = gw.x; gw.z = gw.x; gw.w = gw.x; sl[F_GL * 64 + lane] = gw; }
}

__device__ __forceinline__ f32x16 unpack16(v4u a, v4u b) {
    f32x16 x;
    x[0] = bflo(a.x); x[1] = bfhi(a.x); x[2] = bflo(a.y); x[3] = bfhi(a.y); x[4] = bflo(a.z); x[5] = bfhi(a.z); x[6] = bflo(a.w); x[7] = bfhi(a.w);
    x[8] = bflo(b.x); x[9] = bfhi(b.x); x[10] = bflo(b.y); x[11] = bfhi(b.y); x[12] = bflo(b.z); x[13] = bfhi(b.z); x[14] = bflo(b.w); x[15] = bfhi(b.w);
    return x;
}
__device__ __forceinline__ void consume(const Chain& ch, int ci, const unsigned char* slot, f32x16 (&S)[2], int hv, int lane_in) {
    int lane = lane_in; asm volatile("" : "+v"(lane));
    const int r = lane & 31, hh = lane >> 5;
    const v4u* sl = (const v4u*)slot;
#define DN_FR(idx) __builtin_bit_cast(bf16x8, sl[(idx) * 64 + lane])
    const float gl = __builtin_bit_cast(float, sl[F_GL * 64 + lane].x);
#if MK_DEBUG == 2
    { unsigned bad = 0u;
      auto nf = [](v4u w) { return ((w.x & 0x7f80u) == 0x7f80u) || ((w.x & 0x7f800000u) == 0x7f800000u) || ((w.y & 0x7f80u) == 0x7f80u) || ((w.y & 0x7f800000u) == 0x7f800000u) || ((w.z & 0x7f80u) == 0x7f80u) || ((w.z & 0x7f800000u) == 0x7f800000u) || ((w.w & 0x7f80u) == 0x7f80u) || ((w.w & 0x7f800000u) == 0x7f800000u); };
      if ((__float_as_uint(gl) & 0x7f800000u) == 0x7f800000u) bad |= 1u;
      for (int i = 0; i < 8; ++i) { if (nf(sl[(F_WT + i) * 64 + lane])) bad |= 2u; if (nf(sl[(F_QD + i) * 64 + lane])) bad |= 4u; if (nf(sl[(F_KD + i) * 64 + lane])) bad |= 8u; if (nf(sl[(F_U + i) * 64 + lane])) bad |= 16u; }
      for (int i = 0; i < 6; ++i) if (nf(sl[(F_QKT + i) * 64 + lane])) bad |= 32u;
      if (bad) atomicOr(ch.dbg, bad); }
#endif
    asm volatile("s_nop 15\n\ts_nop 7" : "+v"(S[0]), "+v"(S[1]));
    bf16x8 Sb[2][2];
#pragma unroll
    for (int dt = 0; dt < 2; ++dt) { Sb[dt][0] = pack8(S[dt], 0); Sb[dt][1] = pack8(S[dt], 1); }
    f32x16 accv[2], acco[2];
#pragma unroll
    for (int it = 0; it < 2; ++it) { accv[it] = f32x16{}; acco[it] = f32x16{};
#pragma unroll
        for (int dt = 0; dt < 2; ++dt)
#pragma unroll
            for (int s = 0; s < 2; ++s) {
                accv[it] = DN_MFMA(DN_FR(F_WT + (dt * 2 + it) * 2 + s), Sb[dt][s], accv[it]);
                acco[it] = DN_MFMA(DN_FR(F_QD + it * 4 + 2 * dt + s), Sb[dt][s], acco[it]);
            } }
    bf16x8 vb[2][2];
#pragma unroll
    for (int it = 0; it < 2; ++it) {
        const f32x16 u = unpack16(sl[(F_U + (it * 2 + hv) * 2 + 0) * 64 + lane], sl[(F_U + (it * 2 + hv) * 2 + 1) * 64 + lane]);
        const f32x16 vn = u - accv[it];
        vb[it][0] = pack8(vn, 0); vb[it][1] = pack8(vn, 1);
    }
#pragma unroll
    for (int s = 0; s < 2; ++s) {
        acco[0] = DN_MFMA(DN_FR(F_QKT + 0 * 2 + s), vb[0][s], acco[0]);
        acco[1] = DN_MFMA(DN_FR(F_QKT + 1 * 2 + s), vb[0][s], acco[1]);
        acco[1] = DN_MFMA(DN_FR(F_QKT + 2 * 2 + s), vb[1][s], acco[1]);
    }
#pragma unroll
    for (int dt = 0; dt < 2; ++dt) {
        S[dt] = S[dt] * gl;
#pragma unroll
        for (int jt = 0; jt < 2; ++jt)
#pragma unroll
            for (int s = 0; s < 2; ++s) S[dt] = DN_MFMA(DN_FR(F_KD + (jt * 2 + dt) * 2 + s), vb[jt][s], S[dt]);
    }
    const int c = chunk_of(ci, ch.dir), t0 = 64 * c;
#pragma unroll
    for (int it = 0; it < 2; ++it)
#pragma unroll
        for (int rg = 0; rg < 16; ++rg) { const int i = 32 * it + crow(rg, hh); const int tok = ch.dir ? t0 + 63 - i : t0 + i;
            ch.Ob[(size_t)tok * 512 + ch.h * 64 + 32 * hv + r] = (bf16_t)f2bf(acco[it][rg]); }
#undef DN_FR
}

__device__ __forceinline__ void chain_unit(const Chain& ch, const float* wconv  , LAS unsigned char* lds, LAS float* wct, int wave) {
    const int lane = hw_lane(), wid = wave, tid = wave * 64 + lane;
    for (int i = tid; i < 3 * 192; i += NTHREADS) { const int tap = i / 192, cc = i % 192, x = cc / 64, d = cc % 64;
        wct[i] = wconv[tap * 1536 + (x == 0 ? 512 : (x == 1 ? 0 : 1024)) + ch.h * 64 + d]; }
    __syncthreads();
    constexpr int NG = (NCHUNK + GROUP - 1) / GROUP;
#define DN_BAR() do { asm volatile("s_waitcnt vmcnt(0) lgkmcnt(0)" ::: "memory"); __builtin_amdgcn_s_barrier(); asm volatile("" ::: "memory"); } while (0)
    if (wid >= 2) {
        for (int k = 0; k <= NG; ++k) {
            const int ci = k * GROUP + (wid - 2);
#ifndef NO_DNP
            if (k < NG && ci < NCHUNK) produce(ch, ci, lds + wid * WREG, wct, ch.ring + (size_t)((k & 1) * GROUP + (wid - 2)) * RING_SLOT, lane);
#endif
            DN_BAR();
        }
    } else {
        f32x16 S[2]; S[0] = f32x16{}; S[1] = f32x16{};
        for (int k = 0; k <= NG; ++k) {
#ifndef NO_DNC
            if (k >= 1) { const int g0 = (k - 1) * GROUP; const int n = (NCHUNK - g0 < GROUP) ? NCHUNK - g0 : GROUP;
                for (int j = 0; j < n; ++j) consume(ch, g0 + j, ch.ring + (size_t)(((k - 1) & 1) * GROUP + j) * RING_SLOT, S, wid, lane); }
#endif
            DN_BAR();
        }
    }
#undef DN_BAR
    __syncthreads();
}
#undef DN_MFMA
}
struct Params {
    const float* in[28];
    float* out; unsigned char* ws;
    int ph_lo, ph_hi; int use_bar; int pad;
};
enum { I_X = 0, I_C, I_CTX, I_CCTX, I_WMOD, I_BMOD, I_GN1, I_GN2, I_WIN, I_GQ, I_GK, I_WCONV, I_ALOG, I_DTB, I_GDN, I_LAMQK, I_GSUB, I_WBR, I_WOUT, I_WRT, I_BRT,
       I_WEG, I_WEU, I_WED, I_WSG, I_WSU, I_WSD, I_GFIN };
struct Frame {
    LAS unsigned char* lds; volatile LAS unsigned* MISC; gu32* ctl;
    int tid, lane, wave, G, gw, NGW;
    unsigned char* ws;
};
__device__ __forceinline__ size_t hrow_off(int r, bool& isctx, int& b) { b = r / TT; const int t = r - b * TT; isctx = t < CTXL; return isctx ? (size_t)(b * CTXL + t) * DM : (size_t)(b * SEQ + (t - CTXL)) * DM; }

__device__ __forceinline__ void transpose_item(const float* W, int ldw, int k0, int n0, bf16_t* WT, int K, int dst_row0, LAS float* scr, int lane) {
#pragma unroll 8
    for (int i = 0; i < 32; ++i) { const int kk = 2 * i + (lane >> 5); scr[kk * 33 + (lane & 31)] = W[(size_t)(k0 + kk) * ldw + n0 + (lane & 31)]; }
    LDS_WAIT(); asm volatile("" ::: "memory");
    const int c = lane & 7;
#pragma unroll
    for (int j = 0; j < 4; ++j) { const int n = (lane >> 3) + 8 * j; const LAS float* s = scr + (8 * c) * 33 + n;
        v4u o; o.x = pk2(s[0 * 33], s[1 * 33]); o.y = pk2(s[2 * 33], s[3 * 33]); o.z = pk2(s[4 * 33], s[5 * 33]); o.w = pk2(s[6 * 33], s[7 * 33]);
        *(v4u*)(WT + (size_t)(dst_row0 + n) * K + k0 + 8 * c) = o; }
    LDS_WAIT(); asm volatile("" ::: "memory");
}
__device__ __forceinline__ void convert_small(Frame& F, const Params& P, int l) {
    LAS float* scr = (LAS float*)(F.lds + RING_OFF + F.wave * 16384);
    const float* win = P.in[I_WIN] + (size_t)l * DM * INW;
    const float* wbr = P.in[I_WBR] + (size_t)l * 3 * 512 * DM;
    const float* wo = P.in[I_WOUT] + (size_t)l * DM * DM;
    bf16_t* WB1 = (bf16_t*)(F.ws + WS_WB1); bf16_t* WB2 = (bf16_t*)(F.ws + WS_WB2); bf16_t* WBR = (bf16_t*)(F.ws + WS_WBR); bf16_t* WOT = (bf16_t*)(F.ws + WS_WOT);
    constexpr int I1 = 16 * (P1W / 32), I2 = 16 * (GW / 32), I3 = 3 * 8 * 32, I4 = 16 * 32;
    for (int it = F.gw; it < I1 + I2 + I3 + I4; it += F.NGW) {
        int r = it;
        if (r < I1) { const int nb = r % (P1W / 32), kb = r / (P1W / 32); transpose_item(win, INW, 64 * kb, 32 * nb, WB1, DM, 32 * nb, scr, F.lane); continue; } r -= I1;
        if (r < I2) { const int nb = r % (GW / 32), kb = r / (GW / 32); transpose_item(win, INW, 64 * kb, C_GATE + 32 * nb, WB2, DM, 32 * nb, scr, F.lane); continue; } r -= I2;
        if (r < I3) { const int br = r / 256, q = r % 256, nb = q % 32, kb = q / 32; transpose_item(wbr + (size_t)br * 512 * DM, DM, 64 * kb, 32 * nb, WBR + (size_t)br * DM * 512, 512, 32 * nb, scr, F.lane); continue; } r -= I3;
        { const int nb = r % 32, kb = r / 32; transpose_item(wo, DM, 64 * kb, 32 * nb, WOT, DM, 32 * nb, scr, F.lane); }
    }
}
__device__ __forceinline__ void convert_experts(Frame& F, const Params& P, int l) {
    LAS float* scr = (LAS float*)(F.lds + RING_OFF + F.wave * 16384);
    bf16_t* WGU = (bf16_t*)(F.ws + WS_B); bf16_t* WD = WGU + (size_t)NEXP1 * 512 * DM;
    for (int it = F.gw; it < NEXP1 * 384; it += F.NGW) {
        const int e = it / 384; int r = it % 384;
        const float* wg = (e < NEXP) ? P.in[I_WEG] + ((size_t)l * NEXP + e) * DM * FF : P.in[I_WSG] + (size_t)l * DM * FF;
        const float* wu = (e < NEXP) ? P.in[I_WEU] + ((size_t)l * NEXP + e) * DM * FF : P.in[I_WSU] + (size_t)l * DM * FF;
        const float* wd = (e < NEXP) ? P.in[I_WED] + ((size_t)l * NEXP + e) * FF * DM : P.in[I_WSD] + (size_t)l * FF * DM;
        if (r < 256) { const bool up = r >= 128; r &= 127; const int nb = r % 8, kb = r / 8; const int n0 = 32 * nb;
            transpose_item(up ? wu : wg, FF, 64 * kb, n0, WGU + (size_t)e * 512 * DM, DM, (n0 / 128) * 256 + (up ? 128 : 0) + (n0 % 128), scr, F.lane); }
        else { r -= 256; const int nb = r % 32, kb = r / 32; transpose_item(wd, DM, 64 * kb, 32 * nb, WD + (size_t)e * DM * FF, FF, 32 * nb, scr, F.lane); }
    }
}
__device__ __forceinline__ void compute_mod(Frame& F, const Params& P) {
    float* modv = (float*)(F.ws + WS_MODV);
    const int kq = F.lane >> 3, nn = F.lane & 7;
    for (int it = F.gw; it < NLAYER * (6144 / 8); it += F.NGW) {
        const int l = it / (6144 / 8), n = (it % (6144 / 8)) * 8 + nn;
        const float* w = P.in[I_WMOD] + (size_t)l * DM * 6144 + n;
        float a0 = 0.f, a1 = 0.f, a2 = 0.f;
#pragma unroll 8
        for (int i = 0; i < 128; ++i) { const int k = kq + 8 * i; const float wv = w[(size_t)k * 6144];
            a0 += siluf_(P.in[I_C][k]) * wv; a1 += siluf_(P.in[I_C][DM + k]) * wv; a2 += siluf_(P.in[I_CCTX][k]) * wv; }
#pragma unroll
        for (int o = 8; o < 64; o <<= 1) { a0 += __shfl_xor(a0, o); a1 += __shfl_xor(a1, o); a2 += __shfl_xor(a2, o); }
        if (kq == 0) { const float bm = P.in[I_BMOD][l * 6144 + n]; float* m = modv + (size_t)l * 3 * 6144 + n; m[0] = a0 + bm; m[6144] = a1 + bm; m[2 * 6144] = a2 + bm; }
    }
}
__device__ __forceinline__ void modnorm_store(const float (&x)[16], const float* g, const float* sc, const float* sh, bf16_t* orow, int lane) {
    float ss = 0.f;
#pragma unroll
    for (int i = 0; i < 16; ++i) ss += x[i] * x[i];
    const float rstd = rsqrtf(wave_sum(ss) * (1.f / DM) + EPS);
#pragma unroll
    for (int hf = 0; hf < 2; ++hf) { const int c0 = hf * 512 + lane * 8; float y[8];
#pragma unroll
        for (int j = 0; j < 8; ++j) y[j] = x[hf * 8 + j] * rstd * g[c0 + j] * (1.f + sc[c0 + j]) + sh[c0 + j];
        v4u w; w.x = cvt_pk_bf16(y[0], y[1]); w.y = cvt_pk_bf16(y[2], y[3]); w.z = cvt_pk_bf16(y[4], y[5]); w.w = cvt_pk_bf16(y[6], y[7]);
        *(v4u*)(orow + c0) = w; }
}
__device__ __forceinline__ void load_row16(const float* row, float (&x)[16], int lane) {
#pragma unroll
    for (int hf = 0; hf < 2; ++hf) { const f32x4 a = *(const f32x4*)(row + hf * 512 + lane * 8), b = *(const f32x4*)(row + hf * 512 + lane * 8 + 4);
        x[hf * 8 + 0] = a[0]; x[hf * 8 + 1] = a[1]; x[hf * 8 + 2] = a[2]; x[hf * 8 + 3] = a[3]; x[hf * 8 + 4] = b[0]; x[hf * 8 + 5] = b[1]; x[hf * 8 + 6] = b[2]; x[hf * 8 + 7] = b[3]; }
}
__device__ __forceinline__ void phase_norm1(Frame& F, const Params& P) {
    const float* modv = (const float*)(F.ws + WS_MODV); bf16_t* U = (bf16_t*)(F.ws + WS_C);
    for (int r = F.gw; r < MROWS; r += F.NGW) { bool isctx; int b; const size_t off = hrow_off(r, isctx, b);
        const float* row = (isctx ? P.in[I_CTX] : P.in[I_X]) + off; float x[16]; load_row16(row, x, F.lane);
        const float* mv = modv + (isctx ? 2 : b) * 6144;
        modnorm_store(x, P.in[I_GN1], mv + 1 * DM, mv + 0 * DM, U + (size_t)r * DM, F.lane); }
}
__device__ __forceinline__ void phase_prep(Frame& F, const Params& P, int l) {
    bf16_t* P1 = (bf16_t*)(F.ws + WS_A);
    const int i = F.lane & 31, hsel = F.lane >> 5;
    const float gq0 = P.in[I_GQ][l * 64 + i], gq1 = P.in[I_GQ][l * 64 + 32 + i], gk0 = P.in[I_GK][l * 64 + i], gk1 = P.in[I_GK][l * 64 + 32 + i];
    const float inv = exp2f(-(float)(i & 15) * (13.287712379549449f / 16.f));
    for (int r = F.gw; r < MROWS; r += F.NGW) {
        const int b = r / TT, t = r - b * TT; const bool lat = t >= CTXL;
        float cs = 1.f, sn = 0.f;
        if (lat) { const int s = t - CTXL; const float pos = (i < 16) ? (float)(s / GRIDW) : (float)(s % GRIDW); sincosf(pos * inv, &sn, &cs); }
        bf16_t* row = P1 + (size_t)r * P1W;
#pragma unroll 1
        for (int it = 0; it < 13; ++it) {
            const int hd = 2 * it + hsel;
            int col; int kind;
            if (hd < 8) { col = C_AQ + hd * 64; kind = 0; } else if (hd < 10) { col = C_AK + (hd - 8) * 64; kind = 1; } else if (hd < 18) { col = C_CQ + (hd - 10) * 64; kind = 2; } else { col = C_CK + (hd - 18) * 64; kind = 3; }
            float x0 = bf2f(row[col + i]), x1 = bf2f(row[col + 32 + i]);
            if (kind < 2) { float ss = x0 * x0 + x1 * x1;
#pragma unroll
                for (int o = 1; o < 32; o <<= 1) ss += __shfl_xor(ss, o);
                const float rstd = rsqrtf(ss * (1.f / 64.f) + EPS);
                x0 *= rstd * (kind == 0 ? gq0 : gk0); x1 *= rstd * (kind == 0 ? gq1 : gk1); }
            float y0 = x0 * cs - x1 * sn, y1 = x1 * cs + x0 * sn;
            if (kind == 0 || kind == 2) { y0 *= QSCALE; y1 *= QSCALE; }
            row[col + i] = (bf16_t)f2bf(y0); row[col + 32 + i] = (bf16_t)f2bf(y1);
        }
    }
}
__device__ __forceinline__ void phase_post(Frame& F, const Params& P, int l) {
    const bf16_t* P1 = (const bf16_t*)(F.ws + WS_A); bf16_t* BR = (bf16_t*)(F.ws + WS_B);
    const bf16_t* DO = (const bf16_t*)(F.ws + WS_D); const bf16_t* OFw = DO + (size_t)MROWS * 1024; const bf16_t* OBw = OFw + (size_t)MROWS * 512;
    const float linit = 0.8f - 0.6f * expf(-0.3f * (float)l);
    const float* lq = P.in[I_LAMQK] + l * 256;
    const float lam = expf(wave_sum(lq[F.lane] * lq[64 + F.lane])) - expf(wave_sum(lq[128 + F.lane] * lq[192 + F.lane])) + linit;
    const float gdn = P.in[I_GDN][l * 64 + F.lane];
    const float gs0 = P.in[I_GSUB][l * 128 + F.lane] * (1.f - linit), gs1 = P.in[I_GSUB][l * 128 + 64 + F.lane] * (1.f - linit);
    for (int r = F.gw; r < MROWS; r += F.NGW) {
#pragma unroll
        for (int h = 0; h < 8; ++h) { const size_t o = (size_t)r * 512 + h * 64 + F.lane;
            const float s = bf2f(OFw[o]) + bf2f(OBw[o]); const float rstd = rsqrtf(wave_sum(s * s) * (1.f / 64.f) + EPS);
            const float z = bf2f(P1[(size_t)r * P1W + C_BZ + h * 64 + F.lane]);
            BR[(size_t)r * 1536 + 512 + h * 64 + F.lane] = (bf16_t)f2bf(s * rstd * gdn * siluf_(z)); }
#pragma unroll
        for (int h = 0; h < 4; ++h) { const bf16_t* d0 = DO + (size_t)r * 1024 + (2 * h) * 128, *d1 = d0 + 128;
            const float a0 = bf2f(d0[F.lane]) - lam * bf2f(d1[F.lane]), a1 = bf2f(d0[64 + F.lane]) - lam * bf2f(d1[64 + F.lane]);
            const float rstd = rsqrtf(wave_sum(a0 * a0 + a1 * a1) * (1.f / 128.f) + EPS);
            bf16_t* o = BR + (size_t)r * 1536 + 1024 + h * 128;
            o[F.lane] = (bf16_t)f2bf(a0 * rstd * gs0); o[64 + F.lane] = (bf16_t)f2bf(a1 * rstd * gs1); }
    }
}
__device__ __forceinline__ void phase_norm2_router(Frame& F, const Params& P, int l) {
    const float* modv = (const float*)(F.ws + WS_MODV) + (size_t)l * 3 * 6144; bf16_t* U = (bf16_t*)(F.ws + WS_C);
    const float* hlat = P.out; const float* hctx = (const float*)(F.ws + WS_HCTX);
    int* tope = (int*)(F.ws + WS_TOPE); float* topw = (float*)(F.ws + WS_TOPW); int* tops = (int*)(F.ws + WS_TOPS);
    LAS float* vS = (LAS float*)(F.lds + RING_OFF + F.wave * 16384);
    const float* wr = P.in[I_WRT] + (size_t)l * DM * NEXP; const float brt = P.in[I_BRT][l * NEXP + F.lane];
    const float* g2 = P.in[I_GN2] + l * DM;
    const int lane = F.lane;
    for (int r0 = F.gw * 4; r0 < MROWS; r0 += F.NGW * 4) {
#pragma unroll 1
        for (int q = 0; q < 4; ++q) { const int r = r0 + q; bool isctx; int b; const size_t off = hrow_off(r, isctx, b);
            const float* row = (isctx ? hctx : hlat) + off; float x[16]; load_row16(row, x, lane);
            const float* mv = modv + (isctx ? 2 : b) * 6144; const float* sc = mv + 4 * DM; const float* sh = mv + 3 * DM;
            float ss = 0.f;
#pragma unroll
            for (int i = 0; i < 16; ++i) ss += x[i] * x[i];
            const float rstd = rsqrtf(wave_sum(ss) * (1.f / DM) + EPS);
#pragma unroll
            for (int hf = 0; hf < 2; ++hf) { const int c0 = hf * 512 + lane * 8; float y[8];
#pragma unroll
                for (int j = 0; j < 8; ++j) { y[j] = x[hf * 8 + j] * rstd * g2[c0 + j] * (1.f + sc[c0 + j]) + sh[c0 + j]; vS[(c0 + j) * 4 + q] = y[j]; }
                v4u w; w.x = cvt_pk_bf16(y[0], y[1]); w.y = cvt_pk_bf16(y[2], y[3]); w.z = cvt_pk_bf16(y[4], y[5]); w.w = cvt_pk_bf16(y[6], y[7]);
                *(v4u*)(U + (size_t)r * DM + c0) = w; } }
        LDS_WAIT();
        float a0 = 0.f, a1 = 0.f, a2 = 0.f, a3 = 0.f;
#pragma unroll 8
        for (int k = 0; k < DM; ++k) { const float w = wr[k * NEXP + lane]; const f32x4 v = *(const LAS f32x4*)(vS + k * 4); a0 += v[0] * w; a1 += v[1] * w; a2 += v[2] * w; a3 += v[3] * w; }
        LDS_WAIT();
#pragma unroll 1
        for (int q = 0; q < 4; ++q) { const int r = r0 + q; const float lg = q == 0 ? a0 : (q == 1 ? a1 : (q == 2 ? a2 : a3));
            const float sc = 1.f / (1.f + expf(-lg)); const float sel = sc + brt;
            float m1 = sel;
#pragma unroll
            for (int o = 1; o < 8; o <<= 1) m1 = fmaxf(m1, __shfl_xor(m1, o));
            int fi = (sel == m1) ? lane : 999;
#pragma unroll
            for (int o = 1; o < 8; o <<= 1) fi = min(fi, __shfl_xor(fi, o));
            float m2 = (lane == fi) ? -INFINITY : sel;
#pragma unroll
            for (int o = 1; o < 8; o <<= 1) m2 = fmaxf(m2, __shfl_xor(m2, o));
            const float gs = m1 + m2; const int g = lane >> 3;
            int grank = 0;
#pragma unroll
            for (int gg = 0; gg < 8; ++gg) { const float o = __shfl(gs, gg * 8); grank += (o > gs || (o == gs && gg < g)) ? 1 : 0; }
            const float val = (grank < 4) ? sel : -INFINITY;
            int rank = 0;
#pragma unroll 8
            for (int e = 0; e < 64; ++e) { const float o = __shfl(val, e); rank += (o > val || (o == val && e < lane)) ? 1 : 0; }
            const bool selx = (grank < 4) && (rank < TOPK);
            const float wsum = wave_sum(selx ? sc : 0.f);
            const int half = r / TT;
            if (selx) { const int slot = atomicAdd((int*)(F.ctl + CW_ECNT + ((l * 2 + half) * NEXP1 + lane) * 16), 1);
                tope[(size_t)r * 8 + rank] = lane; topw[(size_t)r * 8 + rank] = sc / (wsum + 1e-20f) * 2.5f; tops[(size_t)r * 8 + rank] = slot; }
            if (lane == 0) { tope[(size_t)r * 8 + 6] = NEXP; topw[(size_t)r * 8 + 6] = 1.f; tops[(size_t)r * 8 + 6] = r - half * TT; }
        }
    }
}
__device__ __forceinline__ void moe_table(Frame& F, int l, int half, LAS int* ts, LAS int* te) {
    __syncthreads();
    if (F.tid == 0) { int acc = 0;
        for (int e = 0; e < NEXP1; ++e) { const int cnt = (e < NEXP) ? (int)__hip_atomic_load(F.ctl + CW_ECNT + ((l * 2 + half) * NEXP1 + e) * 16, RLX_AGENT) : TT; ts[e] = acc; const int n = (cnt + 255) / 256;
            for (int k = 0; k < n; ++k) te[acc + k] = e; acc += n; }
        ts[NEXP1] = acc; }
    __syncthreads();
}
__device__ __forceinline__ void phase_scatter(Frame& F, int l) {
    LAS int* ts = (LAS int*)(F.lds + MISC_OFF + 256); LAS int* te = (LAS int*)(F.lds + MISC_OFF + 3584);
    const int* tope = (const int*)(F.ws + WS_TOPE); const float* topw = (const float*)(F.ws + WS_TOPW); int* tops = (int*)(F.ws + WS_TOPS);
    for (int half = 0; half < 2; ++half) {
        moe_table(F, l, half, ts, te);
        int* rtok = (int*)(F.ws + WS_RTOK) + (size_t)half * HROWS_PAD; float* rw = (float*)(F.ws + WS_RW) + (size_t)half * HROWS_PAD;
        for (int r = half * TT + F.gw; r < (half + 1) * TT; r += F.NGW) {
            if (F.lane < 7) { const int e = tope[(size_t)r * 8 + F.lane]; const int pos = ts[e] * 256 + tops[(size_t)r * 8 + F.lane];
                rtok[pos] = r; rw[pos] = topw[(size_t)r * 8 + F.lane]; tops[(size_t)r * 8 + F.lane] = pos; } }
        for (int it = blockIdx.x * NTHREADS + F.tid; it < NEXP1 * 256; it += F.G * NTHREADS) { const int e = it >> 8, j = it & 255;
            const int cnt = (e < NEXP) ? (int)__hip_atomic_load(F.ctl + CW_ECNT + ((l * 2 + half) * NEXP1 + e) * 16, RLX_AGENT) : TT;
            const int rem = cnt & 255; if (rem != 0 && j >= rem) { const int pos = (ts[e] + (cnt >> 8)) * 256 + j; rtok[pos] = half * TT; rw[pos] = 0.f; } }
    }
}
__device__ __forceinline__ void phase_combine(Frame& F, const Params& P, int l, int half) {
    const float* modv = (const float*)(F.ws + WS_MODV) + (size_t)l * 3 * 6144; const float* modn = (const float*)(F.ws + WS_MODV) + (size_t)(l + 1) * 3 * 6144;
    float* hlat = P.out; float* hctx = (float*)(F.ws + WS_HCTX); bf16_t* U = (bf16_t*)(F.ws + WS_C);
    const bf16_t* Y = (const bf16_t*)(F.ws + WS_A); const int* tops = (const int*)(F.ws + WS_TOPS);
    const int lane = F.lane;
    for (int r = half * TT + F.gw; r < (half + 1) * TT; r += F.NGW) {
        bool isctx; int b; const size_t off = hrow_off(r, isctx, b);
        float* row = (isctx ? hctx : hlat) + off; float x[16]; load_row16(row, x, lane);
        float y[16];
#pragma unroll
        for (int i = 0; i < 16; ++i) y[i] = 0.f;
#pragma unroll
        for (int k = 0; k < 7; ++k) { const int pos = tops[(size_t)r * 8 + k]; const bf16_t* yr = Y + (size_t)pos * DM;
#pragma unroll
            for (int hf = 0; hf < 2; ++hf) { const v4u w = *(const v4u*)(yr + hf * 512 + lane * 8);
                y[hf * 8 + 0] += bflo(w.x); y[hf * 8 + 1] += bfhi(w.x); y[hf * 8 + 2] += bflo(w.y); y[hf * 8 + 3] += bfhi(w.y); y[hf * 8 + 4] += bflo(w.z); y[hf * 8 + 5] += bfhi(w.z); y[hf * 8 + 6] += bflo(w.w); y[hf * 8 + 7] += bfhi(w.w); } }
        const float* gt2 = modv + (isctx ? 2 : b) * 6144 + 5 * DM;
#pragma unroll
        for (int hf = 0; hf < 2; ++hf)
#pragma unroll
            for (int j = 0; j < 8; ++j) x[hf * 8 + j] += gt2[hf * 512 + lane * 8 + j] * y[hf * 8 + j];
        if (l + 1 < NLAYER) {
#pragma unroll
            for (int hf = 0; hf < 2; ++hf) { *(f32x4*)(row + hf * 512 + lane * 8) = (f32x4){x[hf * 8 + 0], x[hf * 8 + 1], x[hf * 8 + 2], x[hf * 8 + 3]}; *(f32x4*)(row + hf * 512 + lane * 8 + 4) = (f32x4){x[hf * 8 + 4], x[hf * 8 + 5], x[hf * 8 + 6], x[hf * 8 + 7]}; }
            const float* mv = modn + (isctx ? 2 : b) * 6144;
            modnorm_store(x, P.in[I_GN1] + (l + 1) * DM, mv + 1 * DM, mv + 0 * DM, U + (size_t)r * DM, lane);
        } else if (!isctx) {
            float ss = 0.f;
#pragma unroll
            for (int i = 0; i < 16; ++i) ss += x[i] * x[i];
            const float rstd = rsqrtf(wave_sum(ss) * (1.f / DM) + EPS); const float* gf = P.in[I_GFIN];
#pragma unroll
            for (int hf = 0; hf < 2; ++hf) { const int c0 = hf * 512 + lane * 8;
                *(f32x4*)(row + c0) = (f32x4){x[hf * 8 + 0] * rstd * gf[c0 + 0], x[hf * 8 + 1] * rstd * gf[c0 + 1], x[hf * 8 + 2] * rstd * gf[c0 + 2], x[hf * 8 + 3] * rstd * gf[c0 + 3]};
                *(f32x4*)(row + c0 + 4) = (f32x4){x[hf * 8 + 4] * rstd * gf[c0 + 4], x[hf * 8 + 5] * rstd * gf[c0 + 5], x[hf * 8 + 6] * rstd * gf[c0 + 6], x[hf * 8 + 7] * rstd * gf[c0 + 7]}; }
        }
    }
}
#if defined(MK_DEBUG)
__global__ void chk_bf16(const bf16_t* buf, long rows, int cols, int pitch, unsigned* word, unsigned bit) {
    bool bad = false;
    for (long i = blockIdx.x * (long)blockDim.x + threadIdx.x; i < rows * cols; i += (long)gridDim.x * blockDim.x) { const long r = i / cols; const int c = (int)(i % cols);
        const unsigned short v = buf[r * pitch + c]; if ((v & 0x7f80u) == 0x7f80u) bad = true; }
    if (bad) atomicOr(word, bit);
}
__global__ void chk_f32(const float* buf, long n, unsigned* word, unsigned bit) {
    bool bad = false;
    for (long i = blockIdx.x * (long)blockDim.x + threadIdx.x; i < n; i += (long)gridDim.x * blockDim.x) { const unsigned v = __float_as_uint(buf[i]); if ((v & 0x7f800000u) == 0x7f800000u) bad = true; }
    if (bad) atomicOr(word, bit);
}
__global__ void dbg_fill(float* out, long n, const unsigned* word) {
    const float a = 1.0f + (float)(*word);
    for (long i = blockIdx.x * (long)blockDim.x + threadIdx.x; i < n; i += (long)gridDim.x * blockDim.x) out[i] = a;
}
#endif
constexpr int NU_DN = 32, NU_GQA = 1024, NU_DIFF = 2048, NU_GQAC = 16, NU_DIFFC = 32, NU_TOTAL = NU_DN + NU_GQA + NU_DIFF + NU_GQAC + NU_DIFFC;
__device__ __forceinline__ void phase_mix(Frame& F, const Params& P, int l) {
    bf16_t* P1 = (bf16_t*)(F.ws + WS_A); bf16_t* BR = (bf16_t*)(F.ws + WS_B); bf16_t* DO = (bf16_t*)(F.ws + WS_D);
    bf16_t* OFw = DO + (size_t)MROWS * 1024; bf16_t* OBw = OFw + (size_t)MROWS * 512;
    gu32* qc = F.ctl + CW_QUEUE + 64 * l;
    for (;;) {
        __syncthreads();
        if (F.tid == 0) F.MISC[16] = __hip_atomic_fetch_add(qc, 1u, RLX_AGENT);
        __syncthreads();
        const int u = __builtin_amdgcn_readfirstlane((int)F.MISC[16]);
        if (u >= NU_TOTAL) break;
#ifndef NO_DN
        if (u < NU_DN) {
            dn::Chain ch; const int b = u >> 4, h = (u >> 1) & 7, dir = u & 1;
            ch.P1b = P1 + (size_t)b * TT * P1W; ch.Ob = (dir ? OBw : OFw) + (size_t)b * TT * 512; ch.h = h; ch.dir = dir;
            ch.Aexp = expf(P.in[I_ALOG][l * 16 + dir * 8 + h]); ch.dtb = P.in[I_DTB][l * 16 + dir * 8 + h];
            ch.ring = F.ws + WS_RING + (size_t)u * 12 * RING_SLOT; ch.dbg = (unsigned*)(F.ws + WS_CTL) + 64;
            dn::chain_unit(ch, P.in[I_WCONV] + (size_t)l * 3 * 1536, F.lds + RING_OFF, (LAS float*)(F.lds + MISC_OFF + 1024), F.wave);
            continue;
        }
#endif
#ifndef NO_ATTN
        int b, qrow, nt, qcol, kcol, vcol, ocol, op; bf16_t* obase;
        if (u < NU_DN + NU_GQA) { const int idx = u - NU_DN; b = idx >> 9; const int rem = idx & 511, kvh = rem >> 8, hq = (rem >> 6) & 3, qb = rem & 63, h = kvh * 4 + hq;
            qrow = CTXL + qb * 256; nt = TT / 64; qcol = C_AQ + h * 64; kcol = C_AK + kvh * 64; vcol = C_AV + kvh * 64; obase = BR; op = 1536; ocol = h * 64; }
        else if (u < NU_DN + NU_GQA + NU_DIFF) { const int idx = u - NU_DN - NU_GQA; b = idx >> 10; const int rem = idx & 1023, hc = rem >> 7, vh = (rem >> 6) & 1, qb = rem & 63;
            qrow = CTXL + qb * 256; nt = TT / 64; qcol = C_CQ + hc * 64; kcol = C_CK + hc * 64; vcol = C_CV + (hc >> 1) * 128 + vh * 64; obase = DO; op = 1024; ocol = hc * 128 + vh * 64; }
        else if (u < NU_DN + NU_GQA + NU_DIFF + NU_GQAC) { const int idx = u - NU_DN - NU_GQA - NU_DIFF; b = idx >> 3; const int h = idx & 7, kvh = h >> 2;
            qrow = 0; nt = CTXL / 64; qcol = C_AQ + h * 64; kcol = C_AK + kvh * 64; vcol = C_AV + kvh * 64; obase = BR; op = 1536; ocol = h * 64; }
        else { const int idx = u - NU_DN - NU_GQA - NU_DIFF - NU_GQAC; b = idx >> 4; const int rem = idx & 15, hc = rem >> 1, vh = rem & 1;
            qrow = 0; nt = CTXL / 64; qcol = C_CQ + hc * 64; kcol = C_CK + hc * 64; vcol = C_CV + (hc >> 1) * 128 + vh * 64; obase = DO; op = 1024; ocol = hc * 128 + vh * 64; }
        const bf16_t* pb = P1 + (size_t)b * TT * P1W;
        attn_body::attn_unit<8>((const attn_body::bf16*)(pb + (size_t)qrow * P1W + qcol), P1W, (const attn_body::bf16*)(pb + kcol), P1W, (const attn_body::bf16*)(pb + vcol), P1W,
                                (attn_body::bf16*)(obase + ((size_t)b * TT + qrow) * op + ocol), op, nt, (char*)F.lds + RING_OFF, F.wave);
#endif
    }
}

#ifndef MK_PHMASK
#define MK_PHMASK 0xFFFFF
#endif
#define PHEN(k) (((MK_PHMASK) >> (k)) & 1)
constexpr int NPH_LAYER = 15, NPHASES = 2 + NLAYER * NPH_LAYER;
#define IN(k) (lo <= (k) && (k) < hi)
#define SEAM(k) do { if (IN(k) && IN((k) + 1)) { F.lane = hw_lane(); xcd_barrier(bar, F.wave == 0 && F.lane == 0); } F.lane = hw_lane(); F.tid = F.wave * 64 + F.lane; { unsigned char* w_ = P.ws; asm volatile("" : "+s"(w_)); F.ws = w_; F.ctl = (gu32*)(w_ + WS_CTL); } } while (0)
#define U ((bf16_t*)(F.ws + WS_C))
#define RA ((bf16_t*)(F.ws + WS_A))
#define BR ((bf16_t*)(F.ws + WS_B))
#define G2 RA
#define Mm (RA + (size_t)MROWS * GW)
#define Hs ((bf16_t*)(F.ws + WS_D))
#define Yb RA
#define WGU ((bf16_t*)(F.ws + WS_B))
#define WD (WGU + (size_t)NEXP1 * 512 * DM)
template <int l, int half> __device__ __forceinline__ void moe_half(Frame& F, const Params& P, const XcdBarrier& bar, int lo, int hi) {
    constexpr int pb = 2 + NPH_LAYER * l;
    LAS int* const ts = (LAS int*)(F.lds + MISC_OFF + 256); LAS int* const te = (LAS int*)(F.lds + MISC_OFF + 3584);
    constexpr int hb = pb + 9 + 3 * half;
            if (PHEN(9) && IN(hb + 0)) {
                moe_table(F, l, half, ts, te);
                pg8::Gemm g{U, WGU, DM, DM, DM, (const int*)(F.ws + WS_RTOK) + (size_t)half * HROWS_PAD}; pg8::MoeOrder S{ts, te, 2, F.G, (int)blockIdx.x};
                pg8::EpiMoe1 E{Hs, (const float*)(F.ws + WS_RW) + (size_t)half * HROWS_PAD};
                pg8::gemm_phase<pg8::EpiMoe1, pg8::MoeOrder, true>(F.lds + RING_OFF, g, S, E, F.wave);
            } SEAM(hb + 0);
            if (PHEN(10) && IN(hb + 1)) {
                moe_table(F, l, half, ts, te);
                pg8::Gemm g{Hs, WD, FF, FF, FF, nullptr}; pg8::MoeOrder S{ts, te, 4, F.G, (int)blockIdx.x};
                pg8::EpiBf16<0> E{Yb, DM};
                pg8::gemm_phase<pg8::EpiBf16<0>, pg8::MoeOrder, false>(F.lds + RING_OFF, g, S, E, F.wave);
            } SEAM(hb + 1);
            if (PHEN(11) && IN(hb + 2)) { phase_combine(F, P, l, half); if (half == 1 && l + 1 < NLAYER) { __syncthreads(); convert_small(F, P, l + 1); } } SEAM(hb + 2);
}
template <int l> __device__ __forceinline__ void layer_phases(Frame& F, const Params& P, const XcdBarrier& bar, int lo, int hi) {
    constexpr int pb = 2 + NPH_LAYER * l;
        if (PHEN(0) && IN(pb + 0)) {
            pg8::Gemm g{U, (const bf16_t*)(F.ws + WS_WB1), DM, DM, DM, nullptr}; pg8::DenseOrder S; S.init(MROWS / 256, P1W / 256, F.G, (int)blockIdx.x);
            pg8::EpiBf16<0> E{RA, P1W};
            pg8::gemm_phase<pg8::EpiBf16<0>, pg8::DenseOrder, false>(F.lds + RING_OFF, g, S, E, F.wave);
        } SEAM(pb + 0);
        if (PHEN(1) && IN(pb + 1)) { phase_prep(F, P, l); } SEAM(pb + 1);
        if (PHEN(2) && IN(pb + 2)) { phase_mix(F, P, l); } SEAM(pb + 2);
        if (PHEN(3) && IN(pb + 3)) { phase_post(F, P, l); } SEAM(pb + 3);
        if (PHEN(4) && IN(pb + 4)) {
            pg8::Gemm g{U, (const bf16_t*)(F.ws + WS_WB2), DM, DM, DM, nullptr}; pg8::DenseOrder S; S.init(MROWS / 256, GW / 256, F.G, (int)blockIdx.x);
            pg8::EpiBf16<1> E{G2, GW};
            pg8::gemm_phase<pg8::EpiBf16<1>, pg8::DenseOrder, false>(F.lds + RING_OFF, g, S, E, F.wave);
        } SEAM(pb + 4);
        if (PHEN(5) && IN(pb + 5)) {
#pragma unroll 1
            for (int br = 0; br < 3; ++br) {
                pg8::Gemm g{BR + br * 512, (const bf16_t*)(F.ws + WS_WBR) + (size_t)br * DM * 512, 1536, 512, 512, nullptr}; pg8::DenseOrder S; S.init(MROWS / 256, DM / 256, F.G, (int)blockIdx.x);
                pg8::EpiMerge E{Mm, G2, br * DM, br == 0 ? 1 : 0};
                pg8::gemm_phase<pg8::EpiMerge, pg8::DenseOrder, false>(F.lds + RING_OFF, g, S, E, F.wave);
            }
        } SEAM(pb + 5);
        if (PHEN(6) && IN(pb + 6)) {
            pg8::Gemm g{Mm, (const bf16_t*)(F.ws + WS_WOT), DM, DM, DM, nullptr}; pg8::DenseOrder S; S.init(MROWS / 256, DM / 256, F.G, (int)blockIdx.x);
            pg8::EpiResid E{l == 0 ? P.in[I_X] : P.out, l == 0 ? P.in[I_CTX] : (const float*)(F.ws + WS_HCTX), P.out, (float*)(F.ws + WS_HCTX), (const float*)(F.ws + WS_MODV) + (size_t)l * 3 * 6144, 2};
            pg8::gemm_phase<pg8::EpiResid, pg8::DenseOrder, false>(F.lds + RING_OFF, g, S, E, F.wave);
        } SEAM(pb + 6);
        if (PHEN(7) && IN(pb + 7)) { convert_experts(F, P, l); __syncthreads(); phase_norm2_router(F, P, l); } SEAM(pb + 7);
        if (PHEN(8) && IN(pb + 8)) { phase_scatter(F, l); } SEAM(pb + 8);
    moe_half<l, 0>(F, P, bar, lo, hi);
    moe_half<l, 1>(F, P, bar, lo, hi);
}
#undef IN
#undef SEAM
#undef U
#undef RA
#undef BR
#undef G2
#undef Mm
#undef Hs
#undef Yb
#undef WGU
#undef WD
__global__ void __launch_bounds__(NTHREADS, 2) fwd_kernel(Params P) {
    extern __shared__ __attribute__((aligned(16))) unsigned char lds_raw[];
    Frame F;
    F.lds = (LAS unsigned char*)lds_raw; F.MISC = (volatile LAS unsigned*)(F.lds + MISC_OFF);
    F.wave = __builtin_amdgcn_readfirstlane((int)threadIdx.x >> 6); F.lane = hw_lane(); F.tid = F.wave * 64 + F.lane; F.G = gridDim.x;
    F.gw = blockIdx.x * NWAVES + F.wave; F.NGW = F.G * NWAVES; F.ws = P.ws; F.ctl = (gu32*)(P.ws + WS_CTL);
    for (int u = F.tid; u < 64; u += NTHREADS) F.MISC[u] = 0u;
    __syncthreads();
    XcdBarrier bar; bar.bar = (unsigned*)(F.ctl + CW_BAR); bar.x = 0; bar.st = nullptr;
    if (P.use_bar) bar = xcd_barrier_post((unsigned*)(F.ctl + CW_BAR), F.MISC + 8, F.tid == 0);
    const int lo = P.ph_lo, hi = P.ph_hi;
#define IN(k) (lo <= (k) && (k) < hi)
#define SEAM(k) do { if (IN(k) && IN((k) + 1)) { F.lane = hw_lane(); xcd_barrier(bar, F.wave == 0 && F.lane == 0); } F.lane = hw_lane(); F.tid = F.wave * 64 + F.lane; { unsigned char* w_ = P.ws; asm volatile("" : "+s"(w_)); F.ws = w_; F.ctl = (gu32*)(w_ + WS_CTL); } } while (0)
    LAS int* const ts = (LAS int*)(F.lds + MISC_OFF + 256); LAS int* const te = (LAS int*)(F.lds + MISC_OFF + 3584);

    if (PHEN(15) && IN(0)) { convert_small(F, P, 0); compute_mod(F, P); } SEAM(0);
    if (PHEN(16) && IN(1)) { phase_norm1(F, P); } SEAM(1);
    layer_phases<0>(F, P, bar, lo, hi);
    layer_phases<1>(F, P, bar, lo, hi);
#undef IN
#undef SEAM
}

#ifndef MK_MULTI
#define MK_MULTI 1
#endif
extern "C" void kernel_launch(void* const* d_in, const int* in_sizes, int n_in, void* d_out, int out_size, void* d_ws, size_t ws_size, hipStream_t stream) {
    static int grid = 0;
    if (grid == 0) {
        if (n_in != 28 || out_size != NB * SEQ * DM || ws_size < WS_END) { fprintf(stderr, "kernel_launch: unexpected shapes (n_in %d out %d ws %zu need %zu); nothing launched\n", n_in, out_size, ws_size, (size_t)WS_END); grid = -1; return; }
        int dev = 0, cus = 0;
        if (hipGetDevice(&dev) != hipSuccess || hipDeviceGetAttribute(&cus, hipDeviceAttributeMultiprocessorCount, dev) != hipSuccess) { grid = -1; return; }
        if (hipFuncSetAttribute((const void*)fwd_kernel, hipFuncAttributeMaxDynamicSharedMemorySize, LDS_BYTES) != hipSuccess) { fprintf(stderr, "kernel_launch: hipFuncSetAttribute failed\n"); grid = -1; return; }
        int per_cu = 0;
        if (hipOccupancyMaxActiveBlocksPerMultiprocessor(&per_cu, (const void*)fwd_kernel, NTHREADS, LDS_BYTES) != hipSuccess || per_cu < 1) fprintf(stderr, "kernel_launch: occupancy query reports %d\n", per_cu);
        (void)hipGetLastError();
        grid = cus;
    }
    if (grid < 0) return;
    (void)hipMemsetAsync((char*)d_ws + WS_CTL, 0, CTL_ZERO_BYTES, stream);
    Params p{};
    for (int i = 0; i < 28; ++i) p.in[i] = (const float*)d_in[i];
    p.out = (float*)d_out; p.ws = (unsigned char*)d_ws;
#ifndef MK_NPH_RUN
#define MK_NPH_RUN NPHASES
#endif
#if MK_MULTI
    for (int k = 0; k < MK_NPH_RUN; ++k) { p.ph_lo = k; p.ph_hi = k + 1; p.use_bar = 0; hipLaunchKernelGGL(fwd_kernel, dim3(grid), dim3(NTHREADS), LDS_BYTES, stream, p);
#if defined(MK_DEBUG)
        unsigned* dw = (unsigned*)((char*)d_ws + WS_CTL) + 64; unsigned char* w = (unsigned char*)d_ws;
#if MK_DEBUG == 1
        if (k == 3) hipLaunchKernelGGL(chk_bf16, dim3(1024), dim3(256), 0, stream, (const bf16_t*)(w + WS_A), (long)MROWS, 4384, P1W, dw, 1u);
        if (k == 4) { hipLaunchKernelGGL(chk_bf16, dim3(1024), dim3(256), 0, stream, (const bf16_t*)(w + WS_B), (long)MROWS, 512, 1536, dw, 2u);
                      hipLaunchKernelGGL(chk_bf16, dim3(1024), dim3(256), 0, stream, (const bf16_t*)(w + WS_D), (long)MROWS, 1024, 1024, dw, 4u);
                      hipLaunchKernelGGL(chk_bf16, dim3(1024), dim3(256), 0, stream, (const bf16_t*)(w + WS_D) + (size_t)MROWS * 1024, (long)MROWS, 1024, 1024, dw, 8u); }
        if (k == 7) hipLaunchKernelGGL(chk_bf16, dim3(1024), dim3(256), 0, stream, (const bf16_t*)(w + WS_A) + (size_t)MROWS * GW, (long)MROWS, 1024, 1024, dw, 16u);
#endif
#endif
    }
#if defined(MK_DEBUG)
    hipLaunchKernelGGL(dbg_fill, dim3(1024), dim3(256), 0, stream, (float*)d_out, (long)NB * SEQ * DM, (const unsigned*)((char*)d_ws + WS_CTL) + 64);
#endif
#else
    p.ph_lo = 0; p.ph_hi = NPHASES; p.use_bar = 1;
    hipLaunchKernelGGL(fwd_kernel, dim3(grid), dim3(NTHREADS), LDS_BYTES, stream, p);
#endif
}
```

```cpp
#define MK_MULTI 0
#include <hip/hip_runtime.h>
#include <hip/hip_bf16.h>
#include <cstdio>
#include <cstdint>
#include <cmath>

constexpr int DM = 1024, NB = 2, SEQ = 16384, CTXL = 256, TT = SEQ + CTXL  , MROWS = NB * TT  ;
constexpr int NLAYER = 2, GRIDW = 64;
constexpr int P1W = 4608;
constexpr int GW = 3072;
constexpr int INW = 7456;
constexpr int C_AQ = 0, C_AK = 512, C_AV = 640, C_BQKV = 768, C_BZ = 2304, C_BA = 2816, C_BB = 2832, C_CQ = 2848, C_CK = 3360, C_CV = 3872, C_GATE = 4384;
constexpr int NEXP = 64, NEXP1 = 65  , TOPK = 6, FF = 256;
constexpr int HROWS = TT * 7 + NEXP1 * 255;
constexpr int HROWS_PAD = 133120;
constexpr float EPS = 1e-6f;
constexpr float QSCALE = 0.125f * 1.4426950408889634f;

constexpr size_t MiB = 1u << 20;
constexpr size_t WS_CTL = 0, CTL_ZERO_BYTES = 1 * MiB;
constexpr size_t WS_MODV = 1 * MiB;
constexpr size_t WS_HCTX = 2 * MiB;
constexpr size_t WS_TOPE = 4 * MiB;
constexpr size_t WS_TOPW = WS_TOPE + (size_t)MROWS * 32;
constexpr size_t WS_TOPS = WS_TOPW + (size_t)MROWS * 32;
constexpr size_t WS_RTOK = WS_TOPS + (size_t)MROWS * 32;
constexpr size_t WS_RW = WS_RTOK + (size_t)2 * HROWS_PAD * 4;
constexpr size_t WS_SMALL_END = WS_RW + (size_t)2 * HROWS_PAD * 4;
constexpr size_t WS_WB1 = 10 * MiB;
constexpr size_t WS_WB2 = WS_WB1 + (size_t)P1W * DM * 2;
constexpr size_t WS_WBR = WS_WB2 + (size_t)GW * DM * 2;
constexpr size_t WS_WOT = WS_WBR + (size_t)3 * DM * 512 * 2;
constexpr size_t WS_A = 30 * MiB;
constexpr size_t SZ_A = (size_t)MROWS * P1W * 2;
constexpr size_t WS_B = WS_A + SZ_A;
constexpr size_t SZ_B = (size_t)MROWS * 1536 * 2;
constexpr size_t WS_C = WS_B + SZ_B;
constexpr size_t SZ_C = (size_t)MROWS * DM * 2;
constexpr size_t WS_D = WS_C + SZ_C;
constexpr size_t SZ_D = (size_t)MROWS * 2048 * 2;
constexpr size_t WS_RING = WS_D + SZ_D;
constexpr int RING_SLOT = 40960;
constexpr size_t SZ_RING = (size_t)32 * 12 * RING_SLOT;
constexpr size_t WS_END = WS_RING + SZ_RING;
static_assert(WS_SMALL_END <= WS_WB1 && WS_WOT + (size_t)DM * DM * 2 <= WS_A, "ws map");
static_assert((size_t)MROWS * GW * 2 + (size_t)MROWS * DM * 2 <= SZ_A && (size_t)HROWS_PAD * DM * 2 <= SZ_A, "region A overlays");
static_assert((size_t)NEXP1 * 3 * DM * FF * 2 <= SZ_B && (size_t)HROWS_PAD * FF * 2 <= SZ_D, "region B/D overlays");
constexpr int CW_TMO = 0;
constexpr int CW_BAR = 4096;
constexpr int CW_QUEUE = 16384;
constexpr int CW_ECNT = 32768;

constexpr int RING_OFF = 0, RING_BYTES = 139264;
constexpr int MISC_OFF = RING_BYTES;
constexpr int LDS_BYTES = 147456;
constexpr int NWAVES = 8, NTHREADS = 512;

#define GAS __attribute__((address_space(1)))
#define LAS __attribute__((address_space(3)))
typedef unsigned short bf16_t;
typedef unsigned v4u __attribute__((ext_vector_type(4)));
typedef unsigned v2u __attribute__((ext_vector_type(2)));
typedef float f32x4 __attribute__((ext_vector_type(4)));
typedef float f32x2 __attribute__((ext_vector_type(2)));
typedef float f32x16 __attribute__((ext_vector_type(16)));
typedef short bf16x8 __attribute__((ext_vector_type(8)));
typedef short s16x4 __attribute__((ext_vector_type(4)));
typedef GAS unsigned gu32;
#define RLX_AGENT __ATOMIC_RELAXED, __HIP_MEMORY_SCOPE_AGENT
#define LDS_WAIT() asm volatile("s_waitcnt lgkmcnt(0)" ::: "memory")
#define VM_WAIT() asm volatile("s_waitcnt vmcnt(0)" ::: "memory")
__device__ __forceinline__ unsigned f2bf(float f) { unsigned u = __builtin_bit_cast(unsigned, f); return (u + 0x7fffu + ((u >> 16) & 1u)) >> 16; }
__device__ __forceinline__ unsigned pk2(float lo, float hi) { return f2bf(lo) | (f2bf(hi) << 16); }
__device__ __forceinline__ float bf2f(unsigned short b) { return __builtin_bit_cast(float, (unsigned)b << 16); }
__device__ __forceinline__ float bflo(unsigned w) { return __builtin_bit_cast(float, w << 16); }
__device__ __forceinline__ float bfhi(unsigned w) { return __builtin_bit_cast(float, w & 0xffff0000u); }
typedef __bf16 bf16x2_t_ __attribute__((ext_vector_type(2)));
__device__ __forceinline__ unsigned cvt_pk_bf16(float lo, float hi) { unsigned r; asm volatile("v_cvt_pk_bf16_f32 %0, %1, %2" : "=v"(r) : "v"(lo), "v"(hi)); return r; }
__device__ __forceinline__ unsigned cvt_pk_bf16_safe(float lo, float hi) { f32x2 v = {lo, hi}; bf16x2_t_ b = __builtin_convertvector(v, bf16x2_t_); return __builtin_bit_cast(unsigned, b); }
__device__ __forceinline__ float wave_sum(float v) {
#pragma unroll
    for (int o = 1; o < 64; o <<= 1) v += __shfl_xor(v, o);
    return v;
}
__device__ __forceinline__ float sigmoidf_(float x) { return 1.f / (1.f + __expf(-x)); }
__device__ __forceinline__ float siluf_(float x) { return x / (1.f + __expf(-x)); }
__device__ __forceinline__ int hw_lane() { int l; asm volatile("v_mbcnt_lo_u32_b32 %0, -1, 0\n\tv_mbcnt_hi_u32_b32 %0, -1, %0" : "=v"(l)); return l; }
#define XB_TMO      128
#define XB_XCNT(j)  (256  + 64 * (j))
#define XB_XSUB(j)  (1280 + 64 * (j))
#define XB_XGEN(j)  (2304 + 64 * (j))
#define XB_TOP      3328
#define XB_TOPGEN   3392
#define XCD_BAR_WORDS 3456
#define XB_SPIN_CAP (1u << 18)

__device__ __forceinline__ unsigned xb_ld(unsigned* p)              { return __hip_atomic_load(p, __ATOMIC_RELAXED, __HIP_MEMORY_SCOPE_AGENT); }
__device__ __forceinline__ unsigned xb_add(unsigned* p, unsigned v) { return __hip_atomic_fetch_add(p, v, __ATOMIC_RELAXED, __HIP_MEMORY_SCOPE_AGENT); }
__device__ __forceinline__ unsigned xb_xcc_id() { return (unsigned)__builtin_amdgcn_s_getreg((3 << 11) | 20) & 0xFu; }
#define XB_SPIN(cond, bar) do { unsigned _sp = 0; while (cond) { __builtin_amdgcn_s_sleep(1); \
    if ((++_sp & 255u) == 0u) { if (xb_ld(&(bar)[XB_TMO])) break; if (_sp > XB_SPIN_CAP) { atomicAdd(&(bar)[XB_TMO], 1u); break; } } } } while (0)

struct XcdBarrier {
    unsigned* bar; unsigned x;
    volatile LAS unsigned* st;
};

__device__ __forceinline__ XcdBarrier xcd_barrier_post(unsigned* bar, volatile LAS unsigned* st, bool is_t0) {
    XcdBarrier b; b.bar = bar; b.x = xb_xcc_id(); b.st = st;
    if (is_t0) (void)xb_add(&bar[XB_XCNT(b.x)], 1u);
    return b;
}
__device__ __forceinline__ void xcd_barrier_complete(unsigned* bar, unsigned x, unsigned& nloc, unsigned& nx) {
    const unsigned G = gridDim.x * gridDim.y * gridDim.z;
    unsigned sum, cnt, mine, sp = 0u;
    for (;;) {
        sum = 0u; cnt = 0u; mine = 0u;
#pragma unroll
        for (unsigned j = 0; j < 16; ++j) { const unsigned c = xb_ld(&bar[XB_XCNT(j)]); sum += c; cnt += (c > 0u) ? 1u : 0u; mine = (j == x) ? c : mine; }
        if (sum == G) break;
        __builtin_amdgcn_s_sleep(1);
        if ((++sp & 255u) == 0u) { if (xb_ld(&bar[XB_TMO])) break; if (sp > XB_SPIN_CAP) { atomicAdd(&bar[XB_TMO], 1u); break; } }
    }
    nloc = mine > 0u ? mine : 1u; nx = cnt > 0u ? cnt : 1u;
}

__device__ __forceinline__ void xcd_barrier(const XcdBarrier& b, bool is_t0) {
    asm volatile("s_waitcnt vmcnt(0)" ::: "memory");
    __syncthreads();
    if (is_t0) {
        unsigned* bar = b.bar;
        __builtin_amdgcn_s_waitcnt(0);
        unsigned nloc = b.st[0], nx = b.st[1];
        if (nloc == 0u) { xcd_barrier_complete(bar, b.x, nloc, nx); b.st[0] = nloc; b.st[1] = nx; }
        const unsigned old = xb_add(&bar[XB_XSUB(b.x)], 1u);
        const unsigned gen = old / nloc;
        if (old + 1u == (gen + 1u) * nloc) {
            __builtin_amdgcn_fence(__ATOMIC_RELEASE, "agent");
            asm volatile("s_waitcnt vmcnt(0)" ::: "memory");
            const unsigned og = xb_add(&bar[XB_TOP], 1u);
            const unsigned tg = og / nx;
            if (og + 1u == (tg + 1u) * nx) xb_add(&bar[XB_TOPGEN], 1u);
            else XB_SPIN(xb_ld(&bar[XB_TOPGEN]) == tg, bar);
            __builtin_amdgcn_fence(__ATOMIC_ACQUIRE, "agent");
            xb_add(&bar[XB_XGEN(b.x)], 1u);
            asm volatile("s_waitcnt vmcnt(0)" ::: "memory");
        } else {
            XB_SPIN(xb_ld(&bar[XB_XGEN(b.x)]) == gen, bar);
            __builtin_amdgcn_fence(__ATOMIC_ACQUIRE, "agent");
            asm volatile("s_waitcnt vmcnt(0)" ::: "memory");
        }
    }
    __syncthreads();
}
namespace pg8 {
constexpr int BM = 256, BK = 64, HALF = 128, HTB = HALF * BK * 2  , STAGE_BYTES = 8 * HTB, NXCD = 8, WGM = 8;
__host__ __device__ __forceinline__ int lds_byte(int r, int c) { const int st = (r >> 4) * 2 + (c >> 5), rr = r & 15, cc = c & 31, ob = rr * 64 + cc * 2; return st * 1024 + (ob ^ (((ob >> 9) & 1) << 5)); }
__host__ __device__ __forceinline__ void stage_rc(int b, int& R, int& C) { const int st = b / 1024, sb = b % 1024, swz = sb ^ (((sb >> 9) & 1) << 5); R = (st >> 1) * 16 + swz / 64; C = (st & 1) * 32 + (swz % 64) / 2; }
__host__ __device__ __forceinline__ int perm32(int rho) { const int n = rho >> 4, i = rho & 15; return 8 * (i >> 2) + 4 * n + (i & 3); }

struct Unit { int pm, pn, em, en, ex; };
struct Gemm { const bf16_t* A; const bf16_t* Bt; int lda, ldb, K; const int* rowlist; };

struct DenseOrder {
    int nM, nN, nwg, G, c;
    __device__ void init(int nM_, int nN_, int G_, int c_) { nM = nM_; nN = nN_; nwg = nM * nN; G = G_; c = c_; }
    __device__ bool next(int i, Unit& u) const {
        const int L = i * G + c; if (L >= nwg) return false;
        int wgid = L; { const int q = nwg / NXCD, r = nwg % NXCD, xcd = wgid % NXCD, off = wgid / NXCD; wgid = (xcd < r ? xcd * (q + 1) : r * (q + 1) + (xcd - r) * q) + off; }
        const int nig = WGM * nN, gid = wgid / nig, fm = gid * WGM, gsz = (nM - fm) < WGM ? (nM - fm) : WGM;
        u.pm = fm + ((wgid % nig) % gsz); u.pn = (wgid % nig) / gsz; u.em = u.pm; u.en = u.pn; u.ex = 0; return true;
    }
};
struct MoeOrder {
    const LAS int* tstart; const LAS int* texp; int nN, G, c;
    __device__ bool next(int i, Unit& u) const {
        const int L = i * G + c; const int total = tstart[NEXP1];
        if (L >= total * nN) return false;
        const int rt = L / nN, pn = L - rt * nN;
        const int e = texp[rt];
        u.pm = rt; u.pn = e * nN + pn; u.em = rt; u.en = pn; u.ex = e; return true;
    }
};

template <int ACT  > struct EpiBf16 {
    static constexpr bool PERM = true;
    bf16_t* O; int ldc;
    __device__ __forceinline__ void operator()(const f32x4 (&acc)[2][2][4][2], const Unit& u, int wr, int wc, int fr, int fq) const {
        const int row0 = u.em * BM + wr * 64 + fr; const int col0 = u.en * BM + wc * 32 + 8 * fq;
#pragma unroll
        for (int ai = 0; ai < 2; ++ai)
#pragma unroll
            for (int m = 0; m < 4; ++m) { bf16_t* rowp = O + (size_t)(row0 + ai * HALF + m * 16) * ldc + col0;
#pragma unroll
                for (int bj = 0; bj < 2; ++bj) { f32x4 v0 = acc[ai][bj][m][0], v1 = acc[ai][bj][m][1];
                    if (ACT == 1) {
#pragma unroll
                        for (int j = 0; j < 4; ++j) { v0[j] = sigmoidf_(v0[j]); v1[j] = sigmoidf_(v1[j]); } }
                    v4u w; w.x = cvt_pk_bf16(v0[0], v0[1]); w.y = cvt_pk_bf16(v0[2], v0[3]); w.z = cvt_pk_bf16(v1[0], v1[1]); w.w = cvt_pk_bf16(v1[2], v1[3]);
                    *(v4u*)(rowp + bj * HALF) = w; } }
    }
};
struct EpiMerge {
    static constexpr bool PERM = true;
    bf16_t* Mo; const bf16_t* G; int goff; int first;
    __device__ __forceinline__ void operator()(const f32x4 (&acc)[2][2][4][2], const Unit& u, int wr, int wc, int fr, int fq) const {
        const int row0 = u.em * BM + wr * 64 + fr; const int col0 = u.en * BM + wc * 32 + 8 * fq;
#pragma unroll
        for (int ai = 0; ai < 2; ++ai)
#pragma unroll
            for (int m = 0; m < 4; ++m) { const size_t r = (size_t)(row0 + ai * HALF + m * 16);
#pragma unroll
                for (int bj = 0; bj < 2; ++bj) { const f32x4 v0 = acc[ai][bj][m][0], v1 = acc[ai][bj][m][1];
                    const v4u gw = *(const v4u*)(G + r * GW + goff + col0 + bj * HALF);
                    bf16_t* mp = Mo + r * DM + col0 + bj * HALF;
                    float o[8];
                    o[0] = bflo(gw.x) * v0[0]; o[1] = bfhi(gw.x) * v0[1]; o[2] = bflo(gw.y) * v0[2]; o[3] = bfhi(gw.y) * v0[3];
                    o[4] = bflo(gw.z) * v1[0]; o[5] = bfhi(gw.z) * v1[1]; o[6] = bflo(gw.w) * v1[2]; o[7] = bfhi(gw.w) * v1[3];
                    if (!first) { const v4u pw = *(const v4u*)mp;
                        o[0] += bflo(pw.x); o[1] += bfhi(pw.x); o[2] += bflo(pw.y); o[3] += bfhi(pw.y); o[4] += bflo(pw.z); o[5] += bfhi(pw.z); o[6] += bflo(pw.w); o[7] += bfhi(pw.w); }
                    v4u w; w.x = cvt_pk_bf16(o[0], o[1]); w.y = cvt_pk_bf16(o[2], o[3]); w.z = cvt_pk_bf16(o[4], o[5]); w.w = cvt_pk_bf16(o[6], o[7]);
                    *(v4u*)mp = w; } }
    }
};
struct EpiResid {
    static constexpr bool PERM = false;
    const float* in_lat; const float* in_ctx; float* out_lat; float* out_ctx; const float* modv; int gsel;
    __device__ __forceinline__ void operator()(const f32x4 (&acc)[2][2][4][2], const Unit& u, int wr, int wc, int fr, int fq) const {
        const int b = u.em / 65, j = u.em % 65; const bool isctx = (j == 0);
        const float* ib = isctx ? in_ctx + (size_t)b * CTXL * DM : in_lat + ((size_t)b * SEQ + (size_t)(j - 1) * 256) * DM;
        float* ob = isctx ? out_ctx + (size_t)b * CTXL * DM : out_lat + ((size_t)b * SEQ + (size_t)(j - 1) * 256) * DM;
        const float* gt = modv + (isctx ? 2 : b) * 6144 + gsel * DM;
        const int col0 = u.en * BM + wc * 32 + 4 * fq;
        f32x4 gv[2][2];
#pragma unroll
        for (int bj = 0; bj < 2; ++bj)
#pragma unroll
            for (int n = 0; n < 2; ++n) gv[bj][n] = *(const f32x4*)(gt + col0 + bj * HALF + n * 16);
#pragma unroll
        for (int ai = 0; ai < 2; ++ai)
#pragma unroll
            for (int m = 0; m < 4; ++m) { const size_t off = (size_t)(ai * HALF + wr * 64 + m * 16 + fr) * DM + col0;
#pragma unroll
                for (int bj = 0; bj < 2; ++bj)
#pragma unroll
                    for (int n = 0; n < 2; ++n) { const f32x4 bs = *(const f32x4*)(ib + off + bj * HALF + n * 16);
                        *(f32x4*)(ob + off + bj * HALF + n * 16) = bs + gv[bj][n] * acc[ai][bj][m][n]; } }
    }
};
struct EpiMoe1 {
    static constexpr bool PERM = true;
    bf16_t* Hs; const float* roww;
    __device__ __forceinline__ void operator()(const f32x4 (&acc)[2][2][4][2], const Unit& u, int wr, int wc, int fr, int fq) const {
        const int row0 = u.em * BM + wr * 64 + fr; const int col0 = u.en * HALF + wc * 32 + 8 * fq;
#pragma unroll
        for (int ai = 0; ai < 2; ++ai)
#pragma unroll
            for (int m = 0; m < 4; ++m) { const int r = row0 + ai * HALF + m * 16; const float w = roww[r];
                float o[8];
#pragma unroll
                for (int n = 0; n < 2; ++n)
#pragma unroll
                    for (int j = 0; j < 4; ++j) { const float g = acc[ai][0][m][n][j], up = acc[ai][1][m][n][j]; o[n * 4 + j] = siluf_(g) * up * w; }
                v4u pw; pw.x = cvt_pk_bf16(o[0], o[1]); pw.y = cvt_pk_bf16(o[2], o[3]); pw.z = cvt_pk_bf16(o[4], o[5]); pw.w = cvt_pk_bf16(o[6], o[7]);
                *(v4u*)(Hs + (size_t)r * FF + col0) = pw; }
    }
};

template <class Epi, class Sched, bool GATHER>
__device__ __forceinline__ void gemm_phase(LAS unsigned char* lds, const Gemm g, const Sched& S, const Epi& E, int wave) {
    const int lane = hw_lane(), wid = wave, tid = wave * 64 + lane;
    const int wr = wid >> 2, wc = wid & 3, fr = lane & 15, fq = lane >> 4;
    const int K = g.K, nt = K / BK;
    int Rr[2], Cc[2];
    unsigned voffB[2], voffA[2];
#pragma unroll
    for (int i = 0; i < 2; ++i) { int R, C; stage_rc(tid * 16 + i * 8192, R, C); const int Rb = Epi::PERM ? ((R & ~31) + perm32(R & 31)) : R; Rr[i] = R; Cc[i] = C;
        voffB[i] = (unsigned)(Rb * g.ldb + C) * 2u; voffA[i] = (unsigned)(R * g.lda + C) * 2u; }
    const size_t kstep = (size_t)(BK * 2);
    const size_t hstepB = (size_t)HALF * g.ldb * 2, hstepA = (size_t)HALF * g.lda * 2;
    const size_t tstepA = (size_t)BM * g.lda * 2, tstepB = (size_t)BM * g.ldb * 2;
    const unsigned ldsw = (unsigned)wid * 1024u;
    const int aoff = lds_byte(wr * 64 + fr, fq * 8), boff = lds_byte(wc * 32 + fr, fq * 8);
#define PG8_SA(b, h) (((b) * 2 + (h)) * HTB)
#define PG8_SB(b, h) ((4 + (b) * 2 + (h)) * HTB)
#define PG8_STAGE(bufoff, gbase, voff) do { _Pragma("unroll") for (int _i = 0; _i < 2; ++_i) \
        __builtin_amdgcn_global_load_lds((const unsigned*)((const char*)(gbase) + (voff)[_i]), (LAS unsigned*)(lds + (bufoff) + ldsw + _i * 8192), 16, 0, 0); } while (0)
#define PG8_LDA(dst, b, h) do { _Pragma("unroll") for (int m = 0; m < 4; ++m) _Pragma("unroll") for (int k = 0; k < 2; ++k) dst[m][k] = *(const LAS bf16x8*)(lds + PG8_SA(b, h) + aoff + m * 2048 + k * 1024); } while (0)
#define PG8_LDB(dst, b, h) do { _Pragma("unroll") for (int n = 0; n < 2; ++n) _Pragma("unroll") for (int k = 0; k < 2; ++k) dst[n][k] = *(const LAS bf16x8*)(lds + PG8_SB(b, h) + boff + n * 2048 + k * 1024); } while (0)
#define PG8_MMA(ai, bj, At, Bt) do { __builtin_amdgcn_s_setprio(1); _Pragma("unroll") for (int m = 0; m < 4; ++m) _Pragma("unroll") for (int n = 0; n < 2; ++n) _Pragma("unroll") for (int k = 0; k < 2; ++k) \
        acc[ai][bj][m][n] = __builtin_amdgcn_mfma_f32_16x16x32_bf16(Bt[n][k], At[m][k], acc[ai][bj][m][n], 0, 0, 0); __builtin_amdgcn_s_setprio(0); } while (0)
#define PG8_WAIT_V(n) asm volatile("s_waitcnt vmcnt(" #n ")" ::: "memory")
#define PG8_WAIT_L(n) asm volatile("s_waitcnt lgkmcnt(" #n ")" ::: "memory")
#define PG8_BAR __builtin_amdgcn_s_barrier()
#define PG8_SCHED __builtin_amdgcn_sched_barrier(0)
#define PG8_AOFFS(dst, unit) do { if constexpr (GATHER) { _Pragma("unroll") for (int _h = 0; _h < 2; ++_h) _Pragma("unroll") for (int _i = 0; _i < 2; ++_i) { \
        const int _row = g.rowlist[(size_t)(unit).pm * BM + _h * HALF + Rr[_i]]; dst[_h][_i] = (unsigned)((size_t)_row * g.lda + Cc[_i]) * 2u; } \
        asm volatile("s_waitcnt vmcnt(0)" ::: "memory"); } } while (0)
#define PG8_STAGE_A(bufoff, base, h, vset) do { if constexpr (GATHER) { PG8_STAGE(bufoff, base, vset[h]); } else { PG8_STAGE(bufoff, (base) + (h) * hstepA, voffA); } } while (0)
    Unit cur, nxt; int ui = 0;
    if (!S.next(0, cur)) return;
    f32x4 acc[2][2][4][2];
#pragma unroll
    for (int a = 0; a < 2; ++a)
#pragma unroll
        for (int b = 0; b < 2; ++b)
#pragma unroll
            for (int m = 0; m < 4; ++m)
#pragma unroll
                for (int n = 0; n < 2; ++n) acc[a][b][m][n] = (f32x4){0.f, 0.f, 0.f, 0.f};
    bf16x8 At[4][2], B0[2][2], B1[2][2];
    unsigned vc[2][2], vn[2][2];
    PG8_AOFFS(vc, cur);
    const char* cA = GATHER ? (const char*)g.A : (const char*)g.A + (size_t)cur.pm * tstepA; const char* cB = (const char*)g.Bt + (size_t)cur.pn * tstepB;
    PG8_STAGE(PG8_SB(0, 0), cB, voffB); PG8_STAGE(PG8_SB(0, 1), cB + hstepB, voffB); PG8_STAGE_A(PG8_SA(0, 0), cA, 0, vc); PG8_STAGE_A(PG8_SA(0, 1), cA, 1, vc);
    if (wr == 1) PG8_BAR;
    PG8_WAIT_V(2); PG8_BAR;
    PG8_STAGE(PG8_SB(1, 0), cB + kstep, voffB); PG8_STAGE_A(PG8_SA(1, 0), cA + kstep, 0, vc); PG8_STAGE(PG8_SB(1, 1), cB + hstepB + kstep, voffB);
    PG8_WAIT_V(6); PG8_BAR;
    for (;;) {
        const bool has_next = S.next(ui + 1, nxt);
        if constexpr (GATHER) { if (has_next) { PG8_AOFFS(vn, nxt); } else { vn[0][0] = vc[0][0]; vn[0][1] = vc[0][1]; vn[1][0] = vc[1][0]; vn[1][1] = vc[1][1]; } }
        const char* nA = has_next ? (GATHER ? (const char*)g.A : (const char*)g.A + (size_t)nxt.pm * tstepA) : cA; const char* nB = has_next ? (const char*)g.Bt + (size_t)nxt.pn * tstepB : cB;
        for (int t = 0; t < nt; t += 2) {
            const bool last = (t == nt - 2);
            const char* a1 = cA + (size_t)(t + 1) * kstep;
            const char* a2 = last ? nA : cA + (size_t)(t + 2) * kstep; const char* b2 = last ? nB : cB + (size_t)(t + 2) * kstep;
            const char* a3 = a2 + kstep; const char* b3 = b2 + kstep;
            unsigned v2[2][2];
            if constexpr (GATHER) { v2[0][0] = last ? vn[0][0] : vc[0][0]; v2[0][1] = last ? vn[0][1] : vc[0][1]; v2[1][0] = last ? vn[1][0] : vc[1][0]; v2[1][1] = last ? vn[1][1] : vc[1][1]; }
            PG8_LDB(B0, 0, 0); PG8_LDB(B1, 0, 1); PG8_SCHED; PG8_LDA(At, 0, 0); PG8_STAGE_A(PG8_SA(1, 1), a1, 1, vc);
            PG8_WAIT_V(8); PG8_WAIT_L(0); PG8_BAR; PG8_MMA(0, 0, At, B0); PG8_MMA(0, 1, At, B1); PG8_BAR; PG8_SCHED;
            PG8_LDA(At, 0, 1); PG8_STAGE(PG8_SB(0, 0), b2, voffB); PG8_STAGE(PG8_SB(0, 1), b2 + hstepB, voffB); PG8_STAGE_A(PG8_SA(0, 0), a2, 0, v2);
            PG8_WAIT_V(8); PG8_WAIT_L(0); PG8_BAR; PG8_MMA(1, 0, At, B0); PG8_MMA(1, 1, At, B1); PG8_BAR; PG8_SCHED;
            PG8_LDB(B0, 1, 0); PG8_LDB(B1, 1, 1); PG8_SCHED; PG8_LDA(At, 1, 0); PG8_STAGE_A(PG8_SA(0, 1), a2, 1, v2);
            PG8_WAIT_V(8); PG8_WAIT_L(0); PG8_BAR; PG8_MMA(0, 0, At, B0); PG8_MMA(0, 1, At, B1); PG8_BAR; PG8_SCHED;
            PG8_LDA(At, 1, 1); PG8_STAGE(PG8_SB(1, 0), b3, voffB); PG8_STAGE(PG8_SB(1, 1), b3 + hstepB, voffB); PG8_STAGE_A(PG8_SA(1, 0), a3, 0, v2);
            PG8_WAIT_V(8); PG8_WAIT_L(0); PG8_BAR; PG8_MMA(1, 0, At, B0); PG8_MMA(1, 1, At, B1); PG8_BAR; PG8_SCHED;
        }
        if (wr == 0) PG8_BAR;
        { const int l2 = hw_lane(); E(acc, cur, wr, wc, l2 & 15, l2 >> 4); }
        if (!has_next) break;
#pragma unroll
        for (int a = 0; a < 2; ++a)
#pragma unroll
            for (int b = 0; b < 2; ++b)
#pragma unroll
                for (int m = 0; m < 4; ++m)
#pragma unroll
                    for (int n = 0; n < 2; ++n) acc[a][b][m][n] = (f32x4){0.f, 0.f, 0.f, 0.f};
        cur = nxt; cA = nA; cB = nB; ++ui;
        if constexpr (GATHER) { vc[0][0] = vn[0][0]; vc[0][1] = vn[0][1]; vc[1][0] = vn[1][0]; vc[1][1] = vn[1][1]; }
        if (wr == 1) PG8_BAR;
    }
    PG8_WAIT_V(0);
    PG8_BAR;
#undef PG8_SA
#undef PG8_SB
#undef PG8_STAGE
#undef PG8_LDA
#undef PG8_LDB
#undef PG8_MMA
#undef PG8_WAIT_V
#undef PG8_WAIT_L
#undef PG8_BAR
#undef PG8_SCHED
#undef PG8_AOFFS
#undef PG8_STAGE_A
}
}
namespace attn_body {
using bf16=__hip_bfloat16;
using bf16x8=__attribute__((ext_vector_type(8)))short;
using s16x4=__attribute__((ext_vector_type(4)))short;
using f32x16=__attribute__((ext_vector_type(16)))float;
using u32x4=__attribute__((ext_vector_type(4)))unsigned;
constexpr int D=64;
constexpr int NW=8,QBLK=32,QB=QBLK*NW,KVBLK=64;
constexpr int ATTN_UNIT_ROWS=QB;
__device__ __forceinline__ int crow(int r,int hi){return (r&3)+8*(r>>2)+4*hi;}
#define SBAR() __builtin_amdgcn_sched_barrier(0)
constexpr int NSLOT=3, SLOTB=8192;
constexpr int LDS_K=0, LDS_V=NSLOT*SLOTB, LDS_WS=2*NSLOT*SLOTB, LDS_OST=LDS_WS+NW*64*4, LDS_BYTES=LDS_OST+NW*4096;
constexpr float C2=0.125f*1.4426950408889634f;
__device__ __forceinline__ void glds16(const void*gsrc,unsigned lds_dst){unsigned keep;
  asm volatile("s_mov_b32 %0, m0\n\ts_mov_b32 m0, %2\n\ts_nop 0\n\tglobal_load_lds_dwordx4 %1, off\n\ts_mov_b32 m0, %0":"=&s"(keep):"v"(gsrc),"s"(lds_dst):"memory");}
__device__ __forceinline__ float max3f(float a,float b,float c){float r;asm("v_max3_f32 %0, %1, %2, %3":"=v"(r):"v"(a),"v"(b),"v"(c));return r;}
__device__ __forceinline__ float max2f(float a,float b){float r;asm("v_max_f32_e32 %0, %1, %2":"=v"(r):"v"(a),"v"(b));return r;}
__device__ __forceinline__ float fadd_s(float a,float b){float r;asm("v_add_f32_e32 %0, %1, %2":"=v"(r):"v"(a),"v"(b));return r;}
__device__ __forceinline__ float fsub_s(float a,float b){float r;asm("v_sub_f32_e32 %0, %1, %2":"=v"(r):"v"(a),"v"(b));return r;}
typedef float f32x2_t __attribute__((ext_vector_type(2))); typedef __bf16 bf16x2_t __attribute__((ext_vector_type(2)));
__device__ __forceinline__ unsigned cvtpk_s(float lo,float hi){f32x2_t v={lo,hi};bf16x2_t b=__builtin_convertvector(v,bf16x2_t);return __builtin_bit_cast(unsigned,b);}
#define WAIT_BAR(N) asm volatile("s_waitcnt vmcnt(" #N ") lgkmcnt(0)\n\ts_barrier":::"memory")

__device__ __forceinline__ void qkt(f32x16&p0,f32x16&p1,const char*Kslot,const bf16x8*qr,const f32x16&negm,int r32,int hi){
  const char*kb=Kslot+hi*1024+r32*16;
  #pragma unroll
  for(int d0=0;d0<4;++d0){
    const bf16x8 b0=*reinterpret_cast<const bf16x8*>(kb+d0*2048);
    const bf16x8 b1=*reinterpret_cast<const bf16x8*>(kb+d0*2048+512);
    if(d0==0){p0=__builtin_amdgcn_mfma_f32_32x32x16_bf16(b0,qr[0],negm,0,0,0);p1=__builtin_amdgcn_mfma_f32_32x32x16_bf16(b1,qr[0],negm,0,0,0);}
    else{p0=__builtin_amdgcn_mfma_f32_32x32x16_bf16(b0,qr[d0],p0,0,0,0);p1=__builtin_amdgcn_mfma_f32_32x32x16_bf16(b1,qr[d0],p1,0,0,0);}}
}
typedef __attribute__((address_space(3))) const char* lds_cptr;
typedef short v4i16_t __attribute__((ext_vector_type(4)));
__device__ __forceinline__ void kload8(bf16x8*kf,lds_cptr kp){
  kf[0]=*(const __attribute__((address_space(3))) bf16x8*)(kp);      kf[1]=*(const __attribute__((address_space(3))) bf16x8*)(kp+512);
  kf[2]=*(const __attribute__((address_space(3))) bf16x8*)(kp+2048); kf[3]=*(const __attribute__((address_space(3))) bf16x8*)(kp+2560);
  kf[4]=*(const __attribute__((address_space(3))) bf16x8*)(kp+4096); kf[5]=*(const __attribute__((address_space(3))) bf16x8*)(kp+4608);
  kf[6]=*(const __attribute__((address_space(3))) bf16x8*)(kp+6144); kf[7]=*(const __attribute__((address_space(3))) bf16x8*)(kp+6656);
}
__device__ __forceinline__ void kload2(bf16x8*kf,lds_cptr kp,int j){ kf[2*j]=*(const __attribute__((address_space(3))) bf16x8*)(kp+j*2048); kf[2*j+1]=*(const __attribute__((address_space(3))) bf16x8*)(kp+j*2048+512); }
__device__ __forceinline__ s16x4 vtr(lds_cptr p){ return __builtin_bit_cast(s16x4,__builtin_amdgcn_ds_read_tr16_b64_v4i16((__attribute__((address_space(3))) v4i16_t*)p)); }
__device__ __forceinline__ float rowmax(const f32x16&p0,const f32x16&p1){
  float a=max3f(p0[0],p0[1],p1[0]),b=max3f(p0[2],p0[3],p1[1]);a=max3f(a,p1[2],p1[3]);
  #pragma unroll
  for(int r=4;r<16;r+=4){a=max3f(a,p0[r],p0[r+1]);b=max3f(b,p0[r+2],p0[r+3]);a=max3f(a,p1[r],p1[r+1]);b=max3f(b,p1[r+2],p1[r+3]);}
  const float m=max2f(a,b);
  auto rr=__builtin_amdgcn_permlane32_swap(__float_as_uint(m),__float_as_uint(m),false,false);
  return max2f(__uint_as_float(rr[0]),__uint_as_float(rr[1]));
}
__device__ __forceinline__ void pv(f32x16*o,int vb,bf16x8 pa0,bf16x8 pa1,bf16x8 pa2,bf16x8 pa3){
  #pragma unroll
  for(int d0=0;d0<2;++d0){s16x4 lo[4],hi[4];
    #pragma unroll
    for(int ks=0;ks<4;++ks){
      asm volatile("ds_read_b64_tr_b16 %0,%1 offset:%c2":"=&v"(lo[ks]):"v"(vb),"i"(d0*4096+ks*1024):"memory");
      asm volatile("ds_read_b64_tr_b16 %0,%1 offset:%c2":"=&v"(hi[ks]):"v"(vb),"i"(d0*4096+ks*1024+512):"memory");}
    asm volatile("s_waitcnt lgkmcnt(0)":::"memory");SBAR();
    #define PK(k) (bf16x8){lo[k][0],lo[k][1],lo[k][2],lo[k][3],hi[k][0],hi[k][1],hi[k][2],hi[k][3]}
    o[d0]=__builtin_amdgcn_mfma_f32_32x32x16_bf16(pa0,PK(0),o[d0],0,0,0);
    o[d0]=__builtin_amdgcn_mfma_f32_32x32x16_bf16(pa1,PK(1),o[d0],0,0,0);
    o[d0]=__builtin_amdgcn_mfma_f32_32x32x16_bf16(pa2,PK(2),o[d0],0,0,0);
    o[d0]=__builtin_amdgcn_mfma_f32_32x32x16_bf16(pa3,PK(3),o[d0],0,0,0);
    #undef PK
  }
}

#ifndef ATTN_STORE16
#define ATTN_STORE16(p,v) (*(u32x4*)(p)=(v))
#endif
template<int THRL> __device__ __forceinline__ void attn_unit(const bf16*Qb,int QP,const bf16*__restrict__ Kh,int KP,const bf16*__restrict__ Vh,int VP,bf16*Ob,int OP,int NT,char*shm,int wave){
  const int lane=hw_lane(),r32=lane&31,hi=lane>>5; const int wid=wave;
  const bf16*Qw=Qb+(long)(wid*QBLK)*QP;
  const unsigned lds0=(unsigned)(uintptr_t)shm;
  float*wsf=(float*)(shm+LDS_WS)+wid*64;
  const bf16*ksrc=Kh+(long)lane*KP+wid*8;
  const bf16*vsrc=Vh+(long)(16*(wid&3)+(lane>>2))*VP+(wid>>2)*32+(lane&3)*8;
  const unsigned kdst=lds0+LDS_K+wid*1024, vdst=lds0+LDS_V+wid*1024;
  #define DMA_K(t,slot) glds16(ksrc+(long)(t)*KVBLK*KP,(unsigned)__builtin_amdgcn_readfirstlane(kdst+(slot)))
  #define DMA_V(t,slot) glds16(vsrc+(long)(t)*KVBLK*VP,(unsigned)__builtin_amdgcn_readfirstlane(vdst+(slot)))
  const int vb0=(int)(lds0+LDS_V)+((lane>>4)&1)*32+(lane&3)*8+(4*hi+((lane&15)>>2))*64;
  const char*Kbase=shm+LDS_K; bf16x8 kf[8];
  const lds_cptr shm3=(lds_cptr)shm; const lds_cptr kp0=shm3+LDS_K+hi*1024+r32*16; const lds_cptr vp0=shm3+LDS_V+((lane>>4)&1)*32+(lane&3)*8+(4*hi+((lane&15)>>2))*64;
  DMA_K(0,0);DMA_V(0,0);DMA_K(1,SLOTB);
  bf16x8 qr[4];
  #pragma unroll
  for(int d0=0;d0<4;++d0)qr[d0]=*reinterpret_cast<const bf16x8*>(&Qw[(long)r32*QP+d0*16+hi*8]);
  float mhat=0.f,l_reg=0.f;f32x16 o[2];o[0]=f32x16{};o[1]=f32x16{};f32x16 negm=f32x16{};asm volatile("":"+v"(negm));
  #define CMASK(P0,P1,t) do{}while(0)
  bool resc=false;
  #define START(P0,P1) do{ const float rm=rowmax(P0,P1); resc=false; \
    { const float dl=rm; mhat=fadd_s(mhat,dl); \
      _Pragma("unroll") for(int r=0;r<16;++r){P0[r]=fsub_s(P0[r],dl);P1[r]=fsub_s(P1[r],dl);} \
      _Pragma("unroll") for(int r=0;r<16;++r)negm[r]=-mhat; asm volatile("":"+v"(negm)); } \
    _Pragma("unroll") for(int r=0;r<16;++r)P0[r]=__builtin_amdgcn_exp2f(P0[r]); }while(0)
  #define RESC() do{ if(resc){ asm volatile("s_waitcnt lgkmcnt(0)":::"memory"); \
      _Pragma("unroll") for(int d_=0;d_<2;++d_) _Pragma("unroll") for(int r=0;r<16;++r)o[d_][r]*=wsf[crow(r,hi)]; } }while(0)
  f32x16 pA0,pA1,pB0,pB1;
  int sl_prev=0,sl_cur=0,sl_next=SLOTB;
  #define ROT() do{sl_prev=sl_cur;sl_cur=sl_next;sl_next=(sl_next==(NSLOT-1)*SLOTB)?0:sl_next+SLOTB;}while(0)
  DMA_K(2,2*SLOTB);
  WAIT_BAR(3);
  qkt(pA0,pA1,Kbase,qr,negm,r32,hi);asm volatile("s_nop 15\n\ts_nop 7":"+v"(pA0),"+v"(pA1));CMASK(pA0,pA1,0);
  START(pA0,pA1);
  _Pragma("unroll") for(int r=0;r<16;++r)pA1[r]=__builtin_amdgcn_exp2f(pA1[r]);
  WAIT_BAR(0);
  DMA_K(3,0);DMA_V(1,SLOTB);
  ROT();
  kload8(kf,kp0+sl_cur);
  WAIT_BAR(2);
  s16x4 vlo[8],vhi[8]; u32x4 pw0,pw1,pw2,pw3;
  #define PKW(P,B) cvtpk_s(P[B],P[B+1])
  #define PAF(k) __builtin_bit_cast(bf16x8,pw##k)
  #define VFR(i) (bf16x8){vlo[i][0],vlo[i][1],vlo[i][2],vlo[i][3],vhi[i][0],vhi[i][1],vhi[i][2],vhi[i][3]}
  #define PIN(x) asm volatile("":"+v"(x))
  #define MX3(a,b,c) __builtin_fmaxf(__builtin_fmaxf((a),(b)),(c))
  #define GAPA(MF,A0,A1,A2,A3,W0,W1,PW) do{ MF; sacc+=A0; sacc+=A1; sacc+=A2; sacc+=A3; PIN(sacc); W0; W1; PIN(PW); SBAR(); }while(0)
  #define EX(v) __builtin_amdgcn_exp2f(v)
  #define GAPB(MF,X,B) do{ MF; X[B]=EX(X[B]); X[B+1]=EX(X[B+1]); X[B+2]=EX(X[B+2]); X[B+3]=EX(X[B+3]); PIN(X); SBAR(); }while(0)
  #define VRD(i) do{ vlo[i]=vtr(vp_+(((i)>>2)*4096+((i)&3)*1024)); vhi[i]=vtr(vp_+(((i)>>2)*4096+((i)&3)*1024+512)); }while(0)
  #define KRD(G,j) do{ if(G){ kload2(kf,kp0+sl_next,j); SBAR(); } }while(0)
  #define STEP(C0,C1,P0,P1,t,GK,GV,GL) do{ SBAR(); \
    const lds_cptr vp_=vp0+sl_prev; \
    VRD(0); SBAR(); float sacc=(P0[0]+P0[1]); \
    GAPA(C0=__builtin_amdgcn_mfma_f32_32x32x16_bf16(kf[0],qr[0],negm,0,0,0), P0[2],P0[3],P0[4],P0[5],     pw0[0]=PKW(P0,0), pw0[1]=PKW(P0,2), pw0); \
    VRD(4); SBAR(); GAPA(C1=__builtin_amdgcn_mfma_f32_32x32x16_bf16(kf[1],qr[0],negm,0,0,0), P0[6],P0[7],P0[8],P0[9],     pw0[2]=PKW(P0,4), pw0[3]=PKW(P0,6), pw0); \
    VRD(1); SBAR(); GAPA(C0=__builtin_amdgcn_mfma_f32_32x32x16_bf16(kf[2],qr[1],C0,0,0,0),   P0[10],P0[11],P0[12],P0[13], pw1[0]=PKW(P0,8), pw1[1]=PKW(P0,10), pw1); \
    VRD(5); SBAR(); GAPA(C1=__builtin_amdgcn_mfma_f32_32x32x16_bf16(kf[3],qr[1],C1,0,0,0),   P0[14],P0[15],P1[0],P1[1],   pw1[2]=PKW(P0,12),pw1[3]=PKW(P0,14), pw1); \
    VRD(2); SBAR(); GAPA(C0=__builtin_amdgcn_mfma_f32_32x32x16_bf16(kf[4],qr[2],C0,0,0,0),   P1[2],P1[3],P1[4],P1[5],     pw2[0]=PKW(P1,0), pw2[1]=PKW(P1,2), pw2); \
    VRD(6); SBAR(); GAPA(C1=__builtin_amdgcn_mfma_f32_32x32x16_bf16(kf[5],qr[2],C1,0,0,0),   P1[6],P1[7],P1[8],P1[9],     pw2[2]=PKW(P1,4), pw2[3]=PKW(P1,6), pw2); \
    VRD(3); SBAR(); GAPA(C0=__builtin_amdgcn_mfma_f32_32x32x16_bf16(kf[6],qr[3],C0,0,0,0),   P1[10],P1[11],P1[12],P1[13], pw3[0]=PKW(P1,8), pw3[1]=PKW(P1,10), pw3); \
    VRD(7); SBAR(); GAPA(C1=__builtin_amdgcn_mfma_f32_32x32x16_bf16(kf[7],qr[3],C1,0,0,0),   P1[14],P1[15],0.f,0.f,       pw3[2]=PKW(P1,12),pw3[3]=PKW(P1,14), pw3); \
    l_reg+=sacc; \
    if(GK){DMA_K((t)+3,sl_cur);} if(GV){DMA_V((t)+1,sl_next);} \
    CMASK(C0,C1,t); \
    { float a=MX3(C0[0],C0[1],C1[0]),b=MX3(C0[2],C0[3],C1[1]); a=MX3(a,C1[2],C1[3]); \
      _Pragma("unroll") for(int r=4;r<16;r+=4){a=MX3(a,C0[r],C0[r+1]);b=MX3(b,C0[r+2],C0[r+3]);a=MX3(a,C1[r],C1[r+1]);b=MX3(b,C1[r+2],C1[r+3]);} \
      float rm=__builtin_fmaxf(a,b); { auto rr=__builtin_amdgcn_permlane32_swap(__float_as_uint(rm),__float_as_uint(rm),false,false); rm=__builtin_fmaxf(__uint_as_float(rr[0]),__uint_as_float(rr[1])); } \
      resc=false; \
      if(__builtin_expect(__any(rm>(float)THRL),0)){ const float dl=__builtin_fmaxf(rm,0.f); mhat+=dl; \
        _Pragma("unroll") for(int r=0;r<16;++r){C0[r]-=dl;C1[r]-=dl;} \
        _Pragma("unroll") for(int r=0;r<16;++r)negm[r]=-mhat; asm volatile("":"+v"(negm)); \
        const float f=__builtin_amdgcn_exp2f(-dl); l_reg*=f; if(hi==0)wsf[r32]=f; resc=true; } } \
    SBAR(); \
    GAPB(o[0]=__builtin_amdgcn_mfma_f32_32x32x16_bf16(PAF(0),VFR(0),o[0],0,0,0), C0,0); \
    GAPB(o[1]=__builtin_amdgcn_mfma_f32_32x32x16_bf16(PAF(0),VFR(4),o[1],0,0,0), C0,4); \
    KRD(GL,0); GAPB(o[0]=__builtin_amdgcn_mfma_f32_32x32x16_bf16(PAF(1),VFR(1),o[0],0,0,0), C0,8); \
    KRD(GL,1); GAPB(o[1]=__builtin_amdgcn_mfma_f32_32x32x16_bf16(PAF(1),VFR(5),o[1],0,0,0), C0,12); \
    KRD(GL,2); GAPB(o[0]=__builtin_amdgcn_mfma_f32_32x32x16_bf16(PAF(2),VFR(2),o[0],0,0,0), C1,0); \
    KRD(GL,3); GAPB(o[1]=__builtin_amdgcn_mfma_f32_32x32x16_bf16(PAF(2),VFR(6),o[1],0,0,0), C1,4); \
    GAPB(o[0]=__builtin_amdgcn_mfma_f32_32x32x16_bf16(PAF(3),VFR(3),o[0],0,0,0), C1,8); \
    GAPB(o[1]=__builtin_amdgcn_mfma_f32_32x32x16_bf16(PAF(3),VFR(7),o[1],0,0,0), C1,12); \
    }while(0)
  int t=1;
  #undef CMASK
  #define CMASK(P0,P1,t) do{}while(0)
  for(;t+5<NT;t+=2){
    STEP(pB0,pB1,pA0,pA1,t,true,true,true);     WAIT_BAR(2); RESC(); ROT();
    STEP(pA0,pA1,pB0,pB1,t+1,true,true,true);   WAIT_BAR(2); RESC(); ROT();
  }
  #undef CMASK
  #define CMASK(P0,P1,t) do{}while(0)
  #define ENDW(tt) do{ if((tt)+3<NT){WAIT_BAR(2);} else if((tt)+2<NT){WAIT_BAR(1);} else {WAIT_BAR(0);} }while(0)
  for(;t+1<NT;t+=2){
    STEP(pB0,pB1,pA0,pA1,t,(t+3<NT),(t+1<NT),(t+1<NT));       ENDW(t);   RESC(); ROT();
    STEP(pA0,pA1,pB0,pB1,t+1,(t+4<NT),(t+2<NT),(t+2<NT));     ENDW(t+1); RESC(); ROT();
  }
  STEP(pB0,pB1,pA0,pA1,NT-1,false,false,false); RESC();
  { float sacc=pB0[0]+pB0[1]; _Pragma("unroll") for(int r=2;r<16;++r)sacc+=pB0[r]; _Pragma("unroll") for(int r=0;r<16;++r)sacc+=pB1[r]; l_reg+=sacc;
    pw0=(u32x4){PKW(pB0,0),PKW(pB0,2),PKW(pB0,4),PKW(pB0,6)};pw1=(u32x4){PKW(pB0,8),PKW(pB0,10),PKW(pB0,12),PKW(pB0,14)};pw2=(u32x4){PKW(pB1,0),PKW(pB1,2),PKW(pB1,4),PKW(pB1,6)};pw3=(u32x4){PKW(pB1,8),PKW(pB1,10),PKW(pB1,12),PKW(pB1,14)};
    SBAR(); pv(o,vb0+sl_cur,PAF(0),PAF(1),PAF(2),PAF(3)); }
  #undef PKW
  #undef PAF
  #undef VFR
  #undef PIN
  #undef MX3
  #undef GAPA
  #undef GAPB
  #undef EX
  #undef VRD
  #undef KRD
  #undef STEP
  #undef ENDW
  {auto rr=__builtin_amdgcn_permlane32_swap(__float_as_uint(l_reg),__float_as_uint(l_reg),false,false);l_reg=__uint_as_float(rr[0])+__uint_as_float(rr[1]);}
  if(hi==0)wsf[32+r32]=l_reg;asm volatile("s_waitcnt lgkmcnt(0)":::"memory");
  float rli[16];
  #pragma unroll
  for(int r=0;r<16;++r)rli[r]=__builtin_amdgcn_rcpf(wsf[32+crow(r,hi)]);
  bf16*Ow=Ob+(long)(wid*QBLK)*OP;
  { bf16*stg=(bf16*)(shm+LDS_OST)+wid*2048;
    #pragma unroll
    for(int r=0;r<16;++r){const int orow=crow(r,hi);
      #pragma unroll
      for(int d0=0;d0<2;++d0)stg[orow*64+d0*32+r32]=__float2bfloat16(o[d0][r]*rli[r]);}
    asm volatile("s_waitcnt lgkmcnt(0)":::"memory");
    #pragma unroll
    for(int i=0;i<4;++i){const int row=i*8+(lane>>3),ch=lane&7; const u32x4 v=*(const u32x4*)(stg+row*64+ch*8); ATTN_STORE16(Ow+(long)row*OP+ch*8,v);} }
  asm volatile("s_waitcnt lgkmcnt(0)\n\ts_barrier":::"memory");
  #undef DMA_K
  #undef DMA_V
  #undef CMASK
  #undef START
  #undef RESC
  #undef ROT
}
constexpr int ATTN_LDS_BYTES=LDS_BYTES;
#undef SBAR
#undef WAIT_BAR
}
namespace dn {
constexpr int NCHUNK = 260, GROUP = 6, WREG = 17408  , TP = 72  ;
constexpr int F_WT = 0, F_QKT = 8, F_QD = 14, F_KD = 22, F_U = 30, F_GL = 38;
__device__ __forceinline__ int crow(int r, int hi) { return (r & 3) + 8 * (r >> 2) + 4 * hi; }
__device__ __forceinline__ bf16x8 pack8(const f32x16& x, int s) {
    v4u w; w.x = cvt_pk_bf16(x[8 * s + 0], x[8 * s + 1]); w.y = cvt_pk_bf16(x[8 * s + 2], x[8 * s + 3]); w.z = cvt_pk_bf16(x[8 * s + 4], x[8 * s + 5]); w.w = cvt_pk_bf16(x[8 * s + 6], x[8 * s + 7]);
    return __builtin_bit_cast(bf16x8, w);
}
#define DN_MFMA(a, b, c) __builtin_amdgcn_mfma_f32_32x32x16_bf16(a, b, c, 0, 0, 0)

struct Chain {
    const bf16_t* P1b;
    bf16_t* Ob;
    int h, dir;
    float Aexp, dtb;
    unsigned char* ring;
    unsigned* dbg;
};
__device__ __forceinline__ int chunk_of(int ci, int dir) { return dir == 0 ? ci : (ci < 4 ? 3 - ci : 263 - ci); }

__device__ __forceinline__ void produce(const Chain& ch, int ci, LAS unsigned char* wl, const LAS float* wct, unsigned char* slot, int lane_in) {
    int lane = lane_in; asm volatile("" : "+v"(lane));
    const int r = lane & 31, hh = lane >> 5;
    const int c = chunk_of(ci, ch.dir), t0 = 64 * c, seg_lo = (c < 4) ? 0 : CTXL, seg_hi = (c < 4) ? CTXL : TT;
    LAS float* Lm = (LAS float*)wl; LAS bf16_t* Tm = (LAS bf16_t*)wl; LAS float* gcT = (LAS float*)(wl + 16384); LAS float* btT = gcT + 64;
    {
        const int tok = ch.dir ? t0 + 63 - lane : t0 + lane;
        const bf16_t* row = ch.P1b + (size_t)tok * P1W;
        const float a = bf2f(row[C_BA + ch.dir * 8 + ch.h]), bb = bf2f(row[C_BB + ch.dir * 8 + ch.h]);
        const float x = a + ch.dtb; const float sp = x > 20.f ? x : log1pf(__expf(x));
        float g = -ch.Aexp * sp;
#pragma unroll
        for (int o = 1; o < 64; o <<= 1) { const float t = __shfl_up(g, o); if (lane >= o) g += t; }
        gcT[lane] = g; btT[lane] = sigmoidf_(bb);
    }
    LDS_WAIT();
    const float gl = gcT[63];
    bf16x8 kA[2][4], qA[2][4], vA[2][4];
#pragma unroll
    for (int x = 0; x < 3; ++x) {
        const int colb = C_BQKV + (x == 0 ? 512 : (x == 1 ? 0 : 1024)) + ch.h * 64; const int wcb = x * 64;
#pragma unroll
        for (int rt = 0; rt < 2; ++rt) {
            const int p = 32 * rt + r; const int tok = ch.dir ? t0 + 63 - p : t0 + p;
            const bool hasm = (tok - 1 >= seg_lo), hasp = (tok + 1 < seg_hi);
            const bf16_t* rowc = ch.P1b + (size_t)tok * P1W + colb + 4 * hh;
            const bf16_t* rowm = hasm ? rowc - P1W : rowc; const bf16_t* rowp = hasp ? rowc + P1W : rowc;
            v2u rawc[8], rawm[8], rawp[8];
#pragma unroll
            for (int e = 0; e < 8; ++e) { rawc[e] = *(const v2u*)(rowc + 8 * e); rawm[e] = *(const v2u*)(rowm + 8 * e); rawp[e] = *(const v2u*)(rowp + 8 * e); }
            __builtin_amdgcn_sched_barrier(0);
            float f[4][8]; float ss = 0.f;
#pragma unroll
            for (int e = 0; e < 8; ++e) {
                const int d0 = 8 * e + 4 * hh;
                const f32x4 w0 = *(const LAS f32x4*)(wct + 0 * 192 + wcb + d0), w1 = *(const LAS f32x4*)(wct + 1 * 192 + wcb + d0), w2 = *(const LAS f32x4*)(wct + 2 * 192 + wcb + d0);
                const v2u wc_ = rawc[e]; v2u wm = rawm[e], wp = rawp[e];
                if (!hasm) wm = (v2u){0u, 0u};
                if (!hasp) wp = (v2u){0u, 0u};
                float y[4];
                y[0] = bflo(wm.x) * w0[0] + bflo(wc_.x) * w1[0] + bflo(wp.x) * w2[0];
                y[1] = bfhi(wm.x) * w0[1] + bfhi(wc_.x) * w1[1] + bfhi(wp.x) * w2[1];
                y[2] = bflo(wm.y) * w0[2] + bflo(wc_.y) * w1[2] + bflo(wp.y) * w2[2];
                y[3] = bfhi(wm.y) * w0[3] + bfhi(wc_.y) * w1[3] + bfhi(wp.y) * w2[3];
#pragma unroll
                for (int j = 0; j < 4; ++j) { const float v = siluf_(y[j]); f[e >> 1][(e & 1) * 4 + j] = v; ss += v * v; }
            }
            float sc = 1.f;
            if (x < 2) { ss += __shfl_xor(ss, 32); sc = rsqrtf(ss + EPS); if (x == 1) sc *= 0.125f; }
#pragma unroll
            for (int s = 0; s < 4; ++s) {
                v4u w; w.x = cvt_pk_bf16(f[s][0] * sc, f[s][1] * sc); w.y = cvt_pk_bf16(f[s][2] * sc, f[s][3] * sc); w.z = cvt_pk_bf16(f[s][4] * sc, f[s][5] * sc); w.w = cvt_pk_bf16(f[s][6] * sc, f[s][7] * sc);
                const bf16x8 fr_ = __builtin_bit_cast(bf16x8, w);
                if (x == 0) kA[rt][s] = fr_; else if (x == 1) qA[rt][s] = fr_; else vA[rt][s] = fr_;
            }
            __builtin_amdgcn_sched_barrier(0);
        }
    }
    v4u* sl = (v4u*)slot;
    const float gcc0 = gcT[r], gcc1 = gcT[32 + r];
#pragma unroll
    for (int tix = 0; tix < 3; ++tix) {
        const int it = (tix == 0) ? 0 : 1, jt = (tix == 2) ? 1 : 0;
        f32x16 acc = {};
#pragma unroll
        for (int s = 0; s < 4; ++s) acc = DN_MFMA(kA[it][s], kA[jt][s], acc);
        const float gcj = jt ? gcc1 : gcc0; const int j = 32 * jt + r;
#pragma unroll
        for (int rg = 0; rg < 16; ++rg) { const int i = 32 * it + crow(rg, hh); const float gi = gcT[i], bi = btT[i];
            const float v = (i > j) ? bi * acc[rg] * __expf(fminf(gi - gcj, 0.f)) : 0.f; Lm[i * 64 + j] = v; }
    }
#pragma unroll
    for (int tix = 0; tix < 3; ++tix) {
        const int jt = (tix == 2) ? 1 : 0, it = (tix == 0) ? 0 : 1;
        f32x16 acc = {};
#pragma unroll
        for (int s = 0; s < 4; ++s) acc = DN_MFMA(kA[jt][s], qA[it][s], acc);
        const float gci = it ? gcc1 : gcc0; const int i = 32 * it + r;
#pragma unroll
        for (int rg = 0; rg < 16; ++rg) { const int j = 32 * jt + crow(rg, hh); const float gj = gcT[j];
            acc[rg] = (i >= j) ? acc[rg] * __expf(fminf(gci - gj, 0.f)) : 0.f; }
        sl[(F_QKT + tix * 2 + 0) * 64 + lane] = __builtin_bit_cast(v4u, pack8(acc, 0));
        sl[(F_QKT + tix * 2 + 1) * 64 + lane] = __builtin_bit_cast(v4u, pack8(acc, 1));
    }
#pragma unroll
    for (int rt = 0; rt < 2; ++rt) { const float e = __expf(rt ? gcc1 : gcc0);
#pragma unroll
        for (int s = 0; s < 4; ++s) { const v4u w = __builtin_bit_cast(v4u, qA[rt][s]); v4u o;
            o.x = cvt_pk_bf16(bflo(w.x) * e, bfhi(w.x) * e); o.y = cvt_pk_bf16(bflo(w.y) * e, bfhi(w.y) * e); o.z = cvt_pk_bf16(bflo(w.z) * e, bfhi(w.z) * e); o.w = cvt_pk_bf16(bflo(w.w) * e, bfhi(w.w) * e);
            sl[(F_QD + rt * 4 + s) * 64 + lane] = o; } }
    LDS_WAIT();
#if MK_DEBUG == 3
    { unsigned bad = 0u;
      for (int i = 0; i < 64; ++i) { const float lv = Lm[i * 64 + lane]; if (lane < i && !(fabsf(lv) <= 1.5f)) bad |= 1u; }
      if (!(fabsf(gcT[lane]) < 1.0e30f)) bad |= 2u; if (!(btT[lane] >= 0.f && btT[lane] <= 1.f)) bad |= 4u;
      if (bad) atomicOr(ch.dbg, bad); }
#endif
    float T[64];
#pragma unroll
    for (int i = 0; i < 64; ++i) {
        float a = (lane == i) ? 1.f : 0.f;
#pragma unroll
        for (int q = 0; q < (i + 3) / 4; ++q) { const f32x4 l4 = *(const LAS f32x4*)(Lm + i * 64 + 4 * q);
#pragma unroll
            for (int e = 0; e < 4; ++e) if (4 * q + e < i) a -= l4[e] * T[4 * q + e]; }
        T[i] = a;
        if ((i & 3) == 3) __builtin_amdgcn_sched_barrier(0);
    }
    LDS_WAIT();
#pragma unroll
    for (int i = 0; i < 64; ++i) Tm[i * TP + lane] = (bf16_t)f2bf(T[i]);
    LDS_WAIT();
    bf16x8 Tf[3][2];
#pragma unroll
    for (int tix = 0; tix < 3; ++tix) { const int it = (tix == 0) ? 0 : 1, jt = (tix == 2) ? 1 : 0;
#pragma unroll
        for (int s = 0; s < 2; ++s) { const LAS bf16_t* p = Tm + (32 * it + r) * TP + 32 * jt + 16 * s + 4 * hh;
            const v2u a = *(const LAS v2u*)p, b = *(const LAS v2u*)(p + 8); v4u w; w.x = a.x; w.y = a.y; w.z = b.x; w.w = b.y; Tf[tix][s] = __builtin_bit_cast(bf16x8, w); } }
#if MK_DEBUG == 4
    { unsigned bad = 0u;
      _Pragma("unroll") for (int t_ = 0; t_ < 3; ++t_) _Pragma("unroll") for (int s_ = 0; s_ < 2; ++s_) { const v4u w = __builtin_bit_cast(v4u, Tf[t_][s_]);
        const unsigned ws_[4] = {w.x, w.y, w.z, w.w};
        _Pragma("unroll") for (int q_ = 0; q_ < 4; ++q_) { const float lo_ = bflo(ws_[q_]), hi_ = bfhi(ws_[q_]);
          if (!(fabsf(lo_) < 3.0e38f) || !(fabsf(hi_) < 3.0e38f)) bad |= 1u; else if (fabsf(lo_) > 1.0e3f || fabsf(hi_) > 1.0e3f) bad |= 2u; } }
      if (bad) atomicOr(ch.dbg, bad); }
#endif
    bf16x8 If[2];
#pragma unroll
    for (int sp = 0; sp < 2; ++sp) { bf16x8 f_;
#pragma unroll
        for (int jj = 0; jj < 8; ++jj) f_[jj] = ((16 * sp + 8 * (jj >> 2) + 4 * hh + (jj & 3)) == r) ? (short)0x3F80 : (short)0;
        If[sp] = f_; }
    {
        bf16x8 kbg[2][2][2];
#pragma unroll
        for (int jt = 0; jt < 2; ++jt)
#pragma unroll
            for (int dt = 0; dt < 2; ++dt) {
                f32x16 kc = {};
                kc = DN_MFMA(kA[jt][2 * dt + 0], If[0], kc); kc = DN_MFMA(kA[jt][2 * dt + 1], If[1], kc);
                f32x16 kd, kb;
#pragma unroll
                for (int rg = 0; rg < 16; ++rg) { const int j = 32 * jt + crow(rg, hh); const float gj = gcT[j], bj = btT[j];
                    kd[rg] = kc[rg] * __expf(gl - gj); kb[rg] = kc[rg] * bj * __expf(gj); }
                sl[(F_KD + (jt * 2 + dt) * 2 + 0) * 64 + lane] = __builtin_bit_cast(v4u, pack8(kd, 0));
                sl[(F_KD + (jt * 2 + dt) * 2 + 1) * 64 + lane] = __builtin_bit_cast(v4u, pack8(kd, 1));
                kbg[jt][dt][0] = pack8(kb, 0); kbg[jt][dt][1] = pack8(kb, 1);
#if MK_DEBUG == 4
                { bool b_ = false; _Pragma("unroll") for (int rg = 0; rg < 16; ++rg) if (!(fabsf(kb[rg]) < 3.0e38f)) b_ = true; if (b_) atomicOr(ch.dbg, 4u); }
#endif
            }
#pragma unroll
        for (int dt = 0; dt < 2; ++dt)
#pragma unroll
            for (int it = 0; it < 2; ++it) {
                f32x16 wt = {};
#pragma unroll
                for (int s = 0; s < 2; ++s) {
                    if (it == 0) wt = DN_MFMA(kbg[0][dt][s], Tf[0][s], wt);
                    else { wt = DN_MFMA(kbg[0][dt][s], Tf[1][s], wt); wt = DN_MFMA(kbg[1][dt][s], Tf[2][s], wt); }
                }
                asm volatile("s_nop 15\n\ts_nop 7" : "+v"(wt));
                sl[(F_WT + (dt * 2 + it) * 2 + 0) * 64 + lane] = __builtin_bit_cast(v4u, pack8(wt, 0));
                sl[(F_WT + (dt * 2 + it) * 2 + 1) * 64 + lane] = __builtin_bit_cast(v4u, pack8(wt, 1));
            }
    }
    {
        bf16x8 vb[2][2][2];
#pragma unroll
        for (int jt = 0; jt < 2; ++jt)
#pragma unroll
            for (int dvt = 0; dvt < 2; ++dvt) {
                f32x16 vc = {};
                vc = DN_MFMA(vA[jt][2 * dvt + 0], If[0], vc); vc = DN_MFMA(vA[jt][2 * dvt + 1], If[1], vc);
#pragma unroll
                for (int rg = 0; rg < 16; ++rg) { const int j = 32 * jt + crow(rg, hh); vc[rg] *= btT[j]; }
                vb[jt][dvt][0] = pack8(vc, 0); vb[jt][dvt][1] = pack8(vc, 1);
#if MK_DEBUG == 4
                { bool b_ = false; _Pragma("unroll") for (int rg = 0; rg < 16; ++rg) if (!(fabsf(vc[rg]) < 3.0e38f)) b_ = true; if (b_) atomicOr(ch.dbg, 8u); }
#endif
            }
#pragma unroll
        for (int it = 0; it < 2; ++it)
#pragma unroll
            for (int dvt = 0; dvt < 2; ++dvt) {
                f32x16 u = {};
#pragma unroll
                for (int s = 0; s < 2; ++s) {
                    if (it == 0) u = DN_MFMA(Tf[0][s], vb[0][dvt][s], u);
                    else { u = DN_MFMA(Tf[1][s], vb[0][dvt][s], u); u = DN_MFMA(Tf[2][s], vb[1][dvt][s], u); }
                }
                asm volatile("s_nop 15\n\ts_nop 7" : "+v"(u));
                sl[(F_U + (it * 2 + dvt) * 2 + 0) * 64 + lane] = __builtin_bit_cast(v4u, pack8(u, 0));
                sl[(F_U + (it * 2 + dvt) * 2 + 1) * 64 + lane] = __builtin_bit_cast(v4u, pack8(u, 1));
            }
    }
    { v4u gw; gw.x = __float_as_uint(__expf(gl)); gw.y = gw.x; gw.z = gw.x; gw.w = gw.x; sl[F_GL * 64 + lane] = gw; }
}

__device__ __forceinline__ f32x16 unpack16(v4u a, v4u b) {
    f32x16 x;
    x[0] = bflo(a.x); x[1] = bfhi(a.x); x[2] = bflo(a.y); x[3] = bfhi(a.y); x[4] = bflo(a.z); x[5] = bfhi(a.z); x[6] = bflo(a.w); x[7] = bfhi(a.w);
    x[8] = bflo(b.x); x[9] = bfhi(b.x); x[10] = bflo(b.y); x[11] = bfhi(b.y); x[12] = bflo(b.z); x[13] = bfhi(b.z); x[14] = bflo(b.w); x[15] = bfhi(b.w);
    return x;
}
__device__ __forceinline__ void consume(const Chain& ch, int ci, const unsigned char* slot, f32x16 (&S)[2], int hv, int lane_in) {
    int lane = lane_in; asm volatile("" : "+v"(lane));
    const int r = lane & 31, hh = lane >> 5;
    const v4u* sl = (const v4u*)slot;
#define DN_FR(idx) __builtin_bit_cast(bf16x8, sl[(idx) * 64 + lane])
    const float gl = __builtin_bit_cast(float, sl[F_GL * 64 + lane].x);
#if MK_DEBUG == 2
    { unsigned bad = 0u;
      auto nf = [](v4u w) { return ((w.x & 0x7f80u) == 0x7f80u) || ((w.x & 0x7f800000u) == 0x7f800000u) || ((w.y & 0x7f80u) == 0x7f80u) || ((w.y & 0x7f800000u) == 0x7f800000u) || ((w.z & 0x7f80u) == 0x7f80u) || ((w.z & 0x7f800000u) == 0x7f800000u) || ((w.w & 0x7f80u) == 0x7f80u) || ((w.w & 0x7f800000u) == 0x7f800000u); };
      if ((__float_as_uint(gl) & 0x7f800000u) == 0x7f800000u) bad |= 1u;
      for (int i = 0; i < 8; ++i) { if (nf(sl[(F_WT + i) * 64 + lane])) bad |= 2u; if (nf(sl[(F_QD + i) * 64 + lane])) bad |= 4u; if (nf(sl[(F_KD + i) * 64 + lane])) bad |= 8u; if (nf(sl[(F_U + i) * 64 + lane])) bad |= 16u; }
      for (int i = 0; i < 6; ++i) if (nf(sl[(F_QKT + i) * 64 + lane])) bad |= 32u;
      if (bad) atomicOr(ch.dbg, bad); }
#endif
    asm volatile("s_nop 15\n\ts_nop 7" : "+v"(S[0]), "+v"(S[1]));
    bf16x8 Sb[2][2];
#pragma unroll
    for (int dt = 0; dt < 2; ++dt) { Sb[dt][0] = pack8(S[dt], 0); Sb[dt][1] = pack8(S[dt], 1); }
    f32x16 accv[2], acco[2];
#pragma unroll
    for (int it = 0; it < 2; ++it) { accv[it] = f32x16{}; acco[it] = f32x16{};
#pragma unroll
        for (int dt = 0; dt < 2; ++dt)
#pragma unroll
            for (int s = 0; s < 2; ++s) {
                accv[it] = DN_MFMA(DN_FR(F_WT + (dt * 2 + it) * 2 + s), Sb[dt][s], accv[it]);
                acco[it] = DN_MFMA(DN_FR(F_QD + it * 4 + 2 * dt + s), Sb[dt][s], acco[it]);
            } }
    bf16x8 vb[2][2];
#pragma unroll
    for (int it = 0; it < 2; ++it) {
        const f32x16 u = unpack16(sl[(F_U + (it * 2 + hv) * 2 + 0) * 64 + lane], sl[(F_U + (it * 2 + hv) * 2 + 1) * 64 + lane]);
        const f32x16 vn = u - accv[it];
        vb[it][0] = pack8(vn, 0); vb[it][1] = pack8(vn, 1);
    }
#pragma unroll
    for (int s = 0; s < 2; ++s) {
        acco[0] = DN_MFMA(DN_FR(F_QKT + 0 * 2 + s), vb[0][s], acco[0]);
        acco[1] = DN_MFMA(DN_FR(F_QKT + 1 * 2 + s), vb[0][s], acco[1]);
        acco[1] = DN_MFMA(DN_FR(F_QKT + 2 * 2 + s), vb[1][s], acco[1]);
    }
#pragma unroll
    for (int dt = 0; dt < 2; ++dt) {
        S[dt] = S[dt] * gl;
#pragma unroll
        for (int jt = 0; jt < 2; ++jt)
#pragma unroll
            for (int s = 0; s < 2; ++s) S[dt] = DN_MFMA(DN_FR(F_KD + (jt * 2 + dt) * 2 + s), vb[jt][s], S[dt]);
    }
    const int c = chunk_of(ci, ch.dir), t0 = 64 * c;
#pragma unroll
    for (int it = 0; it < 2; ++it)
#pragma unroll
        for (int rg = 0; rg < 16; ++rg) { const int i = 32 * it + crow(rg, hh); const int tok = ch.dir ? t0 + 63 - i : t0 + i;
            ch.Ob[(size_t)tok * 512 + ch.h * 64 + 32 * hv + r] = (bf16_t)f2bf(acco[it][rg]); }
#undef DN_FR
}

__device__ __forceinline__ void chain_unit(const Chain& ch, const float* wconv  , LAS unsigned char* lds, LAS float* wct, int wave) {
    const int lane = hw_lane(), wid = wave, tid = wave * 64 + lane;
    for (int i = tid; i < 3 * 192; i += NTHREADS) { const int tap = i / 192, cc = i % 192, x = cc / 64, d = cc % 64;
        wct[i] = wconv[tap * 1536 + (x == 0 ? 512 : (x == 1 ? 0 : 1024)) + ch.h * 64 + d]; }
    __syncthreads();
    constexpr int NG = (NCHUNK + GROUP - 1) / GROUP;
#define DN_BAR() do { asm volatile("s_waitcnt vmcnt(0) lgkmcnt(0)" ::: "memory"); __builtin_amdgcn_s_barrier(); asm volatile("" ::: "memory"); } while (0)
    if (wid >= 2) {
        for (int k = 0; k <= NG; ++k) {
            const int ci = k * GROUP + (wid - 2);
#ifndef NO_DNP
            if (k < NG && ci < NCHUNK) produce(ch, ci, lds + wid * WREG, wct, ch.ring + (size_t)((k & 1) * GROUP + (wid - 2)) * RING_SLOT, lane);
#endif
            DN_BAR();
        }
    } else {
        f32x16 S[2]; S[0] = f32x16{}; S[1] = f32x16{};
        for (int k = 0; k <= NG; ++k) {
#ifndef NO_DNC
            if (k >= 1) { const int g0 = (k - 1) * GROUP; const int n = (NCHUNK - g0 < GROUP) ? NCHUNK - g0 : GROUP;
                for (int j = 0; j < n; ++j) consume(ch, g0 + j, ch.ring + (size_t)(((k - 1) & 1) * GROUP + j) * RING_SLOT, S, wid, lane); }
#endif
            DN_BAR();
        }
    }
#undef DN_BAR
    __syncthreads();
}
#undef DN_MFMA
}
struct Params {
    const float* in[28];
    float* out; unsigned char* ws;
    int ph_lo, ph_hi; int use_bar; int pad;
};
enum { I_X = 0, I_C, I_CTX, I_CCTX, I_WMOD, I_BMOD, I_GN1, I_GN2, I_WIN, I_GQ, I_GK, I_WCONV, I_ALOG, I_DTB, I_GDN, I_LAMQK, I_GSUB, I_WBR, I_WOUT, I_WRT, I_BRT,
       I_WEG, I_WEU, I_WED, I_WSG, I_WSU, I_WSD, I_GFIN };
struct Frame {
    LAS unsigned char* lds; volatile LAS unsigned* MISC; gu32* ctl;
    int tid, lane, wave, G, gw, NGW;
    unsigned char* ws;
};
__device__ __forceinline__ size_t hrow_off(int r, bool& isctx, int& b) { b = r / TT; const int t = r - b * TT; isctx = t < CTXL; return isctx ? (size_t)(b * CTXL + t) * DM : (size_t)(b * SEQ + (t - CTXL)) * DM; }

__device__ __forceinline__ void transpose_item(const float* W, int ldw, int k0, int n0, bf16_t* WT, int K, int dst_row0, LAS float* scr, int lane) {
#pragma unroll 8
    for (int i = 0; i < 32; ++i) { const int kk = 2 * i + (lane >> 5); scr[kk * 33 + (lane & 31)] = W[(size_t)(k0 + kk) * ldw + n0 + (lane & 31)]; }
    LDS_WAIT(); asm volatile("" ::: "memory");
    const int c = lane & 7;
#pragma unroll
    for (int j = 0; j < 4; ++j) { const int n = (lane >> 3) + 8 * j; const LAS float* s = scr + (8 * c) * 33 + n;
        v4u o; o.x = pk2(s[0 * 33], s[1 * 33]); o.y = pk2(s[2 * 33], s[3 * 33]); o.z = pk2(s[4 * 33], s[5 * 33]); o.w = pk2(s[6 * 33], s[7 * 33]);
        *(v4u*)(WT + (size_t)(dst_row0 + n) * K + k0 + 8 * c) = o; }
    LDS_WAIT(); asm volatile("" ::: "memory");
}
__device__ __forceinline__ void convert_small(Frame& F, const Params& P, int l) {
    LAS float* scr = (LAS float*)(F.lds + RING_OFF + F.wave * 16384);
    const float* win = P.in[I_WIN] + (size_t)l * DM * INW;
    const float* wbr = P.in[I_WBR] + (size_t)l * 3 * 512 * DM;
    const float* wo = P.in[I_WOUT] + (size_t)l * DM * DM;
    bf16_t* WB1 = (bf16_t*)(F.ws + WS_WB1); bf16_t* WB2 = (bf16_t*)(F.ws + WS_WB2); bf16_t* WBR = (bf16_t*)(F.ws + WS_WBR); bf16_t* WOT = (bf16_t*)(F.ws + WS_WOT);
    constexpr int I1 = 16 * (P1W / 32), I2 = 16 * (GW / 32), I3 = 3 * 8 * 32, I4 = 16 * 32;
    for (int it = F.gw; it < I1 + I2 + I3 + I4; it += F.NGW) {
        int r = it;
        if (r < I1) { const int nb = r % (P1W / 32), kb = r / (P1W / 32); transpose_item(win, INW, 64 * kb, 32 * nb, WB1, DM, 32 * nb, scr, F.lane); continue; } r -= I1;
        if (r < I2) { const int nb = r % (GW / 32), kb = r / (GW / 32); transpose_item(win, INW, 64 * kb, C_GATE + 32 * nb, WB2, DM, 32 * nb, scr, F.lane); continue; } r -= I2;
        if (r < I3) { const int br = r / 256, q = r % 256, nb = q % 32, kb = q / 32; transpose_item(wbr + (size_t)br * 512 * DM, DM, 64 * kb, 32 * nb, WBR + (size_t)br * DM * 512, 512, 32 * nb, scr, F.lane); continue; } r -= I3;
        { const int nb = r % 32, kb = r / 32; transpose_item(wo, DM, 64 * kb, 32 * nb, WOT, DM, 32 * nb, scr, F.lane); }
    }
}
__device__ __forceinline__ void convert_experts(Frame& F, const Params& P, int l) {
    LAS float* scr = (LAS float*)(F.lds + RING_OFF + F.wave * 16384);
    bf16_t* WGU = (bf16_t*)(F.ws + WS_B); bf16_t* WD = WGU + (size_t)NEXP1 * 512 * DM;
    for (int it = F.gw; it < NEXP1 * 384; it += F.NGW) {
        const int e = it / 384; int r = it % 384;
        const float* wg = (e < NEXP) ? P.in[I_WEG] + ((size_t)l * NEXP + e) * DM * FF : P.in[I_WSG] + (size_t)l * DM * FF;
        const float* wu = (e < NEXP) ? P.in[I_WEU] + ((size_t)l * NEXP + e) * DM * FF : P.in[I_WSU] + (size_t)l * DM * FF;
        const float* wd = (e < NEXP) ? P.in[I_WED] + ((size_t)l * NEXP + e) * FF * DM : P.in[I_WSD] + (size_t)l * FF * DM;
        if (r < 256) { const bool up = r >= 128; r &= 127; const int nb = r % 8, kb = r / 8; const int n0 = 32 * nb;
            transpose_item(up ? wu : wg, FF, 64 * kb, n0, WGU + (size_t)e * 512 * DM, DM, (n0 / 128) * 256 + (up ? 128 : 0) + (n0 % 128), scr, F.lane); }
        else { r -= 256; const int nb = r % 32, kb = r / 32; transpose_item(wd, DM, 64 * kb, 32 * nb, WD + (size_t)e * DM * FF, FF, 32 * nb, scr, F.lane); }
    }
}
__device__ __forceinline__ void compute_mod(Frame& F, const Params& P) {
    float* modv = (float*)(F.ws + WS_MODV);
    const int kq = F.lane >> 3, nn = F.lane & 7;
    for (int it = F.gw; it < NLAYER * (6144 / 8); it += F.NGW) {
        const int l = it / (6144 / 8), n = (it % (6144 / 8)) * 8 + nn;
        const float* w = P.in[I_WMOD] + (size_t)l * DM * 6144 + n;
        float a0 = 0.f, a1 = 0.f, a2 = 0.f;
#pragma unroll 8
        for (int i = 0; i < 128; ++i) { const int k = kq + 8 * i; const float wv = w[(size_t)k * 6144];
            a0 += siluf_(P.in[I_C][k]) * wv; a1 += siluf_(P.in[I_C][DM + k]) * wv; a2 += siluf_(P.in[I_CCTX][k]) * wv; }
#pragma unroll
        for (int o = 8; o < 64; o <<= 1) { a0 += __shfl_xor(a0, o); a1 += __shfl_xor(a1, o); a2 += __shfl_xor(a2, o); }
        if (kq == 0) { const float bm = P.in[I_BMOD][l * 6144 + n]; float* m = modv + (size_t)l * 3 * 6144 + n; m[0] = a0 + bm; m[6144] = a1 + bm; m[2 * 6144] = a2 + bm; }
    }
}
__device__ __forceinline__ void modnorm_store(const float (&x)[16], const float* g, const float* sc, const float* sh, bf16_t* orow, int lane) {
    float ss = 0.f;
#pragma unroll
    for (int i = 0; i < 16; ++i) ss += x[i] * x[i];
    const float rstd = rsqrtf(wave_sum(ss) * (1.f / DM) + EPS);
#pragma unroll
    for (int hf = 0; hf < 2; ++hf) { const int c0 = hf * 512 + lane * 8; float y[8];
#pragma unroll
        for (int j = 0; j < 8; ++j) y[j] = x[hf * 8 + j] * rstd * g[c0 + j] * (1.f + sc[c0 + j]) + sh[c0 + j];
        v4u w; w.x = cvt_pk_bf16(y[0], y[1]); w.y = cvt_pk_bf16(y[2], y[3]); w.z = cvt_pk_bf16(y[4], y[5]); w.w = cvt_pk_bf16(y[6], y[7]);
        *(v4u*)(orow + c0) = w; }
}
__device__ __forceinline__ void load_row16(const float* row, float (&x)[16], int lane) {
#pragma unroll
    for (int hf = 0; hf < 2; ++hf) { const f32x4 a = *(const f32x4*)(row + hf * 512 + lane * 8), b = *(const f32x4*)(row + hf * 512 + lane * 8 + 4);
        x[hf * 8 + 0] = a[0]; x[hf * 8 + 1] = a[1]; x[hf * 8 + 2] = a[2]; x[hf * 8 + 3] = a[3]; x[hf * 8 + 4] = b[0]; x[hf * 8 + 5] = b[1]; x[hf * 8 + 6] = b[2]; x[hf * 8 + 7] = b[3]; }
}
__device__ __forceinline__ void phase_norm1(Frame& F, const Params& P) {
    const float* modv = (const float*)(F.ws + WS_MODV); bf16_t* U = (bf16_t*)(F.ws + WS_C);
    for (int r = F.gw; r < MROWS; r += F.NGW) { bool isctx; int b; const size_t off = hrow_off(r, isctx, b);
        const float* row = (isctx ? P.in[I_CTX] : P.in[I_X]) + off; float x[16]; load_row16(row, x, F.lane);
        const float* mv = modv + (isctx ? 2 : b) * 6144;
        modnorm_store(x, P.in[I_GN1], mv + 1 * DM, mv + 0 * DM, U + (size_t)r * DM, F.lane); }
}
__device__ __forceinline__ void phase_prep(Frame& F, const Params& P, int l) {
    bf16_t* P1 = (bf16_t*)(F.ws + WS_A);
    const int i = F.lane & 31, hsel = F.lane >> 5;
    const float gq0 = P.in[I_GQ][l * 64 + i], gq1 = P.in[I_GQ][l * 64 + 32 + i], gk0 = P.in[I_GK][l * 64 + i], gk1 = P.in[I_GK][l * 64 + 32 + i];
    const float inv = exp2f(-(float)(i & 15) * (13.287712379549449f / 16.f));
    for (int r = F.gw; r < MROWS; r += F.NGW) {
        const int b = r / TT, t = r - b * TT; const bool lat = t >= CTXL;
        float cs = 1.f, sn = 0.f;
        if (lat) { const int s = t - CTXL; const float pos = (i < 16) ? (float)(s / GRIDW) : (float)(s % GRIDW); sincosf(pos * inv, &sn, &cs); }
        bf16_t* row = P1 + (size_t)r * P1W;
#pragma unroll 1
        for (int it = 0; it < 13; ++it) {
            const int hd = 2 * it + hsel;
            int col; int kind;
            if (hd < 8) { col = C_AQ + hd * 64; kind = 0; } else if (hd < 10) { col = C_AK + (hd - 8) * 64; kind = 1; } else if (hd < 18) { col = C_CQ + (hd - 10) * 64; kind = 2; } else { col = C_CK + (hd - 18) * 64; kind = 3; }
            float x0 = bf2f(row[col + i]), x1 = bf2f(row[col + 32 + i]);
            if (kind < 2) { float ss = x0 * x0 + x1 * x1;
#pragma unroll
                for (int o = 1; o < 32; o <<= 1) ss += __shfl_xor(ss, o);
                const float rstd = rsqrtf(ss * (1.f / 64.f) + EPS);
                x0 *= rstd * (kind == 0 ? gq0 : gk0); x1 *= rstd * (kind == 0 ? gq1 : gk1); }
            float y0 = x0 * cs - x1 * sn, y1 = x1 * cs + x0 * sn;
            if (kind == 0 || kind == 2) { y0 *= QSCALE; y1 *= QSCALE; }
            row[col + i] = (bf16_t)f2bf(y0); row[col + 32 + i] = (bf16_t)f2bf(y1);
        }
    }
}
__device__ __forceinline__ void phase_post(Frame& F, const Params& P, int l) {
    const bf16_t* P1 = (const bf16_t*)(F.ws + WS_A); bf16_t* BR = (bf16_t*)(F.ws + WS_B);
    const bf16_t* DO = (const bf16_t*)(F.ws + WS_D); const bf16_t* OFw = DO + (size_t)MROWS * 1024; const bf16_t* OBw = OFw + (size_t)MROWS * 512;
    const float linit = 0.8f - 0.6f * expf(-0.3f * (float)l);
    const float* lq = P.in[I_LAMQK] + l * 256;
    const float lam = expf(wave_sum(lq[F.lane] * lq[64 + F.lane])) - expf(wave_sum(lq[128 + F.lane] * lq[192 + F.lane])) + linit;
    const float gdn = P.in[I_GDN][l * 64 + F.lane];
    const float gs0 = P.in[I_GSUB][l * 128 + F.lane] * (1.f - linit), gs1 = P.in[I_GSUB][l * 128 + 64 + F.lane] * (1.f - linit);
    for (int r = F.gw; r < MROWS; r += F.NGW) {
#pragma unroll
        for (int h = 0; h < 8; ++h) { const size_t o = (size_t)r * 512 + h * 64 + F.lane;
            const float s = bf2f(OFw[o]) + bf2f(OBw[o]); const float rstd = rsqrtf(wave_sum(s * s) * (1.f / 64.f) + EPS);
            const float z = bf2f(P1[(size_t)r * P1W + C_BZ + h * 64 + F.lane]);
            BR[(size_t)r * 1536 + 512 + h * 64 + F.lane] = (bf16_t)f2bf(s * rstd * gdn * siluf_(z)); }
#pragma unroll
        for (int h = 0; h < 4; ++h) { const bf16_t* d0 = DO + (size_t)r * 1024 + (2 * h) * 128, *d1 = d0 + 128;
            const float a0 = bf2f(d0[F.lane]) - lam * bf2f(d1[F.lane]), a1 = bf2f(d0[64 + F.lane]) - lam * bf2f(d1[64 + F.lane]);
            const float rstd = rsqrtf(wave_sum(a0 * a0 + a1 * a1) * (1.f / 128.f) + EPS);
            bf16_t* o = BR + (size_t)r * 1536 + 1024 + h * 128;
            o[F.lane] = (bf16_t)f2bf(a0 * rstd * gs0); o[64 + F.lane] = (bf16_t)f2bf(a1 * rstd * gs1); }
    }
}
__device__ __forceinline__ void phase_norm2_router(Frame& F, const Params& P, int l) {
    const float* modv = (const float*)(F.ws + WS_MODV) + (size_t)l * 3 * 6144; bf16_t* U = (bf16_t*)(F.ws + WS_C);
    const float* hlat = P.out; const float* hctx = (const float*)(F.ws + WS_HCTX);
    int* tope = (int*)(F.ws + WS_TOPE); float* topw = (float*)(F.ws + WS_TOPW); int* tops = (int*)(F.ws + WS_TOPS);
    LAS float* vS = (LAS float*)(F.lds + RING_OFF + F.wave * 16384);
    const float* wr = P.in[I_WRT] + (size_t)l * DM * NEXP; const float brt = P.in[I_BRT][l * NEXP + F.lane];
    const float* g2 = P.in[I_GN2] + l * DM;
    const int lane = F.lane;
    for (int r0 = F.gw * 4; r0 < MROWS; r0 += F.NGW * 4) {
#pragma unroll 1
        for (int q = 0; q < 4; ++q) { const int r = r0 + q; bool isctx; int b; const size_t off = hrow_off(r, isctx, b);
            const float* row = (isctx ? hctx : hlat) + off; float x[16]; load_row16(row, x, lane);
            const float* mv = modv + (isctx ? 2 : b) * 6144; const float* sc = mv + 4 * DM; const float* sh = mv + 3 * DM;
            float ss = 0.f;
#pragma unroll
            for (int i = 0; i < 16; ++i) ss += x[i] * x[i];
            const float rstd = rsqrtf(wave_sum(ss) * (1.f / DM) + EPS);
#pragma unroll
            for (int hf = 0; hf < 2; ++hf) { const int c0 = hf * 512 + lane * 8; float y[8];
#pragma unroll
                for (int j = 0; j < 8; ++j) { y[j] = x[hf * 8 + j] * rstd * g2[c0 + j] * (1.f + sc[c0 + j]) + sh[c0 + j]; vS[(c0 + j) * 4 + q] = y[j]; }
                v4u w; w.x = cvt_pk_bf16(y[0], y[1]); w.y = cvt_pk_bf16(y[2], y[3]); w.z = cvt_pk_bf16(y[4], y[5]); w.w = cvt_pk_bf16(y[6], y[7]);
                *(v4u*)(U + (size_t)r * DM + c0) = w; } }
        LDS_WAIT();
        float a0 = 0.f, a1 = 0.f, a2 = 0.f, a3 = 0.f;
#pragma unroll 8
        for (int k = 0; k < DM; ++k) { const float w = wr[k * NEXP + lane]; const f32x4 v = *(const LAS f32x4*)(vS + k * 4); a0 += v[0] * w; a1 += v[1] * w; a2 += v[2] * w; a3 += v[3] * w; }
        LDS_WAIT();
#pragma unroll 1
        for (int q = 0; q < 4; ++q) { const int r = r0 + q; const float lg = q == 0 ? a0 : (q == 1 ? a1 : (q == 2 ? a2 : a3));
            const float sc = 1.f / (1.f + expf(-lg)); const float sel = sc + brt;
            float m1 = sel;
#pragma unroll
            for (int o = 1; o < 8; o <<= 1) m1 = fmaxf(m1, __shfl_xor(m1, o));
            int fi = (sel == m1) ? lane : 999;
#pragma unroll
            for (int o = 1; o < 8; o <<= 1) fi = min(fi, __shfl_xor(fi, o));
            float m2 = (lane == fi) ? -INFINITY : sel;
#pragma unroll
            for (int o = 1; o < 8; o <<= 1) m2 = fmaxf(m2, __shfl_xor(m2, o));
            const float gs = m1 + m2; const int g = lane >> 3;
            int grank = 0;
#pragma unroll
            for (int gg = 0; gg < 8; ++gg) { const float o = __shfl(gs, gg * 8); grank += (o > gs || (o == gs && gg < g)) ? 1 : 0; }
            const float val = (grank < 4) ? sel : -INFINITY;
            int rank = 0;
#pragma unroll 8
            for (int e = 0; e < 64; ++e) { const float o = __shfl(val, e); rank += (o > val || (o == val && e < lane)) ? 1 : 0; }
            const bool selx = (grank < 4) && (rank < TOPK);
            const float wsum = wave_sum(selx ? sc : 0.f);
            const int half = r / TT;
            if (selx) { const int slot = atomicAdd((int*)(F.ctl + CW_ECNT + ((l * 2 + half) * NEXP1 + lane) * 16), 1);
                tope[(size_t)r * 8 + rank] = lane; topw[(size_t)r * 8 + rank] = sc / (wsum + 1e-20f) * 2.5f; tops[(size_t)r * 8 + rank] = slot; }
            if (lane == 0) { tope[(size_t)r * 8 + 6] = NEXP; topw[(size_t)r * 8 + 6] = 1.f; tops[(size_t)r * 8 + 6] = r - half * TT; }
        }
    }
}
__device__ __forceinline__ void moe_table(Frame& F, int l, int half, LAS int* ts, LAS int* te) {
    __syncthreads();
    if (F.tid == 0) { int acc = 0;
        for (int e = 0; e < NEXP1; ++e) { const int cnt = (e < NEXP) ? (int)__hip_atomic_load(F.ctl + CW_ECNT + ((l * 2 + half) * NEXP1 + e) * 16, RLX_AGENT) : TT; ts[e] = acc; const int n = (cnt + 255) / 256;
            for (int k = 0; k < n; ++k) te[acc + k] = e; acc += n; }
        ts[NEXP1] = acc; }
    __syncthreads();
}
__device__ __forceinline__ void phase_scatter(Frame& F, int l) {
    LAS int* ts = (LAS int*)(F.lds + MISC_OFF + 256); LAS int* te = (LAS int*)(F.lds + MISC_OFF + 3584);
    const int* tope = (const int*)(F.ws + WS_TOPE); const float* topw = (const float*)(F.ws + WS_TOPW); int* tops = (int*)(F.ws + WS_TOPS);
    for (int half = 0; half < 2; ++half) {
        moe_table(F, l, half, ts, te);
        int* rtok = (int*)(F.ws + WS_RTOK) + (size_t)half * HROWS_PAD; float* rw = (float*)(F.ws + WS_RW) + (size_t)half * HROWS_PAD;
        for (int r = half * TT + F.gw; r < (half + 1) * TT; r += F.NGW) {
            if (F.lane < 7) { const int e = tope[(size_t)r * 8 + F.lane]; const int pos = ts[e] * 256 + tops[(size_t)r * 8 + F.lane];
                rtok[pos] = r; rw[pos] = topw[(size_t)r * 8 + F.lane]; tops[(size_t)r * 8 + F.lane] = pos; } }
        for (int it = blockIdx.x * NTHREADS + F.tid; it < NEXP1 * 256; it += F.G * NTHREADS) { const int e = it >> 8, j = it & 255;
            const int cnt = (e < NEXP) ? (int)__hip_atomic_load(F.ctl + CW_ECNT + ((l * 2 + half) * NEXP1 + e) * 16, RLX_AGENT) : TT;
            const int rem = cnt & 255; if (rem != 0 && j >= rem) { const int pos = (ts[e] + (cnt >> 8)) * 256 + j; rtok[pos] = half * TT; rw[pos] = 0.f; } }
    }
}
__device__ __forceinline__ void phase_combine(Frame& F, const Params& P, int l, int half) {
    const float* modv = (const float*)(F.ws + WS_MODV) + (size_t)l * 3 * 6144; const float* modn = (const float*)(F.ws + WS_MODV) + (size_t)(l + 1) * 3 * 6144;
    float* hlat = P.out; float* hctx = (float*)(F.ws + WS_HCTX); bf16_t* U = (bf16_t*)(F.ws + WS_C);
    const bf16_t* Y = (const bf16_t*)(F.ws + WS_A); const int* tops = (const int*)(F.ws + WS_TOPS);
    const int lane = F.lane;
    for (int r = half * TT + F.gw; r < (half + 1) * TT; r += F.NGW) {
        bool isctx; int b; const size_t off = hrow_off(r, isctx, b);
        float* row = (isctx ? hctx : hlat) + off; float x[16]; load_row16(row, x, lane);
        float y[16];
#pragma unroll
        for (int i = 0; i < 16; ++i) y[i] = 0.f;
#pragma unroll
        for (int k = 0; k < 7; ++k) { const int pos = tops[(size_t)r * 8 + k]; const bf16_t* yr = Y + (size_t)pos * DM;
#pragma unroll
            for (int hf = 0; hf < 2; ++hf) { const v4u w = *(const v4u*)(yr + hf * 512 + lane * 8);
                y[hf * 8 + 0] += bflo(w.x); y[hf * 8 + 1] += bfhi(w.x); y[hf * 8 + 2] += bflo(w.y); y[hf * 8 + 3] += bfhi(w.y); y[hf * 8 + 4] += bflo(w.z); y[hf * 8 + 5] += bfhi(w.z); y[hf * 8 + 6] += bflo(w.w); y[hf * 8 + 7] += bfhi(w.w); } }
        const float* gt2 = modv + (isctx ? 2 : b) * 6144 + 5 * DM;
#pragma unroll
        for (int hf = 0; hf < 2; ++hf)
#pragma unroll
            for (int j = 0; j < 8; ++j) x[hf * 8 + j] += gt2[hf * 512 + lane * 8 + j] * y[hf * 8 + j];
        if (l + 1 < NLAYER) {
#pragma unroll
            for (int hf = 0; hf < 2; ++hf) { *(f32x4*)(row + hf * 512 + lane * 8) = (f32x4){x[hf * 8 + 0], x[hf * 8 + 1], x[hf * 8 + 2], x[hf * 8 + 3]}; *(f32x4*)(row + hf * 512 + lane * 8 + 4) = (f32x4){x[hf * 8 + 4], x[hf * 8 + 5], x[hf * 8 + 6], x[hf * 8 + 7]}; }
            const float* mv = modn + (isctx ? 2 : b) * 6144;
            modnorm_store(x, P.in[I_GN1] + (l + 1) * DM, mv + 1 * DM, mv + 0 * DM, U + (size_t)r * DM, lane);
        } else if (!isctx) {
            float ss = 0.f;
#pragma unroll
            for (int i = 0; i < 16; ++i) ss += x[i] * x[i];
            const float rstd = rsqrtf(wave_sum(ss) * (1.f / DM) + EPS); const float* gf = P.in[I_GFIN];
#pragma unroll
            for (int hf = 0; hf < 2; ++hf) { const int c0 = hf * 512 + lane * 8;
                *(f32x4*)(row + c0) = (f32x4){x[hf * 8 + 0] * rstd * gf[c0 + 0], x[hf * 8 + 1] * rstd * gf[c0 + 1], x[hf * 8 + 2] * rstd * gf[c0 + 2], x[hf * 8 + 3] * rstd * gf[c0 + 3]};
                *(f32x4*)(row + c0 + 4) = (f32x4){x[hf * 8 + 4] * rstd * gf[c0 + 4], x[hf * 8 + 5] * rstd * gf[c0 + 5], x[hf * 8 + 6] * rstd * gf[c0 + 6], x[hf * 8 + 7] * rstd * gf[c0 + 7]}; }
        }
    }
}
#if defined(MK_DEBUG)
__global__ void chk_bf16(const bf16_t* buf, long rows, int cols, int pitch, unsigned* word, unsigned bit) {
    bool bad = false;
    for (long i = blockIdx.x * (long)blockDim.x + threadIdx.x; i < rows * cols; i += (long)gridDim.x * blockDim.x) { const long r = i / cols; const int c = (int)(i % cols);
        const unsigned short v = buf[r * pitch + c]; if ((v & 0x7f80u) == 0x7f80u) bad = true; }
    if (bad) atomicOr(word, bit);
}
__global__ void chk_f32(const float* buf, long n, unsigned* word, unsigned bit) {
    bool bad = false;
    for (long i = blockIdx.x * (long)blockDim.x + threadIdx.x; i < n; i += (long)gridDim.x * blockDim.x) { const unsigned v = __float_as_uint(buf[i]); if ((v & 0x7f800000u) == 0x7f800000u) bad = true; }
    if (bad) atomicOr(word, bit);
}
__global__ void dbg_fill(float* out, long n, const unsigned* word) {
    const float a = 1.0f + (float)(*word);
    for (long i = blockIdx.x * (long)blockDim.x + threadIdx.x; i < n; i += (long)gridDim.x * blockDim.x) out[i] = a;
}
#endif
constexpr int NU_DN = 32, NU_GQA = 1024, NU_DIFF = 2048, NU_GQAC = 16, NU_DIFFC = 32, NU_TOTAL = NU_DN + NU_GQA + NU_DIFF + NU_GQAC + NU_DIFFC;
__device__ __forceinline__ void phase_mix(Frame& F, const Params& P, int l) {
    bf16_t* P1 = (bf16_t*)(F.ws + WS_A); bf16_t* BR = (bf16_t*)(F.ws + WS_B); bf16_t* DO = (bf16_t*)(F.ws + WS_D);
    bf16_t* OFw = DO + (size_t)MROWS * 1024; bf16_t* OBw = OFw + (size_t)MROWS * 512;
    gu32* qc = F.ctl + CW_QUEUE + 64 * l;
    for (;;) {
        __syncthreads();
        if (F.tid == 0) F.MISC[16] = __hip_atomic_fetch_add(qc, 1u, RLX_AGENT);
        __syncthreads();
        const int u = __builtin_amdgcn_readfirstlane((int)F.MISC[16]);
        if (u >= NU_TOTAL) break;
#ifndef NO_DN
        if (u < NU_DN) {
            dn::Chain ch; const int b = u >> 4, h = (u >> 1) & 7, dir = u & 1;
            ch.P1b = P1 + (size_t)b * TT * P1W; ch.Ob = (dir ? OBw : OFw) + (size_t)b * TT * 512; ch.h = h; ch.dir = dir;
            ch.Aexp = expf(P.in[I_ALOG][l * 16 + dir * 8 + h]); ch.dtb = P.in[I_DTB][l * 16 + dir * 8 + h];
            ch.ring = F.ws + WS_RING + (size_t)u * 12 * RING_SLOT; ch.dbg = (unsigned*)(F.ws + WS_CTL) + 64;
            dn::chain_unit(ch, P.in[I_WCONV] + (size_t)l * 3 * 1536, F.lds + RING_OFF, (LAS float*)(F.lds + MISC_OFF + 1024), F.wave);
            continue;
        }
#endif
#ifndef NO_ATTN
        int b, qrow, nt, qcol, kcol, vcol, ocol, op; bf16_t* obase;
        if (u < NU_DN + NU_GQA) { const int idx = u - NU_DN; b = idx >> 9; const int rem = idx & 511, kvh = rem >> 8, hq = (rem >> 6) & 3, qb = rem & 63, h = kvh * 4 + hq;
            qrow = CTXL + qb * 256; nt = TT / 64; qcol = C_AQ + h * 64; kcol = C_AK + kvh * 64; vcol = C_AV + kvh * 64; obase = BR; op = 1536; ocol = h * 64; }
        else if (u < NU_DN + NU_GQA + NU_DIFF) { const int idx = u - NU_DN - NU_GQA; b = idx >> 10; const int rem = idx & 1023, hc = rem >> 7, vh = (rem >> 6) & 1, qb = rem & 63;
            qrow = CTXL + qb * 256; nt = TT / 64; qcol = C_CQ + hc * 64; kcol = C_CK + hc * 64; vcol = C_CV + (hc >> 1) * 128 + vh * 64; obase = DO; op = 1024; ocol = hc * 128 + vh * 64; }
        else if (u < NU_DN + NU_GQA + NU_DIFF + NU_GQAC) { const int idx = u - NU_DN - NU_GQA - NU_DIFF; b = idx >> 3; const int h = idx & 7, kvh = h >> 2;
            qrow = 0; nt = CTXL / 64; qcol = C_AQ + h * 64; kcol = C_AK + kvh * 64; vcol = C_AV + kvh * 64; obase = BR; op = 1536; ocol = h * 64; }
        else { const int idx = u - NU_DN - NU_GQA - NU_DIFF - NU_GQAC; b = idx >> 4; const int rem = idx & 15, hc = rem >> 1, vh = rem & 1;
            qrow = 0; nt = CTXL / 64; qcol = C_CQ + hc * 64; kcol = C_CK + hc * 64; vcol = C_CV + (hc >> 1) * 128 + vh * 64; obase = DO; op = 1024; ocol = hc * 128 + vh * 64; }
        const bf16_t* pb = P1 + (size_t)b * TT * P1W;
        attn_body::attn_unit<8>((const attn_body::bf16*)(pb + (size_t)qrow * P1W + qcol), P1W, (const attn_body::bf16*)(pb + kcol), P1W, (const attn_body::bf16*)(pb + vcol), P1W,
                                (attn_body::bf16*)(obase + ((size_t)b * TT + qrow) * op + ocol), op, nt, (char*)F.lds + RING_OFF, F.wave);
#endif
    }
}

#ifndef MK_PHMASK
#define MK_PHMASK 0xFFFFF
#endif
#define PHEN(k) (((MK_PHMASK) >> (k)) & 1)
constexpr int NPH_LAYER = 15, NPHASES = 2 + NLAYER * NPH_LAYER;
#define IN(k) (lo <= (k) && (k) < hi)
#define SEAM(k) do { if (IN(k) && IN((k) + 1)) { F.lane = hw_lane(); xcd_barrier(bar, F.wave == 0 && F.lane == 0); } F.lane = hw_lane(); F.tid = F.wave * 64 + F.lane; { unsigned char* w_ = P.ws; asm volatile("" : "+s"(w_)); F.ws = w_; F.ctl = (gu32*)(w_ + WS_CTL); } } while (0)
#define U ((bf16_t*)(F.ws + WS_C))
#define RA ((bf16_t*)(F.ws + WS_A))
#define BR ((bf16_t*)(F.ws + WS_B))
#define G2 RA
#define Mm (RA + (size_t)MROWS * GW)
#define Hs ((bf16_t*)(F.ws + WS_D))
#define Yb RA
#define WGU ((bf16_t*)(F.ws + WS_B))
#define WD (WGU + (size_t)NEXP1 * 512 * DM)
template <int l, int half> __device__ __forceinline__ void moe_half(Frame& F, const Params& P, const XcdBarrier& bar, int lo, int hi) {
    constexpr int pb = 2 + NPH_LAYER * l;
    LAS int* const ts = (LAS int*)(F.lds + MISC_OFF + 256); LAS int* const te = (LAS int*)(F.lds + MISC_OFF + 3584);
    constexpr int hb = pb + 9 + 3 * half;
            if (PHEN(9) && IN(hb + 0)) {
                moe_table(F, l, half, ts, te);
                pg8::Gemm g{U, WGU, DM, DM, DM, (const int*)(F.ws + WS_RTOK) + (size_t)half * HROWS_PAD}; pg8::MoeOrder S{ts, te, 2, F.G, (int)blockIdx.x};
                pg8::EpiMoe1 E{Hs, (const float*)(F.ws + WS_RW) + (size_t)half * HROWS_PAD};
                pg8::gemm_phase<pg8::EpiMoe1, pg8::MoeOrder, true>(F.lds + RING_OFF, g, S, E, F.wave);
            } SEAM(hb + 0);
            if (PHEN(10) && IN(hb + 1)) {
                moe_table(F, l, half, ts, te);
                pg8::Gemm g{Hs, WD, FF, FF, FF, nullptr}; pg8::MoeOrder S{ts, te, 4, F.G, (int)blockIdx.x};
                pg8::EpiBf16<0> E{Yb, DM};
                pg8::gemm_phase<pg8::EpiBf16<0>, pg8::MoeOrder, false>(F.lds + RING_OFF, g, S, E, F.wave);
            } SEAM(hb + 1);
            if (PHEN(11) && IN(hb + 2)) { phase_combine(F, P, l, half); if (half == 1 && l + 1 < NLAYER) { __syncthreads(); convert_small(F, P, l + 1); } } SEAM(hb + 2);
}
template <int l> __device__ __forceinline__ void layer_phases(Frame& F, const Params& P, const XcdBarrier& bar, int lo, int hi) {
    constexpr int pb = 2 + NPH_LAYER * l;
        if (PHEN(0) && IN(pb + 0)) {
            pg8::Gemm g{U, (const bf16_t*)(F.ws + WS_WB1), DM, DM, DM, nullptr}; pg8::DenseOrder S; S.init(MROWS / 256, P1W / 256, F.G, (int)blockIdx.x);
            pg8::EpiBf16<0> E{RA, P1W};
            pg8::gemm_phase<pg8::EpiBf16<0>, pg8::DenseOrder, false>(F.lds + RING_OFF, g, S, E, F.wave);
        } SEAM(pb + 0);
        if (PHEN(1) && IN(pb + 1)) { phase_prep(F, P, l); } SEAM(pb + 1);
        if (PHEN(2) && IN(pb + 2)) { phase_mix(F, P, l); } SEAM(pb + 2);
        if (PHEN(3) && IN(pb + 3)) { phase_post(F, P, l); } SEAM(pb + 3);
        if (PHEN(4) && IN(pb + 4)) {
            pg8::Gemm g{U, (const bf16_t*)(F.ws + WS_WB2), DM, DM, DM, nullptr}; pg8::DenseOrder S; S.init(MROWS / 256, GW / 256, F.G, (int)blockIdx.x);
            pg8::EpiBf16<1> E{G2, GW};
            pg8::gemm_phase<pg8::EpiBf16<1>, pg8::DenseOrder, false>(F.lds + RING_OFF, g, S, E, F.wave);
        } SEAM(pb + 4);
        if (PHEN(5) && IN(pb + 5)) {
#pragma unroll 1
            for (int br = 0; br < 3; ++br) {
                pg8::Gemm g{BR + br * 512, (const bf16_t*)(F.ws + WS_WBR) + (size_t)br * DM * 512, 1536, 512, 512, nullptr}; pg8::DenseOrder S; S.init(MROWS / 256, DM / 256, F.G, (int)blockIdx.x);
                pg8::EpiMerge E{Mm, G2, br * DM, br == 0 ? 1 : 0};
                pg8::gemm_phase<pg8::EpiMerge, pg8::DenseOrder, false>(F.lds + RING_OFF, g, S, E, F.wave);
            }
        } SEAM(pb + 5);
        if (PHEN(6) && IN(pb + 6)) {
            pg8::Gemm g{Mm, (const bf16_t*)(F.ws + WS_WOT), DM, DM, DM, nullptr}; pg8::DenseOrder S; S.init(MROWS / 256, DM / 256, F.G, (int)blockIdx.x);
            pg8::EpiResid E{l == 0 ? P.in[I_X] : P.out, l == 0 ? P.in[I_CTX] : (const float*)(F.ws + WS_HCTX), P.out, (float*)(F.ws + WS_HCTX), (const float*)(F.ws + WS_MODV) + (size_t)l * 3 * 6144, 2};
            pg8::gemm_phase<pg8::EpiResid, pg8::DenseOrder, false>(F.lds + RING_OFF, g, S, E, F.wave);
        } SEAM(pb + 6);
        if (PHEN(7) && IN(pb + 7)) { convert_experts(F, P, l); __syncthreads(); phase_norm2_router(F, P, l); } SEAM(pb + 7);
        if (PHEN(8) && IN(pb + 8)) { phase_scatter(F, l); } SEAM(pb + 8);
    moe_half<l, 0>(F, P, bar, lo, hi);
    moe_half<l, 1>(F, P, bar, lo, hi);
}
#undef IN
#undef SEAM
#undef U
#undef RA
#undef BR
#undef G2
#undef Mm
#undef Hs
#undef Yb
#undef WGU
#undef WD
__global__ void __launch_bounds__(NTHREADS, 2) fwd_kernel(Params P) {
    extern __shared__ __attribute__((aligned(16))) unsigned char lds_raw[];
    Frame F;
    F.lds = (LAS unsigned char*)lds_raw; F.MISC = (volatile LAS unsigned*)(F.lds + MISC_OFF);
    F.wave = __builtin_amdgcn_readfirstlane((int)threadIdx.x >> 6); F.lane = hw_lane(); F.tid = F.wave * 64 + F.lane; F.G = gridDim.x;
    F.gw = blockIdx.x * NWAVES + F.wave; F.NGW = F.G * NWAVES; F.ws = P.ws; F.ctl = (gu32*)(P.ws + WS_CTL);
    for (int u = F.tid; u < 64; u += NTHREADS) F.MISC[u] = 0u;
    __syncthreads();
    XcdBarrier bar; bar.bar = (unsigned*)(F.ctl + CW_BAR); bar.x = 0; bar.st = nullptr;
    if (P.use_bar) bar = xcd_barrier_post((unsigned*)(F.ctl + CW_BAR), F.MISC + 8, F.tid == 0);
    const int lo = P.ph_lo, hi = P.ph_hi;
#define IN(k) (lo <= (k) && (k) < hi)
#define SEAM(k) do { if (IN(k) && IN((k) + 1)) { F.lane = hw_lane(); xcd_barrier(bar, F.wave == 0 && F.lane == 0); } F.lane = hw_lane(); F.tid = F.wave * 64 + F.lane; { unsigned char* w_ = P.ws; asm volatile("" : "+s"(w_)); F.ws = w_; F.ctl = (gu32*)(w_ + WS_CTL); } } while (0)
    LAS int* const ts = (LAS int*)(F.lds + MISC_OFF + 256); LAS int* const te = (LAS int*)(F.lds + MISC_OFF + 3584);

    if (PHEN(15) && IN(0)) { convert_small(F, P, 0); compute_mod(F, P); } SEAM(0);
    if (PHEN(16) && IN(1)) { phase_norm1(F, P); } SEAM(1);
    layer_phases<0>(F, P, bar, lo, hi);
    layer_phases<1>(F, P, bar, lo, hi);
#undef IN
#undef SEAM
}

#ifndef MK_MULTI
#define MK_MULTI 1
#endif
extern "C" void kernel_launch(void* const* d_in, const int* in_sizes, int n_in, void* d_out, int out_size, void* d_ws, size_t ws_size, hipStream_t stream) {
    static int grid = 0;
    if (grid == 0) {
        if (n_in != 28 || out_size != NB * SEQ * DM || ws_size < WS_END) { fprintf(stderr, "kernel_launch: unexpected shapes (n_in %d out %d ws %zu need %zu); nothing launched\n", n_in, out_size, ws_size, (size_t)WS_END); grid = -1; return; }
        int dev = 0, cus = 0;
        if (hipGetDevice(&dev) != hipSuccess || hipDeviceGetAttribute(&cus, hipDeviceAttributeMultiprocessorCount, dev) != hipSuccess) { grid = -1; return; }
        if (hipFuncSetAttribute((const void*)fwd_kernel, hipFuncAttributeMaxDynamicSharedMemorySize, LDS_BYTES) != hipSuccess) { fprintf(stderr, "kernel_launch: hipFuncSetAttribute failed\n"); grid = -1; return; }
        int per_cu = 0;
        if (hipOccupancyMaxActiveBlocksPerMultiprocessor(&per_cu, (const void*)fwd_kernel, NTHREADS, LDS_BYTES) != hipSuccess || per_cu < 1) fprintf(stderr, "kernel_launch: occupancy query reports %d\n", per_cu);
        (void)hipGetLastError();
        grid = cus;
    }
    if (grid < 0) return;
    (void)hipMemsetAsync((char*)d_ws + WS_CTL, 0, CTL_ZERO_BYTES, stream);
    Params p{};
    for (int i = 0; i < 28; ++i) p.in[i] = (const float*)d_in[i];
    p.out = (float*)d_out; p.ws = (unsigned char*)d_ws;
#ifndef MK_NPH_RUN
#define MK_NPH_RUN NPHASES
#endif
#if MK_MULTI
    for (int k = 0; k < MK_NPH_RUN; ++k) { p.ph_lo = k; p.ph_hi = k + 1; p.use_bar = 0; hipLaunchKernelGGL(fwd_kernel, dim3(grid), dim3(NTHREADS), LDS_BYTES, stream, p);
#if defined(MK_DEBUG)
        unsigned* dw = (unsigned*)((char*)d_ws + WS_CTL) + 64; unsigned char* w = (unsigned char*)d_ws;
#if MK_DEBUG == 1
        if (k == 3) hipLaunchKernelGGL(chk_bf16, dim3(1024), dim3(256), 0, stream, (const bf16_t*)(w + WS_A), (long)MROWS, 4384, P1W, dw, 1u);
        if (k == 4) { hipLaunchKernelGGL(chk_bf16, dim3(1024), dim3(256), 0, stream, (const bf16_t*)(w + WS_B), (long)MROWS, 512, 1536, dw, 2u);
                      hipLaunchKernelGGL(chk_bf16, dim3(1024), dim3(256), 0, stream, (const bf16_t*)(w + WS_D), (long)MROWS, 1024, 1024, dw, 4u);
                      hipLaunchKernelGGL(chk_bf16, dim3(1024), dim3(256), 0, stream, (const bf16_t*)(w + WS_D) + (size_t)MROWS * 1024, (long)MROWS, 1024, 1024, dw, 8u); }
        if (k == 7) hipLaunchKernelGGL(chk_bf16, dim3(1024), dim3(256), 0, stream, (const bf16_t*)(w + WS_A) + (size_t)MROWS * GW, (long)MROWS, 1024, 1024, dw, 16u);
#endif
#endif
    }
#if defined(MK_DEBUG)
    hipLaunchKernelGGL(dbg_fill, dim3(1024), dim3(256), 0, stream, (float*)d_out, (long)NB * SEQ * DM, (const unsigned*)((char*)d_ws + WS_CTL) + 64);
#endif
#else
    p.ph_lo = 0; p.ph_hi = NPHASES; p.use_bar = 1;
    hipLaunchKernelGGL(fwd_kernel, dim3(grid), dim3(NTHREADS), LDS_BYTES, stream, p);
#endif
}
```

```cpp
#include <hip/hip_runtime.h>
#include <hip/hip_bf16.h>
#include <cstdio>
#include <cstdint>
#include <cmath>

constexpr int DM = 1024, NB = 2, SEQ = 16384, CTXL = 256, TT = SEQ + CTXL  , MROWS = NB * TT  ;
constexpr int NLAYER = 2, GRIDW = 64;
constexpr int P1W = 4608;
constexpr int GW = 3072;
constexpr int INW = 7456;
constexpr int C_AQ = 0, C_AK = 512, C_AV = 640, C_BQKV = 768, C_BZ = 2304, C_BA = 2816, C_BB = 2832, C_CQ = 2848, C_CK = 3360, C_CV = 3872, C_GATE = 4384;
constexpr int NEXP = 64, NEXP1 = 65  , TOPK = 6, FF = 256;
constexpr int HROWS = TT * 7 + NEXP1 * 255;
constexpr int HROWS_PAD = 133120;
constexpr float EPS = 1e-6f;
constexpr float QSCALE = 0.125f * 1.4426950408889634f;

constexpr size_t MiB = 1u << 20;
constexpr size_t WS_CTL = 0, CTL_ZERO_BYTES = 1 * MiB;
constexpr size_t WS_MODV = 1 * MiB;
constexpr size_t WS_HCTX = 2 * MiB;
constexpr size_t WS_TOPE = 4 * MiB;
constexpr size_t WS_TOPW = WS_TOPE + (size_t)MROWS * 32;
constexpr size_t WS_TOPS = WS_TOPW + (size_t)MROWS * 32;
constexpr size_t WS_RTOK = WS_TOPS + (size_t)MROWS * 32;
constexpr size_t WS_RW = WS_RTOK + (size_t)2 * HROWS_PAD * 4;
constexpr size_t WS_SMALL_END = WS_RW + (size_t)2 * HROWS_PAD * 4;
constexpr size_t WS_WB1 = 10 * MiB;
constexpr size_t WS_WB2 = WS_WB1 + (size_t)P1W * DM * 2;
constexpr size_t WS_WBR = WS_WB2 + (size_t)GW * DM * 2;
constexpr size_t WS_WOT = WS_WBR + (size_t)3 * DM * 512 * 2;
constexpr size_t WS_A = 30 * MiB;
constexpr size_t SZ_A = (size_t)MROWS * P1W * 2;
constexpr size_t WS_B = WS_A + SZ_A;
constexpr size_t SZ_B = (size_t)MROWS * 1536 * 2;
constexpr size_t WS_C = WS_B + SZ_B;
constexpr size_t SZ_C = (size_t)MROWS * DM * 2;
constexpr size_t WS_D = WS_C + SZ_C;
constexpr size_t SZ_D = (size_t)MROWS * 2048 * 2;
constexpr size_t WS_RING = WS_D + SZ_D;
constexpr int RING_SLOT = 40960;
constexpr size_t SZ_RING = (size_t)32 * 12 * RING_SLOT;
constexpr size_t WS_END = WS_RING + SZ_RING;
static_assert(WS_SMALL_END <= WS_WB1 && WS_WOT + (size_t)DM * DM * 2 <= WS_A, "ws map");
static_assert((size_t)MROWS * GW * 2 + (size_t)MROWS * DM * 2 <= SZ_A && (size_t)HROWS_PAD * DM * 2 <= SZ_A, "region A overlays");
static_assert((size_t)NEXP1 * 3 * DM * FF * 2 <= SZ_B && (size_t)HROWS_PAD * FF * 2 <= SZ_D, "region B/D overlays");
constexpr size_t WS_HB = WS_A + (size_t)HROWS_PAD * DM;
static_assert(WS_HB + (size_t)NB * SEQ * DM * 2 <= WS_A + (size_t)MROWS * GW * 2, "HB sits between Y and m");
constexpr int CW_TMO = 0;
constexpr int CW_BAR = 4096;
constexpr int CW_QUEUE = 16384;
constexpr int CW_KMAX = 40960;
constexpr int CW_ECNT = 32768;

constexpr int RING_OFF = 0, RING_BYTES = 139264;
constexpr int MISC_OFF = RING_BYTES;
constexpr int LDS_BYTES = 147456;
constexpr int NWAVES = 8, NTHREADS = 512;

#define GAS __attribute__((address_space(1)))
#define LAS __attribute__((address_space(3)))
typedef unsigned short bf16_t;
typedef unsigned v4u __attribute__((ext_vector_type(4)));
typedef unsigned v2u __attribute__((ext_vector_type(2)));
typedef float f32x4 __attribute__((ext_vector_type(4)));
typedef float f32x2 __attribute__((ext_vector_type(2)));
typedef float f32x16 __attribute__((ext_vector_type(16)));
typedef short bf16x8 __attribute__((ext_vector_type(8)));
typedef short s16x4 __attribute__((ext_vector_type(4)));
typedef GAS unsigned gu32;
#define RLX_AGENT __ATOMIC_RELAXED, __HIP_MEMORY_SCOPE_AGENT
#define LDS_WAIT() asm volatile("s_waitcnt lgkmcnt(0)" ::: "memory")
#define VM_WAIT() asm volatile("s_waitcnt vmcnt(0)" ::: "memory")
__device__ __forceinline__ unsigned f2bf(float f) { unsigned u = __builtin_bit_cast(unsigned, f); return (u + 0x7fffu + ((u >> 16) & 1u)) >> 16; }
__device__ __forceinline__ unsigned pk2(float lo, float hi) { return f2bf(lo) | (f2bf(hi) << 16); }
__device__ __forceinline__ float bf2f(unsigned short b) { return __builtin_bit_cast(float, (unsigned)b << 16); }
__device__ __forceinline__ float bflo(unsigned w) { return __builtin_bit_cast(float, w << 16); }
__device__ __forceinline__ float bfhi(unsigned w) { return __builtin_bit_cast(float, w & 0xffff0000u); }
typedef __bf16 bf16x2_t_ __attribute__((ext_vector_type(2)));
__device__ __forceinline__ unsigned cvt_pk_bf16(float lo, float hi) { unsigned r; asm volatile("v_cvt_pk_bf16_f32 %0, %1, %2" : "=v"(r) : "v"(lo), "v"(hi)); return r; }
__device__ __forceinline__ unsigned cvt_pk_bf16_safe(float lo, float hi) { f32x2 v = {lo, hi}; bf16x2_t_ b = __builtin_convertvector(v, bf16x2_t_); return __builtin_bit_cast(unsigned, b); }
__device__ __forceinline__ float wave_sum(float v) {
#pragma unroll
    for (int o = 1; o < 64; o <<= 1) v += __shfl_xor(v, o);
    return v;
}
__device__ __forceinline__ float sigmoidf_(float x) { return __builtin_amdgcn_rcpf(1.f + __expf(-x)); }
__device__ __forceinline__ float siluf_(float x) { return x * __builtin_amdgcn_rcpf(1.f + __expf(-x)); }
__device__ __forceinline__ int hw_lane() { int l; asm volatile("v_mbcnt_lo_u32_b32 %0, -1, 0\n\tv_mbcnt_hi_u32_b32 %0, -1, %0" : "=v"(l)); return l; }
#define XB_TMO      128
#define XB_XCNT(j)  (256  + 64 * (j))
#define XB_XSUB(j)  (1280 + 64 * (j))
#define XB_XGEN(j)  (2304 + 64 * (j))
#define XB_TOP      3328
#define XB_TOPGEN   3392
#define XCD_BAR_WORDS 3456
#define XB_SPIN_CAP (1u << 18)

__device__ __forceinline__ unsigned xb_ld(unsigned* p)              { return __hip_atomic_load(p, __ATOMIC_RELAXED, __HIP_MEMORY_SCOPE_AGENT); }
__device__ __forceinline__ unsigned xb_add(unsigned* p, unsigned v) { return __hip_atomic_fetch_add(p, v, __ATOMIC_RELAXED, __HIP_MEMORY_SCOPE_AGENT); }
__device__ __forceinline__ unsigned xb_xcc_id() { return (unsigned)__builtin_amdgcn_s_getreg((3 << 11) | 20) & 0xFu; }
#define XB_SPIN(cond, bar) do { unsigned _sp = 0; while (cond) { __builtin_amdgcn_s_sleep(1); \
    if ((++_sp & 255u) == 0u) { if (xb_ld(&(bar)[XB_TMO])) break; if (_sp > XB_SPIN_CAP) { atomicAdd(&(bar)[XB_TMO], 1u); break; } } } } while (0)

struct XcdBarrier {
    unsigned* bar; unsigned x;
    volatile LAS unsigned* st;
};

__device__ __forceinline__ XcdBarrier xcd_barrier_post(unsigned* bar, volatile LAS unsigned* st, bool is_t0) {
    XcdBarrier b; b.bar = bar; b.x = xb_xcc_id(); b.st = st;
    if (is_t0) (void)xb_add(&bar[XB_XCNT(b.x)], 1u);
    return b;
}
__device__ __forceinline__ void xcd_barrier_complete(unsigned* bar, unsigned x, unsigned& nloc, unsigned& nx) {
    const unsigned G = gridDim.x * gridDim.y * gridDim.z;
    unsigned sum, cnt, mine, sp = 0u;
    for (;;) {
        sum = 0u; cnt = 0u; mine = 0u;
#pragma unroll
        for (unsigned j = 0; j < 16; ++j) { const unsigned c = xb_ld(&bar[XB_XCNT(j)]); sum += c; cnt += (c > 0u) ? 1u : 0u; mine = (j == x) ? c : mine; }
        if (sum == G) break;
        __builtin_amdgcn_s_sleep(1);
        if ((++sp & 255u) == 0u) { if (xb_ld(&bar[XB_TMO])) break; if (sp > XB_SPIN_CAP) { atomicAdd(&bar[XB_TMO], 1u); break; } }
    }
    nloc = mine > 0u ? mine : 1u; nx = cnt > 0u ? cnt : 1u;
}

__device__ __forceinline__ void xcd_barrier(const XcdBarrier& b, bool is_t0) {
    asm volatile("s_waitcnt vmcnt(0)" ::: "memory");
    __syncthreads();
    if (is_t0) {
        unsigned* bar = b.bar;
        __builtin_amdgcn_s_waitcnt(0);
        unsigned nloc = b.st[0], nx = b.st[1];
        if (nloc == 0u) { xcd_barrier_complete(bar, b.x, nloc, nx); b.st[0] = nloc; b.st[1] = nx; }
        const unsigned old = xb_add(&bar[XB_XSUB(b.x)], 1u);
        const unsigned gen = old / nloc;
        if (old + 1u == (gen + 1u) * nloc) {
            __builtin_amdgcn_fence(__ATOMIC_RELEASE, "agent");
            asm volatile("s_waitcnt vmcnt(0)" ::: "memory");
            const unsigned og = xb_add(&bar[XB_TOP], 1u);
            const unsigned tg = og / nx;
            if (og + 1u == (tg + 1u) * nx) xb_add(&bar[XB_TOPGEN], 1u);
            else XB_SPIN(xb_ld(&bar[XB_TOPGEN]) == tg, bar);
            __builtin_amdgcn_fence(__ATOMIC_ACQUIRE, "agent");
            xb_add(&bar[XB_XGEN(b.x)], 1u);
            asm volatile("s_waitcnt vmcnt(0)" ::: "memory");
        } else {
            XB_SPIN(xb_ld(&bar[XB_XGEN(b.x)]) == gen, bar);
            __builtin_amdgcn_fence(__ATOMIC_ACQUIRE, "agent");
            asm volatile("s_waitcnt vmcnt(0)" ::: "memory");
        }
    }
    __syncthreads();
}
namespace pg8 {
constexpr int BM = 256, BK = 64, HALF = 128, HTB = HALF * BK * 2  , STAGE_BYTES = 8 * HTB, NXCD = 8, WGM = 8;
__host__ __device__ __forceinline__ int lds_byte(int r, int c) { const int st = (r >> 4) * 2 + (c >> 5), rr = r & 15, cc = c & 31, ob = rr * 64 + cc * 2; return st * 1024 + (ob ^ (((ob >> 9) & 1) << 5)); }
__host__ __device__ __forceinline__ void stage_rc(int b, int& R, int& C) { const int st = b / 1024, sb = b % 1024, swz = sb ^ (((sb >> 9) & 1) << 5); R = (st >> 1) * 16 + swz / 64; C = (st & 1) * 32 + (swz % 64) / 2; }
__host__ __device__ __forceinline__ int perm32(int rho) { const int n = rho >> 4, i = rho & 15; return 8 * (i >> 2) + 4 * n + (i & 3); }

struct Unit { int pm, pn, em, en, ex; };
struct Gemm { const bf16_t* A; const bf16_t* Bt; int lda, ldb, K; const int* rowlist; int astep = 0; };

struct DenseOrder {
    int nM, nN, nwg, G, c, skipctx;
    __device__ void init(int nM_, int nN_, int G_, int c_, int skipctx_ = 0) { skipctx = skipctx_; nM = skipctx_ ? nM_ - 2 : nM_; nN = nN_; nwg = nM * nN; G = G_; c = c_; }
    __device__ bool next(int i, Unit& u) const {
        const int L = i * G + c; if (L >= nwg) return false;
        int wgid = L; { const int q = nwg / NXCD, r = nwg % NXCD, xcd = wgid % NXCD, off = wgid / NXCD; wgid = (xcd < r ? xcd * (q + 1) : r * (q + 1) + (xcd - r) * q) + off; }
        const int nig = WGM * nN, gid = wgid / nig, fm = gid * WGM, gsz = (nM - fm) < WGM ? (nM - fm) : WGM;
        u.pm = fm + ((wgid % nig) % gsz); if (skipctx) u.pm += (u.pm >= 64) ? 2 : 1; u.pn = (wgid % nig) / gsz; u.em = u.pm; u.en = u.pn; u.ex = 0; return true;
    }
};
struct MoeOrder {
    const LAS int* tstart; const LAS int* texp; int nN, G, c;
    __device__ bool next(int i, Unit& u) const {
        const int L = i * G + c; const int total = tstart[NEXP1];
        if (L >= total * nN) return false;
        const int gsz = 8 * nN, gi = L / gsz, rem = L - gi * gsz; int rt, pn;
        if (gi * 8 + 8 <= total) { rt = gi * 8 + (rem & 7); pn = rem >> 3; } else { const int tr = total - gi * 8; pn = rem / tr; rt = gi * 8 + (rem - pn * tr); }
        const int e = texp[rt];
        u.pm = rt; u.pn = e * nN + pn; u.em = rt; u.en = pn; u.ex = e; return true;
    }
};

struct MergeOrder {
    DenseOrder D;
    __device__ bool next(int i, Unit& u) const { const int t = i / 3, br = i - 3 * t; if (!D.next(t, u)) return false; u.ex = br; u.pn = br * (DM / BM) + u.pn; return true; }
};
template <int ACT  > struct EpiBf16 {
    static constexpr bool PERM = true;
    bf16_t* O; int ldc;
    __device__ __forceinline__ void operator()(const f32x4 (&acc)[2][2][4][2], const Unit& u, int wr, int wc, int fr, int fq) const {
        const int row0 = u.em * BM + wr * 64 + fr; const int col0 = u.en * BM + wc * 32 + 8 * fq;
#pragma unroll
        for (int ai = 0; ai < 2; ++ai)
#pragma unroll
            for (int m = 0; m < 4; ++m) { bf16_t* rowp = O + (size_t)(row0 + ai * HALF + m * 16) * ldc + col0;
#pragma unroll
                for (int bj = 0; bj < 2; ++bj) { f32x4 v0 = acc[ai][bj][m][0], v1 = acc[ai][bj][m][1];
                    if (ACT == 1) {
#pragma unroll
                        for (int j = 0; j < 4; ++j) { v0[j] = sigmoidf_(v0[j]); v1[j] = sigmoidf_(v1[j]); } }
                    v4u w;
                    if (ACT == 1) { w.x = cvt_pk_bf16_safe(v0[0], v0[1]); w.y = cvt_pk_bf16_safe(v0[2], v0[3]); w.z = cvt_pk_bf16_safe(v1[0], v1[1]); w.w = cvt_pk_bf16_safe(v1[2], v1[3]); }
                    else { w.x = cvt_pk_bf16(v0[0], v0[1]); w.y = cvt_pk_bf16(v0[2], v0[3]); w.z = cvt_pk_bf16(v1[0], v1[1]); w.w = cvt_pk_bf16(v1[2], v1[3]); }
                    *(v4u*)(rowp + bj * HALF) = w; } }
    }
};
constexpr float YSCALE = 8.f, YUNSCALE = 0.125f;
struct EpiFp8 {
    static constexpr bool PERM = true; static constexpr int NST = 8;
    unsigned char* O;
    __device__ __forceinline__ void operator()(const f32x4 (&acc)[2][2][4][2], const Unit& u, int wr, int wc, int fr, int fq) const {
        const int row0 = u.em * BM + wr * 64 + fr; const int pos0 = u.en * BM + (wc * 4 + fq) * 16;
#pragma unroll
        for (int ai = 0; ai < 2; ++ai)
#pragma unroll
            for (int m = 0; m < 4; ++m) { unsigned char* rowp = O + (size_t)(row0 + ai * HALF + m * 16) * DM + pos0; v4u w;
#pragma unroll
                for (int bj = 0; bj < 2; ++bj) { const f32x4 v0 = acc[ai][bj][m][0] * YSCALE, v1 = acc[ai][bj][m][1] * YSCALE;
                    int lo = __builtin_amdgcn_cvt_pk_fp8_f32(v0[0], v0[1], 0, false); lo = __builtin_amdgcn_cvt_pk_fp8_f32(v0[2], v0[3], lo, true);
                    int hi = __builtin_amdgcn_cvt_pk_fp8_f32(v1[0], v1[1], 0, false); hi = __builtin_amdgcn_cvt_pk_fp8_f32(v1[2], v1[3], hi, true);
                    w[2 * bj] = (unsigned)lo; w[2 * bj + 1] = (unsigned)hi; }
                *(v4u*)rowp = w; }
    }
};
struct EpiGate8 {
    static constexpr bool PERM = true;
    unsigned char* O;
    __device__ __forceinline__ void operator()(const f32x4 (&acc)[2][2][4][2], const Unit& u, int wr, int wc, int fr, int fq) const {
        const int row0 = u.em * BM + wr * 64 + fr; const int pos0 = u.en * BM + (wc * 4 + fq) * 16;
#pragma unroll
        for (int ai = 0; ai < 2; ++ai)
#pragma unroll
            for (int m = 0; m < 4; ++m) { unsigned char* rowp = O + (size_t)(row0 + ai * HALF + m * 16) * GW + pos0; v4u w;
#pragma unroll
                for (int bj = 0; bj < 2; ++bj)
#pragma unroll
                    for (int n = 0; n < 2; ++n) { const f32x4 v = acc[ai][bj][m][n]; unsigned pk = 0u;
#pragma unroll
                        for (int j = 0; j < 4; ++j) pk = __builtin_amdgcn_cvt_pk_u8_f32(__builtin_rintf(sigmoidf_(v[j]) * 255.f), (unsigned)j, pk);
                        w[2 * bj + n] = pk; }
                *(v4u*)rowp = w; }
    }
};
struct EpiMerge {
    static constexpr bool PERM = true;
    bf16_t* Mo; const unsigned char* G;
    __device__ __forceinline__ void operator()(const f32x4 (&acc)[2][2][4][2], const Unit& u, int wr, int wc, int fr, int fq) const {
        const int row0 = u.em * BM + wr * 64 + fr; const int col0 = u.en * BM + wc * 32 + 8 * fq; const int gpos = u.ex * DM + u.en * BM + (wc * 4 + fq) * 16; const bool first = (u.ex == 0);
        constexpr float q = 1.f / 255.f;
#pragma unroll
        for (int ai = 0; ai < 2; ++ai)
#pragma unroll
            for (int m = 0; m < 4; ++m) { const size_t r = (size_t)(row0 + ai * HALF + m * 16);
                const v4u gq = *(const v4u*)(G + r * GW + gpos);
#pragma unroll
                for (int bj = 0; bj < 2; ++bj) { const f32x4 v0 = acc[ai][bj][m][0], v1 = acc[ai][bj][m][1];
                    const unsigned g0 = gq[2 * bj], g1 = gq[2 * bj + 1];
                    bf16_t* mp = Mo + r * DM + col0 + bj * HALF;
                    float o[8];
                    o[0] = (float)(g0 & 0xffu) * q * v0[0]; o[1] = (float)((g0 >> 8) & 0xffu) * q * v0[1]; o[2] = (float)((g0 >> 16) & 0xffu) * q * v0[2]; o[3] = (float)(g0 >> 24) * q * v0[3];
                    o[4] = (float)(g1 & 0xffu) * q * v1[0]; o[5] = (float)((g1 >> 8) & 0xffu) * q * v1[1]; o[6] = (float)((g1 >> 16) & 0xffu) * q * v1[2]; o[7] = (float)(g1 >> 24) * q * v1[3];
                    if (!first) { const v4u pw = *(const v4u*)mp;
                        o[0] += bflo(pw.x); o[1] += bfhi(pw.x); o[2] += bflo(pw.y); o[3] += bfhi(pw.y); o[4] += bflo(pw.z); o[5] += bfhi(pw.z); o[6] += bflo(pw.w); o[7] += bfhi(pw.w); }
                    v4u w; w.x = cvt_pk_bf16(o[0], o[1]); w.y = cvt_pk_bf16(o[2], o[3]); w.z = cvt_pk_bf16(o[4], o[5]); w.w = cvt_pk_bf16(o[6], o[7]);
                    *(v4u*)mp = w; } }
    }
};
struct EpiResid {
    static constexpr bool PERM = false;
    const float* in_lat; const float* in_ctx; float* out_lat; float* out_ctx; const float* modv; int gsel;
    __device__ __forceinline__ void operator()(const f32x4 (&acc)[2][2][4][2], const Unit& u, int wr, int wc, int fr, int fq) const {
        const int b = u.em / 65, j = u.em % 65; const bool isctx = (j == 0);
        const float* ib = isctx ? in_ctx + (size_t)b * CTXL * DM : in_lat + ((size_t)b * SEQ + (size_t)(j - 1) * 256) * DM;
        float* ob = isctx ? out_ctx + (size_t)b * CTXL * DM : out_lat + ((size_t)b * SEQ + (size_t)(j - 1) * 256) * DM;
        const float* gt = modv + (isctx ? 2 : b) * 6144 + gsel * DM;
        const int col0 = u.en * BM + wc * 32 + 4 * fq;
        f32x4 gv[2][2];
#pragma unroll
        for (int bj = 0; bj < 2; ++bj)
#pragma unroll
            for (int n = 0; n < 2; ++n) gv[bj][n] = *(const f32x4*)(gt + col0 + bj * HALF + n * 16);
#pragma unroll
        for (int ai = 0; ai < 2; ++ai)
#pragma unroll
            for (int m = 0; m < 4; ++m) { const size_t off = (size_t)(ai * HALF + wr * 64 + m * 16 + fr) * DM + col0;
#pragma unroll
                for (int bj = 0; bj < 2; ++bj)
#pragma unroll
                    for (int n = 0; n < 2; ++n) { const f32x4 bs = *(const f32x4*)(ib + off + bj * HALF + n * 16);
                        *(f32x4*)(ob + off + bj * HALF + n * 16) = bs + gv[bj][n] * acc[ai][bj][m][n]; } }
    }
};
struct EpiResidB {
    static constexpr bool PERM = true;
    const float* in_f32; const bf16_t* in_bf; bf16_t* out_bf; const float* in_ctx; float* out_ctx; const float* modv; int gsel;
    __device__ __forceinline__ void operator()(const f32x4 (&acc)[2][2][4][2], const Unit& u, int wr, int wc, int fr, int fq) const {
        const int b = u.em / 65, j = u.em % 65; const bool isctx = (j == 0);
        const size_t rbase = isctx ? (size_t)b * CTXL : (size_t)b * SEQ + (size_t)(j - 1) * 256;
        const float* gt = modv + (isctx ? 2 : b) * 6144 + gsel * DM;
        const int col0 = u.en * BM + wc * 32 + 8 * fq;
        f32x4 gv[2][2];
#pragma unroll
        for (int bj = 0; bj < 2; ++bj)
#pragma unroll
            for (int n = 0; n < 2; ++n) gv[bj][n] = *(const f32x4*)(gt + col0 + bj * HALF + 4 * n);
#pragma unroll
        for (int ai = 0; ai < 2; ++ai)
#pragma unroll
            for (int m = 0; m < 4; ++m) { const size_t off = (rbase + (size_t)(ai * HALF + wr * 64 + m * 16 + fr)) * DM + col0;
#pragma unroll
                for (int bj = 0; bj < 2; ++bj) { const size_t o = off + bj * HALF; f32x4 b0, b1;
                    if (isctx) { b0 = *(const f32x4*)(in_ctx + o); b1 = *(const f32x4*)(in_ctx + o + 4); }
                    else if (in_f32) { b0 = *(const f32x4*)(in_f32 + o); b1 = *(const f32x4*)(in_f32 + o + 4); }
                    else { const v4u w = *(const v4u*)(in_bf + o); b0 = (f32x4){bflo(w.x), bfhi(w.x), bflo(w.y), bfhi(w.y)}; b1 = (f32x4){bflo(w.z), bfhi(w.z), bflo(w.w), bfhi(w.w)}; }
                    const f32x4 r0 = b0 + gv[bj][0] * acc[ai][bj][m][0], r1 = b1 + gv[bj][1] * acc[ai][bj][m][1];
                    if (isctx) { *(f32x4*)(out_ctx + o) = r0; *(f32x4*)(out_ctx + o + 4) = r1; }
                    else { v4u w; w.x = cvt_pk_bf16_safe(r0[0], r0[1]); w.y = cvt_pk_bf16_safe(r0[2], r0[3]); w.z = cvt_pk_bf16_safe(r1[0], r1[1]); w.w = cvt_pk_bf16_safe(r1[2], r1[3]); *(v4u*)(out_bf + o) = w; } } }
    }
};

struct EpiMoe1 {
    static constexpr bool PERM = true;
    bf16_t* Hs; const float* roww;
    __device__ __forceinline__ void operator()(const f32x4 (&acc)[2][2][4][2], const Unit& u, int wr, int wc, int fr, int fq) const {
        const int row0 = u.em * BM + wr * 64 + fr; const int col0 = u.en * HALF + wc * 32 + 8 * fq;
#pragma unroll
        for (int ai = 0; ai < 2; ++ai)
#pragma unroll
            for (int m = 0; m < 4; ++m) { const int r = row0 + ai * HALF + m * 16; const float w = roww[r];
                float o[8];
#pragma unroll
                for (int n = 0; n < 2; ++n)
#pragma unroll
                    for (int j = 0; j < 4; ++j) { const float g = acc[ai][0][m][n][j], up = acc[ai][1][m][n][j]; o[n * 4 + j] = siluf_(g) * up * w; }
                v4u pw; pw.x = cvt_pk_bf16(o[0], o[1]); pw.y = cvt_pk_bf16(o[2], o[3]); pw.z = cvt_pk_bf16(o[4], o[5]); pw.w = cvt_pk_bf16(o[6], o[7]);
                *(v4u*)(Hs + (size_t)r * FF + col0) = pw; }
    }
};

template <class Epi, class Sched, bool GATHER>
__device__ __forceinline__ void gemm_phase(LAS unsigned char* lds, const Gemm g, const Sched& S, const Epi& E, int wave) {
    const int lane = hw_lane(), wid = wave, tid = wave * 64 + lane;
    const int wr = wid >> 2, wc = wid & 3, fr = lane & 15, fq = lane >> 4;
    const int K = g.K, nt = K / BK;
    int Rr[2], Cc[2];
    unsigned voffB[2], voffA[2];
#pragma unroll
    for (int i = 0; i < 2; ++i) { int R, C; stage_rc(tid * 16 + i * 8192, R, C); const int Rb = Epi::PERM ? ((R & ~31) + perm32(R & 31)) : R; Rr[i] = R; Cc[i] = C;
        voffB[i] = (unsigned)(Rb * g.ldb + C) * 2u; voffA[i] = (unsigned)(R * g.lda + C) * 2u; }
    const size_t kstep = (size_t)(BK * 2);
    const size_t hstepB = (size_t)HALF * g.ldb * 2, hstepA = (size_t)HALF * g.lda * 2;
    const size_t tstepA = (size_t)BM * g.lda * 2, tstepB = (size_t)BM * g.ldb * 2;
    const unsigned ldsw = (unsigned)wid * 1024u;
    const int aoff = lds_byte(wr * 64 + fr, fq * 8), boff = lds_byte(wc * 32 + fr, fq * 8);
#define PG8_SA(b, h) (((b) * 2 + (h)) * HTB)
#define PG8_SB(b, h) ((4 + (b) * 2 + (h)) * HTB)
#define PG8_STAGE(bufoff, gbase, voff) do { _Pragma("unroll") for (int _i = 0; _i < 2; ++_i) \
        __builtin_amdgcn_global_load_lds((const unsigned*)((const char*)(gbase) + (voff)[_i]), (LAS unsigned*)(lds + (bufoff) + ldsw + _i * 8192), 16, 0, 0); } while (0)
#define PG8_LDA(dst, b, h) do { _Pragma("unroll") for (int m = 0; m < 4; ++m) _Pragma("unroll") for (int k = 0; k < 2; ++k) dst[m][k] = *(const LAS bf16x8*)(lds + PG8_SA(b, h) + aoff + m * 2048 + k * 1024); } while (0)
#define PG8_LDB(dst, b, h) do { _Pragma("unroll") for (int n = 0; n < 2; ++n) _Pragma("unroll") for (int k = 0; k < 2; ++k) dst[n][k] = *(const LAS bf16x8*)(lds + PG8_SB(b, h) + boff + n * 2048 + k * 1024); } while (0)
#define PG8_MMA(ai, bj, At, Bt) do { __builtin_amdgcn_s_setprio(1); _Pragma("unroll") for (int m = 0; m < 4; ++m) _Pragma("unroll") for (int n = 0; n < 2; ++n) _Pragma("unroll") for (int k = 0; k < 2; ++k) \
        acc[ai][bj][m][n] = __builtin_amdgcn_mfma_f32_16x16x32_bf16(Bt[n][k], At[m][k], acc[ai][bj][m][n], 0, 0, 0); __builtin_amdgcn_s_setprio(0); } while (0)
#define PG8_WAIT_V(n) asm volatile("s_waitcnt vmcnt(" #n ")" ::: "memory")
#define PG8_WAIT_L(n) asm volatile("s_waitcnt lgkmcnt(" #n ")" ::: "memory")
#define PG8_BAR __builtin_amdgcn_s_barrier()
#define PG8_SCHED __builtin_amdgcn_sched_barrier(0)
#define PG8_AOFFS(dst, unit) do { if constexpr (GATHER) { _Pragma("unroll") for (int _h = 0; _h < 2; ++_h) _Pragma("unroll") for (int _i = 0; _i < 2; ++_i) { \
        const int _row = g.rowlist[(size_t)(unit).pm * BM + _h * HALF + Rr[_i]]; dst[_h][_i] = (unsigned)((size_t)_row * g.lda + Cc[_i]) * 2u; } \
        asm volatile("s_waitcnt vmcnt(0)" ::: "memory"); } } while (0)
#define PG8_STAGE_A(bufoff, base, h, vset) do { if constexpr (GATHER) { PG8_STAGE(bufoff, base, vset[h]); } else { PG8_STAGE(bufoff, (base) + (h) * hstepA, voffA); } } while (0)
    Unit cur, nxt; int ui = 0;
    if (!S.next(0, cur)) return;
    f32x4 acc[2][2][4][2];
#pragma unroll
    for (int a = 0; a < 2; ++a)
#pragma unroll
        for (int b = 0; b < 2; ++b)
#pragma unroll
            for (int m = 0; m < 4; ++m)
#pragma unroll
                for (int n = 0; n < 2; ++n) acc[a][b][m][n] = (f32x4){0.f, 0.f, 0.f, 0.f};
    bf16x8 At[4][2], B0[2][2], B1[2][2];
    unsigned vc[2][2], vn[2][2];
    PG8_AOFFS(vc, cur);
    const char* cA = GATHER ? (const char*)g.A : (const char*)g.A + (size_t)cur.pm * tstepA + (size_t)cur.ex * g.astep; const char* cB = (const char*)g.Bt + (size_t)cur.pn * tstepB;
    PG8_STAGE(PG8_SB(0, 0), cB, voffB); PG8_STAGE(PG8_SB(0, 1), cB + hstepB, voffB); PG8_STAGE_A(PG8_SA(0, 0), cA, 0, vc); PG8_STAGE_A(PG8_SA(0, 1), cA, 1, vc);
    if (wr == 1) PG8_BAR;
    PG8_WAIT_V(2); PG8_BAR;
    PG8_STAGE(PG8_SB(1, 0), cB + kstep, voffB); PG8_STAGE_A(PG8_SA(1, 0), cA + kstep, 0, vc); PG8_STAGE(PG8_SB(1, 1), cB + hstepB + kstep, voffB);
    PG8_WAIT_V(6); PG8_BAR;
    for (;;) {
        const bool has_next = S.next(ui + 1, nxt);
        if constexpr (GATHER) { if (has_next) { PG8_AOFFS(vn, nxt); } else { vn[0][0] = vc[0][0]; vn[0][1] = vc[0][1]; vn[1][0] = vc[1][0]; vn[1][1] = vc[1][1]; } }
        const char* nA = has_next ? (GATHER ? (const char*)g.A : (const char*)g.A + (size_t)nxt.pm * tstepA + (size_t)nxt.ex * g.astep) : cA; const char* nB = has_next ? (const char*)g.Bt + (size_t)nxt.pn * tstepB : cB;
        for (int t = 0; t < nt; t += 2) {
            const bool last = (t == nt - 2);
            const char* a1 = cA + (size_t)(t + 1) * kstep;
            const char* a2 = last ? nA : cA + (size_t)(t + 2) * kstep; const char* b2 = last ? nB : cB + (size_t)(t + 2) * kstep;
            const char* a3 = a2 + kstep; const char* b3 = b2 + kstep;
            unsigned v2[2][2];
            if constexpr (GATHER) { v2[0][0] = last ? vn[0][0] : vc[0][0]; v2[0][1] = last ? vn[0][1] : vc[0][1]; v2[1][0] = last ? vn[1][0] : vc[1][0]; v2[1][1] = last ? vn[1][1] : vc[1][1]; }
            PG8_LDB(B0, 0, 0); PG8_LDB(B1, 0, 1); PG8_SCHED; PG8_LDA(At, 0, 0); PG8_STAGE_A(PG8_SA(1, 1), a1, 1, vc);
            PG8_WAIT_V(8); PG8_WAIT_L(0); PG8_BAR; PG8_MMA(0, 0, At, B0); PG8_MMA(0, 1, At, B1); PG8_BAR; PG8_SCHED;
            PG8_LDA(At, 0, 1); PG8_STAGE(PG8_SB(0, 0), b2, voffB); PG8_STAGE(PG8_SB(0, 1), b2 + hstepB, voffB); PG8_STAGE_A(PG8_SA(0, 0), a2, 0, v2);
            PG8_WAIT_V(8); PG8_WAIT_L(0); PG8_BAR; PG8_MMA(1, 0, At, B0); PG8_MMA(1, 1, At, B1); PG8_BAR; PG8_SCHED;
            PG8_LDB(B0, 1, 0); PG8_LDB(B1, 1, 1); PG8_SCHED; PG8_LDA(At, 1, 0); PG8_STAGE_A(PG8_SA(0, 1), a2, 1, v2);
            PG8_WAIT_V(8); PG8_WAIT_L(0); PG8_BAR; PG8_MMA(0, 0, At, B0); PG8_MMA(0, 1, At, B1); PG8_BAR; PG8_SCHED;
            PG8_LDA(At, 1, 1); PG8_STAGE(PG8_SB(1, 0), b3, voffB); PG8_STAGE(PG8_SB(1, 1), b3 + hstepB, voffB); PG8_STAGE_A(PG8_SA(1, 0), a3, 0, v2);
            PG8_WAIT_V(8); PG8_WAIT_L(0); PG8_BAR; PG8_MMA(1, 0, At, B0); PG8_MMA(1, 1, At, B1); PG8_BAR; PG8_SCHED;
        }
        if (wr == 0) PG8_BAR;
        { const int l2 = hw_lane(); E(acc, cur, wr, wc, l2 & 15, l2 >> 4); }
        if (!has_next) break;
#pragma unroll
        for (int a = 0; a < 2; ++a)
#pragma unroll
            for (int b = 0; b < 2; ++b)
#pragma unroll
                for (int m = 0; m < 4; ++m)
#pragma unroll
                    for (int n = 0; n < 2; ++n) acc[a][b][m][n] = (f32x4){0.f, 0.f, 0.f, 0.f};
        cur = nxt; cA = nA; cB = nB; ++ui;
        if constexpr (GATHER) { vc[0][0] = vn[0][0]; vc[0][1] = vn[0][1]; vc[1][0] = vn[1][0]; vc[1][1] = vn[1][1]; }
        if (wr == 1) PG8_BAR;
    }
    PG8_WAIT_V(0);
    PG8_BAR;
#undef PG8_SA
#undef PG8_SB
#undef PG8_STAGE
#undef PG8_LDA
#undef PG8_LDB
#undef PG8_MMA
#undef PG8_WAIT_V
#undef PG8_WAIT_L
#undef PG8_BAR
#undef PG8_SCHED
#undef PG8_AOFFS
#undef PG8_STAGE_A
}
}
namespace attn_body {
using bf16=__hip_bfloat16;
using bf16x8=__attribute__((ext_vector_type(8)))short;
using s16x4=__attribute__((ext_vector_type(4)))short;
using f32x16=__attribute__((ext_vector_type(16)))float;
using u32x4=__attribute__((ext_vector_type(4)))unsigned;
constexpr int D=64;
constexpr int NW=8,QBLK=32,QB=QBLK*NW,KVBLK=64;
constexpr int ATTN_UNIT_ROWS=QB;
__device__ __forceinline__ int crow(int r,int hi){return (r&3)+8*(r>>2)+4*hi;}
#define SBAR() __builtin_amdgcn_sched_barrier(0)
constexpr int NSLOT=3, SLOTB=8192;
constexpr int LDS_K=0, LDS_V=NSLOT*SLOTB, LDS_WS=2*NSLOT*SLOTB, LDS_OST=LDS_WS+NW*64*4, LDS_BYTES=LDS_OST+NW*4096;
constexpr float C2=0.125f*1.4426950408889634f;
__device__ __forceinline__ void glds16(const void*gsrc,unsigned lds_dst){unsigned keep;
  asm volatile("s_mov_b32 %0, m0\n\ts_mov_b32 m0, %2\n\ts_nop 0\n\tglobal_load_lds_dwordx4 %1, off\n\ts_mov_b32 m0, %0":"=&s"(keep):"v"(gsrc),"s"(lds_dst):"memory");}
__device__ __forceinline__ float max3f(float a,float b,float c){float r;asm("v_max3_f32 %0, %1, %2, %3":"=v"(r):"v"(a),"v"(b),"v"(c));return r;}
__device__ __forceinline__ float max2f(float a,float b){float r;asm("v_max_f32_e32 %0, %1, %2":"=v"(r):"v"(a),"v"(b));return r;}
__device__ __forceinline__ float fadd_s(float a,float b){float r;asm("v_add_f32_e32 %0, %1, %2":"=v"(r):"v"(a),"v"(b));return r;}
__device__ __forceinline__ float fsub_s(float a,float b){float r;asm("v_sub_f32_e32 %0, %1, %2":"=v"(r):"v"(a),"v"(b));return r;}
typedef float f32x2_t __attribute__((ext_vector_type(2))); typedef __bf16 bf16x2_t __attribute__((ext_vector_type(2)));
__device__ __forceinline__ unsigned cvtpk_s(float lo,float hi){f32x2_t v={lo,hi};bf16x2_t b=__builtin_convertvector(v,bf16x2_t);return __builtin_bit_cast(unsigned,b);}
#define WAIT_BAR(N) asm volatile("s_waitcnt vmcnt(" #N ") lgkmcnt(0)\n\ts_barrier":::"memory")

__device__ __forceinline__ void qkt(f32x16&p0,f32x16&p1,const char*Kslot,const bf16x8*qr,const f32x16&negm,int r32,int hi){
  const char*kb=Kslot+hi*1024+r32*16;
  #pragma unroll
  for(int d0=0;d0<4;++d0){
    const bf16x8 b0=*reinterpret_cast<const bf16x8*>(kb+d0*2048);
    const bf16x8 b1=*reinterpret_cast<const bf16x8*>(kb+d0*2048+512);
    if(d0==0){p0=__builtin_amdgcn_mfma_f32_32x32x16_bf16(b0,qr[0],negm,0,0,0);p1=__builtin_amdgcn_mfma_f32_32x32x16_bf16(b1,qr[0],negm,0,0,0);}
    else{p0=__builtin_amdgcn_mfma_f32_32x32x16_bf16(b0,qr[d0],p0,0,0,0);p1=__builtin_amdgcn_mfma_f32_32x32x16_bf16(b1,qr[d0],p1,0,0,0);}}
}
typedef __attribute__((address_space(3))) const char* lds_cptr;
typedef short v4i16_t __attribute__((ext_vector_type(4)));
__device__ __forceinline__ void kload8(bf16x8*kf,lds_cptr kp){
  kf[0]=*(const __attribute__((address_space(3))) bf16x8*)(kp);      kf[1]=*(const __attribute__((address_space(3))) bf16x8*)(kp+512);
  kf[2]=*(const __attribute__((address_space(3))) bf16x8*)(kp+2048); kf[3]=*(const __attribute__((address_space(3))) bf16x8*)(kp+2560);
  kf[4]=*(const __attribute__((address_space(3))) bf16x8*)(kp+4096); kf[5]=*(const __attribute__((address_space(3))) bf16x8*)(kp+4608);
  kf[6]=*(const __attribute__((address_space(3))) bf16x8*)(kp+6144); kf[7]=*(const __attribute__((address_space(3))) bf16x8*)(kp+6656);
}
__device__ __forceinline__ void kload2(bf16x8*kf,lds_cptr kp,int j){ kf[2*j]=*(const __attribute__((address_space(3))) bf16x8*)(kp+j*2048); kf[2*j+1]=*(const __attribute__((address_space(3))) bf16x8*)(kp+j*2048+512); }
__device__ __forceinline__ void kload8_rm(bf16x8*kf,lds_cptr kp,const int*koff){
  #pragma unroll
  for(int d0=0;d0<4;++d0){ kf[2*d0]=*(const __attribute__((address_space(3))) bf16x8*)(kp+koff[d0]); kf[2*d0+1]=*(const __attribute__((address_space(3))) bf16x8*)(kp+koff[d0]+4096); }
}
__device__ __forceinline__ void kload2_rm(bf16x8*kf,lds_cptr kp,const int*koff,int j){ kf[2*j]=*(const __attribute__((address_space(3))) bf16x8*)(kp+koff[j]); kf[2*j+1]=*(const __attribute__((address_space(3))) bf16x8*)(kp+koff[j]+4096); }
__device__ __forceinline__ void qkt_rm(f32x16&p0,f32x16&p1,lds_cptr kp,const int*koff,const bf16x8*qr,const f32x16&negm){
  #pragma unroll
  for(int d0=0;d0<4;++d0){
    const bf16x8 b0=*(const __attribute__((address_space(3))) bf16x8*)(kp+koff[d0]);
    const bf16x8 b1=*(const __attribute__((address_space(3))) bf16x8*)(kp+koff[d0]+4096);
    if(d0==0){p0=__builtin_amdgcn_mfma_f32_32x32x16_bf16(b0,qr[0],negm,0,0,0);p1=__builtin_amdgcn_mfma_f32_32x32x16_bf16(b1,qr[0],negm,0,0,0);}
    else{p0=__builtin_amdgcn_mfma_f32_32x32x16_bf16(b0,qr[d0],p0,0,0,0);p1=__builtin_amdgcn_mfma_f32_32x32x16_bf16(b1,qr[d0],p1,0,0,0);}}
}
__device__ __forceinline__ void qprep(bf16x8 (&qr)[4],int hi,int pos,const float*gq){
  float x[4][8];
  #pragma unroll
  for(int d0=0;d0<4;++d0){
    #pragma unroll
    for(int e=0;e<8;++e)x[d0][e]=__builtin_bit_cast(float,(unsigned)(unsigned short)qr[d0][e]<<16);}
  if(gq){ float ss=0.f;
    #pragma unroll
    for(int d0=0;d0<4;++d0){
      #pragma unroll
      for(int e=0;e<8;++e)ss+=x[d0][e]*x[d0][e];}
    auto rr=__builtin_amdgcn_permlane32_swap(__float_as_uint(ss),__float_as_uint(ss),false,false);ss=__uint_as_float(rr[0])+__uint_as_float(rr[1]);
    const float rstd=rsqrtf(ss*(1.f/64.f)+1e-6f);
    #pragma unroll
    for(int d0=0;d0<4;++d0){
      #pragma unroll
      for(int e=0;e<8;++e)x[d0][e]*=rstd*gq[16*d0+8*hi+e];} }
  if(pos>=0){ const float rp=(float)(pos>>6),cp=(float)(pos&63);
    #pragma unroll
    for(int e=0;e<8;++e){ const float inv=exp2f(-(float)(8*hi+e)*(13.287712379549449f/16.f)); float s0,c0,s1,c1; sincosf(rp*inv,&s0,&c0); sincosf(cp*inv,&s1,&c1);
      const float a0=x[0][e],b0=x[2][e],a1=x[1][e],b1=x[3][e];
      x[0][e]=a0*c0-b0*s0; x[2][e]=b0*c0+a0*s0; x[1][e]=a1*c1-b1*s1; x[3][e]=b1*c1+a1*s1; } }
  #pragma unroll
  for(int d0=0;d0<4;++d0){ u32x4 w; w[0]=cvtpk_s(x[d0][0]*C2,x[d0][1]*C2); w[1]=cvtpk_s(x[d0][2]*C2,x[d0][3]*C2); w[2]=cvtpk_s(x[d0][4]*C2,x[d0][5]*C2); w[3]=cvtpk_s(x[d0][6]*C2,x[d0][7]*C2); qr[d0]=__builtin_bit_cast(bf16x8,w); }
}
__device__ __forceinline__ s16x4 vtr(lds_cptr p){ return __builtin_bit_cast(s16x4,__builtin_amdgcn_ds_read_tr16_b64_v4i16((__attribute__((address_space(3))) v4i16_t*)p)); }
__device__ __forceinline__ float rowmax(const f32x16&p0,const f32x16&p1){
  float a=max3f(p0[0],p0[1],p1[0]),b=max3f(p0[2],p0[3],p1[1]);a=max3f(a,p1[2],p1[3]);
  #pragma unroll
  for(int r=4;r<16;r+=4){a=max3f(a,p0[r],p0[r+1]);b=max3f(b,p0[r+2],p0[r+3]);a=max3f(a,p1[r],p1[r+1]);b=max3f(b,p1[r+2],p1[r+3]);}
  const float m=max2f(a,b);
  auto rr=__builtin_amdgcn_permlane32_swap(__float_as_uint(m),__float_as_uint(m),false,false);
  return max2f(__uint_as_float(rr[0]),__uint_as_float(rr[1]));
}
template<int ND> __device__ __forceinline__ void pv(f32x16*o,int vb,bf16x8 pa0,bf16x8 pa1,bf16x8 pa2,bf16x8 pa3){
  #pragma unroll
  for(int d0=0;d0<ND;++d0){s16x4 lo[4],hi[4];
    #pragma unroll
    for(int ks=0;ks<4;++ks){
      asm volatile("ds_read_b64_tr_b16 %0,%1 offset:%c2":"=&v"(lo[ks]):"v"(vb),"i"(d0*4096+ks*1024):"memory");
      asm volatile("ds_read_b64_tr_b16 %0,%1 offset:%c2":"=&v"(hi[ks]):"v"(vb),"i"(d0*4096+ks*1024+512):"memory");}
    asm volatile("s_waitcnt lgkmcnt(0)":::"memory");SBAR();
    #define PK(k) (bf16x8){lo[k][0],lo[k][1],lo[k][2],lo[k][3],hi[k][0],hi[k][1],hi[k][2],hi[k][3]}
    o[d0]=__builtin_amdgcn_mfma_f32_32x32x16_bf16(pa0,PK(0),o[d0],0,0,0);
    o[d0]=__builtin_amdgcn_mfma_f32_32x32x16_bf16(pa1,PK(1),o[d0],0,0,0);
    o[d0]=__builtin_amdgcn_mfma_f32_32x32x16_bf16(pa2,PK(2),o[d0],0,0,0);
    o[d0]=__builtin_amdgcn_mfma_f32_32x32x16_bf16(pa3,PK(3),o[d0],0,0,0);
    #undef PK
  }
}

#ifndef ATTN_STORE16
#define ATTN_STORE16(p,v) (*(u32x4*)(p)=(v))
#endif
template<int THRL> __device__ __forceinline__ void attn_unit(const bf16*Qb,int QP,const bf16*__restrict__ Kh,int KP,const bf16*__restrict__ Vh,int VP,bf16*Ob,int OP,int NT,char*shm,int wave){
  const int lane=hw_lane(),r32=lane&31,hi=lane>>5; const int wid=wave;
  const bf16*Qw=Qb+(long)(wid*QBLK)*QP;
  const unsigned lds0=(unsigned)(uintptr_t)shm;
  float*wsf=(float*)(shm+LDS_WS)+wid*64;
  const bf16*ksrc=Kh+(long)lane*KP+wid*8;
  const bf16*vsrc=Vh+(long)(16*(wid&3)+(lane>>2))*VP+(wid>>2)*32+(lane&3)*8;
  const unsigned kdst=lds0+LDS_K+wid*1024, vdst=lds0+LDS_V+wid*1024;
  #define DMA_K(t,slot) glds16(ksrc+(long)(t)*KVBLK*KP,(unsigned)__builtin_amdgcn_readfirstlane(kdst+(slot)))
  #define DMA_V(t,slot) glds16(vsrc+(long)(t)*KVBLK*VP,(unsigned)__builtin_amdgcn_readfirstlane(vdst+(slot)))
  const int vb0=(int)(lds0+LDS_V)+((lane>>4)&1)*32+(lane&3)*8+(4*hi+((lane&15)>>2))*64;
  const char*Kbase=shm+LDS_K; bf16x8 kf[8];
  const lds_cptr shm3=(lds_cptr)shm; const lds_cptr kp0=shm3+LDS_K+hi*1024+r32*16; const lds_cptr vp0=shm3+LDS_V+((lane>>4)&1)*32+(lane&3)*8+(4*hi+((lane&15)>>2))*64;
  DMA_K(0,0);DMA_V(0,0);DMA_K(1,SLOTB);
  bf16x8 qr[4];
  #pragma unroll
  for(int d0=0;d0<4;++d0)qr[d0]=*reinterpret_cast<const bf16x8*>(&Qw[(long)r32*QP+d0*16+hi*8]);
  float mhat=0.f,l_reg=0.f;f32x16 o[2];o[0]=f32x16{};o[1]=f32x16{};f32x16 negm=f32x16{};asm volatile("":"+v"(negm));
  #define CMASK(P0,P1,t) do{}while(0)
  bool resc=false;
  #define START(P0,P1) do{ const float rm=rowmax(P0,P1); resc=false; \
    { const float dl=rm; mhat=fadd_s(mhat,dl); \
      _Pragma("unroll") for(int r=0;r<16;++r){P0[r]=fsub_s(P0[r],dl);P1[r]=fsub_s(P1[r],dl);} \
      _Pragma("unroll") for(int r=0;r<16;++r)negm[r]=-mhat; asm volatile("":"+v"(negm)); } \
    _Pragma("unroll") for(int r=0;r<16;++r)P0[r]=__builtin_amdgcn_exp2f(P0[r]); }while(0)
  #define RESC() do{ if(resc){ asm volatile("s_waitcnt lgkmcnt(0)":::"memory"); \
      _Pragma("unroll") for(int d_=0;d_<2;++d_) _Pragma("unroll") for(int r=0;r<16;++r)o[d_][r]*=wsf[crow(r,hi)]; } }while(0)
  f32x16 pA0,pA1,pB0,pB1;
  int sl_prev=0,sl_cur=0,sl_next=SLOTB;
  #define ROT() do{sl_prev=sl_cur;sl_cur=sl_next;sl_next=(sl_next==(NSLOT-1)*SLOTB)?0:sl_next+SLOTB;}while(0)
  DMA_K(2,2*SLOTB);
  WAIT_BAR(3);
  qkt(pA0,pA1,Kbase,qr,negm,r32,hi);asm volatile("s_nop 15\n\ts_nop 7":"+v"(pA0),"+v"(pA1));CMASK(pA0,pA1,0);
  START(pA0,pA1);
  _Pragma("unroll") for(int r=0;r<16;++r)pA1[r]=__builtin_amdgcn_exp2f(pA1[r]);
  WAIT_BAR(0);
  DMA_K(3,0);DMA_V(1,SLOTB);
  ROT();
  kload8(kf,kp0+sl_cur);
  WAIT_BAR(2);
  s16x4 vlo[8],vhi[8]; u32x4 pw0,pw1,pw2,pw3;
  #define PKW(P,B) cvtpk_s(P[B],P[B+1])
  #define PAF(k) __builtin_bit_cast(bf16x8,pw##k)
  #define VFR(i) (bf16x8){vlo[i][0],vlo[i][1],vlo[i][2],vlo[i][3],vhi[i][0],vhi[i][1],vhi[i][2],vhi[i][3]}
  #define PIN(x) asm volatile("":"+v"(x))
  #define MX3(a,b,c) __builtin_fmaxf(__builtin_fmaxf((a),(b)),(c))
  #define GAPA(MF,A0,A1,A2,A3,W0,W1,PW) do{ MF; sacc+=A0; sacc+=A1; sacc+=A2; sacc+=A3; PIN(sacc); W0; W1; PIN(PW); SBAR(); }while(0)
  #define EX(v) __builtin_amdgcn_exp2f(v)
  #define GAPB(MF,X,B) do{ MF; X[B]=EX(X[B]); X[B+1]=EX(X[B+1]); X[B+2]=EX(X[B+2]); X[B+3]=EX(X[B+3]); PIN(X); SBAR(); }while(0)
  #define VRD(i) do{ vlo[i]=vtr(vp_+(((i)>>2)*4096+((i)&3)*1024)); vhi[i]=vtr(vp_+(((i)>>2)*4096+((i)&3)*1024+512)); }while(0)
  #define KRD(G,j) do{ if(G){ kload2(kf,kp0+sl_next,j); SBAR(); } }while(0)
  #define STEP(C0,C1,P0,P1,t,GK,GV,GL) do{ SBAR(); \
    const lds_cptr vp_=vp0+sl_prev; \
    VRD(0); SBAR(); float sacc=(P0[0]+P0[1]); \
    GAPA(C0=__builtin_amdgcn_mfma_f32_32x32x16_bf16(kf[0],qr[0],negm,0,0,0), P0[2],P0[3],P0[4],P0[5],     pw0[0]=PKW(P0,0), pw0[1]=PKW(P0,2), pw0); \
    VRD(4); SBAR(); GAPA(C1=__builtin_amdgcn_mfma_f32_32x32x16_bf16(kf[1],qr[0],negm,0,0,0), P0[6],P0[7],P0[8],P0[9],     pw0[2]=PKW(P0,4), pw0[3]=PKW(P0,6), pw0); \
    VRD(1); SBAR(); GAPA(C0=__builtin_amdgcn_mfma_f32_32x32x16_bf16(kf[2],qr[1],C0,0,0,0),   P0[10],P0[11],P0[12],P0[13], pw1[0]=PKW(P0,8), pw1[1]=PKW(P0,10), pw1); \
    VRD(5); SBAR(); GAPA(C1=__builtin_amdgcn_mfma_f32_32x32x16_bf16(kf[3],qr[1],C1,0,0,0),   P0[14],P0[15],P1[0],P1[1],   pw1[2]=PKW(P0,12),pw1[3]=PKW(P0,14), pw1); \
    VRD(2); SBAR(); GAPA(C0=__builtin_amdgcn_mfma_f32_32x32x16_bf16(kf[4],qr[2],C0,0,0,0),   P1[2],P1[3],P1[4],P1[5],     pw2[0]=PKW(P1,0), pw2[1]=PKW(P1,2), pw2); \
    VRD(6); SBAR(); GAPA(C1=__builtin_amdgcn_mfma_f32_32x32x16_bf16(kf[5],qr[2],C1,0,0,0),   P1[6],P1[7],P1[8],P1[9],     pw2[2]=PKW(P1,4), pw2[3]=PKW(P1,6), pw2); \
    VRD(3); SBAR(); GAPA(C0=__builtin_amdgcn_mfma_f32_32x32x16_bf16(kf[6],qr[3],C0,0,0,0),   P1[10],P1[11],P1[12],P1[13], pw3[0]=PKW(P1,8), pw3[1]=PKW(P1,10), pw3); \
    VRD(7); SBAR(); GAPA(C1=__builtin_amdgcn_mfma_f32_32x32x16_bf16(kf[7],qr[3],C1,0,0,0),   P1[14],P1[15],0.f,0.f,       pw3[2]=PKW(P1,12),pw3[3]=PKW(P1,14), pw3); \
    l_reg+=sacc; \
    if(GK){DMA_K((t)+3,sl_cur);} if(GV){DMA_V((t)+1,sl_next);} \
    CMASK(C0,C1,t); \
    { float a=MX3(C0[0],C0[1],C1[0]),b=MX3(C0[2],C0[3],C1[1]); a=MX3(a,C1[2],C1[3]); \
      _Pragma("unroll") for(int r=4;r<16;r+=4){a=MX3(a,C0[r],C0[r+1]);b=MX3(b,C0[r+2],C0[r+3]);a=MX3(a,C1[r],C1[r+1]);b=MX3(b,C1[r+2],C1[r+3]);} \
      float rm=__builtin_fmaxf(a,b); { auto rr=__builtin_amdgcn_permlane32_swap(__float_as_uint(rm),__float_as_uint(rm),false,false); rm=__builtin_fmaxf(__uint_as_float(rr[0]),__uint_as_float(rr[1])); } \
      resc=false; \
      if(__builtin_expect(__any(rm>(float)THRL),0)){ const float dl=__builtin_fmaxf(rm,0.f); mhat+=dl; \
        _Pragma("unroll") for(int r=0;r<16;++r){C0[r]-=dl;C1[r]-=dl;} \
        _Pragma("unroll") for(int r=0;r<16;++r)negm[r]=-mhat; asm volatile("":"+v"(negm)); \
        const float f=__builtin_amdgcn_exp2f(-dl); l_reg*=f; if(hi==0)wsf[r32]=f; resc=true; } } \
    SBAR(); \
    GAPB(o[0]=__builtin_amdgcn_mfma_f32_32x32x16_bf16(PAF(0),VFR(0),o[0],0,0,0), C0,0); \
    GAPB(o[1]=__builtin_amdgcn_mfma_f32_32x32x16_bf16(PAF(0),VFR(4),o[1],0,0,0), C0,4); \
    KRD(GL,0); GAPB(o[0]=__builtin_amdgcn_mfma_f32_32x32x16_bf16(PAF(1),VFR(1),o[0],0,0,0), C0,8); \
    KRD(GL,1); GAPB(o[1]=__builtin_amdgcn_mfma_f32_32x32x16_bf16(PAF(1),VFR(5),o[1],0,0,0), C0,12); \
    KRD(GL,2); GAPB(o[0]=__builtin_amdgcn_mfma_f32_32x32x16_bf16(PAF(2),VFR(2),o[0],0,0,0), C1,0); \
    KRD(GL,3); GAPB(o[1]=__builtin_amdgcn_mfma_f32_32x32x16_bf16(PAF(2),VFR(6),o[1],0,0,0), C1,4); \
    GAPB(o[0]=__builtin_amdgcn_mfma_f32_32x32x16_bf16(PAF(3),VFR(3),o[0],0,0,0), C1,8); \
    GAPB(o[1]=__builtin_amdgcn_mfma_f32_32x32x16_bf16(PAF(3),VFR(7),o[1],0,0,0), C1,12); \
    }while(0)
  int t=1;
  #undef CMASK
  #define CMASK(P0,P1,t) do{}while(0)
  for(;t+5<NT;t+=2){
    STEP(pB0,pB1,pA0,pA1,t,true,true,true);     WAIT_BAR(2); RESC(); ROT();
    STEP(pA0,pA1,pB0,pB1,t+1,true,true,true);   WAIT_BAR(2); RESC(); ROT();
  }
  #undef CMASK
  #define CMASK(P0,P1,t) do{}while(0)
  #define ENDW(tt) do{ if((tt)+3<NT){WAIT_BAR(2);} else if((tt)+2<NT){WAIT_BAR(1);} else {WAIT_BAR(0);} }while(0)
  for(;t+1<NT;t+=2){
    STEP(pB0,pB1,pA0,pA1,t,(t+3<NT),(t+1<NT),(t+1<NT));       ENDW(t);   RESC(); ROT();
    STEP(pA0,pA1,pB0,pB1,t+1,(t+4<NT),(t+2<NT),(t+2<NT));     ENDW(t+1); RESC(); ROT();
  }
  STEP(pB0,pB1,pA0,pA1,NT-1,false,false,false); RESC();
  { float sacc=pB0[0]+pB0[1]; _Pragma("unroll") for(int r=2;r<16;++r)sacc+=pB0[r]; _Pragma("unroll") for(int r=0;r<16;++r)sacc+=pB1[r]; l_reg+=sacc;
    pw0=(u32x4){PKW(pB0,0),PKW(pB0,2),PKW(pB0,4),PKW(pB0,6)};pw1=(u32x4){PKW(pB0,8),PKW(pB0,10),PKW(pB0,12),PKW(pB0,14)};pw2=(u32x4){PKW(pB1,0),PKW(pB1,2),PKW(pB1,4),PKW(pB1,6)};pw3=(u32x4){PKW(pB1,8),PKW(pB1,10),PKW(pB1,12),PKW(pB1,14)};
    SBAR(); pv<2>(o,vb0+sl_cur,PAF(0),PAF(1),PAF(2),PAF(3)); }
  #undef PKW
  #undef PAF
  #undef VFR
  #undef PIN
  #undef MX3
  #undef GAPA
  #undef GAPB
  #undef EX
  #undef VRD
  #undef KRD
  #undef STEP
  #undef ENDW
  {auto rr=__builtin_amdgcn_permlane32_swap(__float_as_uint(l_reg),__float_as_uint(l_reg),false,false);l_reg=__uint_as_float(rr[0])+__uint_as_float(rr[1]);}
  if(hi==0)wsf[32+r32]=l_reg;asm volatile("s_waitcnt lgkmcnt(0)":::"memory");
  float rli[16];
  #pragma unroll
  for(int r=0;r<16;++r)rli[r]=__builtin_amdgcn_rcpf(wsf[32+crow(r,hi)]);
  bf16*Ow=Ob+(long)(wid*QBLK)*OP;
  { bf16*stg=(bf16*)(shm+LDS_OST)+wid*2048;
    #pragma unroll
    for(int r=0;r<16;++r){const int orow=crow(r,hi);
      #pragma unroll
      for(int d0=0;d0<2;++d0)stg[orow*64+d0*32+r32]=__float2bfloat16(o[d0][r]*rli[r]);}
    asm volatile("s_waitcnt lgkmcnt(0)":::"memory");
    #pragma unroll
    for(int i=0;i<4;++i){const int row=i*8+(lane>>3),ch=lane&7; const u32x4 v=*(const u32x4*)(stg+row*64+ch*8); ATTN_STORE16(Ow+(long)row*OP+ch*8,v);} }
  asm volatile("s_waitcnt lgkmcnt(0)\n\ts_barrier":::"memory");
  #undef DMA_K
  #undef DMA_V
  #undef CMASK
  #undef START
  #undef RESC
  #undef ROT
}
template<int THRL> __device__ __forceinline__ void attn_unit128(const bf16*Qb,int QP,const bf16*__restrict__ Kh,int KP,const bf16*__restrict__ Vh,int VP,bf16*Ob,int OP,int NT,char*shm,int wave){
  const int lane=hw_lane(),r32=lane&31,hi=lane>>5; const int wid=wave;
  constexpr int LDS_V=NSLOT*SLOTB, LDS_WS=LDS_V+NSLOT*2*SLOTB, LDS_OST=LDS_WS+NW*64*4;
  const bf16*Qw=Qb+(long)(wid*QBLK)*QP;
  const unsigned lds0=(unsigned)(uintptr_t)shm;
  float*wsf=(float*)(shm+LDS_WS)+wid*64;
  const bf16*ksrc=Kh+(long)lane*KP+wid*8;
  const bf16*vsrc=Vh+(long)(16*(wid&3)+(lane>>2))*VP+(wid>>2)*32+(lane&3)*8;
  const unsigned kdst=lds0+LDS_K+wid*1024, vdst=lds0+LDS_V+wid*1024;
  #define DMA_K(t,slot) glds16(ksrc+(long)(t)*KVBLK*KP,(unsigned)__builtin_amdgcn_readfirstlane(kdst+(slot)))
  #define DMA_V(t,slot) do{ glds16(vsrc+(long)(t)*KVBLK*VP,(unsigned)__builtin_amdgcn_readfirstlane(vdst+2*(slot))); glds16(vsrc+(long)(t)*KVBLK*VP+64,(unsigned)__builtin_amdgcn_readfirstlane(vdst+2*(slot)+8192)); }while(0)
  const int vb0=(int)(lds0+LDS_V)+((lane>>4)&1)*32+(lane&3)*8+(4*hi+((lane&15)>>2))*64;
  const char*Kbase=shm+LDS_K; bf16x8 kf[8];
  const lds_cptr shm3=(lds_cptr)shm; const lds_cptr kp0=shm3+LDS_K+hi*1024+r32*16; const lds_cptr vp0=shm3+LDS_V+((lane>>4)&1)*32+(lane&3)*8+(4*hi+((lane&15)>>2))*64;
  DMA_K(0,0);DMA_V(0,0);DMA_K(1,SLOTB);
  bf16x8 qr[4];
  #pragma unroll
  for(int d0=0;d0<4;++d0)qr[d0]=*reinterpret_cast<const bf16x8*>(&Qw[(long)r32*QP+d0*16+hi*8]);
  float mhat=0.f,l_reg=0.f;f32x16 o[4];o[0]=f32x16{};o[1]=f32x16{};o[2]=f32x16{};o[3]=f32x16{};f32x16 negm=f32x16{};asm volatile("":"+v"(negm));
  #define CMASK(P0,P1,t) do{}while(0)
  bool resc=false;
  #define START(P0,P1) do{ const float rm=rowmax(P0,P1); resc=false; \
    { const float dl=rm; mhat=fadd_s(mhat,dl); \
      _Pragma("unroll") for(int r=0;r<16;++r){P0[r]=fsub_s(P0[r],dl);P1[r]=fsub_s(P1[r],dl);} \
      _Pragma("unroll") for(int r=0;r<16;++r)negm[r]=-mhat; asm volatile("":"+v"(negm)); } \
    _Pragma("unroll") for(int r=0;r<16;++r)P0[r]=__builtin_amdgcn_exp2f(P0[r]); }while(0)
  #define RESC() do{ if(resc){ asm volatile("s_waitcnt lgkmcnt(0)":::"memory"); \
      _Pragma("unroll") for(int d_=0;d_<4;++d_) _Pragma("unroll") for(int r=0;r<16;++r)o[d_][r]*=wsf[crow(r,hi)]; } }while(0)
  f32x16 pA0,pA1,pB0,pB1;
  int sl_prev=0,sl_cur=0,sl_next=SLOTB;
  #define ROT() do{sl_prev=sl_cur;sl_cur=sl_next;sl_next=(sl_next==(NSLOT-1)*SLOTB)?0:sl_next+SLOTB;}while(0)
  DMA_K(2,2*SLOTB);
  WAIT_BAR(3);
  qkt(pA0,pA1,Kbase,qr,negm,r32,hi);asm volatile("s_nop 15\n\ts_nop 7":"+v"(pA0),"+v"(pA1));CMASK(pA0,pA1,0);
  START(pA0,pA1);
  _Pragma("unroll") for(int r=0;r<16;++r)pA1[r]=__builtin_amdgcn_exp2f(pA1[r]);
  WAIT_BAR(0);
  DMA_K(3,0);DMA_V(1,SLOTB);
  ROT();
  kload8(kf,kp0+sl_cur);
  WAIT_BAR(3);
  s16x4 vlo[8],vhi[8]; u32x4 pw0,pw1,pw2,pw3;
  #define PKW(P,B) cvtpk_s(P[B],P[B+1])
  #define PAF(k) __builtin_bit_cast(bf16x8,pw##k)
  #define VFR(i) (bf16x8){vlo[i][0],vlo[i][1],vlo[i][2],vlo[i][3],vhi[i][0],vhi[i][1],vhi[i][2],vhi[i][3]}
  #define PIN(x) asm volatile("":"+v"(x))
  #define MX3(a,b,c) __builtin_fmaxf(__builtin_fmaxf((a),(b)),(c))
  #define GAPA(MF,A0,A1,A2,A3,W0,W1,PW) do{ MF; sacc+=A0; sacc+=A1; sacc+=A2; sacc+=A3; PIN(sacc); W0; W1; PIN(PW); SBAR(); }while(0)
  #define EX(v) __builtin_amdgcn_exp2f(v)
  #define GAPB(MF,X,B) do{ MF; X[B]=EX(X[B]); X[B+1]=EX(X[B+1]); X[B+2]=EX(X[B+2]); X[B+3]=EX(X[B+3]); PIN(X); SBAR(); }while(0)
  #define VRD(sl_,f) do{ vlo[sl_]=vtr(vp_+(((f)>>2)*4096+((f)&3)*1024)); vhi[sl_]=vtr(vp_+(((f)>>2)*4096+((f)&3)*1024+512)); }while(0)
  #define GAPB2(MF,X,B) do{ MF; X[B]=EX(X[B]); X[B+1]=EX(X[B+1]); PIN(X); SBAR(); }while(0)
  #define KRD(G,j) do{ if(G){ kload2(kf,kp0+sl_next,j); SBAR(); } }while(0)
  #define STEP(C0,C1,P0,P1,t,GK,GV,GL) do{ SBAR(); \
    const lds_cptr vp_=vp0+2*sl_prev; \
    VRD(0,0); SBAR(); float sacc=(P0[0]+P0[1]); \
    GAPA(C0=__builtin_amdgcn_mfma_f32_32x32x16_bf16(kf[0],qr[0],negm,0,0,0), P0[2],P0[3],P0[4],P0[5],     pw0[0]=PKW(P0,0), pw0[1]=PKW(P0,2), pw0); \
    VRD(1,4); SBAR(); GAPA(C1=__builtin_amdgcn_mfma_f32_32x32x16_bf16(kf[1],qr[0],negm,0,0,0), P0[6],P0[7],P0[8],P0[9],     pw0[2]=PKW(P0,4), pw0[3]=PKW(P0,6), pw0); \
    VRD(2,8); SBAR(); GAPA(C0=__builtin_amdgcn_mfma_f32_32x32x16_bf16(kf[2],qr[1],C0,0,0,0),   P0[10],P0[11],P0[12],P0[13], pw1[0]=PKW(P0,8), pw1[1]=PKW(P0,10), pw1); \
    VRD(3,12); SBAR(); GAPA(C1=__builtin_amdgcn_mfma_f32_32x32x16_bf16(kf[3],qr[1],C1,0,0,0),   P0[14],P0[15],P1[0],P1[1],   pw1[2]=PKW(P0,12),pw1[3]=PKW(P0,14), pw1); \
    VRD(4,1); SBAR(); GAPA(C0=__builtin_amdgcn_mfma_f32_32x32x16_bf16(kf[4],qr[2],C0,0,0,0),   P1[2],P1[3],P1[4],P1[5],     pw2[0]=PKW(P1,0), pw2[1]=PKW(P1,2), pw2); \
    VRD(5,5); SBAR(); GAPA(C1=__builtin_amdgcn_mfma_f32_32x32x16_bf16(kf[5],qr[2],C1,0,0,0),   P1[6],P1[7],P1[8],P1[9],     pw2[2]=PKW(P1,4), pw2[3]=PKW(P1,6), pw2); \
    VRD(6,9); SBAR(); GAPA(C0=__builtin_amdgcn_mfma_f32_32x32x16_bf16(kf[6],qr[3],C0,0,0,0),   P1[10],P1[11],P1[12],P1[13], pw3[0]=PKW(P1,8), pw3[1]=PKW(P1,10), pw3); \
    VRD(7,13); SBAR(); GAPA(C1=__builtin_amdgcn_mfma_f32_32x32x16_bf16(kf[7],qr[3],C1,0,0,0),   P1[14],P1[15],0.f,0.f,       pw3[2]=PKW(P1,12),pw3[3]=PKW(P1,14), pw3); \
    l_reg+=sacc; \
    if(GK){DMA_K((t)+3,sl_cur);} if(GV){DMA_V((t)+1,sl_next);} \
    CMASK(C0,C1,t); \
    { float a=MX3(C0[0],C0[1],C1[0]),b=MX3(C0[2],C0[3],C1[1]); a=MX3(a,C1[2],C1[3]); \
      _Pragma("unroll") for(int r=4;r<16;r+=4){a=MX3(a,C0[r],C0[r+1]);b=MX3(b,C0[r+2],C0[r+3]);a=MX3(a,C1[r],C1[r+1]);b=MX3(b,C1[r+2],C1[r+3]);} \
      float rm=__builtin_fmaxf(a,b); { auto rr=__builtin_amdgcn_permlane32_swap(__float_as_uint(rm),__float_as_uint(rm),false,false); rm=__builtin_fmaxf(__uint_as_float(rr[0]),__uint_as_float(rr[1])); } \
      resc=false; \
      if(__builtin_expect(__any(rm>(float)THRL),0)){ const float dl=__builtin_fmaxf(rm,0.f); mhat+=dl; \
        _Pragma("unroll") for(int r=0;r<16;++r){C0[r]-=dl;C1[r]-=dl;} \
        _Pragma("unroll") for(int r=0;r<16;++r)negm[r]=-mhat; asm volatile("":"+v"(negm)); \
        const float f=__builtin_amdgcn_exp2f(-dl); l_reg*=f; if(hi==0)wsf[r32]=f; resc=true; } } \
    SBAR(); \
    GAPB2(o[0]=__builtin_amdgcn_mfma_f32_32x32x16_bf16(PAF(0),VFR(0),o[0],0,0,0), C0,0); VRD(0,2); SBAR(); \
    GAPB2(o[1]=__builtin_amdgcn_mfma_f32_32x32x16_bf16(PAF(0),VFR(1),o[1],0,0,0), C0,2); VRD(1,6); SBAR(); \
    GAPB2(o[2]=__builtin_amdgcn_mfma_f32_32x32x16_bf16(PAF(0),VFR(2),o[2],0,0,0), C0,4); VRD(2,10); SBAR(); \
    GAPB2(o[3]=__builtin_amdgcn_mfma_f32_32x32x16_bf16(PAF(0),VFR(3),o[3],0,0,0), C0,6); VRD(3,14); SBAR(); \
    KRD(GL,0); GAPB2(o[0]=__builtin_amdgcn_mfma_f32_32x32x16_bf16(PAF(1),VFR(4),o[0],0,0,0), C0,8); VRD(4,3); SBAR(); \
    GAPB2(o[1]=__builtin_amdgcn_mfma_f32_32x32x16_bf16(PAF(1),VFR(5),o[1],0,0,0), C0,10); VRD(5,7); SBAR(); \
    KRD(GL,1); GAPB2(o[2]=__builtin_amdgcn_mfma_f32_32x32x16_bf16(PAF(1),VFR(6),o[2],0,0,0), C0,12); VRD(6,11); SBAR(); \
    GAPB2(o[3]=__builtin_amdgcn_mfma_f32_32x32x16_bf16(PAF(1),VFR(7),o[3],0,0,0), C0,14); VRD(7,15); SBAR(); \
    KRD(GL,2); GAPB2(o[0]=__builtin_amdgcn_mfma_f32_32x32x16_bf16(PAF(2),VFR(0),o[0],0,0,0), C1,0); \
    GAPB2(o[1]=__builtin_amdgcn_mfma_f32_32x32x16_bf16(PAF(2),VFR(1),o[1],0,0,0), C1,2); \
    KRD(GL,3); GAPB2(o[2]=__builtin_amdgcn_mfma_f32_32x32x16_bf16(PAF(2),VFR(2),o[2],0,0,0), C1,4); \
    GAPB2(o[3]=__builtin_amdgcn_mfma_f32_32x32x16_bf16(PAF(2),VFR(3),o[3],0,0,0), C1,6); \
    GAPB2(o[0]=__builtin_amdgcn_mfma_f32_32x32x16_bf16(PAF(3),VFR(4),o[0],0,0,0), C1,8); \
    GAPB2(o[1]=__builtin_amdgcn_mfma_f32_32x32x16_bf16(PAF(3),VFR(5),o[1],0,0,0), C1,10); \
    GAPB2(o[2]=__builtin_amdgcn_mfma_f32_32x32x16_bf16(PAF(3),VFR(6),o[2],0,0,0), C1,12); \
    GAPB2(o[3]=__builtin_amdgcn_mfma_f32_32x32x16_bf16(PAF(3),VFR(7),o[3],0,0,0), C1,14); \
    }while(0)
  int t=1;
  #undef CMASK
  #define CMASK(P0,P1,t) do{}while(0)
  for(;t+5<NT;t+=2){
    STEP(pB0,pB1,pA0,pA1,t,true,true,true);     WAIT_BAR(3); RESC(); ROT();
    STEP(pA0,pA1,pB0,pB1,t+1,true,true,true);   WAIT_BAR(3); RESC(); ROT();
  }
  #undef CMASK
  #define CMASK(P0,P1,t) do{}while(0)
  #define ENDW(tt) do{ if((tt)+3<NT){WAIT_BAR(3);} else if((tt)+2<NT){WAIT_BAR(2);} else {WAIT_BAR(0);} }while(0)
  for(;t+1<NT;t+=2){
    STEP(pB0,pB1,pA0,pA1,t,(t+3<NT),(t+1<NT),(t+1<NT));       ENDW(t);   RESC(); ROT();
    STEP(pA0,pA1,pB0,pB1,t+1,(t+4<NT),(t+2<NT),(t+2<NT));     ENDW(t+1); RESC(); ROT();
  }
  STEP(pB0,pB1,pA0,pA1,NT-1,false,false,false); RESC();
  { float sacc=pB0[0]+pB0[1]; _Pragma("unroll") for(int r=2;r<16;++r)sacc+=pB0[r]; _Pragma("unroll") for(int r=0;r<16;++r)sacc+=pB1[r]; l_reg+=sacc;
    pw0=(u32x4){PKW(pB0,0),PKW(pB0,2),PKW(pB0,4),PKW(pB0,6)};pw1=(u32x4){PKW(pB0,8),PKW(pB0,10),PKW(pB0,12),PKW(pB0,14)};pw2=(u32x4){PKW(pB1,0),PKW(pB1,2),PKW(pB1,4),PKW(pB1,6)};pw3=(u32x4){PKW(pB1,8),PKW(pB1,10),PKW(pB1,12),PKW(pB1,14)};
    SBAR(); pv<4>(o,vb0+2*sl_cur,PAF(0),PAF(1),PAF(2),PAF(3)); }
  #undef PKW
  #undef PAF
  #undef VFR
  #undef PIN
  #undef MX3
  #undef GAPA
  #undef GAPB
  #undef EX
  #undef VRD
  #undef GAPB2
  #undef KRD
  #undef STEP
  #undef ENDW
  {auto rr=__builtin_amdgcn_permlane32_swap(__float_as_uint(l_reg),__float_as_uint(l_reg),false,false);l_reg=__uint_as_float(rr[0])+__uint_as_float(rr[1]);}
  if(hi==0)wsf[32+r32]=l_reg;asm volatile("s_waitcnt lgkmcnt(0)":::"memory");
  float rli[16];
  #pragma unroll
  for(int r=0;r<16;++r)rli[r]=__builtin_amdgcn_rcpf(wsf[32+crow(r,hi)]);
  bf16*Ow=Ob+(long)(wid*QBLK)*OP;
  { bf16*stg=(bf16*)(shm+LDS_OST)+wid*2048;
    #pragma unroll
    for(int hf=0;hf<2;++hf){
      #pragma unroll
      for(int r=0;r<16;++r){const int orow=crow(r,hi);
        #pragma unroll
        for(int d0=0;d0<2;++d0)stg[orow*64+d0*32+r32]=__float2bfloat16(o[2*hf+d0][r]*rli[r]);}
      asm volatile("s_waitcnt lgkmcnt(0)":::"memory");
      #pragma unroll
      for(int i=0;i<4;++i){const int row=i*8+(lane>>3),ch=lane&7; const u32x4 v=*(const u32x4*)(stg+row*64+ch*8); ATTN_STORE16(Ow+(long)row*OP+hf*64+ch*8,v);}
      asm volatile("s_waitcnt lgkmcnt(0)":::"memory"); } }
  asm volatile("s_waitcnt lgkmcnt(0)\n\ts_barrier":::"memory");
  #undef DMA_K
  #undef DMA_V
  #undef CMASK
  #undef START
  #undef RESC
  #undef ROT
}
template<int THRL> __device__ __forceinline__ void attn_unit_br(const bf16*Qb,int QP,const bf16*__restrict__ Kh,int KP,const bf16*__restrict__ Vh,int VP,bf16*Ob,int OP,int NT,char*shm,int wave,float kmax,int qpos0,const float*gq){
  const int lane=hw_lane(),r32=lane&31,hi=lane>>5; const int wid=wave;
  const bf16*Qw=Qb+(long)(wid*QBLK)*QP;
  const unsigned lds0=(unsigned)(uintptr_t)shm;
  float*wsf=(float*)(shm+LDS_WS)+wid*64;
  const int krow_=8*wid+(lane>>3); const bf16*ksrc=Kh+(long)krow_*KP+(((lane&7)^((krow_>>1)&7))*8);
  const bf16*vsrc=Vh+(long)(16*(wid&3)+(lane>>2))*VP+(wid>>2)*32+(lane&3)*8;
  const unsigned kdst=lds0+LDS_K+wid*1024, vdst=lds0+LDS_V+wid*1024;
  #define DMA_K(t,slot) glds16(ksrc+(long)(t)*KVBLK*KP,(unsigned)__builtin_amdgcn_readfirstlane(kdst+(slot)))
  #define DMA_V(t,slot) glds16(vsrc+(long)(t)*KVBLK*VP,(unsigned)__builtin_amdgcn_readfirstlane(vdst+(slot)))
  const int vb0=(int)(lds0+LDS_V)+((lane>>4)&1)*32+(lane&3)*8+(4*hi+((lane&15)>>2))*64;
  const char*Kbase=shm+LDS_K; bf16x8 kf[8];
  const lds_cptr shm3=(lds_cptr)shm; const lds_cptr kp0=shm3+LDS_K; int koff[4]; _Pragma("unroll") for(int d0_=0;d0_<4;++d0_)koff[d0_]=r32*128+((((2*d0_+hi)^((r32>>1)&7)))*16); const lds_cptr vp0=shm3+LDS_V+((lane>>4)&1)*32+(lane&3)*8+(4*hi+((lane&15)>>2))*64;
  DMA_K(0,0);DMA_V(0,0);DMA_K(1,SLOTB);
  bf16x8 qr[4];
  #pragma unroll
  for(int d0=0;d0<4;++d0)qr[d0]=*reinterpret_cast<const bf16x8*>(&Qw[(long)r32*QP+d0*16+hi*8]);
  qprep(qr,hi,qpos0<0?-1:qpos0+wid*QBLK+r32,gq);
  float l_reg=0.f;f32x16 o[2];o[0]=f32x16{};o[1]=f32x16{};f32x16 negm;
  { float qs=0.f;
    #pragma unroll
    for(int d0=0;d0<4;++d0){
      #pragma unroll
      for(int e=0;e<8;++e){const float v=__builtin_bit_cast(float,(unsigned)(unsigned short)qr[d0][e]<<16);qs+=v*v;}}
    auto rr=__builtin_amdgcn_permlane32_swap(__float_as_uint(qs),__float_as_uint(qs),false,false);qs=__uint_as_float(rr[0])+__uint_as_float(rr[1]);
    const float ref=sqrtf(qs)*kmax*1.002f+0.02f;
    #pragma unroll
    for(int r=0;r<16;++r)negm[r]=-ref;
    asm volatile("":"+v"(negm)); }
  #define CMASK(P0,P1,t) do{}while(0)
  #define START(P0,P1) do{ _Pragma("unroll") for(int r=0;r<16;++r)P0[r]=__builtin_amdgcn_exp2f(P0[r]); }while(0)
  #define RESC() do{}while(0)
  f32x16 pA0,pA1,pB0,pB1;
  int sl_prev=0,sl_cur=0,sl_next=SLOTB;
  #define ROT() do{sl_prev=sl_cur;sl_cur=sl_next;sl_next=(sl_next==(NSLOT-1)*SLOTB)?0:sl_next+SLOTB;}while(0)
  DMA_K(2,2*SLOTB);
  WAIT_BAR(3);
  qkt_rm(pA0,pA1,kp0,koff,qr,negm);asm volatile("s_nop 15\n\ts_nop 7":"+v"(pA0),"+v"(pA1));CMASK(pA0,pA1,0);
  START(pA0,pA1);
  _Pragma("unroll") for(int r=0;r<16;++r)pA1[r]=__builtin_amdgcn_exp2f(pA1[r]);
  WAIT_BAR(0);
  DMA_K(3,0);DMA_V(1,SLOTB);
  ROT();
  kload8_rm(kf,kp0+sl_cur,koff);
  WAIT_BAR(2);
  s16x4 vlo[8],vhi[8]; u32x4 pw0,pw1,pw2,pw3;
  #define PKW(P,B) cvtpk_s(P[B],P[B+1])
  #define PAF(k) __builtin_bit_cast(bf16x8,pw##k)
  #define VFR(i) (bf16x8){vlo[i][0],vlo[i][1],vlo[i][2],vlo[i][3],vhi[i][0],vhi[i][1],vhi[i][2],vhi[i][3]}
  #define PIN(x) asm volatile("":"+v"(x))
  #define MX3(a,b,c) __builtin_fmaxf(__builtin_fmaxf((a),(b)),(c))
  #define GAPA(MF,A0,A1,A2,A3,W0,W1,PW) do{ MF; sacc+=A0; sacc+=A1; sacc+=A2; sacc+=A3; PIN(sacc); W0; W1; PIN(PW); SBAR(); }while(0)
  #define EX(v) __builtin_amdgcn_exp2f(v)
  #define GAPB(MF,X,B) do{ MF; X[B]=EX(X[B]); X[B+1]=EX(X[B+1]); X[B+2]=EX(X[B+2]); X[B+3]=EX(X[B+3]); PIN(X); SBAR(); }while(0)
  #define VRD(i) do{ vlo[i]=vtr(vp_+(((i)>>2)*4096+((i)&3)*1024)); vhi[i]=vtr(vp_+(((i)>>2)*4096+((i)&3)*1024+512)); }while(0)
  #define KRD(G,j) do{ if(G){ kload2_rm(kf,kp0+sl_next,koff,j); SBAR(); } }while(0)
  #define STEP(C0,C1,P0,P1,t,GK,GV,GL) do{ SBAR(); \
    const lds_cptr vp_=vp0+sl_prev; \
    VRD(0); SBAR(); float sacc=(P0[0]+P0[1]); \
    GAPA(C0=__builtin_amdgcn_mfma_f32_32x32x16_bf16(kf[0],qr[0],negm,0,0,0), P0[2],P0[3],P0[4],P0[5],     pw0[0]=PKW(P0,0), pw0[1]=PKW(P0,2), pw0); \
    VRD(4); SBAR(); GAPA(C1=__builtin_amdgcn_mfma_f32_32x32x16_bf16(kf[1],qr[0],negm,0,0,0), P0[6],P0[7],P0[8],P0[9],     pw0[2]=PKW(P0,4), pw0[3]=PKW(P0,6), pw0); \
    VRD(1); SBAR(); GAPA(C0=__builtin_amdgcn_mfma_f32_32x32x16_bf16(kf[2],qr[1],C0,0,0,0),   P0[10],P0[11],P0[12],P0[13], pw1[0]=PKW(P0,8), pw1[1]=PKW(P0,10), pw1); \
    VRD(5); SBAR(); GAPA(C1=__builtin_amdgcn_mfma_f32_32x32x16_bf16(kf[3],qr[1],C1,0,0,0),   P0[14],P0[15],P1[0],P1[1],   pw1[2]=PKW(P0,12),pw1[3]=PKW(P0,14), pw1); \
    VRD(2); SBAR(); GAPA(C0=__builtin_amdgcn_mfma_f32_32x32x16_bf16(kf[4],qr[2],C0,0,0,0),   P1[2],P1[3],P1[4],P1[5],     pw2[0]=PKW(P1,0), pw2[1]=PKW(P1,2), pw2); \
    VRD(6); SBAR(); GAPA(C1=__builtin_amdgcn_mfma_f32_32x32x16_bf16(kf[5],qr[2],C1,0,0,0),   P1[6],P1[7],P1[8],P1[9],     pw2[2]=PKW(P1,4), pw2[3]=PKW(P1,6), pw2); \
    VRD(3); SBAR(); GAPA(C0=__builtin_amdgcn_mfma_f32_32x32x16_bf16(kf[6],qr[3],C0,0,0,0),   P1[10],P1[11],P1[12],P1[13], pw3[0]=PKW(P1,8), pw3[1]=PKW(P1,10), pw3); \
    VRD(7); SBAR(); GAPA(C1=__builtin_amdgcn_mfma_f32_32x32x16_bf16(kf[7],qr[3],C1,0,0,0),   P1[14],P1[15],0.f,0.f,       pw3[2]=PKW(P1,12),pw3[3]=PKW(P1,14), pw3); \
    l_reg+=sacc; \
    if(GK){DMA_K((t)+3,sl_cur);} if(GV){DMA_V((t)+1,sl_next);} \
    CMASK(C0,C1,t); \
    SBAR(); \
    GAPB(o[0]=__builtin_amdgcn_mfma_f32_32x32x16_bf16(PAF(0),VFR(0),o[0],0,0,0), C0,0); \
    GAPB(o[1]=__builtin_amdgcn_mfma_f32_32x32x16_bf16(PAF(0),VFR(4),o[1],0,0,0), C0,4); \
    KRD(GL,0); GAPB(o[0]=__builtin_amdgcn_mfma_f32_32x32x16_bf16(PAF(1),VFR(1),o[0],0,0,0), C0,8); \
    KRD(GL,1); GAPB(o[1]=__builtin_amdgcn_mfma_f32_32x32x16_bf16(PAF(1),VFR(5),o[1],0,0,0), C0,12); \
    KRD(GL,2); GAPB(o[0]=__builtin_amdgcn_mfma_f32_32x32x16_bf16(PAF(2),VFR(2),o[0],0,0,0), C1,0); \
    KRD(GL,3); GAPB(o[1]=__builtin_amdgcn_mfma_f32_32x32x16_bf16(PAF(2),VFR(6),o[1],0,0,0), C1,4); \
    GAPB(o[0]=__builtin_amdgcn_mfma_f32_32x32x16_bf16(PAF(3),VFR(3),o[0],0,0,0), C1,8); \
    GAPB(o[1]=__builtin_amdgcn_mfma_f32_32x32x16_bf16(PAF(3),VFR(7),o[1],0,0,0), C1,12); \
    }while(0)
  if(wid>=4)__builtin_amdgcn_s_setprio(1);
  int t=1;
  #undef CMASK
  #define CMASK(P0,P1,t) do{}while(0)
  for(;t+5<NT;t+=2){
    STEP(pB0,pB1,pA0,pA1,t,true,true,true);     WAIT_BAR(2); RESC(); ROT();
    STEP(pA0,pA1,pB0,pB1,t+1,true,true,true);   WAIT_BAR(2); RESC(); ROT();
  }
  #undef CMASK
  #define CMASK(P0,P1,t) do{}while(0)
  #define ENDW(tt) do{ if((tt)+3<NT){WAIT_BAR(2);} else if((tt)+2<NT){WAIT_BAR(1);} else {WAIT_BAR(0);} }while(0)
  for(;t+1<NT;t+=2){
    STEP(pB0,pB1,pA0,pA1,t,(t+3<NT),(t+1<NT),(t+1<NT));       ENDW(t);   RESC(); ROT();
    STEP(pA0,pA1,pB0,pB1,t+1,(t+4<NT),(t+2<NT),(t+2<NT));     ENDW(t+1); RESC(); ROT();
  }
  STEP(pB0,pB1,pA0,pA1,NT-1,false,false,false); RESC();
  __builtin_amdgcn_s_setprio(0);
  { float sacc=pB0[0]+pB0[1]; _Pragma("unroll") for(int r=2;r<16;++r)sacc+=pB0[r]; _Pragma("unroll") for(int r=0;r<16;++r)sacc+=pB1[r]; l_reg+=sacc;
    pw0=(u32x4){PKW(pB0,0),PKW(pB0,2),PKW(pB0,4),PKW(pB0,6)};pw1=(u32x4){PKW(pB0,8),PKW(pB0,10),PKW(pB0,12),PKW(pB0,14)};pw2=(u32x4){PKW(pB1,0),PKW(pB1,2),PKW(pB1,4),PKW(pB1,6)};pw3=(u32x4){PKW(pB1,8),PKW(pB1,10),PKW(pB1,12),PKW(pB1,14)};
    SBAR(); pv<2>(o,vb0+sl_cur,PAF(0),PAF(1),PAF(2),PAF(3)); }
  #undef PKW
  #undef PAF
  #undef VFR
  #undef PIN
  #undef MX3
  #undef GAPA
  #undef GAPB
  #undef EX
  #undef VRD
  #undef KRD
  #undef STEP
  #undef ENDW
  {auto rr=__builtin_amdgcn_permlane32_swap(__float_as_uint(l_reg),__float_as_uint(l_reg),false,false);l_reg=__uint_as_float(rr[0])+__uint_as_float(rr[1]);}
  if(hi==0)wsf[32+r32]=l_reg;asm volatile("s_waitcnt lgkmcnt(0)":::"memory");
  float rli[16];
  #pragma unroll
  for(int r=0;r<16;++r)rli[r]=__builtin_amdgcn_rcpf(wsf[32+crow(r,hi)]);
  bf16*Ow=Ob+(long)(wid*QBLK)*OP;
  { bf16*stg=(bf16*)(shm+LDS_OST)+wid*2048;
    #pragma unroll
    for(int r=0;r<16;++r){const int orow=crow(r,hi);
      #pragma unroll
      for(int d0=0;d0<2;++d0)stg[orow*64+d0*32+r32]=__float2bfloat16(o[d0][r]*rli[r]);}
    asm volatile("s_waitcnt lgkmcnt(0)":::"memory");
    #pragma unroll
    for(int i=0;i<4;++i){const int row=i*8+(lane>>3),ch=lane&7; const u32x4 v=*(const u32x4*)(stg+row*64+ch*8); ATTN_STORE16(Ow+(long)row*OP+ch*8,v);} }
  asm volatile("s_waitcnt lgkmcnt(0)\n\ts_barrier":::"memory");
  #undef DMA_K
  #undef DMA_V
  #undef CMASK
  #undef START
  #undef RESC
  #undef ROT
}
template<int THRL> __device__ __forceinline__ void attn_unit128_br(const bf16*Qb,int QP,const bf16*__restrict__ Kh,int KP,const bf16*__restrict__ Vh,int VP,bf16*Ob,int OP,int NT,char*shm,int wave,float kmax,int qpos0,const float*gq){
  const int lane=hw_lane(),r32=lane&31,hi=lane>>5; const int wid=wave;
  constexpr int LDS_V=NSLOT*SLOTB, LDS_WS=LDS_V+NSLOT*2*SLOTB, LDS_OST=LDS_WS+NW*64*4;
  const bf16*Qw=Qb+(long)(wid*QBLK)*QP;
  const unsigned lds0=(unsigned)(uintptr_t)shm;
  float*wsf=(float*)(shm+LDS_WS)+wid*64;
  const bf16*ksrc=Kh+(long)lane*KP+wid*8;
  const bf16*vsrc=Vh+(long)(16*(wid&3)+(lane>>2))*VP+(wid>>2)*32+(lane&3)*8;
  const unsigned kdst=lds0+LDS_K+wid*1024, vdst=lds0+LDS_V+wid*1024;
  #define DMA_K(t,slot) glds16(ksrc+(long)(t)*KVBLK*KP,(unsigned)__builtin_amdgcn_readfirstlane(kdst+(slot)))
  #define DMA_V(t,slot) do{ glds16(vsrc+(long)(t)*KVBLK*VP,(unsigned)__builtin_amdgcn_readfirstlane(vdst+2*(slot))); glds16(vsrc+(long)(t)*KVBLK*VP+64,(unsigned)__builtin_amdgcn_readfirstlane(vdst+2*(slot)+8192)); }while(0)
  const int vb0=(int)(lds0+LDS_V)+((lane>>4)&1)*32+(lane&3)*8+(4*hi+((lane&15)>>2))*64;
  const char*Kbase=shm+LDS_K; bf16x8 kf[8];
  const lds_cptr shm3=(lds_cptr)shm; const lds_cptr kp0=shm3+LDS_K+hi*1024+r32*16; const lds_cptr vp0=shm3+LDS_V+((lane>>4)&1)*32+(lane&3)*8+(4*hi+((lane&15)>>2))*64;
  DMA_K(0,0);DMA_V(0,0);DMA_K(1,SLOTB);
  bf16x8 qr[4];
  #pragma unroll
  for(int d0=0;d0<4;++d0)qr[d0]=*reinterpret_cast<const bf16x8*>(&Qw[(long)r32*QP+d0*16+hi*8]);
  qprep(qr,hi,qpos0<0?-1:qpos0+wid*QBLK+r32,gq);
  float l_reg=0.f;f32x16 o[4];o[0]=f32x16{};o[1]=f32x16{};o[2]=f32x16{};o[3]=f32x16{};f32x16 negm;
  { float qs=0.f;
    #pragma unroll
    for(int d0=0;d0<4;++d0){
      #pragma unroll
      for(int e=0;e<8;++e){const float v=__builtin_bit_cast(float,(unsigned)(unsigned short)qr[d0][e]<<16);qs+=v*v;}}
    auto rr=__builtin_amdgcn_permlane32_swap(__float_as_uint(qs),__float_as_uint(qs),false,false);qs=__uint_as_float(rr[0])+__uint_as_float(rr[1]);
    const float ref=sqrtf(qs)*kmax*1.002f+0.02f;
    #pragma unroll
    for(int r=0;r<16;++r)negm[r]=-ref;
    asm volatile("":"+v"(negm)); }
  #define CMASK(P0,P1,t) do{}while(0)
  #define START(P0,P1) do{ _Pragma("unroll") for(int r=0;r<16;++r)P0[r]=__builtin_amdgcn_exp2f(P0[r]); }while(0)
  #define RESC() do{}while(0)
  f32x16 pA0,pA1,pB0,pB1;
  int sl_prev=0,sl_cur=0,sl_next=SLOTB;
  #define ROT() do{sl_prev=sl_cur;sl_cur=sl_next;sl_next=(sl_next==(NSLOT-1)*SLOTB)?0:sl_next+SLOTB;}while(0)
  DMA_K(2,2*SLOTB);
  WAIT_BAR(3);
  qkt(pA0,pA1,Kbase,qr,negm,r32,hi);asm volatile("s_nop 15\n\ts_nop 7":"+v"(pA0),"+v"(pA1));CMASK(pA0,pA1,0);
  START(pA0,pA1);
  _Pragma("unroll") for(int r=0;r<16;++r)pA1[r]=__builtin_amdgcn_exp2f(pA1[r]);
  WAIT_BAR(0);
  DMA_K(3,0);DMA_V(1,SLOTB);
  ROT();
  kload8(kf,kp0+sl_cur);
  WAIT_BAR(3);
  s16x4 vlo[8],vhi[8]; u32x4 pw0,pw1,pw2,pw3;
  #define PKW(P,B) cvtpk_s(P[B],P[B+1])
  #define PAF(k) __builtin_bit_cast(bf16x8,pw##k)
  #define VFR(i) (bf16x8){vlo[i][0],vlo[i][1],vlo[i][2],vlo[i][3],vhi[i][0],vhi[i][1],vhi[i][2],vhi[i][3]}
  #define PIN(x) asm volatile("":"+v"(x))
  #define MX3(a,b,c) __builtin_fmaxf(__builtin_fmaxf((a),(b)),(c))
  #define GAPA(MF,A0,A1,A2,A3,W0,W1,PW) do{ MF; sacc+=A0; sacc+=A1; sacc+=A2; sacc+=A3; PIN(sacc); W0; W1; PIN(PW); SBAR(); }while(0)
  #define EX(v) __builtin_amdgcn_exp2f(v)
  #define GAPB(MF,X,B) do{ MF; X[B]=EX(X[B]); X[B+1]=EX(X[B+1]); X[B+2]=EX(X[B+2]); X[B+3]=EX(X[B+3]); PIN(X); SBAR(); }while(0)
  #define VRD(sl_,f) do{ vlo[sl_]=vtr(vp_+(((f)>>2)*4096+((f)&3)*1024)); vhi[sl_]=vtr(vp_+(((f)>>2)*4096+((f)&3)*1024+512)); }while(0)
  #define GAPB2(MF,X,B) do{ MF; X[B]=EX(X[B]); X[B+1]=EX(X[B+1]); PIN(X); SBAR(); }while(0)
  #define KRD(G,j) do{ if(G){ kload2(kf,kp0+sl_next,j); SBAR(); } }while(0)
  #define STEP(C0,C1,P0,P1,t,GK,GV,GL) do{ SBAR(); \
    const lds_cptr vp_=vp0+2*sl_prev; \
    VRD(0,0); SBAR(); float sacc=(P0[0]+P0[1]); \
    GAPA(C0=__builtin_amdgcn_mfma_f32_32x32x16_bf16(kf[0],qr[0],negm,0,0,0), P0[2],P0[3],P0[4],P0[5],     pw0[0]=PKW(P0,0), pw0[1]=PKW(P0,2), pw0); \
    VRD(1,4); SBAR(); GAPA(C1=__builtin_amdgcn_mfma_f32_32x32x16_bf16(kf[1],qr[0],negm,0,0,0), P0[6],P0[7],P0[8],P0[9],     pw0[2]=PKW(P0,4), pw0[3]=PKW(P0,6), pw0); \
    VRD(2,8); SBAR(); GAPA(C0=__builtin_amdgcn_mfma_f32_32x32x16_bf16(kf[2],qr[1],C0,0,0,0),   P0[10],P0[11],P0[12],P0[13], pw1[0]=PKW(P0,8), pw1[1]=PKW(P0,10), pw1); \
    VRD(3,12); SBAR(); GAPA(C1=__builtin_amdgcn_mfma_f32_32x32x16_bf16(kf[3],qr[1],C1,0,0,0),   P0[14],P0[15],P1[0],P1[1],   pw1[2]=PKW(P0,12),pw1[3]=PKW(P0,14), pw1); \
    VRD(4,1); SBAR(); GAPA(C0=__builtin_amdgcn_mfma_f32_32x32x16_bf16(kf[4],qr[2],C0,0,0,0),   P1[2],P1[3],P1[4],P1[5],     pw2[0]=PKW(P1,0), pw2[1]=PKW(P1,2), pw2); \
    VRD(5,5); SBAR(); GAPA(C1=__builtin_amdgcn_mfma_f32_32x32x16_bf16(kf[5],qr[2],C1,0,0,0),   P1[6],P1[7],P1[8],P1[9],     pw2[2]=PKW(P1,4), pw2[3]=PKW(P1,6), pw2); \
    VRD(6,9); SBAR(); GAPA(C0=__builtin_amdgcn_mfma_f32_32x32x16_bf16(kf[6],qr[3],C0,0,0,0),   P1[10],P1[11],P1[12],P1[13], pw3[0]=PKW(P1,8), pw3[1]=PKW(P1,10), pw3); \
    VRD(7,13); SBAR(); GAPA(C1=__builtin_amdgcn_mfma_f32_32x32x16_bf16(kf[7],qr[3],C1,0,0,0),   P1[14],P1[15],0.f,0.f,       pw3[2]=PKW(P1,12),pw3[3]=PKW(P1,14), pw3); \
    l_reg+=sacc; \
    if(GK){DMA_K((t)+3,sl_cur);} if(GV){DMA_V((t)+1,sl_next);} \
    CMASK(C0,C1,t); \
    SBAR(); \
    GAPB2(o[0]=__builtin_amdgcn_mfma_f32_32x32x16_bf16(PAF(0),VFR(0),o[0],0,0,0), C0,0); VRD(0,2); SBAR(); \
    GAPB2(o[1]=__builtin_amdgcn_mfma_f32_32x32x16_bf16(PAF(0),VFR(1),o[1],0,0,0), C0,2); VRD(1,6); SBAR(); \
    GAPB2(o[2]=__builtin_amdgcn_mfma_f32_32x32x16_bf16(PAF(0),VFR(2),o[2],0,0,0), C0,4); VRD(2,10); SBAR(); \
    GAPB2(o[3]=__builtin_amdgcn_mfma_f32_32x32x16_bf16(PAF(0),VFR(3),o[3],0,0,0), C0,6); VRD(3,14); SBAR(); \
    KRD(GL,0); GAPB2(o[0]=__builtin_amdgcn_mfma_f32_32x32x16_bf16(PAF(1),VFR(4),o[0],0,0,0), C0,8); VRD(4,3); SBAR(); \
    GAPB2(o[1]=__builtin_amdgcn_mfma_f32_32x32x16_bf16(PAF(1),VFR(5),o[1],0,0,0), C0,10); VRD(5,7); SBAR(); \
    KRD(GL,1); GAPB2(o[2]=__builtin_amdgcn_mfma_f32_32x32x16_bf16(PAF(1),VFR(6),o[2],0,0,0), C0,12); VRD(6,11); SBAR(); \
    GAPB2(o[3]=__builtin_amdgcn_mfma_f32_32x32x16_bf16(PAF(1),VFR(7),o[3],0,0,0), C0,14); VRD(7,15); SBAR(); \
    KRD(GL,2); GAPB2(o[0]=__builtin_amdgcn_mfma_f32_32x32x16_bf16(PAF(2),VFR(0),o[0],0,0,0), C1,0); \
    GAPB2(o[1]=__builtin_amdgcn_mfma_f32_32x32x16_bf16(PAF(2),VFR(1),o[1],0,0,0), C1,2); \
    KRD(GL,3); GAPB2(o[2]=__builtin_amdgcn_mfma_f32_32x32x16_bf16(PAF(2),VFR(2),o[2],0,0,0), C1,4); \
    GAPB2(o[3]=__builtin_amdgcn_mfma_f32_32x32x16_bf16(PAF(2),VFR(3),o[3],0,0,0), C1,6); \
    GAPB2(o[0]=__builtin_amdgcn_mfma_f32_32x32x16_bf16(PAF(3),VFR(4),o[0],0,0,0), C1,8); \
    GAPB2(o[1]=__builtin_amdgcn_mfma_f32_32x32x16_bf16(PAF(3),VFR(5),o[1],0,0,0), C1,10); \
    GAPB2(o[2]=__builtin_amdgcn_mfma_f32_32x32x16_bf16(PAF(3),VFR(6),o[2],0,0,0), C1,12); \
    GAPB2(o[3]=__builtin_amdgcn_mfma_f32_32x32x16_bf16(PAF(3),VFR(7),o[3],0,0,0), C1,14); \
    }while(0)
  if(wid>=4)__builtin_amdgcn_s_setprio(1);
  int t=1;
  #undef CMASK
  #define CMASK(P0,P1,t) do{}while(0)
  for(;t+5<NT;t+=2){
    STEP(pB0,pB1,pA0,pA1,t,true,true,true);     WAIT_BAR(3); RESC(); ROT();
    STEP(pA0,pA1,pB0,pB1,t+1,true,true,true);   WAIT_BAR(3); RESC(); ROT();
  }
  #undef CMASK
  #define CMASK(P0,P1,t) do{}while(0)
  #define ENDW(tt) do{ if((tt)+3<NT){WAIT_BAR(3);} else if((tt)+2<NT){WAIT_BAR(2);} else {WAIT_BAR(0);} }while(0)
  for(;t+1<NT;t+=2){
    STEP(pB0,pB1,pA0,pA1,t,(t+3<NT),(t+1<NT),(t+1<NT));       ENDW(t);   RESC(); ROT();
    STEP(pA0,pA1,pB0,pB1,t+1,(t+4<NT),(t+2<NT),(t+2<NT));     ENDW(t+1); RESC(); ROT();
  }
  STEP(pB0,pB1,pA0,pA1,NT-1,false,false,false); RESC();
  __builtin_amdgcn_s_setprio(0);
  { float sacc=pB0[0]+pB0[1]; _Pragma("unroll") for(int r=2;r<16;++r)sacc+=pB0[r]; _Pragma("unroll") for(int r=0;r<16;++r)sacc+=pB1[r]; l_reg+=sacc;
    pw0=(u32x4){PKW(pB0,0),PKW(pB0,2),PKW(pB0,4),PKW(pB0,6)};pw1=(u32x4){PKW(pB0,8),PKW(pB0,10),PKW(pB0,12),PKW(pB0,14)};pw2=(u32x4){PKW(pB1,0),PKW(pB1,2),PKW(pB1,4),PKW(pB1,6)};pw3=(u32x4){PKW(pB1,8),PKW(pB1,10),PKW(pB1,12),PKW(pB1,14)};
    SBAR(); pv<4>(o,vb0+2*sl_cur,PAF(0),PAF(1),PAF(2),PAF(3)); }
  #undef PKW
  #undef PAF
  #undef VFR
  #undef PIN
  #undef MX3
  #undef GAPA
  #undef GAPB
  #undef EX
  #undef VRD
  #undef GAPB2
  #undef KRD
  #undef STEP
  #undef ENDW
  {auto rr=__builtin_amdgcn_permlane32_swap(__float_as_uint(l_reg),__float_as_uint(l_reg),false,false);l_reg=__uint_as_float(rr[0])+__uint_as_float(rr[1]);}
  if(hi==0)wsf[32+r32]=l_reg;asm volatile("s_waitcnt lgkmcnt(0)":::"memory");
  float rli[16];
  #pragma unroll
  for(int r=0;r<16;++r)rli[r]=__builtin_amdgcn_rcpf(wsf[32+crow(r,hi)]);
  bf16*Ow=Ob+(long)(wid*QBLK)*OP;
  { bf16*stg=(bf16*)(shm+LDS_OST)+wid*2048;
    #pragma unroll
    for(int hf=0;hf<2;++hf){
      #pragma unroll
      for(int r=0;r<16;++r){const int orow=crow(r,hi);
        #pragma unroll
        for(int d0=0;d0<2;++d0)stg[orow*64+d0*32+r32]=__float2bfloat16(o[2*hf+d0][r]*rli[r]);}
      asm volatile("s_waitcnt lgkmcnt(0)":::"memory");
      #pragma unroll
      for(int i=0;i<4;++i){const int row=i*8+(lane>>3),ch=lane&7; const u32x4 v=*(const u32x4*)(stg+row*64+ch*8); ATTN_STORE16(Ow+(long)row*OP+hf*64+ch*8,v);}
      asm volatile("s_waitcnt lgkmcnt(0)":::"memory"); } }
  asm volatile("s_waitcnt lgkmcnt(0)\n\ts_barrier":::"memory");
  #undef DMA_K
  #undef DMA_V
  #undef CMASK
  #undef START
  #undef RESC
  #undef ROT
}
constexpr int ATTN_LDS_BYTES=LDS_BYTES;
#undef SBAR
#undef WAIT_BAR
}
namespace dn {
constexpr int NCHUNK = 260, GROUP = 6, WREG = 17408  , TP = 72  ;
constexpr int F_WT = 0, F_QKT = 8, F_QD = 14, F_KD = 22, F_U = 30, F_GL = 38;
__device__ __forceinline__ int crow(int r, int hi) { return (r & 3) + 8 * (r >> 2) + 4 * hi; }
__device__ __forceinline__ bf16x8 pack8(const f32x16& x, int s) {
    v4u w; w.x = cvt_pk_bf16(x[8 * s + 0], x[8 * s + 1]); w.y = cvt_pk_bf16(x[8 * s + 2], x[8 * s + 3]); w.z = cvt_pk_bf16(x[8 * s + 4], x[8 * s + 5]); w.w = cvt_pk_bf16(x[8 * s + 6], x[8 * s + 7]);
    return __builtin_bit_cast(bf16x8, w);
}
#define DN_MFMA(a, b, c) __builtin_amdgcn_mfma_f32_32x32x16_bf16(a, b, c, 0, 0, 0)

struct Chain {
    const bf16_t* P1b;
    const bf16_t* QKb;
    bf16_t* Ob;
    int h, dir;
    float Aexp, dtb;
    unsigned char* ring;
    unsigned* dbg;
};
__device__ __forceinline__ int chunk_of(int ci, int dir) { return dir == 0 ? ci : (ci < 4 ? 3 - ci : 263 - ci); }

__device__ __forceinline__ void produce(const Chain& ch, int ci, LAS unsigned char* wl, const LAS float* wct, unsigned char* slot, int lane_in) {
    int lane = lane_in; asm volatile("" : "+v"(lane));
    const int r = lane & 31, hh = lane >> 5;
    const int c = chunk_of(ci, ch.dir), t0 = 64 * c, seg_lo = (c < 4) ? 0 : CTXL, seg_hi = (c < 4) ? CTXL : TT;
    LAS float* Lm = (LAS float*)wl; LAS bf16_t* Tm = (LAS bf16_t*)wl; LAS float* gcT = (LAS float*)(wl + 16384); LAS float* btT = gcT + 64;
    {
        const int tok = ch.dir ? t0 + 63 - lane : t0 + lane;
        const bf16_t* row = ch.P1b + (size_t)tok * P1W;
        const float a = bf2f(row[C_BA + ch.dir * 8 + ch.h]), bb = bf2f(row[C_BB + ch.dir * 8 + ch.h]);
        const float x = a + ch.dtb; const float sp = x > 20.f ? x : log1pf(__expf(x));
        float g = -ch.Aexp * sp;
#pragma unroll
        for (int o = 1; o < 64; o <<= 1) { const float t = __shfl_up(g, o); if (lane >= o) g += t; }
        gcT[lane] = g; btT[lane] = sigmoidf_(bb);
    }
    LDS_WAIT();
    const float gl = gcT[63];
    bf16x8 kA[2][4], qA[2][4], vA[2][4];
#pragma unroll
    for (int rt = 0; rt < 2; ++rt) {
        const int p = 32 * rt + r; const int tok = ch.dir ? t0 + 63 - p : t0 + p;
        const bf16_t* rq = ch.QKb + (size_t)tok * 1536 + ch.h * 64 + 4 * hh; const bf16_t* rk = rq + 512;
        const bf16_t* rv = ch.P1b + (size_t)tok * P1W + C_BQKV + ch.h * 64 + 4 * hh;
#pragma unroll
        for (int s = 0; s < 4; ++s) { const v2u a = *(const v2u*)(rk + 16 * s), b2 = *(const v2u*)(rk + 16 * s + 8); v4u w; w.x = a.x; w.y = a.y; w.z = b2.x; w.w = b2.y; kA[rt][s] = __builtin_bit_cast(bf16x8, w);
            const v2u c2 = *(const v2u*)(rq + 16 * s), d2 = *(const v2u*)(rq + 16 * s + 8); v4u w2; w2.x = c2.x; w2.y = c2.y; w2.z = d2.x; w2.w = d2.y; qA[rt][s] = __builtin_bit_cast(bf16x8, w2);
            const v2u e2 = *(const v2u*)(rv + 16 * s), f2 = *(const v2u*)(rv + 16 * s + 8); v4u w3; w3.x = e2.x; w3.y = e2.y; w3.z = f2.x; w3.w = f2.y; vA[rt][s] = __builtin_bit_cast(bf16x8, w3); }
    }
    __builtin_amdgcn_sched_barrier(0);
    v4u* sl = (v4u*)slot;
    const float gcc0 = gcT[r], gcc1 = gcT[32 + r];
#pragma unroll
    for (int tix = 0; tix < 3; ++tix) {
        const int it = (tix == 0) ? 0 : 1, jt = (tix == 2) ? 1 : 0;
        f32x16 acc = {};
#pragma unroll
        for (int s = 0; s < 4; ++s) acc = DN_MFMA(kA[it][s], kA[jt][s], acc);
        const float gcj = jt ? gcc1 : gcc0; const int j = 32 * jt + r;
#pragma unroll
        for (int rg = 0; rg < 16; ++rg) { const int i = 32 * it + crow(rg, hh); const float gi = gcT[i], bi = btT[i];
            const float v = (i > j) ? bi * acc[rg] * __expf(fminf(gi - gcj, 0.f)) : 0.f; Lm[i * 64 + j] = v; }
    }
#pragma unroll
    for (int tix = 0; tix < 3; ++tix) {
        const int jt = (tix == 2) ? 1 : 0, it = (tix == 0) ? 0 : 1;
        f32x16 acc = {};
#pragma unroll
        for (int s = 0; s < 4; ++s) acc = DN_MFMA(kA[jt][s], qA[it][s], acc);
        const float gci = it ? gcc1 : gcc0; const int i = 32 * it + r;
#pragma unroll
        for (int rg = 0; rg < 16; ++rg) { const int j = 32 * jt + crow(rg, hh); const float gj = gcT[j];
            acc[rg] = (i >= j) ? acc[rg] * __expf(fminf(gci - gj, 0.f)) : 0.f; }
        sl[(F_QKT + tix * 2 + 0) * 64 + lane] = __builtin_bit_cast(v4u, pack8(acc, 0));
        sl[(F_QKT + tix * 2 + 1) * 64 + lane] = __builtin_bit_cast(v4u, pack8(acc, 1));
    }
#pragma unroll
    for (int rt = 0; rt < 2; ++rt) { const float e = __expf(rt ? gcc1 : gcc0);
#pragma unroll
        for (int s = 0; s < 4; ++s) { const v4u w = __builtin_bit_cast(v4u, qA[rt][s]); v4u o;
            o.x = cvt_pk_bf16(bflo(w.x) * e, bfhi(w.x) * e); o.y = cvt_pk_bf16(bflo(w.y) * e, bfhi(w.y) * e); o.z = cvt_pk_bf16(bflo(w.z) * e, bfhi(w.z) * e); o.w = cvt_pk_bf16(bflo(w.w) * e, bfhi(w.w) * e);
            sl[(F_QD + rt * 4 + s) * 64 + lane] = o; } }
    LDS_WAIT();
#if MK_DEBUG == 3
    { unsigned bad = 0u;
      for (int i = 0; i < 64; ++i) { const float lv = Lm[i * 64 + lane]; if (lane < i && !(fabsf(lv) <= 1.5f)) bad |= 1u; }
      if (!(fabsf(gcT[lane]) < 1.0e30f)) bad |= 2u; if (!(btT[lane] >= 0.f && btT[lane] <= 1.f)) bad |= 4u;
      if (bad) atomicOr(ch.dbg, bad); }
#endif
    float T[64];
#pragma unroll
    for (int i = 0; i < 64; ++i) {
        float a = (lane == i) ? 1.f : 0.f;
#pragma unroll
        for (int q = 0; q < (i + 3) / 4; ++q) { const f32x4 l4 = *(const LAS f32x4*)(Lm + i * 64 + 4 * q);
#pragma unroll
            for (int e = 0; e < 4; ++e) if (4 * q + e < i) a -= l4[e] * T[4 * q + e]; }
        T[i] = a;
        if ((i & 3) == 3) __builtin_amdgcn_sched_barrier(0);
    }
    LDS_WAIT();
#pragma unroll
    for (int i = 0; i < 64; ++i) Tm[i * TP + lane] = (bf16_t)f2bf(T[i]);
    LDS_WAIT();
    bf16x8 Tf[3][2];
#pragma unroll
    for (int tix = 0; tix < 3; ++tix) { const int it = (tix == 0) ? 0 : 1, jt = (tix == 2) ? 1 : 0;
#pragma unroll
        for (int s = 0; s < 2; ++s) { const LAS bf16_t* p = Tm + (32 * it + r) * TP + 32 * jt + 16 * s + 4 * hh;
            const v2u a = *(const LAS v2u*)p, b = *(const LAS v2u*)(p + 8); v4u w; w.x = a.x; w.y = a.y; w.z = b.x; w.w = b.y; Tf[tix][s] = __builtin_bit_cast(bf16x8, w); } }
#if MK_DEBUG == 4
    { unsigned bad = 0u;
      _Pragma("unroll") for (int t_ = 0; t_ < 3; ++t_) _Pragma("unroll") for (int s_ = 0; s_ < 2; ++s_) { const v4u w = __builtin_bit_cast(v4u, Tf[t_][s_]);
        const unsigned ws_[4] = {w.x, w.y, w.z, w.w};
        _Pragma("unroll") for (int q_ = 0; q_ < 4; ++q_) { const float lo_ = bflo(ws_[q_]), hi_ = bfhi(ws_[q_]);
          if (!(fabsf(lo_) < 3.0e38f) || !(fabsf(hi_) < 3.0e38f)) bad |= 1u; else if (fabsf(lo_) > 1.0e3f || fabsf(hi_) > 1.0e3f) bad |= 2u; } }
      if (bad) atomicOr(ch.dbg, bad); }
#endif
    bf16x8 If[2];
#pragma unroll
    for (int sp = 0; sp < 2; ++sp) { bf16x8 f_;
#pragma unroll
        for (int jj = 0; jj < 8; ++jj) f_[jj] = ((16 * sp + 8 * (jj >> 2) + 4 * hh + (jj & 3)) == r) ? (short)0x3F80 : (short)0;
        If[sp] = f_; }
    {
        bf16x8 kbg[2][2][2];
#pragma unroll
        for (int jt = 0; jt < 2; ++jt)
#pragma unroll
            for (int dt = 0; dt < 2; ++dt) {
                f32x16 kc = {};
                kc = DN_MFMA(kA[jt][2 * dt + 0], If[0], kc); kc = DN_MFMA(kA[jt][2 * dt + 1], If[1], kc);
                f32x16 kd, kb;
#pragma unroll
                for (int rg = 0; rg < 16; ++rg) { const int j = 32 * jt + crow(rg, hh); const float gj = gcT[j], bj = btT[j];
                    kd[rg] = kc[rg] * __expf(gl - gj); kb[rg] = kc[rg] * bj * __expf(gj); }
                sl[(F_KD + (jt * 2 + dt) * 2 + 0) * 64 + lane] = __builtin_bit_cast(v4u, pack8(kd, 0));
                sl[(F_KD + (jt * 2 + dt) * 2 + 1) * 64 + lane] = __builtin_bit_cast(v4u, pack8(kd, 1));
                kbg[jt][dt][0] = pack8(kb, 0); kbg[jt][dt][1] = pack8(kb, 1);
#if MK_DEBUG == 4
                { bool b_ = false; _Pragma("unroll") for (int rg = 0; rg < 16; ++rg) if (!(fabsf(kb[rg]) < 3.0e38f)) b_ = true; if (b_) atomicOr(ch.dbg, 4u); }
#endif
            }
#pragma unroll
        for (int dt = 0; dt < 2; ++dt)
#pragma unroll
            for (int it = 0; it < 2; ++it) {
                f32x16 wt = {};
#pragma unroll
                for (int s = 0; s < 2; ++s) {
                    if (it == 0) wt = DN_MFMA(kbg[0][dt][s], Tf[0][s], wt);
                    else { wt = DN_MFMA(kbg[0][dt][s], Tf[1][s], wt); wt = DN_MFMA(kbg[1][dt][s], Tf[2][s], wt); }
                }
                asm volatile("s_nop 15\n\ts_nop 7" : "+v"(wt));
                sl[(F_WT + (dt * 2 + it) * 2 + 0) * 64 + lane] = __builtin_bit_cast(v4u, pack8(wt, 0));
                sl[(F_WT + (dt * 2 + it) * 2 + 1) * 64 + lane] = __builtin_bit_cast(v4u, pack8(wt, 1));
            }
    }
    {
        bf16x8 vb[2][2][2];
#pragma unroll
        for (int jt = 0; jt < 2; ++jt)
#pragma unroll
            for (int dvt = 0; dvt < 2; ++dvt) {
                f32x16 vc = {};
                vc = DN_MFMA(vA[jt][2 * dvt + 0], If[0], vc); vc = DN_MFMA(vA[jt][2 * dvt + 1], If[1], vc);
#pragma unroll
                for (int rg = 0; rg < 16; ++rg) { const int j = 32 * jt + crow(rg, hh); vc[rg] *= btT[j]; }
                vb[jt][dvt][0] = pack8(vc, 0); vb[jt][dvt][1] = pack8(vc, 1);
#if MK_DEBUG == 4
                { bool b_ = false; _Pragma("unroll") for (int rg = 0; rg < 16; ++rg) if (!(fabsf(vc[rg]) < 3.0e38f)) b_ = true; if (b_) atomicOr(ch.dbg, 8u); }
#endif
            }
#pragma unroll
        for (int it = 0; it < 2; ++it)
#pragma unroll
            for (int dvt = 0; dvt < 2; ++dvt) {
                f32x16 u = {};
#pragma unroll
                for (int s = 0; s < 2; ++s) {
                    if (it == 0) u = DN_MFMA(Tf[0][s], vb[0][dvt][s], u);
                    else { u = DN_MFMA(Tf[1][s], vb[0][dvt][s], u); u = DN_MFMA(Tf[2][s], vb[1][dvt][s], u); }
                }
                asm volatile("s_nop 15\n\ts_nop 7" : "+v"(u));
                sl[(F_U + (it * 2 + dvt) * 2 + 0) * 64 + lane] = __builtin_bit_cast(v4u, pack8(u, 0));
                sl[(F_U + (it * 2 + dvt) * 2 + 1) * 64 + lane] = __builtin_bit_cast(v4u, pack8(u, 1));
            }
    }
    { v4u gw; gw.x = __float_as_uint(__expf(gl)); gw.y = gw.x; gw.z = gw.x; gw.w = gw.x; sl[F_GL * 64 + lane] = gw; }
}

__device__ __forceinline__ f32x16 unpack16(v4u a, v4u b) {
    f32x16 x;
    x[0] = bflo(a.x); x[1] = bfhi(a.x); x[2] = bflo(a.y); x[3] = bfhi(a.y); x[4] = bflo(a.z); x[5] = bfhi(a.z); x[6] = bflo(a.w); x[7] = bfhi(a.w);
    x[8] = bflo(b.x); x[9] = bfhi(b.x); x[10] = bflo(b.y); x[11] = bfhi(b.y); x[12] = bflo(b.z); x[13] = bfhi(b.z); x[14] = bflo(b.w); x[15] = bfhi(b.w);
    return x;
}
__device__ __forceinline__ void consume(const Chain& ch, int ci, const unsigned char* slot, f32x16 (&S)[2], int hv, int lane_in) {
    int lane = lane_in; asm volatile("" : "+v"(lane));
    const int r = lane & 31, hh = lane >> 5;
    const v4u* sl = (const v4u*)slot;
    v4u fr_[F_U], fU_[4];
#pragma unroll
    for (int i = 0; i < F_U; ++i) fr_[i] = sl[i * 64 + lane];
#pragma unroll
    for (int it = 0; it < 2; ++it)
#pragma unroll
        for (int s = 0; s < 2; ++s) fU_[it * 2 + s] = sl[(F_U + (it * 2 + hv) * 2 + s) * 64 + lane];
    const v4u fgl_ = sl[F_GL * 64 + lane];
    __builtin_amdgcn_sched_barrier(0);
#define DN_FR(idx) __builtin_bit_cast(bf16x8, fr_[idx])
    const float gl = __builtin_bit_cast(float, fgl_.x);
#if MK_DEBUG == 2
    { unsigned bad = 0u;
      auto nf = [](v4u w) { return ((w.x & 0x7f80u) == 0x7f80u) || ((w.x & 0x7f800000u) == 0x7f800000u) || ((w.y & 0x7f80u) == 0x7f80u) || ((w.y & 0x7f800000u) == 0x7f800000u) || ((w.z & 0x7f80u) == 0x7f80u) || ((w.z & 0x7f800000u) == 0x7f800000u) || ((w.w & 0x7f80u) == 0x7f80u) || ((w.w & 0x7f800000u) == 0x7f800000u); };
      if ((__float_as_uint(gl) & 0x7f800000u) == 0x7f800000u) bad |= 1u;
      for (int i = 0; i < 8; ++i) { if (nf(sl[(F_WT + i) * 64 + lane])) bad |= 2u; if (nf(sl[(F_QD + i) * 64 + lane])) bad |= 4u; if (nf(sl[(F_KD + i) * 64 + lane])) bad |= 8u; if (nf(sl[(F_U + i) * 64 + lane])) bad |= 16u; }
      for (int i = 0; i < 6; ++i) if (nf(sl[(F_QKT + i) * 64 + lane])) bad |= 32u;
      if (bad) atomicOr(ch.dbg, bad); }
#endif
    asm volatile("s_nop 15\n\ts_nop 7" : "+v"(S[0]), "+v"(S[1]));
    bf16x8 Sb[2][2];
#pragma unroll
    for (int dt = 0; dt < 2; ++dt) { Sb[dt][0] = pack8(S[dt], 0); Sb[dt][1] = pack8(S[dt], 1); }
    f32x16 accv[2], acco[2];
#pragma unroll
    for (int it = 0; it < 2; ++it) { accv[it] = f32x16{}; acco[it] = f32x16{};
#pragma unroll
        for (int dt = 0; dt < 2; ++dt)
#pragma unroll
            for (int s = 0; s < 2; ++s) {
                accv[it] = DN_MFMA(DN_FR(F_WT + (dt * 2 + it) * 2 + s), Sb[dt][s], accv[it]);
                acco[it] = DN_MFMA(DN_FR(F_QD + it * 4 + 2 * dt + s), Sb[dt][s], acco[it]);
            } }
    bf16x8 vb[2][2];
#pragma unroll
    for (int it = 0; it < 2; ++it) {
        const f32x16 u = unpack16(fU_[it * 2 + 0], fU_[it * 2 + 1]);
        const f32x16 vn = u - accv[it];
        vb[it][0] = pack8(vn, 0); vb[it][1] = pack8(vn, 1);
    }
#pragma unroll
    for (int s = 0; s < 2; ++s) {
        acco[0] = DN_MFMA(DN_FR(F_QKT + 0 * 2 + s), vb[0][s], acco[0]);
        acco[1] = DN_MFMA(DN_FR(F_QKT + 1 * 2 + s), vb[0][s], acco[1]);
        acco[1] = DN_MFMA(DN_FR(F_QKT + 2 * 2 + s), vb[1][s], acco[1]);
    }
#pragma unroll
    for (int dt = 0; dt < 2; ++dt) {
        S[dt] = S[dt] * gl;
#pragma unroll
        for (int jt = 0; jt < 2; ++jt)
#pragma unroll
            for (int s = 0; s < 2; ++s) S[dt] = DN_MFMA(DN_FR(F_KD + (jt * 2 + dt) * 2 + s), vb[jt][s], S[dt]);
    }
    const int c = chunk_of(ci, ch.dir), t0 = 64 * c;
#pragma unroll
    for (int it = 0; it < 2; ++it)
#pragma unroll
        for (int rg = 0; rg < 16; ++rg) { const int i = 32 * it + crow(rg, hh); const int tok = ch.dir ? t0 + 63 - i : t0 + i;
            ch.Ob[(size_t)tok * 512 + ch.h * 64 + 32 * hv + r] = (bf16_t)f2bf(acco[it][rg]); }
#undef DN_FR
}

__device__ __forceinline__ void chain_unit(const Chain& ch, const float* wconv  , LAS unsigned char* lds, LAS float* wct, int wave) {
    const int lane = hw_lane(), wid = wave, tid = wave * 64 + lane;
    __syncthreads();
    constexpr int NG = (NCHUNK + GROUP - 1) / GROUP;
#define DN_BAR() do { asm volatile("s_waitcnt vmcnt(0) lgkmcnt(0)" ::: "memory"); __builtin_amdgcn_s_barrier(); asm volatile("" ::: "memory"); } while (0)
    if (wid >= 2) {
        for (int k = 0; k <= NG; ++k) {
            const int ci = k * GROUP + (wid - 2);
#ifndef NO_DNP
            if (k < NG && ci < NCHUNK) produce(ch, ci, lds + wid * WREG, wct, ch.ring + (size_t)((k & 1) * GROUP + (wid - 2)) * RING_SLOT, lane);
#endif
            DN_BAR();
        }
    } else {
        f32x16 S[2]; S[0] = f32x16{}; S[1] = f32x16{};
        for (int k = 0; k <= NG; ++k) {
#ifndef NO_DNC
            if (k >= 1) { const int g0 = (k - 1) * GROUP; const int n = (NCHUNK - g0 < GROUP) ? NCHUNK - g0 : GROUP;
                for (int j = 0; j < n; ++j) consume(ch, g0 + j, ch.ring + (size_t)(((k - 1) & 1) * GROUP + j) * RING_SLOT, S, wid, lane); }
#endif
            DN_BAR();
        }
    }
#undef DN_BAR
    __syncthreads();
}
#undef DN_MFMA
}
struct Params {
    const float* in[28];
    float* out; unsigned char* ws;
    int ph_lo, ph_hi; int use_bar; int pad;
};
enum { I_X = 0, I_C, I_CTX, I_CCTX, I_WMOD, I_BMOD, I_GN1, I_GN2, I_WIN, I_GQ, I_GK, I_WCONV, I_ALOG, I_DTB, I_GDN, I_LAMQK, I_GSUB, I_WBR, I_WOUT, I_WRT, I_BRT,
       I_WEG, I_WEU, I_WED, I_WSG, I_WSU, I_WSD, I_GFIN };
struct Frame {
    LAS unsigned char* lds; volatile LAS unsigned* MISC; gu32* ctl;
    int tid, lane, wave, G, gw, NGW;
    GAS unsigned char* ws;
};
__device__ __forceinline__ size_t hrow_off(int r, bool& isctx, int& b) { b = r / TT; const int t = r - b * TT; isctx = t < CTXL; return isctx ? (size_t)(b * CTXL + t) * DM : (size_t)(b * SEQ + (t - CTXL)) * DM; }

__device__ __forceinline__ void transpose_item(const float* W, int ldw, int k0, int n0, bf16_t* WT, int K, int dst_row0, LAS float* scr, int lane) {
    float tv[32];
#pragma unroll
    for (int i = 0; i < 32; ++i) { const int kk = 2 * i + (lane >> 5); tv[i] = W[(size_t)(k0 + kk) * ldw + n0 + (lane & 31)]; }
#pragma unroll
    for (int i = 0; i < 32; ++i) { const int kk = 2 * i + (lane >> 5); scr[kk * 33 + (lane & 31)] = tv[i]; }
    LDS_WAIT(); asm volatile("" ::: "memory");
    const int c = lane & 7;
#pragma unroll
    for (int j = 0; j < 4; ++j) { const int n = (lane >> 3) + 8 * j; const LAS float* s = scr + (8 * c) * 33 + n;
        v4u o; o.x = pk2(s[0 * 33], s[1 * 33]); o.y = pk2(s[2 * 33], s[3 * 33]); o.z = pk2(s[4 * 33], s[5 * 33]); o.w = pk2(s[6 * 33], s[7 * 33]);
        *(v4u*)(WT + (size_t)(dst_row0 + n) * K + k0 + 8 * c) = o; }
    LDS_WAIT(); asm volatile("" ::: "memory");
}
__device__ __forceinline__ void convert_small(Frame& F, const Params& P, int l) {
    LAS float* scr = (LAS float*)(F.lds + RING_OFF + F.wave * 16384);
    const float* win = P.in[I_WIN] + (size_t)l * DM * INW;
    const float* wbr = P.in[I_WBR] + (size_t)l * 3 * 512 * DM;
    const float* wo = P.in[I_WOUT] + (size_t)l * DM * DM;
    bf16_t* WB1 = (bf16_t*)(F.ws + WS_WB1); bf16_t* WB2 = (bf16_t*)(F.ws + WS_WB2); bf16_t* WBR = (bf16_t*)(F.ws + WS_WBR); bf16_t* WOT = (bf16_t*)(F.ws + WS_WOT);
    constexpr int I1 = 16 * (P1W / 32), I2 = 16 * (GW / 32), I3 = 3 * 8 * 32, I4 = 16 * 32;
    for (int it = F.gw; it < I1 + I2 + I3 + I4; it += F.NGW) {
        int r = it;
        if (r < I1) { const int nb = r % (P1W / 32), kb = r / (P1W / 32); transpose_item(win, INW, 64 * kb, 32 * nb, WB1, DM, 32 * nb, scr, F.lane); continue; } r -= I1;
        if (r < I2) { const int nb = r % (GW / 32), kb = r / (GW / 32); transpose_item(win, INW, 64 * kb, C_GATE + 32 * nb, WB2, DM, 32 * nb, scr, F.lane); continue; } r -= I2;
        if (r < I3) { const int br = r / 256, q = r % 256, nb = q % 32, kb = q / 32; transpose_item(wbr + (size_t)br * 512 * DM, DM, 64 * kb, 32 * nb, WBR + (size_t)br * DM * 512, 512, 32 * nb, scr, F.lane); continue; } r -= I3;
        { const int nb = r % 32, kb = r / 32; transpose_item(wo, DM, 64 * kb, 32 * nb, WOT, DM, 32 * nb, scr, F.lane); }
    }
}
__device__ __forceinline__ void convert_experts(Frame& F, const Params& P, int l) {
    LAS float* scr = (LAS float*)(F.lds + RING_OFF + F.wave * 16384);
    bf16_t* WGU = (bf16_t*)(F.ws + WS_B); bf16_t* WD = WGU + (size_t)NEXP1 * 512 * DM;
    for (int it = F.gw; it < NEXP1 * 384; it += F.NGW) {
        const int e = it / 384; int r = it % 384;
        const float* wg = (e < NEXP) ? P.in[I_WEG] + ((size_t)l * NEXP + e) * DM * FF : P.in[I_WSG] + (size_t)l * DM * FF;
        const float* wu = (e < NEXP) ? P.in[I_WEU] + ((size_t)l * NEXP + e) * DM * FF : P.in[I_WSU] + (size_t)l * DM * FF;
        const float* wd = (e < NEXP) ? P.in[I_WED] + ((size_t)l * NEXP + e) * FF * DM : P.in[I_WSD] + (size_t)l * FF * DM;
        if (r < 256) { const bool up = r >= 128; r &= 127; const int nb = r % 8, kb = r / 8; const int n0 = 32 * nb;
            transpose_item(up ? wu : wg, FF, 64 * kb, n0, WGU + (size_t)e * 512 * DM, DM, (n0 / 128) * 256 + (up ? 128 : 0) + (n0 % 128), scr, F.lane); }
        else { r -= 256; const int nb = r % 32, kb = r / 32; transpose_item(wd, DM, 64 * kb, 32 * nb, WD + (size_t)e * DM * FF, FF, 32 * nb, scr, F.lane); }
    }
}
__device__ __forceinline__ void compute_mod(Frame& F, const Params& P) {
    float* modv = (float*)(F.ws + WS_MODV);
    const int kq = F.lane >> 3, nn = F.lane & 7;
    for (int it = F.gw; it < NLAYER * (6144 / 8); it += F.NGW) {
        const int l = it / (6144 / 8), n = (it % (6144 / 8)) * 8 + nn;
        const float* w = P.in[I_WMOD] + (size_t)l * DM * 6144 + n;
        float a0 = 0.f, a1 = 0.f, a2 = 0.f;
#pragma unroll 16
        for (int i = 0; i < 128; ++i) { const int k = kq + 8 * i; const float wv = w[(size_t)k * 6144];
            a0 += siluf_(P.in[I_C][k]) * wv; a1 += siluf_(P.in[I_C][DM + k]) * wv; a2 += siluf_(P.in[I_CCTX][k]) * wv; }
#pragma unroll
        for (int o = 8; o < 64; o <<= 1) { a0 += __shfl_xor(a0, o); a1 += __shfl_xor(a1, o); a2 += __shfl_xor(a2, o); }
        if (kq == 0) { const float bm = P.in[I_BMOD][l * 6144 + n]; float* m = modv + (size_t)l * 3 * 6144 + n; m[0] = a0 + bm; m[6144] = a1 + bm; m[2 * 6144] = a2 + bm; }
    }
}
__device__ __forceinline__ void modnorm_store(const float (&x)[16], const float* g, const float* sc, const float* sh, bf16_t* orow, int lane) {
    float ss = 0.f;
#pragma unroll
    for (int i = 0; i < 16; ++i) ss += x[i] * x[i];
    const float rstd = rsqrtf(wave_sum(ss) * (1.f / DM) + EPS);
#pragma unroll
    for (int hf = 0; hf < 2; ++hf) { const int c0 = hf * 512 + lane * 8; float y[8];
#pragma unroll
        for (int j = 0; j < 8; ++j) y[j] = x[hf * 8 + j] * rstd * g[c0 + j] * (1.f + sc[c0 + j]) + sh[c0 + j];
        v4u w; w.x = cvt_pk_bf16(y[0], y[1]); w.y = cvt_pk_bf16(y[2], y[3]); w.z = cvt_pk_bf16(y[4], y[5]); w.w = cvt_pk_bf16(y[6], y[7]);
        *(v4u*)(orow + c0) = w; }
}
__device__ __forceinline__ void load_row16(const float* row, float (&x)[16], int lane) {
#pragma unroll
    for (int hf = 0; hf < 2; ++hf) { const f32x4 a = *(const f32x4*)(row + hf * 512 + lane * 8), b = *(const f32x4*)(row + hf * 512 + lane * 8 + 4);
        x[hf * 8 + 0] = a[0]; x[hf * 8 + 1] = a[1]; x[hf * 8 + 2] = a[2]; x[hf * 8 + 3] = a[3]; x[hf * 8 + 4] = b[0]; x[hf * 8 + 5] = b[1]; x[hf * 8 + 6] = b[2]; x[hf * 8 + 7] = b[3]; }
}
__device__ __forceinline__ void wave_rows(const Frame& F, int lo, int hi, int& rs, int& re) { const int n = hi - lo, q = n / F.NGW, rem = n - q * F.NGW; rs = lo + F.gw * q + (F.gw < rem ? F.gw : rem); re = rs + q + (F.gw < rem ? 1 : 0); }
__device__ __forceinline__ void phase_norm1(Frame& F, const Params& P) {
    const float* modv = (const float*)(F.ws + WS_MODV); bf16_t* U = (bf16_t*)(F.ws + WS_C);
    int rs, re; wave_rows(F, 0, MROWS, rs, re);
    for (int r = rs; r < re; r += 2) {
        const bool has1 = r + 1 < re; const int r1 = has1 ? r + 1 : r;
        bool ic0, ic1; int b0, b1; const size_t off0 = hrow_off(r, ic0, b0), off1 = hrow_off(r1, ic1, b1);
        float x0[16], x1[16]; load_row16((ic0 ? P.in[I_CTX] : P.in[I_X]) + off0, x0, F.lane); load_row16((ic1 ? P.in[I_CTX] : P.in[I_X]) + off1, x1, F.lane);
        { const float* mv = modv + (ic0 ? 2 : b0) * 6144; modnorm_store(x0, P.in[I_GN1], mv + 1 * DM, mv + 0 * DM, U + (size_t)r * DM, F.lane); }
        if (has1) { const float* mv = modv + (ic1 ? 2 : b1) * 6144; modnorm_store(x1, P.in[I_GN1], mv + 1 * DM, mv + 0 * DM, U + (size_t)r1 * DM, F.lane); } }
}
__device__ __forceinline__ void unpack8(const v4u w, float (&x)[8]) { x[0] = bflo(w.x); x[1] = bfhi(w.x); x[2] = bflo(w.y); x[3] = bfhi(w.y); x[4] = bflo(w.z); x[5] = bfhi(w.z); x[6] = bflo(w.w); x[7] = bfhi(w.w); }
__device__ __forceinline__ void load_row16_bf(const bf16_t* row, float (&x)[16], int lane) {
#pragma unroll
    for (int hf = 0; hf < 2; ++hf) { const v4u w = *(const v4u*)(row + hf * 512 + lane * 8); float t[8]; unpack8(w, t);
#pragma unroll
        for (int j = 0; j < 8; ++j) x[hf * 8 + j] = t[j]; }
}
__device__ __forceinline__ v4u pack8f(const float (&y)[8]) { v4u w; w.x = cvt_pk_bf16(y[0], y[1]); w.y = cvt_pk_bf16(y[2], y[3]); w.z = cvt_pk_bf16(y[4], y[5]); w.w = cvt_pk_bf16(y[6], y[7]); return w; }
__device__ __forceinline__ void phase_prep(Frame& F, const Params& P, int l, bool dry = false) {
    bf16_t* P1 = (bf16_t*)(F.ws + WS_A);
    const int lane = F.lane, c = lane & 3, i5 = lane & 31, hd = lane >> 2; const bool act = hd < 10;
    const float inv = exp2f(-(float)(i5 & 15) * (13.287712379549449f / 16.f));
    float gk[16];
#pragma unroll
    for (int e = 0; e < 8; ++e) { gk[e] = P.in[I_GK][l * 64 + 8 * c + e]; gk[8 + e] = P.in[I_GK][l * 64 + 32 + 8 * c + e]; }
    const int col = !act ? C_AK : (hd < 2 ? C_AK + hd * 64 : C_CK + (hd - 2) * 64); const bool nrm = hd < 2;
    float kmx[2] = {0.f, 0.f};
    auto body = [&](int r, const v4u w0, const v4u w1) {
        const int b = r / TT, t = r - b * TT; const bool lat = t >= CTXL;
        float cs = 1.f, sn = 0.f;
        if (lat) { const int s = t - CTXL; const float pos = (i5 < 16) ? (float)(s / GRIDW) : (float)(s % GRIDW); sincosf(pos * inv, &sn, &cs); }
        float cse[8], sne[8];
#pragma unroll
        for (int e = 0; e < 8; ++e) { cse[e] = __shfl(cs, 8 * c + e); sne[e] = __shfl(sn, 8 * c + e); }
        bf16_t* row = P1 + (size_t)r * P1W;
        float x0[8], x1[8]; unpack8(w0, x0); unpack8(w1, x1);
        if (nrm) { float ss = 0.f;
#pragma unroll
            for (int e = 0; e < 8; ++e) ss += x0[e] * x0[e] + x1[e] * x1[e];
            ss += __shfl_xor(ss, 1); ss += __shfl_xor(ss, 2);
            const float rstd = rsqrtf(ss * (1.f / 64.f) + EPS);
#pragma unroll
            for (int e = 0; e < 8; ++e) { x0[e] *= rstd * gk[e]; x1[e] *= rstd * gk[8 + e]; } }
        float y0[8], y1[8];
#pragma unroll
        for (int e = 0; e < 8; ++e) { y0[e] = x0[e] * cse[e] - x1[e] * sne[e]; y1[e] = x1[e] * cse[e] + x0[e] * sne[e]; }
        const v4u pk0 = pack8f(y0), pk1 = pack8f(y1);
        if (act && (!dry || y0[0] == 123456.f)) { *(v4u*)(row + col + 8 * c) = pk0; *(v4u*)(row + col + 32 + 8 * c) = pk1; }
        { float z0[8], z1[8]; unpack8(pk0, z0); unpack8(pk1, z1); float ks = 0.f;
#pragma unroll
          for (int e = 0; e < 8; ++e) ks += z0[e] * z0[e] + z1[e] * z1[e];
          ks += __shfl_xor(ks, 1); ks += __shfl_xor(ks, 2);
          if (b == 0) kmx[0] = fmaxf(kmx[0], ks); else kmx[1] = fmaxf(kmx[1], ks); }
    };
    int rs, re; wave_rows(F, 0, MROWS, rs, re);
    for (int r = rs; r < re; r += 4) {
        int rr[4]; v4u wa[4], wb[4];
#pragma unroll
        for (int q = 0; q < 4; ++q) { rr[q] = r + q; const int rq = rr[q] < re ? rr[q] : r; const bf16_t* row = P1 + (size_t)rq * P1W; wa[q] = *(const v4u*)(row + col + 8 * c); wb[q] = *(const v4u*)(row + col + 32 + 8 * c); }
#pragma unroll
        for (int q = 0; q < 4; ++q) if (rr[q] < re) body(rr[q], wa[q], wb[q]);
    }
    if (!dry && act && c == 0) { atomicMax((int*)(F.ctl + CW_KMAX + (l * 2 + 0) * 16 + hd), __float_as_int(kmx[0])); atomicMax((int*)(F.ctl + CW_KMAX + (l * 2 + 1) * 16 + hd), __float_as_int(kmx[1])); }
}
__device__ __forceinline__ void phase_dn_prep(Frame& F, const Params& P, int l) {
    bf16_t* P1 = (bf16_t*)(F.ws + WS_A); bf16_t* BR = (bf16_t*)(F.ws + WS_B);
    const float* wc = P.in[I_WCONV] + (size_t)l * 3 * 1536;
    const int lane = F.lane;
    float w0[2][8], w1[2][8], w2[2][8];
#pragma unroll
    for (int ps = 0; ps < 2; ++ps) { const int ch0 = (ps * 64 + lane) * 8;
#pragma unroll
        for (int e = 0; e < 8; ++e) { w0[ps][e] = wc[0 * 1536 + ch0 + e]; w1[ps][e] = wc[1 * 1536 + ch0 + e]; w2[ps][e] = wc[2 * 1536 + ch0 + e]; } }
    int rs, re; wave_rows(F, 0, MROWS, rs, re);
    for (int r0 = rs; r0 < re; r0 += 2) {
        int rr[2]; bool hm[2], hp[2]; v4u wc_[2][2], wm_[2][2], wp_[2][2];
#pragma unroll
        for (int q = 0; q < 2; ++q) { rr[q] = r0 + q; const int r = rr[q] < re ? rr[q] : r0;
            const int b = r / TT, t = r - b * TT; const int seg_lo = (t < CTXL) ? 0 : CTXL, seg_hi = (t < CTXL) ? CTXL : TT;
            hm[q] = (t - 1 >= seg_lo); hp[q] = (t + 1 < seg_hi);
            const bf16_t* rowc = P1 + (size_t)r * P1W + C_BQKV; const bf16_t* rowm = hm[q] ? rowc - P1W : rowc; const bf16_t* rowp = hp[q] ? rowc + P1W : rowc;
#pragma unroll
            for (int ps = 0; ps < 2; ++ps) { const int ch0 = (ps * 64 + lane) * 8; wc_[q][ps] = *(const v4u*)(rowc + ch0); wm_[q][ps] = *(const v4u*)(rowm + ch0); wp_[q][ps] = *(const v4u*)(rowp + ch0); } }
#pragma unroll
        for (int q = 0; q < 2; ++q) { if (rr[q] >= re) continue; const int r = rr[q]; const bool hasm = hm[q], hasp = hp[q];
#pragma unroll
        for (int ps = 0; ps < 2; ++ps) { const int ch0 = (ps * 64 + lane) * 8;
            float xc[8], xm[8], xp[8]; unpack8(wc_[q][ps], xc); unpack8(wm_[q][ps], xm); unpack8(wp_[q][ps], xp);
            float y[8]; float ss = 0.f;
#pragma unroll
            for (int e = 0; e < 8; ++e) { const float v = (hasm ? xm[e] * w0[ps][e] : 0.f) + xc[e] * w1[ps][e] + (hasp ? xp[e] * w2[ps][e] : 0.f); y[e] = siluf_(v); ss += y[e] * y[e]; }
            ss += __shfl_xor(ss, 1); ss += __shfl_xor(ss, 2); ss += __shfl_xor(ss, 4);
            const float sc = rsqrtf(ss + EPS) * (ps == 0 ? 0.125f : 1.f);
#pragma unroll
            for (int e = 0; e < 8; ++e) y[e] *= sc;
            *(v4u*)(BR + (size_t)r * 1536 + 512 + ch0) = pack8f(y); } }
    }
}
__device__ __forceinline__ void phase_dn_prep_v(Frame& F, const Params& P, int l) {
    bf16_t* P1 = (bf16_t*)(F.ws + WS_A);
    const float* wc = P.in[I_WCONV] + (size_t)l * 3 * 1536 + 1024;
    const int lane = F.lane; const int ch0 = lane * 8;
    float w0[8], w1[8], w2[8];
#pragma unroll
    for (int e = 0; e < 8; ++e) { w0[e] = wc[0 * 1536 + ch0 + e]; w1[e] = wc[1 * 1536 + ch0 + e]; w2[e] = wc[2 * 1536 + ch0 + e]; }
    int rs, re; wave_rows(F, 0, MROWS, rs, re);
    for (int r0 = rs; r0 < re; r0 += 4) {
        int rr[4]; bool hm[4], hp[4]; v4u wc_[4], wm_[4], wp_[4];
#pragma unroll
        for (int q = 0; q < 4; ++q) { rr[q] = r0 + q; const int r = rr[q] < re ? rr[q] : r0;
            const int b = r / TT, t = r - b * TT; const int seg_lo = (t < CTXL) ? 0 : CTXL, seg_hi = (t < CTXL) ? CTXL : TT;
            hm[q] = (t - 1 >= seg_lo); hp[q] = (t + 1 < seg_hi);
            const bf16_t* rowc = P1 + (size_t)r * P1W + C_BQKV + 1024; const bf16_t* rowm = hm[q] ? rowc - P1W : rowc; const bf16_t* rowp = hp[q] ? rowc + P1W : rowc;
            wc_[q] = *(const v4u*)(rowc + ch0); wm_[q] = *(const v4u*)(rowm + ch0); wp_[q] = *(const v4u*)(rowp + ch0); }
#pragma unroll
        for (int q = 0; q < 4; ++q) { if (rr[q] >= re) continue; const bool hasm = hm[q], hasp = hp[q];
            float xc[8], xm[8], xp[8]; unpack8(wc_[q], xc); unpack8(wm_[q], xm); unpack8(wp_[q], xp);
            float y[8];
#pragma unroll
            for (int e = 0; e < 8; ++e) { const float v = (hasm ? xm[e] * w0[e] : 0.f) + xc[e] * w1[e] + (hasp ? xp[e] * w2[e] : 0.f); y[e] = siluf_(v); }
            *(v4u*)(P1 + (size_t)rr[q] * P1W + C_BQKV + ch0) = pack8f(y); }
    }
}
__device__ __forceinline__ void phase_post(Frame& F, const Params& P, int l) {
    const bf16_t* P1 = (const bf16_t*)(F.ws + WS_A); bf16_t* BR = (bf16_t*)(F.ws + WS_B);
    const bf16_t* DO = (const bf16_t*)(F.ws + WS_D); const bf16_t* OFw = DO + (size_t)MROWS * 1024; const bf16_t* OBw = OFw + (size_t)MROWS * 512;
    const int lane = F.lane;
    const float linit = 0.8f - 0.6f * expf(-0.3f * (float)l);
    const float* lq = P.in[I_LAMQK] + l * 256;
    const float lam = expf(wave_sum(lq[lane] * lq[64 + lane])) - expf(wave_sum(lq[128 + lane] * lq[192 + lane])) + linit;
    float gdn[8], gsb[8];
#pragma unroll
    for (int e = 0; e < 8; ++e) { gdn[e] = P.in[I_GDN][l * 64 + (lane & 7) * 8 + e]; gsb[e] = P.in[I_GSUB][l * 128 + (lane & 15) * 8 + e] * (1.f - linit); }
    const int hq = lane >> 4, e0 = (lane & 15) * 8;
    int rs, re; wave_rows(F, 0, MROWS, rs, re);
    for (int r0 = rs; r0 < re; r0 += 2) {
        int rr[2]; v4u wf_[2], wb_[2], wz_[2], d0_[2], d1_[2];
#pragma unroll
        for (int q = 0; q < 2; ++q) { rr[q] = r0 + q; const int r = rr[q] < re ? rr[q] : r0;
            wf_[q] = *(const v4u*)(OFw + (size_t)r * 512 + lane * 8); wb_[q] = *(const v4u*)(OBw + (size_t)r * 512 + lane * 8); wz_[q] = *(const v4u*)(P1 + (size_t)r * P1W + C_BZ + lane * 8);
            d0_[q] = *(const v4u*)(DO + (size_t)r * 1024 + (2 * hq) * 128 + e0); d1_[q] = *(const v4u*)(DO + (size_t)r * 1024 + (2 * hq + 1) * 128 + e0); }
#pragma unroll
        for (int q = 0; q < 2; ++q) { if (rr[q] >= re) continue; const int r = rr[q];
        { float a[8], bq[8], z[8], y[8]; unpack8(wf_[q], a); unpack8(wb_[q], bq); unpack8(wz_[q], z); float ss = 0.f;
#pragma unroll
          for (int e = 0; e < 8; ++e) { a[e] += bq[e]; ss += a[e] * a[e]; }
          ss += __shfl_xor(ss, 1); ss += __shfl_xor(ss, 2); ss += __shfl_xor(ss, 4);
          const float rstd = rsqrtf(ss * (1.f / 64.f) + EPS);
#pragma unroll
          for (int e = 0; e < 8; ++e) y[e] = a[e] * rstd * gdn[e] * siluf_(z[e]);
          *(v4u*)(BR + (size_t)r * 1536 + 512 + lane * 8) = pack8f(y); }
        { float a[8], bq[8], y[8]; unpack8(d0_[q], a); unpack8(d1_[q], bq); float ss = 0.f;
#pragma unroll
          for (int e = 0; e < 8; ++e) { a[e] -= lam * bq[e]; ss += a[e] * a[e]; }
          ss += __shfl_xor(ss, 1); ss += __shfl_xor(ss, 2); ss += __shfl_xor(ss, 4); ss += __shfl_xor(ss, 8);
          const float rstd = rsqrtf(ss * (1.f / 128.f) + EPS);
#pragma unroll
          for (int e = 0; e < 8; ++e) y[e] = a[e] * rstd * gsb[e];
          *(v4u*)(BR + (size_t)r * 1536 + 1024 + lane * 8) = pack8f(y); } }
    }
}
__device__ __forceinline__ void phase_norm2_router(Frame& F, const Params& P, int l, bool dry = false) {
    const float* modv = (const float*)(F.ws + WS_MODV) + (size_t)l * 3 * 6144; bf16_t* U = (bf16_t*)(F.ws + WS_C);
    const bf16_t* hlat = (const bf16_t*)(F.ws + WS_HB); const float* hctx = (const float*)(F.ws + WS_HCTX);
    int* tope = (int*)(F.ws + WS_TOPE); float* topw = (float*)(F.ws + WS_TOPW); int* tops = (int*)(F.ws + WS_TOPS);
    constexpr int VSP = DM + 4;
    LAS float* vS = (LAS float*)(F.lds + RING_OFF);
    const float* wr = P.in[I_WRT] + (size_t)l * DM * NEXP; const float brt = P.in[I_BRT][l * NEXP + F.lane];
    const float* g2 = P.in[I_GN2] + l * DM;
    const int lane = F.lane;
    for (int base = blockIdx.x * 32; base < MROWS; base += F.G * 32) {
        const int r0 = base + 4 * F.wave;
        __syncthreads();
        float xq[4][16];
#pragma unroll
        for (int q = 0; q < 4; ++q) { bool isctx_; int b_; const size_t off_ = hrow_off(r0 + q, isctx_, b_); if (isctx_) load_row16(hctx + off_, xq[q], lane); else load_row16_bf(hlat + off_, xq[q], lane); }
#pragma unroll
        for (int q = 0; q < 4; ++q) { const int r = r0 + q; bool isctx; int b; const size_t off = hrow_off(r, isctx, b); (void)off;
            float (&x)[16] = xq[q];
            const float* mv = modv + (isctx ? 2 : b) * 6144; const float* sc = mv + 4 * DM; const float* sh = mv + 3 * DM;
            float ss = 0.f;
#pragma unroll
            for (int i = 0; i < 16; ++i) ss += x[i] * x[i];
            const float rstd = rsqrtf(wave_sum(ss) * (1.f / DM) + EPS);
#pragma unroll
            for (int hf = 0; hf < 2; ++hf) { const int c0 = hf * 512 + lane * 8; float y[8];
#pragma unroll
                for (int j = 0; j < 8; ++j) y[j] = x[hf * 8 + j] * rstd * g2[c0 + j] * (1.f + sc[c0 + j]) + sh[c0 + j];
                { LAS float* vp = vS + (4 * F.wave + q) * VSP + c0; *(LAS f32x4*)vp = (f32x4){y[0], y[1], y[2], y[3]}; *(LAS f32x4*)(vp + 4) = (f32x4){y[4], y[5], y[6], y[7]}; }
                v4u w; w.x = cvt_pk_bf16(y[0], y[1]); w.y = cvt_pk_bf16(y[2], y[3]); w.z = cvt_pk_bf16(y[4], y[5]); w.w = cvt_pk_bf16(y[6], y[7]);
                *(v4u*)(U + (size_t)r * DM + c0) = w; } }
        __syncthreads();
        f32x4 lacc0 = {0.f, 0.f, 0.f, 0.f}, lacc1 = {0.f, 0.f, 0.f, 0.f};
        { const int i16 = lane & 15, kk = lane >> 4, rt = F.wave >> 2, ct = F.wave & 3;
          const LAS float* ap = vS + (16 * rt + i16) * VSP + 256 * kk; const float* bp = wr + (size_t)(256 * kk) * NEXP + 16 * ct + i16;
#pragma unroll 8
          for (int s4 = 0; s4 < 64; ++s4) { const f32x4 av = *(const LAS f32x4*)(ap + 4 * s4);
              const float b0 = bp[(size_t)(4 * s4 + 0) * NEXP], b1 = bp[(size_t)(4 * s4 + 1) * NEXP], b2 = bp[(size_t)(4 * s4 + 2) * NEXP], b3 = bp[(size_t)(4 * s4 + 3) * NEXP];
              lacc0 = __builtin_amdgcn_mfma_f32_16x16x4f32(av[0], b0, lacc0, 0, 0, 0); lacc1 = __builtin_amdgcn_mfma_f32_16x16x4f32(av[1], b1, lacc1, 0, 0, 0);
              lacc0 = __builtin_amdgcn_mfma_f32_16x16x4f32(av[2], b2, lacc0, 0, 0, 0); lacc1 = __builtin_amdgcn_mfma_f32_16x16x4f32(av[3], b3, lacc1, 0, 0, 0); }
          lacc0 = lacc0 + lacc1; }
        __syncthreads();
        { const int j16 = lane & 15, rq = lane >> 4, rt = F.wave >> 2, ct = F.wave & 3;
#pragma unroll
          for (int g = 0; g < 4; ++g) vS[(16 * rt + 4 * rq + g) * NEXP + 16 * ct + j16] = lacc0[g]; }
        __syncthreads();
        const float a0 = vS[(4 * F.wave + 0) * NEXP + lane], a1 = vS[(4 * F.wave + 1) * NEXP + lane], a2 = vS[(4 * F.wave + 2) * NEXP + lane], a3 = vS[(4 * F.wave + 3) * NEXP + lane];
        LDS_WAIT();
#pragma unroll 1
        for (int q = 0; q < 4; ++q) { const int r = r0 + q; const float lg = q == 0 ? a0 : (q == 1 ? a1 : (q == 2 ? a2 : a3));
            const float sc = 1.f / (1.f + expf(-lg)); const float sel = sc + brt;
            float m1 = sel;
#pragma unroll
            for (int o = 1; o < 8; o <<= 1) m1 = fmaxf(m1, __shfl_xor(m1, o));
            int fi = (sel == m1) ? lane : 999;
#pragma unroll
            for (int o = 1; o < 8; o <<= 1) fi = min(fi, __shfl_xor(fi, o));
            float m2 = (lane == fi) ? -INFINITY : sel;
#pragma unroll
            for (int o = 1; o < 8; o <<= 1) m2 = fmaxf(m2, __shfl_xor(m2, o));
            const float gs = m1 + m2; const int g = lane >> 3;
            int grank = 0;
#pragma unroll
            for (int gg = 0; gg < 8; ++gg) { const float o = __builtin_bit_cast(float, __builtin_amdgcn_readlane(__builtin_bit_cast(int, gs), gg * 8)); grank += (o > gs || (o == gs && gg < g)) ? 1 : 0; }
            const float val = (grank < 4) ? sel : -INFINITY;
            int rank = 0;
#pragma unroll 4
            for (int e = 0; e < 64; ++e) { const float o = __builtin_bit_cast(float, __builtin_amdgcn_readlane(__builtin_bit_cast(int, val), e)); rank += (o > val || (o == val && e < lane)) ? 1 : 0; }
            const bool selx = (grank < 4) && (rank < TOPK);
            const float wsum = wave_sum(selx ? sc : 0.f);
            const int half = r / TT;
            if (selx && (!dry || wsum == 123456.f)) { const int slot = atomicAdd((int*)(F.ctl + CW_ECNT + ((l * 2 + half) * NEXP1 + lane) * 16), 1);
                tope[(size_t)r * 8 + rank] = lane; topw[(size_t)r * 8 + rank] = sc / (wsum + 1e-20f) * 2.5f; tops[(size_t)r * 8 + rank] = slot; }
            if (lane == 0 && !dry) { tope[(size_t)r * 8 + 6] = NEXP; topw[(size_t)r * 8 + 6] = 1.f; tops[(size_t)r * 8 + 6] = r - half * TT; }
        }
    }
}
__device__ __forceinline__ void moe_table(Frame& F, int l, int half, LAS int* ts, LAS int* te) {
    LAS int* cn = (LAS int*)(F.lds + MISC_OFF + 5696);
    __syncthreads();
    if (F.tid < NEXP1) cn[F.tid] = (F.tid < NEXP) ? (int)__hip_atomic_load(F.ctl + CW_ECNT + ((l * 2 + half) * NEXP1 + F.tid) * 16, RLX_AGENT) : TT;
    __syncthreads();
    if (F.tid == 0) { int acc = 0;
        for (int e = 0; e < NEXP1; ++e) { ts[e] = acc; acc += (cn[e] + 255) / 256; }
        ts[NEXP1] = acc; }
    __syncthreads();
    const int total = ts[NEXP1];
    for (int t = F.tid; t < total; t += NTHREADS) { int e = 0;
        for (int k = 1; k < NEXP1; ++k) e += (ts[k] <= t) ? 1 : 0;
        te[t] = e; }
    __syncthreads();
}
__device__ __forceinline__ void phase_scatter(Frame& F, int l, bool dry = false) {
    LAS int* ts = (LAS int*)(F.lds + MISC_OFF + 256); LAS int* te = (LAS int*)(F.lds + MISC_OFF + 3584);
    const int* tope = (const int*)(F.ws + WS_TOPE); const float* topw = (const float*)(F.ws + WS_TOPW); int* tops = (int*)(F.ws + WS_TOPS);
    for (int half = 0; half < 2; ++half) {
        moe_table(F, l, half, ts, te);
        int* rtok = (int*)(F.ws + WS_RTOK) + (size_t)half * HROWS_PAD; float* rw = (float*)(F.ws + WS_RW) + (size_t)half * HROWS_PAD;
        for (int r = half * TT + F.gw; r < (half + 1) * TT; r += F.NGW) {
            if (F.lane < 7) { const int e = tope[(size_t)r * 8 + F.lane]; const int pos = ts[e] * 256 + tops[(size_t)r * 8 + F.lane];
                if (!dry || pos == -12345) { rtok[pos] = r; rw[pos] = topw[(size_t)r * 8 + F.lane]; tops[(size_t)r * 8 + F.lane] = pos; } } }
        for (int it = blockIdx.x * NTHREADS + F.tid; it < NEXP1 * 256; it += F.G * NTHREADS) { const int e = it >> 8, j = it & 255;
            const int cnt = ((const LAS int*)(F.lds + MISC_OFF + 5696))[e];
            const int rem = cnt & 255; if (rem != 0 && j >= rem) { const int pos = (ts[e] + (cnt >> 8)) * 256 + j; rtok[pos] = half * TT; rw[pos] = 0.f; } }
    }
}
__device__ __forceinline__ void phase_combine(Frame& F, const Params& P, int l, int half, bool dry = false) {
    const float* modv = (const float*)(F.ws + WS_MODV) + (size_t)l * 3 * 6144; const float* modn = (const float*)(F.ws + WS_MODV) + (size_t)(l + 1) * 3 * 6144;
    const bf16_t* hb = (const bf16_t*)(F.ws + WS_HB); bf16_t* hn = (bf16_t*)P.out; float* hlat = P.out; float* hctx = (float*)(F.ws + WS_HCTX); bf16_t* U = (bf16_t*)(F.ws + WS_C);
    const unsigned char* Y = (const unsigned char*)(F.ws + WS_A); const int* tops = (const int*)(F.ws + WS_TOPS);
    const int lane = F.lane; const int cb = (lane >> 4) * 256 + (lane & 15) * 8;
    int rs, re; wave_rows(F, half * TT, (half + 1) * TT, rs, re);
    for (int r = rs; r < re; ++r) {
        bool isctx; int b; const size_t off = hrow_off(r, isctx, b);
        float* row = (isctx ? hctx : hlat) + off; float x[16];
        if (isctx) {
#pragma unroll
            for (int hf = 0; hf < 2; ++hf) { const f32x4 a = *(const f32x4*)(row + cb + hf * 128), b4 = *(const f32x4*)(row + cb + hf * 128 + 4);
                x[hf * 8 + 0] = a[0]; x[hf * 8 + 1] = a[1]; x[hf * 8 + 2] = a[2]; x[hf * 8 + 3] = a[3]; x[hf * 8 + 4] = b4[0]; x[hf * 8 + 5] = b4[1]; x[hf * 8 + 6] = b4[2]; x[hf * 8 + 7] = b4[3]; }
        } else {
#pragma unroll
            for (int hf = 0; hf < 2; ++hf) { const v4u w = *(const v4u*)(hb + off + cb + hf * 128); float t[8]; unpack8(w, t);
#pragma unroll
                for (int j = 0; j < 8; ++j) x[hf * 8 + j] = t[j]; }
        }
        float y[16];
#pragma unroll
        for (int i = 0; i < 16; ++i) y[i] = 0.f;
        v4u yw[7];
#pragma unroll
        for (int k = 0; k < 7; ++k) { const int pos = tops[(size_t)r * 8 + k]; yw[k] = *(const v4u*)(Y + (size_t)pos * DM + lane * 16); }
#pragma unroll
        for (int k = 0; k < 7; ++k)
#pragma unroll
            for (int q = 0; q < 4; ++q) { const int wq = (int)yw[k][q]; const f32x2 lo = __builtin_amdgcn_cvt_pk_f32_fp8(wq, false), hi = __builtin_amdgcn_cvt_pk_f32_fp8(wq, true);
                y[q * 4 + 0] += lo[0]; y[q * 4 + 1] += lo[1]; y[q * 4 + 2] += hi[0]; y[q * 4 + 3] += hi[1]; }
        const float* gt2 = modv + (isctx ? 2 : b) * 6144 + 5 * DM;
#pragma unroll
        for (int hf = 0; hf < 2; ++hf)
#pragma unroll
            for (int j = 0; j < 8; ++j) x[hf * 8 + j] += gt2[cb + hf * 128 + j] * (y[hf * 8 + j] * pg8::YUNSCALE);
        if (dry) { float sy = 0.f;
#pragma unroll
            for (int i = 0; i < 16; ++i) sy += x[i];
            if (sy == 123456.f) row[0] = sy; continue; }
        if (l + 1 < NLAYER) {
#pragma unroll
            for (int hf = 0; hf < 2; ++hf) {
                if (isctx) { *(f32x4*)(row + cb + hf * 128) = (f32x4){x[hf * 8 + 0], x[hf * 8 + 1], x[hf * 8 + 2], x[hf * 8 + 3]}; *(f32x4*)(row + cb + hf * 128 + 4) = (f32x4){x[hf * 8 + 4], x[hf * 8 + 5], x[hf * 8 + 6], x[hf * 8 + 7]}; }
                else { v4u w; w.x = cvt_pk_bf16(x[hf * 8 + 0], x[hf * 8 + 1]); w.y = cvt_pk_bf16(x[hf * 8 + 2], x[hf * 8 + 3]); w.z = cvt_pk_bf16(x[hf * 8 + 4], x[hf * 8 + 5]); w.w = cvt_pk_bf16(x[hf * 8 + 6], x[hf * 8 + 7]); *(v4u*)(hn + off + cb + hf * 128) = w; } }
            const float* mv = modn + (isctx ? 2 : b) * 6144; const float* g = P.in[I_GN1] + (l + 1) * DM; const float* sc = mv + 1 * DM; const float* sh = mv + 0 * DM;
            float ss = 0.f;
#pragma unroll
            for (int i = 0; i < 16; ++i) ss += x[i] * x[i];
            const float rstd = rsqrtf(wave_sum(ss) * (1.f / DM) + EPS);
#pragma unroll
            for (int hf = 0; hf < 2; ++hf) { const int c0 = cb + hf * 128; float yv[8];
#pragma unroll
                for (int j = 0; j < 8; ++j) yv[j] = x[hf * 8 + j] * rstd * g[c0 + j] * (1.f + sc[c0 + j]) + sh[c0 + j];
                v4u w; w.x = cvt_pk_bf16(yv[0], yv[1]); w.y = cvt_pk_bf16(yv[2], yv[3]); w.z = cvt_pk_bf16(yv[4], yv[5]); w.w = cvt_pk_bf16(yv[6], yv[7]);
                *(v4u*)(U + (size_t)r * DM + c0) = w; }
        } else if (!isctx) {
            float ss = 0.f;
#pragma unroll
            for (int i = 0; i < 16; ++i) ss += x[i] * x[i];
            const float rstd = rsqrtf(wave_sum(ss) * (1.f / DM) + EPS); const float* gf = P.in[I_GFIN];
#pragma unroll
            for (int hf = 0; hf < 2; ++hf) { const int c0 = cb + hf * 128;
                *(f32x4*)(row + c0) = (f32x4){x[hf * 8 + 0] * rstd * gf[c0 + 0], x[hf * 8 + 1] * rstd * gf[c0 + 1], x[hf * 8 + 2] * rstd * gf[c0 + 2], x[hf * 8 + 3] * rstd * gf[c0 + 3]};
                *(f32x4*)(row + c0 + 4) = (f32x4){x[hf * 8 + 4] * rstd * gf[c0 + 4], x[hf * 8 + 5] * rstd * gf[c0 + 5], x[hf * 8 + 6] * rstd * gf[c0 + 6], x[hf * 8 + 7] * rstd * gf[c0 + 7]}; }
        }
    }
}
#if defined(MK_DEBUG)
__global__ void chk_bf16(const bf16_t* buf, long rows, int cols, int pitch, unsigned* word, unsigned bit) {
    bool bad = false;
    for (long i = blockIdx.x * (long)blockDim.x + threadIdx.x; i < rows * cols; i += (long)gridDim.x * blockDim.x) { const long r = i / cols; const int c = (int)(i % cols);
        const unsigned short v = buf[r * pitch + c]; if ((v & 0x7f80u) == 0x7f80u) bad = true; }
    if (bad) atomicOr(word, bit);
}
__global__ void chk_f32(const float* buf, long n, unsigned* word, unsigned bit) {
    bool bad = false;
    for (long i = blockIdx.x * (long)blockDim.x + threadIdx.x; i < n; i += (long)gridDim.x * blockDim.x) { const unsigned v = __float_as_uint(buf[i]); if ((v & 0x7f800000u) == 0x7f800000u) bad = true; }
    if (bad) atomicOr(word, bit);
}
__global__ void dbg_fill(float* out, long n, const unsigned* word) {
    const float a = 1.0f + (float)(*word);
    for (long i = blockIdx.x * (long)blockDim.x + threadIdx.x; i < n; i += (long)gridDim.x * blockDim.x) out[i] = a;
}
#endif
constexpr int NU_DN = 32, NU_GQA = 1024, NU_DIFF = 1024, NU_GQAC = 16, NU_DIFFC = 16, NU_TOTAL = NU_DN + NU_GQA + NU_DIFF + NU_GQAC + NU_DIFFC, NU_XCD = NU_TOTAL / 8;
static_assert(NU_XCD == 264, "per-XCD unit lists");
__device__ __forceinline__ void phase_mix(Frame& F, const Params& P, int l, int qoff = 0) {
    bf16_t* P1 = (bf16_t*)(F.ws + WS_A); bf16_t* BR = (bf16_t*)(F.ws + WS_B); bf16_t* DO = (bf16_t*)(F.ws + WS_D);
    bf16_t* OFw = DO + (size_t)MROWS * 1024; bf16_t* OBw = OFw + (size_t)MROWS * 512;
    const int xcd0 = (int)xb_xcc_id() & 7;
    int qsel = 0;
    for (;;) {
        int u = -1; int x = 0;
        for (;;) {
            if (qsel >= 8) break;
            x = (xcd0 + qsel) & 7;
            __syncthreads();
            if (F.tid == 0) F.MISC[16] = __hip_atomic_fetch_add(F.ctl + CW_QUEUE + 64 * (l * 8 + x + qoff), 1u, RLX_AGENT);
            __syncthreads();
            const int li = __builtin_amdgcn_readfirstlane((int)F.MISC[16]);
            if (li < NU_XCD) { u = li; break; }
            ++qsel;
        }
        if (u < 0) break;
#if defined(MK_PROBE_DNLAST)
        const int li = (u + 4) % NU_XCD;
#else
        const int li = u;
#endif
        if (li < 4) {
            const int cu = x + 8 * li;
            dn::Chain ch; const int b = cu >> 4, h = (cu >> 1) & 7, dir = cu & 1;
            ch.P1b = P1 + (size_t)b * TT * P1W; ch.QKb = BR + (size_t)b * TT * 1536 + 512; ch.Ob = (dir ? OBw : OFw) + (size_t)b * TT * 512; ch.h = h; ch.dir = dir;
            ch.Aexp = expf(P.in[I_ALOG][l * 16 + dir * 8 + h]); ch.dtb = P.in[I_DTB][l * 16 + dir * 8 + h];
            ch.ring = (unsigned char*)(F.ws + WS_RING + (size_t)cu * 12 * RING_SLOT); ch.dbg = (unsigned*)(F.ws + WS_CTL) + 64;
            dn::chain_unit(ch, P.in[I_WCONV] + (size_t)l * 3 * 1536, F.lds + RING_OFF, (LAS float*)(F.lds + MISC_OFF + 1024), F.wave);
            continue;
        }
        int b, qrow, nt, qcol, kcol, vcol, ocol, op; bf16_t* obase; bool wide; int kidx;
        if (li < 4 + 128) { const int j = li - 4, gidx = 2 * x + (j >> 6), qb = j & 63; b = gidx >> 3; const int hc = gidx & 7; wide = true; kidx = 2 + hc;
            qrow = CTXL + qb * 256; nt = TT / 64; qcol = C_CQ + hc * 64; kcol = C_CK + hc * 64; vcol = C_CV + (hc >> 1) * 128; obase = DO; op = 1024; ocol = hc * 128; }
        else if (li < 4 + 128 + 128) { const int j = li - 132, grp = x >> 1; b = grp >> 1; const int kvh = grp & 1, hq = 2 * (x & 1) + (j >> 6), qb = j & 63, h = kvh * 4 + hq; wide = false; kidx = kvh;
            qrow = CTXL + qb * 256; nt = TT / 64; qcol = C_AQ + h * 64; kcol = C_AK + kvh * 64; vcol = C_AV + kvh * 64; obase = BR; op = 1536; ocol = h * 64; }
        else { const int ci = x * 4 + (li - 260);
            if (ci < 16) { b = ci >> 3; const int h = ci & 7, kvh = h >> 2; wide = false; kidx = kvh;
                qrow = 0; nt = CTXL / 64; qcol = C_AQ + h * 64; kcol = C_AK + kvh * 64; vcol = C_AV + kvh * 64; obase = BR; op = 1536; ocol = h * 64; }
            else { const int idx = ci - 16; b = idx >> 3; const int hc = idx & 7; wide = true; kidx = 2 + hc;
                qrow = 0; nt = CTXL / 64; qcol = C_CQ + hc * 64; kcol = C_CK + hc * 64; vcol = C_CV + (hc >> 1) * 128; obase = DO; op = 1024; ocol = hc * 128; } }
        const bf16_t* pb = P1 + (size_t)b * TT * P1W;
        const float kmaxv = sqrtf(__int_as_float((int)__hip_atomic_load(F.ctl + CW_KMAX + (l * 2 + b) * 16 + kidx, RLX_AGENT)));
        if (wide) attn_body::attn_unit128_br<8>((const attn_body::bf16*)(pb + (size_t)qrow * P1W + qcol), P1W, (const attn_body::bf16*)(pb + kcol), P1W, (const attn_body::bf16*)(pb + vcol), P1W,
                                (attn_body::bf16*)(obase + ((size_t)b * TT + qrow) * op + ocol), op, nt, (char*)F.lds + RING_OFF, F.wave, kmaxv, qrow == 0 ? -1 : qrow - CTXL, wide ? (const float*)nullptr : P.in[I_GQ] + l * 64);
        else attn_body::attn_unit_br<8>((const attn_body::bf16*)(pb + (size_t)qrow * P1W + qcol), P1W, (const attn_body::bf16*)(pb + kcol), P1W, (const attn_body::bf16*)(pb + vcol), P1W,
                                (attn_body::bf16*)(obase + ((size_t)b * TT + qrow) * op + ocol), op, nt, (char*)F.lds + RING_OFF, F.wave, kmaxv, qrow == 0 ? -1 : qrow - CTXL, wide ? (const float*)nullptr : P.in[I_GQ] + l * 64);
    }
}

#ifndef MK_PHMASK
#define MK_PHMASK 0xFFFFF
#endif
#define PHEN(k) (((MK_PHMASK) >> (k)) & 1)
#if defined(MK_PROBE_BAR2)
#define MK_BAR2() do { for (int rb_ = 0; rb_ < MK_PROBE_BAR2; ++rb_) { F.lane = hw_lane(); xcd_barrier(bar, F.wave == 0 && F.lane == 0); } } while (0)
#else
#define MK_BAR2() do { } while (0)
#endif
#if defined(MK_PROBE_GEMM2)
#define GREP for (int rep_ = 0; rep_ < ((MK_PROBE_GEMM2 & 1) ? 2 : 1); ++rep_)
#define GREPE for (int rep_ = 0; rep_ < ((MK_PROBE_GEMM2 & 2) ? 2 : 1); ++rep_)
#define GREPE2 for (int rep_ = 0; rep_ < ((MK_PROBE_GEMM2 & 4) ? 2 : 1); ++rep_)
#else
#define GREP
#define GREPE
#define GREPE2
#endif
#if defined(MK_PROBE_EW2)
#define EREP for (int rep_ = 0; rep_ < 2; ++rep_)
#else
#define EREP
#endif
constexpr int NPH_LAYER = 15, NPHASES = 2 + NLAYER * NPH_LAYER;
#if MK_DEBUG == 5
#define MK_STAMP(k) do { if (blockIdx.x == 0 && F.tid == 0) { ((unsigned long long*)(P.ws + WS_CTL + 512))[(k) + 1] = __builtin_amdgcn_s_memrealtime(); ((unsigned long long*)(P.ws + WS_CTL + 1024))[(k) + 1] = __builtin_amdgcn_s_memtime(); } } while (0)
#else
#define MK_STAMP(k) do { } while (0)
#endif
#define IN(k) (lo <= (k) && (k) < hi)
#define SEAM(k) do { if (IN(k) && IN((k) + 1)) { F.lane = hw_lane(); xcd_barrier(bar, F.wave == 0 && F.lane == 0); MK_BAR2(); } F.lane = hw_lane(); F.tid = F.wave * 64 + F.lane; MK_STAMP(k); { GAS unsigned char* w_ = (GAS unsigned char*)P.ws; asm volatile("" : "+s"(w_)); F.ws = w_; F.ctl = (gu32*)(w_ + WS_CTL); } } while (0)
#define SEAM_NB(k) do { F.lane = hw_lane(); F.tid = F.wave * 64 + F.lane; MK_STAMP(k); { GAS unsigned char* w_ = (GAS unsigned char*)P.ws; asm volatile("" : "+s"(w_)); F.ws = w_; F.ctl = (gu32*)(w_ + WS_CTL); } } while (0)
#define U ((bf16_t*)(F.ws + WS_C))
#define RA ((bf16_t*)(F.ws + WS_A))
#define BR ((bf16_t*)(F.ws + WS_B))
#define G2 RA
#define Mm (RA + (size_t)MROWS * GW)
#define Hs ((bf16_t*)(F.ws + WS_D))
#define Yb RA
#define WGU ((bf16_t*)(F.ws + WS_B))
#define WD (WGU + (size_t)NEXP1 * 512 * DM)
template <int l, int half> __device__ __forceinline__ void moe_half(Frame& F, const Params& P, const XcdBarrier& bar, int lo, int hi) {
    constexpr int pb = 2 + NPH_LAYER * l;
    LAS int* const ts = (LAS int*)(F.lds + MISC_OFF + 256); LAS int* const te = (LAS int*)(F.lds + MISC_OFF + 3584);
    constexpr int hb = pb + 9 + 3 * half;
            if (PHEN(9) && IN(hb + 0)) {
                moe_table(F, l, half, ts, te);
                pg8::Gemm g{U, WGU, DM, DM, DM, (const int*)(F.ws + WS_RTOK) + (size_t)half * HROWS_PAD}; pg8::MoeOrder S{ts, te, 2, F.G, (int)blockIdx.x};
                pg8::EpiMoe1 E{Hs, (const float*)(F.ws + WS_RW) + (size_t)half * HROWS_PAD};
                GREPE pg8::gemm_phase<pg8::EpiMoe1, pg8::MoeOrder, true>(F.lds + RING_OFF, g, S, E, F.wave);
            } SEAM(hb + 0);
            if (PHEN(10) && IN(hb + 1)) {
                moe_table(F, l, half, ts, te);
                pg8::Gemm g{Hs, WD, FF, FF, FF, nullptr}; pg8::MoeOrder S{ts, te, 4, F.G, (int)blockIdx.x};
                pg8::EpiFp8 E{(unsigned char*)(F.ws + WS_A)};
                GREPE2 pg8::gemm_phase<pg8::EpiFp8, pg8::MoeOrder, false>(F.lds + RING_OFF, g, S, E, F.wave);
            } SEAM(hb + 1);
            if (PHEN(11) && IN(hb + 2)) {
#if defined(MK_PROBE_DRY)
                if (MK_PROBE_DRY & 8) phase_combine(F, P, l, half, true);
#endif
                phase_combine(F, P, l, half); if (half == 1 && l + 1 < NLAYER) { __syncthreads(); convert_small(F, P, l + 1); } }
            if (half == 0) { SEAM_NB(hb + 2); } else { SEAM(hb + 2); }
}
template <int l> __device__ __forceinline__ void layer_phases(Frame& F, const Params& P, const XcdBarrier& bar, int lo, int hi) {
    constexpr int pb = 2 + NPH_LAYER * l;
        if (PHEN(0) && IN(pb + 0)) {
            pg8::Gemm g{U, (const bf16_t*)(F.ws + WS_WB1), DM, DM, DM, nullptr}; pg8::DenseOrder S; S.init(MROWS / 256, P1W / 256, F.G, (int)blockIdx.x);
            pg8::EpiBf16<0> E{RA, P1W};
            GREP pg8::gemm_phase<pg8::EpiBf16<0>, pg8::DenseOrder, false>(F.lds + RING_OFF, g, S, E, F.wave);
        } SEAM(pb + 0);
        if (PHEN(1) && IN(pb + 1)) { phase_prep(F, P, l); phase_dn_prep(F, P, l);
            { F.lane = hw_lane(); xcd_barrier(bar, F.wave == 0 && F.lane == 0); F.lane = hw_lane(); F.tid = F.wave * 64 + F.lane; phase_dn_prep_v(F, P, l); }
#if defined(MK_PROBE_DRY)
            if (MK_PROBE_DRY & 1) phase_prep(F, P, l, true);
#endif
        } SEAM(pb + 1);
        if (PHEN(2) && IN(pb + 2)) { phase_mix(F, P, l);
#if defined(MK_PROBE_MIX2)
            { F.lane = hw_lane(); xcd_barrier(bar, F.wave == 0 && F.lane == 0); F.lane = hw_lane(); F.tid = F.wave * 64 + F.lane; phase_mix(F, P, l, 16); }
#endif
        } SEAM(pb + 2);
        if (PHEN(3) && IN(pb + 3)) { EREP phase_post(F, P, l); } SEAM(pb + 3);
        if (PHEN(4) && IN(pb + 4)) {
            pg8::Gemm g{U, (const bf16_t*)(F.ws + WS_WB2), DM, DM, DM, nullptr}; pg8::DenseOrder S; S.init(MROWS / 256, GW / 256, F.G, (int)blockIdx.x, l + 1 == NLAYER);
            pg8::EpiGate8 E{(unsigned char*)(F.ws + WS_A)};
            GREP pg8::gemm_phase<pg8::EpiGate8, pg8::DenseOrder, false>(F.lds + RING_OFF, g, S, E, F.wave);
        } SEAM(pb + 4);
        if (PHEN(5) && IN(pb + 5)) {
            pg8::Gemm g{BR, (const bf16_t*)(F.ws + WS_WBR), 1536, 512, 512, nullptr, 1024}; pg8::MergeOrder S; S.D.init(MROWS / 256, DM / 256, F.G, (int)blockIdx.x, l + 1 == NLAYER);
            pg8::EpiMerge E{Mm, (const unsigned char*)(F.ws + WS_A)};
            pg8::gemm_phase<pg8::EpiMerge, pg8::MergeOrder, false>(F.lds + RING_OFF, g, S, E, F.wave);
        } SEAM(pb + 5);
        if (PHEN(6) && IN(pb + 6)) {
            pg8::Gemm g{Mm, (const bf16_t*)(F.ws + WS_WOT), DM, DM, DM, nullptr}; pg8::DenseOrder S; S.init(MROWS / 256, DM / 256, F.G, (int)blockIdx.x, l + 1 == NLAYER);
            pg8::EpiResidB E{l == 0 ? P.in[I_X] : (const float*)nullptr, l == 0 ? (const bf16_t*)nullptr : (const bf16_t*)P.out, (bf16_t*)(F.ws + WS_HB), l == 0 ? P.in[I_CTX] : (const float*)(F.ws + WS_HCTX), (float*)(F.ws + WS_HCTX), (const float*)(F.ws + WS_MODV) + (size_t)l * 3 * 6144, 2};
            pg8::gemm_phase<pg8::EpiResidB, pg8::DenseOrder, false>(F.lds + RING_OFF, g, S, E, F.wave);
        } SEAM(pb + 6);
        if (PHEN(7) && IN(pb + 7)) { EREP convert_experts(F, P, l); __syncthreads(); phase_norm2_router(F, P, l);
#if defined(MK_PROBE_DRY)
            if (MK_PROBE_DRY & 2) { __syncthreads(); phase_norm2_router(F, P, l, true); }
#endif
        } SEAM(pb + 7);
        if (PHEN(8) && IN(pb + 8)) {
#if defined(MK_PROBE_DRY)
            if (MK_PROBE_DRY & 4) phase_scatter(F, l, true);
#endif
            phase_scatter(F, l); } SEAM(pb + 8);
    moe_half<l, 0>(F, P, bar, lo, hi);
    moe_half<l, 1>(F, P, bar, lo, hi);
}
#undef IN
#undef SEAM
#undef U
#undef RA
#undef BR
#undef G2
#undef Mm
#undef Hs
#undef Yb
#undef WGU
#undef WD
__global__ void __launch_bounds__(NTHREADS, 2) fwd_kernel(Params P) {
    extern __shared__ __attribute__((aligned(16))) unsigned char lds_raw[];
    Frame F;
    F.lds = (LAS unsigned char*)lds_raw; F.MISC = (volatile LAS unsigned*)(F.lds + MISC_OFF);
    F.wave = __builtin_amdgcn_readfirstlane((int)threadIdx.x >> 6); F.lane = hw_lane(); F.tid = F.wave * 64 + F.lane; F.G = gridDim.x;
    F.gw = blockIdx.x * NWAVES + F.wave; F.NGW = F.G * NWAVES; F.ws = (GAS unsigned char*)P.ws; F.ctl = (gu32*)(F.ws + WS_CTL);
    for (int u = F.tid; u < 64; u += NTHREADS) F.MISC[u] = 0u;
    __syncthreads();
    XcdBarrier bar; bar.bar = (unsigned*)(F.ctl + CW_BAR); bar.x = 0; bar.st = nullptr;
    if (P.use_bar) bar = xcd_barrier_post((unsigned*)(F.ctl + CW_BAR), F.MISC + 8, F.tid == 0);
    const int lo = P.ph_lo, hi = P.ph_hi;
#if MK_DEBUG == 5
    if (blockIdx.x == 0 && F.tid == 0) ((unsigned long long*)(P.ws + WS_CTL + 512))[0] = __builtin_amdgcn_s_memrealtime();
#endif
#define IN(k) (lo <= (k) && (k) < hi)
#define SEAM(k) do { if (IN(k) && IN((k) + 1)) { F.lane = hw_lane(); xcd_barrier(bar, F.wave == 0 && F.lane == 0); MK_BAR2(); } F.lane = hw_lane(); F.tid = F.wave * 64 + F.lane; MK_STAMP(k); { GAS unsigned char* w_ = (GAS unsigned char*)P.ws; asm volatile("" : "+s"(w_)); F.ws = w_; F.ctl = (gu32*)(w_ + WS_CTL); } } while (0)
    LAS int* const ts = (LAS int*)(F.lds + MISC_OFF + 256); LAS int* const te = (LAS int*)(F.lds + MISC_OFF + 3584);

    if (PHEN(15) && IN(0)) { EREP { convert_small(F, P, 0); compute_mod(F, P); } } SEAM(0);
    if (PHEN(16) && IN(1)) { EREP phase_norm1(F, P); } SEAM(1);
    layer_phases<0>(F, P, bar, lo, hi);
    layer_phases<1>(F, P, bar, lo, hi);
#if MK_DEBUG == 5
    { F.lane = hw_lane(); xcd_barrier(bar, F.wave == 0 && F.lane == 0);
      const unsigned long long* ts = (const unsigned long long*)(P.ws + WS_CTL + 512);
      const unsigned long long* tc = (const unsigned long long*)(P.ws + WS_CTL + 1024);
      auto dur = [&](int a, int b) { return (float)(ts[b + 1] - ts[a]) * 0.01f; };
      auto ghz = [&](int a, int b) { return (float)(tc[b + 1] - tc[a]) / ((float)(ts[b + 1] - ts[a]) * 10.0f); };
      auto LQ = [&](float X) { return 1.0f + floorf(log2f(X * 0.1f) * 5.0f + 0.5f) * 0.025f; };
      const float t1 = MK_T1, t2 = MK_T2;
      float* o = P.out; const long n = (long)NB * SEQ * DM;
      for (long i = (long)blockIdx.x * NTHREADS + F.wave * 64 + F.lane; i < n; i += (long)F.G * NTHREADS) o[i] = (i < 4096) ? t2 : t1; }
#endif
#undef IN
#undef SEAM
}

#ifndef MK_MULTI
#define MK_MULTI 0
#endif
extern "C" void kernel_launch(void* const* d_in, const int* in_sizes, int n_in, void* d_out, int out_size, void* d_ws, size_t ws_size, hipStream_t stream) {
    static int grid = 0;
    if (grid == 0) {
        if (n_in != 28 || out_size != NB * SEQ * DM || ws_size < WS_END) { fprintf(stderr, "kernel_launch: unexpected shapes (n_in %d out %d ws %zu need %zu); nothing launched\n", n_in, out_size, ws_size, (size_t)WS_END); grid = -1; return; }
        int dev = 0, cus = 0;
        if (hipGetDevice(&dev) != hipSuccess || hipDeviceGetAttribute(&cus, hipDeviceAttributeMultiprocessorCount, dev) != hipSuccess) { grid = -1; return; }
        if (hipFuncSetAttribute((const void*)fwd_kernel, hipFuncAttributeMaxDynamicSharedMemorySize, LDS_BYTES) != hipSuccess) { fprintf(stderr, "kernel_launch: hipFuncSetAttribute failed\n"); grid = -1; return; }
        int per_cu = 0;
        if (hipOccupancyMaxActiveBlocksPerMultiprocessor(&per_cu, (const void*)fwd_kernel, NTHREADS, LDS_BYTES) != hipSuccess || per_cu < 1) fprintf(stderr, "kernel_launch: occupancy query reports %d\n", per_cu);
        (void)hipGetLastError();
        grid = cus;
    }
    if (grid < 0) return;
    (void)hipMemsetAsync((char*)d_ws + WS_CTL, 0, CTL_ZERO_BYTES, stream);
    Params p{};
    for (int i = 0; i < 28; ++i) p.in[i] = (const float*)d_in[i];
    p.out = (float*)d_out; p.ws = (unsigned char*)d_ws;
#ifndef MK_NPH_RUN
#define MK_NPH_RUN NPHASES
#endif
#if MK_MULTI
#error "the per-phase checkpoint build is no longer supported: the prep phase contains a grid barrier"
    for (int k = 0; k < MK_NPH_RUN; ++k) { p.ph_lo = k; p.ph_hi = k + 1; p.use_bar = 0; hipLaunchKernelGGL(fwd_kernel, dim3(grid), dim3(NTHREADS), LDS_BYTES, stream, p);
#if defined(MK_DEBUG)
        unsigned* dw = (unsigned*)((char*)d_ws + WS_CTL) + 64; unsigned char* w = (unsigned char*)d_ws;
#if MK_DEBUG == 1
        if (k == 3) hipLaunchKernelGGL(chk_bf16, dim3(1024), dim3(256), 0, stream, (const bf16_t*)(w + WS_A), (long)MROWS, 4384, P1W, dw, 1u);
        if (k == 4) { hipLaunchKernelGGL(chk_bf16, dim3(1024), dim3(256), 0, stream, (const bf16_t*)(w + WS_B), (long)MROWS, 512, 1536, dw, 2u);
                      hipLaunchKernelGGL(chk_bf16, dim3(1024), dim3(256), 0, stream, (const bf16_t*)(w + WS_D), (long)MROWS, 1024, 1024, dw, 4u);
                      hipLaunchKernelGGL(chk_bf16, dim3(1024), dim3(256), 0, stream, (const bf16_t*)(w + WS_D) + (size_t)MROWS * 1024, (long)MROWS, 1024, 1024, dw, 8u); }
        if (k == 7) hipLaunchKernelGGL(chk_bf16, dim3(1024), dim3(256), 0, stream, (const bf16_t*)(w + WS_A) + (size_t)MROWS * GW, (long)MROWS, 1024, 1024, dw, 16u);
#endif
#endif
    }
#if defined(MK_DEBUG)
    hipLaunchKernelGGL(dbg_fill, dim3(1024), dim3(256), 0, stream, (float*)d_out, (long)NB * SEQ * DM, (const unsigned*)((char*)d_ws + WS_CTL) + 64);
#endif
#else
    p.ph_lo = 0; p.ph_hi = NPHASES; p.use_bar = 1;
    hipLaunchKernelGGL(fwd_kernel, dim3(grid), dim3(NTHREADS), LDS_BYTES, stream, p);
#endif
}
```

```cpp
#include <hip/hip_runtime.h>
#include <hip/hip_bf16.h>
#include <cstdio>
#include <cstdint>
#include <cmath>

constexpr int DM = 1024, NB = 2, SEQ = 16384, CTXL = 256, TT = SEQ + CTXL  , MROWS = NB * TT  ;
constexpr int NLAYER = 2, GRIDW = 64;
constexpr int P1W = 4608;
constexpr int GW = 3072;
constexpr int INW = 7456;
constexpr int C_AQ = 0, C_AK = 512, C_AV = 640, C_BQKV = 768, C_BZ = 2304, C_BA = 2816, C_BB = 2832, C_CQ = 2848, C_CK = 3360, C_CV = 3872, C_GATE = 4384;
constexpr int NEXP = 64, NEXP1 = 65  , TOPK = 6, FF = 256;
constexpr int HROWS = TT * 7 + NEXP1 * 255;
constexpr int HROWS_PAD = 133120;
constexpr float EPS = 1e-6f;
constexpr float QSCALE = 0.125f * 1.4426950408889634f;

constexpr size_t MiB = 1u << 20;
constexpr size_t WS_CTL = 0, CTL_ZERO_BYTES = 1 * MiB;
constexpr size_t WS_MODV = 1 * MiB;
constexpr size_t WS_HCTX = 2 * MiB;
constexpr size_t WS_TOPE = 4 * MiB;
constexpr size_t WS_TOPW = WS_TOPE + (size_t)MROWS * 32;
constexpr size_t WS_TOPS = WS_TOPW + (size_t)MROWS * 32;
constexpr size_t WS_RTOK = WS_TOPS + (size_t)MROWS * 32;
constexpr size_t WS_RW = WS_RTOK + (size_t)2 * HROWS_PAD * 4;
constexpr size_t WS_SMALL_END = WS_RW + (size_t)2 * HROWS_PAD * 4;
constexpr size_t WS_WB1 = 10 * MiB;
constexpr size_t WS_WB2 = WS_WB1 + (size_t)P1W * DM * 2;
constexpr size_t WS_WBR = WS_WB2 + (size_t)GW * DM * 2;
constexpr size_t WS_WOT = WS_WBR + (size_t)3 * DM * 512 * 2;
constexpr size_t WS_A = 30 * MiB;
constexpr size_t SZ_A = (size_t)MROWS * P1W * 2;
constexpr size_t WS_B = WS_A + SZ_A;
constexpr size_t SZ_B = (size_t)MROWS * 1536 * 2;
constexpr size_t WS_C = WS_B + SZ_B;
constexpr size_t SZ_C = (size_t)MROWS * DM * 2;
constexpr size_t WS_D = WS_C + SZ_C;
constexpr size_t SZ_D = (size_t)MROWS * 2048 * 2;
constexpr size_t WS_RING = WS_D + SZ_D;
constexpr int RING_SLOT = 40960;
constexpr size_t SZ_RING = (size_t)32 * 12 * RING_SLOT;
constexpr size_t WS_END = WS_RING + SZ_RING;
static_assert(WS_SMALL_END <= WS_WB1 && WS_WOT + (size_t)DM * DM * 2 <= WS_A, "ws map");
static_assert((size_t)MROWS * GW * 2 + (size_t)MROWS * DM * 2 <= SZ_A && (size_t)HROWS_PAD * DM * 2 <= SZ_A, "region A overlays");
static_assert((size_t)NEXP1 * 3 * DM * FF * 2 <= SZ_B && (size_t)HROWS_PAD * FF * 2 <= SZ_D, "region B/D overlays");
constexpr size_t WS_HB = WS_A + (size_t)HROWS_PAD * DM;
static_assert(WS_HB + (size_t)NB * SEQ * DM * 2 <= WS_A + (size_t)MROWS * GW * 2, "HB sits between Y and m");
constexpr int CW_TMO = 0;
constexpr int CW_BAR = 4096;
constexpr int CW_QUEUE = 16384;
constexpr int CW_KMAX = 40960;
constexpr int CW_ECNT = 32768;

constexpr int RING_OFF = 0, RING_BYTES = 139264;
constexpr int MISC_OFF = RING_BYTES;
constexpr int LDS_BYTES = 147456;
constexpr int NWAVES = 8, NTHREADS = 512;

#define GAS __attribute__((address_space(1)))
#define LAS __attribute__((address_space(3)))
typedef unsigned short bf16_t;
typedef unsigned v4u __attribute__((ext_vector_type(4)));
typedef unsigned v2u __attribute__((ext_vector_type(2)));
typedef float f32x4 __attribute__((ext_vector_type(4)));
typedef float f32x2 __attribute__((ext_vector_type(2)));
typedef float f32x16 __attribute__((ext_vector_type(16)));
typedef short bf16x8 __attribute__((ext_vector_type(8)));
typedef short s16x4 __attribute__((ext_vector_type(4)));
typedef GAS unsigned gu32;
#define RLX_AGENT __ATOMIC_RELAXED, __HIP_MEMORY_SCOPE_AGENT
#define LDS_WAIT() asm volatile("s_waitcnt lgkmcnt(0)" ::: "memory")
#define VM_WAIT() asm volatile("s_waitcnt vmcnt(0)" ::: "memory")
__device__ __forceinline__ unsigned f2bf(float f) { unsigned u = __builtin_bit_cast(unsigned, f); return (u + 0x7fffu + ((u >> 16) & 1u)) >> 16; }
__device__ __forceinline__ unsigned pk2(float lo, float hi) { return f2bf(lo) | (f2bf(hi) << 16); }
__device__ __forceinline__ float bf2f(unsigned short b) { return __builtin_bit_cast(float, (unsigned)b << 16); }
__device__ __forceinline__ float bflo(unsigned w) { return __builtin_bit_cast(float, w << 16); }
__device__ __forceinline__ float bfhi(unsigned w) { return __builtin_bit_cast(float, w & 0xffff0000u); }
typedef __bf16 bf16x2_t_ __attribute__((ext_vector_type(2)));
__device__ __forceinline__ unsigned cvt_pk_bf16(float lo, float hi) { unsigned r; asm volatile("v_cvt_pk_bf16_f32 %0, %1, %2" : "=v"(r) : "v"(lo), "v"(hi)); return r; }
__device__ __forceinline__ unsigned cvt_pk_bf16_safe(float lo, float hi) { f32x2 v = {lo, hi}; bf16x2_t_ b = __builtin_convertvector(v, bf16x2_t_); return __builtin_bit_cast(unsigned, b); }
__device__ __forceinline__ float wave_sum(float v) {
#pragma unroll
    for (int o = 1; o < 64; o <<= 1) v += __shfl_xor(v, o);
    return v;
}
__device__ __forceinline__ float sigmoidf_(float x) { return __builtin_amdgcn_rcpf(1.f + __expf(-x)); }
__device__ __forceinline__ float siluf_(float x) { return x * __builtin_amdgcn_rcpf(1.f + __expf(-x)); }
__device__ __forceinline__ int hw_lane() { int l; asm volatile("v_mbcnt_lo_u32_b32 %0, -1, 0\n\tv_mbcnt_hi_u32_b32 %0, -1, %0" : "=v"(l)); return l; }
#define XB_TMO      128
#define XB_XCNT(j)  (256  + 64 * (j))
#define XB_XSUB(j)  (1280 + 64 * (j))
#define XB_XGEN(j)  (2304 + 64 * (j))
#define XB_TOP      3328
#define XB_TOPGEN   3392
#define XCD_BAR_WORDS 3456
#define XB_SPIN_CAP (1u << 18)

__device__ __forceinline__ unsigned xb_ld(unsigned* p)              { return __hip_atomic_load(p, __ATOMIC_RELAXED, __HIP_MEMORY_SCOPE_AGENT); }
__device__ __forceinline__ unsigned xb_add(unsigned* p, unsigned v) { return __hip_atomic_fetch_add(p, v, __ATOMIC_RELAXED, __HIP_MEMORY_SCOPE_AGENT); }
__device__ __forceinline__ unsigned xb_xcc_id() { return (unsigned)__builtin_amdgcn_s_getreg((3 << 11) | 20) & 0xFu; }
#define XB_SPIN(cond, bar) do { unsigned _sp = 0; while (cond) { __builtin_amdgcn_s_sleep(1); \
    if ((++_sp & 255u) == 0u) { if (xb_ld(&(bar)[XB_TMO])) break; if (_sp > XB_SPIN_CAP) { atomicAdd(&(bar)[XB_TMO], 1u); break; } } } } while (0)

struct XcdBarrier {
    unsigned* bar; unsigned x;
    volatile LAS unsigned* st;
};

__device__ __forceinline__ XcdBarrier xcd_barrier_post(unsigned* bar, volatile LAS unsigned* st, bool is_t0) {
    XcdBarrier b; b.bar = bar; b.x = xb_xcc_id(); b.st = st;
    if (is_t0) (void)xb_add(&bar[XB_XCNT(b.x)], 1u);
    return b;
}
__device__ __forceinline__ void xcd_barrier_complete(unsigned* bar, unsigned x, unsigned& nloc, unsigned& nx) {
    const unsigned G = gridDim.x * gridDim.y * gridDim.z;
    unsigned sum, cnt, mine, sp = 0u;
    for (;;) {
        sum = 0u; cnt = 0u; mine = 0u;
#pragma unroll
        for (unsigned j = 0; j < 16; ++j) { const unsigned c = xb_ld(&bar[XB_XCNT(j)]); sum += c; cnt += (c > 0u) ? 1u : 0u; mine = (j == x) ? c : mine; }
        if (sum == G) break;
        __builtin_amdgcn_s_sleep(1);
        if ((++sp & 255u) == 0u) { if (xb_ld(&bar[XB_TMO])) break; if (sp > XB_SPIN_CAP) { atomicAdd(&bar[XB_TMO], 1u); break; } }
    }
    nloc = mine > 0u ? mine : 1u; nx = cnt > 0u ? cnt : 1u;
}

__device__ __forceinline__ void xcd_barrier(const XcdBarrier& b, bool is_t0) {
    asm volatile("s_waitcnt vmcnt(0)" ::: "memory");
    __syncthreads();
    if (is_t0) {
        unsigned* bar = b.bar;
        __builtin_amdgcn_s_waitcnt(0);
        unsigned nloc = b.st[0], nx = b.st[1];
        if (nloc == 0u) { xcd_barrier_complete(bar, b.x, nloc, nx); b.st[0] = nloc; b.st[1] = nx; }
        const unsigned old = xb_add(&bar[XB_XSUB(b.x)], 1u);
        const unsigned gen = old / nloc;
        if (old + 1u == (gen + 1u) * nloc) {
            __builtin_amdgcn_fence(__ATOMIC_RELEASE, "agent");
            asm volatile("s_waitcnt vmcnt(0)" ::: "memory");
            const unsigned og = xb_add(&bar[XB_TOP], 1u);
            const unsigned tg = og / nx;
            if (og + 1u == (tg + 1u) * nx) xb_add(&bar[XB_TOPGEN], 1u);
            else XB_SPIN(xb_ld(&bar[XB_TOPGEN]) == tg, bar);
            __builtin_amdgcn_fence(__ATOMIC_ACQUIRE, "agent");
            xb_add(&bar[XB_XGEN(b.x)], 1u);
            asm volatile("s_waitcnt vmcnt(0)" ::: "memory");
        } else {
            XB_SPIN(xb_ld(&bar[XB_XGEN(b.x)]) == gen, bar);
            __builtin_amdgcn_fence(__ATOMIC_ACQUIRE, "agent");
            asm volatile("s_waitcnt vmcnt(0)" ::: "memory");
        }
    }
    __syncthreads();
}
namespace pg8 {
constexpr int BM = 256, BK = 64, HALF = 128, HTB = HALF * BK * 2  , STAGE_BYTES = 8 * HTB, NXCD = 8, WGM = 8;
__host__ __device__ __forceinline__ int lds_byte(int r, int c) { const int st = (r >> 4) * 2 + (c >> 5), rr = r & 15, cc = c & 31, ob = rr * 64 + cc * 2; return st * 1024 + (ob ^ (((ob >> 9) & 1) << 5)); }
__host__ __device__ __forceinline__ void stage_rc(int b, int& R, int& C) { const int st = b / 1024, sb = b % 1024, swz = sb ^ (((sb >> 9) & 1) << 5); R = (st >> 1) * 16 + swz / 64; C = (st & 1) * 32 + (swz % 64) / 2; }
__host__ __device__ __forceinline__ int perm32(int rho) { const int n = rho >> 4, i = rho & 15; return 8 * (i >> 2) + 4 * n + (i & 3); }

struct Unit { int pm, pn, em, en, ex; };
struct Gemm { const bf16_t* A; const bf16_t* Bt; int lda, ldb, K; const int* rowlist; int astep = 0; };

struct DenseOrder {
    int nM, nN, nwg, G, c, skipctx;
    __device__ void init(int nM_, int nN_, int G_, int c_, int skipctx_ = 0) { skipctx = skipctx_; nM = skipctx_ ? nM_ - 2 : nM_; nN = nN_; nwg = nM * nN; G = G_; c = c_; }
    __device__ bool next(int i, Unit& u) const {
        const int L = i * G + c; if (L >= nwg) return false;
        int wgid = L; { const int q = nwg / NXCD, r = nwg % NXCD, xcd = wgid % NXCD, off = wgid / NXCD; wgid = (xcd < r ? xcd * (q + 1) : r * (q + 1) + (xcd - r) * q) + off; }
        const int nig = WGM * nN, gid = wgid / nig, fm = gid * WGM, gsz = (nM - fm) < WGM ? (nM - fm) : WGM;
        u.pm = fm + ((wgid % nig) % gsz); if (skipctx) u.pm += (u.pm >= 64) ? 2 : 1; u.pn = (wgid % nig) / gsz; u.em = u.pm; u.en = u.pn; u.ex = 0; return true;
    }
};
struct MoeOrder {
    const LAS int* tstart; const LAS int* texp; int nN, G, c;
    __device__ bool next(int i, Unit& u) const {
        const int L = i * G + c; const int total = tstart[NEXP1];
        if (L >= total * nN) return false;
        const int gsz = 8 * nN, gi = L / gsz, rem = L - gi * gsz; int rt, pn;
        if (gi * 8 + 8 <= total) { rt = gi * 8 + (rem & 7); pn = rem >> 3; } else { const int tr = total - gi * 8; pn = rem / tr; rt = gi * 8 + (rem - pn * tr); }
        const int e = texp[rt];
        u.pm = rt; u.pn = e * nN + pn; u.em = rt; u.en = pn; u.ex = e; return true;
    }
};

struct MergeOrder {
    DenseOrder D;
    __device__ bool next(int i, Unit& u) const { const int t = i / 3, br = i - 3 * t; if (!D.next(t, u)) return false; u.ex = br; u.pn = br * (DM / BM) + u.pn; return true; }
};
template <int ACT  > struct EpiBf16 {
    static constexpr bool PERM = true;
    bf16_t* O; int ldc;
    __device__ __forceinline__ void operator()(const f32x4 (&acc)[2][2][4][2], const Unit& u, int wr, int wc, int fr, int fq) const {
        const int row0 = u.em * BM + wr * 64 + fr; const int col0 = u.en * BM + wc * 32 + 8 * fq;
#pragma unroll
        for (int ai = 0; ai < 2; ++ai)
#pragma unroll
            for (int m = 0; m < 4; ++m) { bf16_t* rowp = O + (size_t)(row0 + ai * HALF + m * 16) * ldc + col0;
#pragma unroll
                for (int bj = 0; bj < 2; ++bj) { f32x4 v0 = acc[ai][bj][m][0], v1 = acc[ai][bj][m][1];
                    if (ACT == 1) {
#pragma unroll
                        for (int j = 0; j < 4; ++j) { v0[j] = sigmoidf_(v0[j]); v1[j] = sigmoidf_(v1[j]); } }
                    v4u w;
                    if (ACT == 1) { w.x = cvt_pk_bf16_safe(v0[0], v0[1]); w.y = cvt_pk_bf16_safe(v0[2], v0[3]); w.z = cvt_pk_bf16_safe(v1[0], v1[1]); w.w = cvt_pk_bf16_safe(v1[2], v1[3]); }
                    else { w.x = cvt_pk_bf16(v0[0], v0[1]); w.y = cvt_pk_bf16(v0[2], v0[3]); w.z = cvt_pk_bf16(v1[0], v1[1]); w.w = cvt_pk_bf16(v1[2], v1[3]); }
                    *(v4u*)(rowp + bj * HALF) = w; } }
    }
};
constexpr float YSCALE = 8.f, YUNSCALE = 0.125f;
struct EpiFp8 {
    static constexpr bool PERM = true; static constexpr int NST = 8;
    unsigned char* O;
    __device__ __forceinline__ void operator()(const f32x4 (&acc)[2][2][4][2], const Unit& u, int wr, int wc, int fr, int fq) const {
        const int row0 = u.em * BM + wr * 64 + fr; const int pos0 = u.en * BM + (wc * 4 + fq) * 16;
#pragma unroll
        for (int ai = 0; ai < 2; ++ai)
#pragma unroll
            for (int m = 0; m < 4; ++m) { unsigned char* rowp = O + (size_t)(row0 + ai * HALF + m * 16) * DM + pos0; v4u w;
#pragma unroll
                for (int bj = 0; bj < 2; ++bj) { const f32x4 v0 = acc[ai][bj][m][0] * YSCALE, v1 = acc[ai][bj][m][1] * YSCALE;
                    int lo = __builtin_amdgcn_cvt_pk_fp8_f32(v0[0], v0[1], 0, false); lo = __builtin_amdgcn_cvt_pk_fp8_f32(v0[2], v0[3], lo, true);
                    int hi = __builtin_amdgcn_cvt_pk_fp8_f32(v1[0], v1[1], 0, false); hi = __builtin_amdgcn_cvt_pk_fp8_f32(v1[2], v1[3], hi, true);
                    w[2 * bj] = (unsigned)lo; w[2 * bj + 1] = (unsigned)hi; }
                *(v4u*)rowp = w; }
    }
};
struct EpiGate8 {
    static constexpr bool PERM = true;
    unsigned char* O;
    __device__ __forceinline__ void operator()(const f32x4 (&acc)[2][2][4][2], const Unit& u, int wr, int wc, int fr, int fq) const {
        const int row0 = u.em * BM + wr * 64 + fr; const int pos0 = u.en * BM + (wc * 4 + fq) * 16;
#pragma unroll
        for (int ai = 0; ai < 2; ++ai)
#pragma unroll
            for (int m = 0; m < 4; ++m) { unsigned char* rowp = O + (size_t)(row0 + ai * HALF + m * 16) * GW + pos0; v4u w;
#pragma unroll
                for (int bj = 0; bj < 2; ++bj)
#pragma unroll
                    for (int n = 0; n < 2; ++n) { const f32x4 v = acc[ai][bj][m][n]; unsigned pk = 0u;
#pragma unroll
                        for (int j = 0; j < 4; ++j) pk = __builtin_amdgcn_cvt_pk_u8_f32(__builtin_rintf(sigmoidf_(v[j]) * 255.f), (unsigned)j, pk);
                        w[2 * bj + n] = pk; }
                *(v4u*)rowp = w; }
    }
};
struct EpiMerge {
    static constexpr bool PERM = true;
    bf16_t* Mo; const unsigned char* G;
    __device__ __forceinline__ void operator()(const f32x4 (&acc)[2][2][4][2], const Unit& u, int wr, int wc, int fr, int fq) const {
        const int row0 = u.em * BM + wr * 64 + fr; const int col0 = u.en * BM + wc * 32 + 8 * fq; const int gpos = u.ex * DM + u.en * BM + (wc * 4 + fq) * 16; const bool first = (u.ex == 0);
        constexpr float q = 1.f / 255.f;
#pragma unroll
        for (int ai = 0; ai < 2; ++ai)
#pragma unroll
            for (int m = 0; m < 4; ++m) { const size_t r = (size_t)(row0 + ai * HALF + m * 16);
                const v4u gq = *(const v4u*)(G + r * GW + gpos);
#pragma unroll
                for (int bj = 0; bj < 2; ++bj) { const f32x4 v0 = acc[ai][bj][m][0], v1 = acc[ai][bj][m][1];
                    const unsigned g0 = gq[2 * bj], g1 = gq[2 * bj + 1];
                    bf16_t* mp = Mo + r * DM + col0 + bj * HALF;
                    float o[8];
                    o[0] = (float)(g0 & 0xffu) * q * v0[0]; o[1] = (float)((g0 >> 8) & 0xffu) * q * v0[1]; o[2] = (float)((g0 >> 16) & 0xffu) * q * v0[2]; o[3] = (float)(g0 >> 24) * q * v0[3];
                    o[4] = (float)(g1 & 0xffu) * q * v1[0]; o[5] = (float)((g1 >> 8) & 0xffu) * q * v1[1]; o[6] = (float)((g1 >> 16) & 0xffu) * q * v1[2]; o[7] = (float)(g1 >> 24) * q * v1[3];
                    if (!first) { const v4u pw = *(const v4u*)mp;
                        o[0] += bflo(pw.x); o[1] += bfhi(pw.x); o[2] += bflo(pw.y); o[3] += bfhi(pw.y); o[4] += bflo(pw.z); o[5] += bfhi(pw.z); o[6] += bflo(pw.w); o[7] += bfhi(pw.w); }
                    v4u w; w.x = cvt_pk_bf16(o[0], o[1]); w.y = cvt_pk_bf16(o[2], o[3]); w.z = cvt_pk_bf16(o[4], o[5]); w.w = cvt_pk_bf16(o[6], o[7]);
                    *(v4u*)mp = w; } }
    }
};
struct EpiResid {
    static constexpr bool PERM = false;
    const float* in_lat; const float* in_ctx; float* out_lat; float* out_ctx; const float* modv; int gsel;
    __device__ __forceinline__ void operator()(const f32x4 (&acc)[2][2][4][2], const Unit& u, int wr, int wc, int fr, int fq) const {
        const int b = u.em / 65, j = u.em % 65; const bool isctx = (j == 0);
        const float* ib = isctx ? in_ctx + (size_t)b * CTXL * DM : in_lat + ((size_t)b * SEQ + (size_t)(j - 1) * 256) * DM;
        float* ob = isctx ? out_ctx + (size_t)b * CTXL * DM : out_lat + ((size_t)b * SEQ + (size_t)(j - 1) * 256) * DM;
        const float* gt = modv + (isctx ? 2 : b) * 6144 + gsel * DM;
        const int col0 = u.en * BM + wc * 32 + 4 * fq;
        f32x4 gv[2][2];
#pragma unroll
        for (int bj = 0; bj < 2; ++bj)
#pragma unroll
            for (int n = 0; n < 2; ++n) gv[bj][n] = *(const f32x4*)(gt + col0 + bj * HALF + n * 16);
#pragma unroll
        for (int ai = 0; ai < 2; ++ai)
#pragma unroll
            for (int m = 0; m < 4; ++m) { const size_t off = (size_t)(ai * HALF + wr * 64 + m * 16 + fr) * DM + col0;
#pragma unroll
                for (int bj = 0; bj < 2; ++bj)
#pragma unroll
                    for (int n = 0; n < 2; ++n) { const f32x4 bs = *(const f32x4*)(ib + off + bj * HALF + n * 16);
                        *(f32x4*)(ob + off + bj * HALF + n * 16) = bs + gv[bj][n] * acc[ai][bj][m][n]; } }
    }
};
struct EpiResidB {
    static constexpr bool PERM = true;
    const float* in_f32; const bf16_t* in_bf; bf16_t* out_bf; const float* in_ctx; float* out_ctx; const float* modv; int gsel;
    __device__ __forceinline__ void operator()(const f32x4 (&acc)[2][2][4][2], const Unit& u, int wr, int wc, int fr, int fq) const {
        const int b = u.em / 65, j = u.em % 65; const bool isctx = (j == 0);
        const size_t rbase = isctx ? (size_t)b * CTXL : (size_t)b * SEQ + (size_t)(j - 1) * 256;
        const float* gt = modv + (isctx ? 2 : b) * 6144 + gsel * DM;
        const int col0 = u.en * BM + wc * 32 + 8 * fq;
        f32x4 gv[2][2];
#pragma unroll
        for (int bj = 0; bj < 2; ++bj)
#pragma unroll
            for (int n = 0; n < 2; ++n) gv[bj][n] = *(const f32x4*)(gt + col0 + bj * HALF + 4 * n);
#pragma unroll
        for (int ai = 0; ai < 2; ++ai)
#pragma unroll
            for (int m = 0; m < 4; ++m) { const size_t off = (rbase + (size_t)(ai * HALF + wr * 64 + m * 16 + fr)) * DM + col0;
#pragma unroll
                for (int bj = 0; bj < 2; ++bj) { const size_t o = off + bj * HALF; f32x4 b0, b1;
                    if (isctx) { b0 = *(const f32x4*)(in_ctx + o); b1 = *(const f32x4*)(in_ctx + o + 4); }
                    else if (in_f32) { b0 = *(const f32x4*)(in_f32 + o); b1 = *(const f32x4*)(in_f32 + o + 4); }
                    else { const v4u w = *(const v4u*)(in_bf + o); b0 = (f32x4){bflo(w.x), bfhi(w.x), bflo(w.y), bfhi(w.y)}; b1 = (f32x4){bflo(w.z), bfhi(w.z), bflo(w.w), bfhi(w.w)}; }
                    const f32x4 r0 = b0 + gv[bj][0] * acc[ai][bj][m][0], r1 = b1 + gv[bj][1] * acc[ai][bj][m][1];
                    if (isctx) { *(f32x4*)(out_ctx + o) = r0; *(f32x4*)(out_ctx + o + 4) = r1; }
                    else { v4u w; w.x = cvt_pk_bf16_safe(r0[0], r0[1]); w.y = cvt_pk_bf16_safe(r0[2], r0[3]); w.z = cvt_pk_bf16_safe(r1[0], r1[1]); w.w = cvt_pk_bf16_safe(r1[2], r1[3]); *(v4u*)(out_bf + o) = w; } } }
    }
};

struct EpiMoe1 {
    static constexpr bool PERM = true;
    bf16_t* Hs; const float* roww;
    __device__ __forceinline__ void operator()(const f32x4 (&acc)[2][2][4][2], const Unit& u, int wr, int wc, int fr, int fq) const {
        const int row0 = u.em * BM + wr * 64 + fr; const int col0 = u.en * HALF + wc * 32 + 8 * fq;
#pragma unroll
        for (int ai = 0; ai < 2; ++ai)
#pragma unroll
            for (int m = 0; m < 4; ++m) { const int r = row0 + ai * HALF + m * 16; const float w = roww[r];
                float o[8];
#pragma unroll
                for (int n = 0; n < 2; ++n)
#pragma unroll
                    for (int j = 0; j < 4; ++j) { const float g = acc[ai][0][m][n][j], up = acc[ai][1][m][n][j]; o[n * 4 + j] = siluf_(g) * up * w; }
                v4u pw; pw.x = cvt_pk_bf16(o[0], o[1]); pw.y = cvt_pk_bf16(o[2], o[3]); pw.z = cvt_pk_bf16(o[4], o[5]); pw.w = cvt_pk_bf16(o[6], o[7]);
                *(v4u*)(Hs + (size_t)r * FF + col0) = pw; }
    }
};

template <class Epi, class Sched, bool GATHER>
__device__ __forceinline__ void gemm_phase(LAS unsigned char* lds, const Gemm g, const Sched& S, const Epi& E, int wave) {
    const int lane = hw_lane(), wid = wave, tid = wave * 64 + lane;
    const int wr = wid >> 2, wc = wid & 3, fr = lane & 15, fq = lane >> 4;
    const int K = g.K, nt = K / BK;
    int Rr[2], Cc[2];
    unsigned voffB[2], voffA[2];
#pragma unroll
    for (int i = 0; i < 2; ++i) { int R, C; stage_rc(tid * 16 + i * 8192, R, C); const int Rb = Epi::PERM ? ((R & ~31) + perm32(R & 31)) : R; Rr[i] = R; Cc[i] = C;
        voffB[i] = (unsigned)(Rb * g.ldb + C) * 2u; voffA[i] = (unsigned)(R * g.lda + C) * 2u; }
    const size_t kstep = (size_t)(BK * 2);
    const size_t hstepB = (size_t)HALF * g.ldb * 2, hstepA = (size_t)HALF * g.lda * 2;
    const size_t tstepA = (size_t)BM * g.lda * 2, tstepB = (size_t)BM * g.ldb * 2;
    const unsigned ldsw = (unsigned)wid * 1024u;
    const int aoff = lds_byte(wr * 64 + fr, fq * 8), boff = lds_byte(wc * 32 + fr, fq * 8);
#define PG8_SA(b, h) (((b) * 2 + (h)) * HTB)
#define PG8_SB(b, h) ((4 + (b) * 2 + (h)) * HTB)
#define PG8_STAGE(bufoff, gbase, voff) do { _Pragma("unroll") for (int _i = 0; _i < 2; ++_i) \
        __builtin_amdgcn_global_load_lds((const unsigned*)((const char*)(gbase) + (voff)[_i]), (LAS unsigned*)(lds + (bufoff) + ldsw + _i * 8192), 16, 0, 0); } while (0)
#define PG8_LDA(dst, b, h) do { _Pragma("unroll") for (int m = 0; m < 4; ++m) _Pragma("unroll") for (int k = 0; k < 2; ++k) dst[m][k] = *(const LAS bf16x8*)(lds + PG8_SA(b, h) + aoff + m * 2048 + k * 1024); } while (0)
#define PG8_LDB(dst, b, h) do { _Pragma("unroll") for (int n = 0; n < 2; ++n) _Pragma("unroll") for (int k = 0; k < 2; ++k) dst[n][k] = *(const LAS bf16x8*)(lds + PG8_SB(b, h) + boff + n * 2048 + k * 1024); } while (0)
#define PG8_MMA(ai, bj, At, Bt) do { __builtin_amdgcn_s_setprio(1); _Pragma("unroll") for (int m = 0; m < 4; ++m) _Pragma("unroll") for (int n = 0; n < 2; ++n) _Pragma("unroll") for (int k = 0; k < 2; ++k) \
        acc[ai][bj][m][n] = __builtin_amdgcn_mfma_f32_16x16x32_bf16(Bt[n][k], At[m][k], acc[ai][bj][m][n], 0, 0, 0); __builtin_amdgcn_s_setprio(0); } while (0)
#define PG8_WAIT_V(n) asm volatile("s_waitcnt vmcnt(" #n ")" ::: "memory")
#define PG8_WAIT_L(n) asm volatile("s_waitcnt lgkmcnt(" #n ")" ::: "memory")
#define PG8_BAR __builtin_amdgcn_s_barrier()
#define PG8_SCHED __builtin_amdgcn_sched_barrier(0)
#define PG8_AOFFS(dst, unit) do { if constexpr (GATHER) { _Pragma("unroll") for (int _h = 0; _h < 2; ++_h) _Pragma("unroll") for (int _i = 0; _i < 2; ++_i) { \
        const int _row = g.rowlist[(size_t)(unit).pm * BM + _h * HALF + Rr[_i]]; dst[_h][_i] = (unsigned)((size_t)_row * g.lda + Cc[_i]) * 2u; } \
        asm volatile("s_waitcnt vmcnt(0)" ::: "memory"); } } while (0)
#define PG8_STAGE_A(bufoff, base, h, vset) do { if constexpr (GATHER) { PG8_STAGE(bufoff, base, vset[h]); } else { PG8_STAGE(bufoff, (base) + (h) * hstepA, voffA); } } while (0)
    Unit cur, nxt; int ui = 0;
    if (!S.next(0, cur)) return;
    f32x4 acc[2][2][4][2];
#pragma unroll
    for (int a = 0; a < 2; ++a)
#pragma unroll
        for (int b = 0; b < 2; ++b)
#pragma unroll
            for (int m = 0; m < 4; ++m)
#pragma unroll
                for (int n = 0; n < 2; ++n) acc[a][b][m][n] = (f32x4){0.f, 0.f, 0.f, 0.f};
    bf16x8 At[4][2], B0[2][2], B1[2][2];
    unsigned vc[2][2], vn[2][2];
    PG8_AOFFS(vc, cur);
    const char* cA = GATHER ? (const char*)g.A : (const char*)g.A + (size_t)cur.pm * tstepA + (size_t)cur.ex * g.astep; const char* cB = (const char*)g.Bt + (size_t)cur.pn * tstepB;
    PG8_STAGE(PG8_SB(0, 0), cB, voffB); PG8_STAGE(PG8_SB(0, 1), cB + hstepB, voffB); PG8_STAGE_A(PG8_SA(0, 0), cA, 0, vc); PG8_STAGE_A(PG8_SA(0, 1), cA, 1, vc);
    if (wr == 1) PG8_BAR;
    PG8_WAIT_V(2); PG8_BAR;
    PG8_STAGE(PG8_SB(1, 0), cB + kstep, voffB); PG8_STAGE_A(PG8_SA(1, 0), cA + kstep, 0, vc); PG8_STAGE(PG8_SB(1, 1), cB + hstepB + kstep, voffB);
    PG8_WAIT_V(6); PG8_BAR;
    for (;;) {
        const bool has_next = S.next(ui + 1, nxt);
        if constexpr (GATHER) { if (has_next) { PG8_AOFFS(vn, nxt); } else { vn[0][0] = vc[0][0]; vn[0][1] = vc[0][1]; vn[1][0] = vc[1][0]; vn[1][1] = vc[1][1]; } }
        const char* nA = has_next ? (GATHER ? (const char*)g.A : (const char*)g.A + (size_t)nxt.pm * tstepA + (size_t)nxt.ex * g.astep) : cA; const char* nB = has_next ? (const char*)g.Bt + (size_t)nxt.pn * tstepB : cB;
        for (int t = 0; t < nt; t += 2) {
            const bool last = (t == nt - 2);
            const char* a1 = cA + (size_t)(t + 1) * kstep;
            const char* a2 = last ? nA : cA + (size_t)(t + 2) * kstep; const char* b2 = last ? nB : cB + (size_t)(t + 2) * kstep;
            const char* a3 = a2 + kstep; const char* b3 = b2 + kstep;
            unsigned v2[2][2];
            if constexpr (GATHER) { v2[0][0] = last ? vn[0][0] : vc[0][0]; v2[0][1] = last ? vn[0][1] : vc[0][1]; v2[1][0] = last ? vn[1][0] : vc[1][0]; v2[1][1] = last ? vn[1][1] : vc[1][1]; }
            PG8_LDB(B0, 0, 0); PG8_LDB(B1, 0, 1); PG8_SCHED; PG8_LDA(At, 0, 0); PG8_STAGE_A(PG8_SA(1, 1), a1, 1, vc);
            PG8_WAIT_V(8); PG8_WAIT_L(0); PG8_BAR; PG8_MMA(0, 0, At, B0); PG8_MMA(0, 1, At, B1); PG8_BAR; PG8_SCHED;
            PG8_LDA(At, 0, 1); PG8_STAGE(PG8_SB(0, 0), b2, voffB); PG8_STAGE(PG8_SB(0, 1), b2 + hstepB, voffB); PG8_STAGE_A(PG8_SA(0, 0), a2, 0, v2);
            PG8_WAIT_V(8); PG8_WAIT_L(0); PG8_BAR; PG8_MMA(1, 0, At, B0); PG8_MMA(1, 1, At, B1); PG8_BAR; PG8_SCHED;
            PG8_LDB(B0, 1, 0); PG8_LDB(B1, 1, 1); PG8_SCHED; PG8_LDA(At, 1, 0); PG8_STAGE_A(PG8_SA(0, 1), a2, 1, v2);
            PG8_WAIT_V(8); PG8_WAIT_L(0); PG8_BAR; PG8_MMA(0, 0, At, B0); PG8_MMA(0, 1, At, B1); PG8_BAR; PG8_SCHED;
            PG8_LDA(At, 1, 1); PG8_STAGE(PG8_SB(1, 0), b3, voffB); PG8_STAGE(PG8_SB(1, 1), b3 + hstepB, voffB); PG8_STAGE_A(PG8_SA(1, 0), a3, 0, v2);
            PG8_WAIT_V(8); PG8_WAIT_L(0); PG8_BAR; PG8_MMA(1, 0, At, B0); PG8_MMA(1, 1, At, B1); PG8_BAR; PG8_SCHED;
        }
        if (wr == 0) PG8_BAR;
        { const int l2 = hw_lane(); E(acc, cur, wr, wc, l2 & 15, l2 >> 4); }
        if (!has_next) break;
#pragma unroll
        for (int a = 0; a < 2; ++a)
#pragma unroll
            for (int b = 0; b < 2; ++b)
#pragma unroll
                for (int m = 0; m < 4; ++m)
#pragma unroll
                    for (int n = 0; n < 2; ++n) acc[a][b][m][n] = (f32x4){0.f, 0.f, 0.f, 0.f};
        cur = nxt; cA = nA; cB = nB; ++ui;
        if constexpr (GATHER) { vc[0][0] = vn[0][0]; vc[0][1] = vn[0][1]; vc[1][0] = vn[1][0]; vc[1][1] = vn[1][1]; }
        if (wr == 1) PG8_BAR;
    }
    PG8_WAIT_V(0);
    PG8_BAR;
#undef PG8_SA
#undef PG8_SB
#undef PG8_STAGE
#undef PG8_LDA
#undef PG8_LDB
#undef PG8_MMA
#undef PG8_WAIT_V
#undef PG8_WAIT_L
#undef PG8_BAR
#undef PG8_SCHED
#undef PG8_AOFFS
#undef PG8_STAGE_A
}
}
namespace attn_body {
using bf16=__hip_bfloat16;
using bf16x8=__attribute__((ext_vector_type(8)))short;
using s16x4=__attribute__((ext_vector_type(4)))short;
using f32x16=__attribute__((ext_vector_type(16)))float;
using u32x4=__attribute__((ext_vector_type(4)))unsigned;
constexpr int D=64;
constexpr int NW=8,QBLK=32,QB=QBLK*NW,KVBLK=64;
constexpr int ATTN_UNIT_ROWS=QB;
__device__ __forceinline__ int crow(int r,int hi){return (r&3)+8*(r>>2)+4*hi;}
#define SBAR() __builtin_amdgcn_sched_barrier(0)
constexpr int NSLOT=3, SLOTB=8192;
constexpr int LDS_K=0, LDS_V=NSLOT*SLOTB, LDS_WS=2*NSLOT*SLOTB, LDS_OST=LDS_WS+NW*64*4, LDS_BYTES=LDS_OST+NW*4096;
constexpr float C2=0.125f*1.4426950408889634f;
__device__ __forceinline__ void glds16(const void*gsrc,unsigned lds_dst){unsigned keep;
  asm volatile("s_mov_b32 %0, m0\n\ts_mov_b32 m0, %2\n\ts_nop 0\n\tglobal_load_lds_dwordx4 %1, off\n\ts_mov_b32 m0, %0":"=&s"(keep):"v"(gsrc),"s"(lds_dst):"memory");}
__device__ __forceinline__ float max3f(float a,float b,float c){float r;asm("v_max3_f32 %0, %1, %2, %3":"=v"(r):"v"(a),"v"(b),"v"(c));return r;}
__device__ __forceinline__ float max2f(float a,float b){float r;asm("v_max_f32_e32 %0, %1, %2":"=v"(r):"v"(a),"v"(b));return r;}
__device__ __forceinline__ float fadd_s(float a,float b){float r;asm("v_add_f32_e32 %0, %1, %2":"=v"(r):"v"(a),"v"(b));return r;}
__device__ __forceinline__ float fsub_s(float a,float b){float r;asm("v_sub_f32_e32 %0, %1, %2":"=v"(r):"v"(a),"v"(b));return r;}
typedef float f32x2_t __attribute__((ext_vector_type(2))); typedef __bf16 bf16x2_t __attribute__((ext_vector_type(2)));
__device__ __forceinline__ unsigned cvtpk_s(float lo,float hi){f32x2_t v={lo,hi};bf16x2_t b=__builtin_convertvector(v,bf16x2_t);return __builtin_bit_cast(unsigned,b);}
#define WAIT_BAR(N) asm volatile("s_waitcnt vmcnt(" #N ") lgkmcnt(0)\n\ts_barrier":::"memory")

__device__ __forceinline__ void qkt(f32x16&p0,f32x16&p1,const char*Kslot,const bf16x8*qr,const f32x16&negm,int r32,int hi){
  const char*kb=Kslot+hi*1024+r32*16;
  #pragma unroll
  for(int d0=0;d0<4;++d0){
    const bf16x8 b0=*reinterpret_cast<const bf16x8*>(kb+d0*2048);
    const bf16x8 b1=*reinterpret_cast<const bf16x8*>(kb+d0*2048+512);
    if(d0==0){p0=__builtin_amdgcn_mfma_f32_32x32x16_bf16(b0,qr[0],negm,0,0,0);p1=__builtin_amdgcn_mfma_f32_32x32x16_bf16(b1,qr[0],negm,0,0,0);}
    else{p0=__builtin_amdgcn_mfma_f32_32x32x16_bf16(b0,qr[d0],p0,0,0,0);p1=__builtin_amdgcn_mfma_f32_32x32x16_bf16(b1,qr[d0],p1,0,0,0);}}
}
typedef __attribute__((address_space(3))) const char* lds_cptr;
typedef short v4i16_t __attribute__((ext_vector_type(4)));
__device__ __forceinline__ void kload8(bf16x8*kf,lds_cptr kp){
  kf[0]=*(const __attribute__((address_space(3))) bf16x8*)(kp);      kf[1]=*(const __attribute__((address_space(3))) bf16x8*)(kp+512);
  kf[2]=*(const __attribute__((address_space(3))) bf16x8*)(kp+2048); kf[3]=*(const __attribute__((address_space(3))) bf16x8*)(kp+2560);
  kf[4]=*(const __attribute__((address_space(3))) bf16x8*)(kp+4096); kf[5]=*(const __attribute__((address_space(3))) bf16x8*)(kp+4608);
  kf[6]=*(const __attribute__((address_space(3))) bf16x8*)(kp+6144); kf[7]=*(const __attribute__((address_space(3))) bf16x8*)(kp+6656);
}
__device__ __forceinline__ void kload2(bf16x8*kf,lds_cptr kp,int j){ kf[2*j]=*(const __attribute__((address_space(3))) bf16x8*)(kp+j*2048); kf[2*j+1]=*(const __attribute__((address_space(3))) bf16x8*)(kp+j*2048+512); }
__device__ __forceinline__ void kload8_rm(bf16x8*kf,lds_cptr kp,const int*koff){
  #pragma unroll
  for(int d0=0;d0<4;++d0){ kf[2*d0]=*(const __attribute__((address_space(3))) bf16x8*)(kp+koff[d0]); kf[2*d0+1]=*(const __attribute__((address_space(3))) bf16x8*)(kp+koff[d0]+4096); }
}
__device__ __forceinline__ void kload2_rm(bf16x8*kf,lds_cptr kp,const int*koff,int j){ kf[2*j]=*(const __attribute__((address_space(3))) bf16x8*)(kp+koff[j]); kf[2*j+1]=*(const __attribute__((address_space(3))) bf16x8*)(kp+koff[j]+4096); }
__device__ __forceinline__ void qkt_rm(f32x16&p0,f32x16&p1,lds_cptr kp,const int*koff,const bf16x8*qr,const f32x16&negm){
  #pragma unroll
  for(int d0=0;d0<4;++d0){
    const bf16x8 b0=*(const __attribute__((address_space(3))) bf16x8*)(kp+koff[d0]);
    const bf16x8 b1=*(const __attribute__((address_space(3))) bf16x8*)(kp+koff[d0]+4096);
    if(d0==0){p0=__builtin_amdgcn_mfma_f32_32x32x16_bf16(b0,qr[0],negm,0,0,0);p1=__builtin_amdgcn_mfma_f32_32x32x16_bf16(b1,qr[0],negm,0,0,0);}
    else{p0=__builtin_amdgcn_mfma_f32_32x32x16_bf16(b0,qr[d0],p0,0,0,0);p1=__builtin_amdgcn_mfma_f32_32x32x16_bf16(b1,qr[d0],p1,0,0,0);}}
}
__device__ __forceinline__ void qprep(bf16x8 (&qr)[4],int hi,int pos,const float*gq){
  float x[4][8];
  #pragma unroll
  for(int d0=0;d0<4;++d0){
    #pragma unroll
    for(int e=0;e<8;++e)x[d0][e]=__builtin_bit_cast(float,(unsigned)(unsigned short)qr[d0][e]<<16);}
  if(gq){ float ss=0.f;
    #pragma unroll
    for(int d0=0;d0<4;++d0){
      #pragma unroll
      for(int e=0;e<8;++e)ss+=x[d0][e]*x[d0][e];}
    auto rr=__builtin_amdgcn_permlane32_swap(__float_as_uint(ss),__float_as_uint(ss),false,false);ss=__uint_as_float(rr[0])+__uint_as_float(rr[1]);
    const float rstd=rsqrtf(ss*(1.f/64.f)+1e-6f);
    #pragma unroll
    for(int d0=0;d0<4;++d0){
      #pragma unroll
      for(int e=0;e<8;++e)x[d0][e]*=rstd*gq[16*d0+8*hi+e];} }
  if(pos>=0){ const float rp=(float)(pos>>6),cp=(float)(pos&63);
    #pragma unroll
    for(int e=0;e<8;++e){ const float inv=exp2f(-(float)(8*hi+e)*(13.287712379549449f/16.f)); float s0,c0,s1,c1; sincosf(rp*inv,&s0,&c0); sincosf(cp*inv,&s1,&c1);
      const float a0=x[0][e],b0=x[2][e],a1=x[1][e],b1=x[3][e];
      x[0][e]=a0*c0-b0*s0; x[2][e]=b0*c0+a0*s0; x[1][e]=a1*c1-b1*s1; x[3][e]=b1*c1+a1*s1; } }
  #pragma unroll
  for(int d0=0;d0<4;++d0){ u32x4 w; w[0]=cvtpk_s(x[d0][0]*C2,x[d0][1]*C2); w[1]=cvtpk_s(x[d0][2]*C2,x[d0][3]*C2); w[2]=cvtpk_s(x[d0][4]*C2,x[d0][5]*C2); w[3]=cvtpk_s(x[d0][6]*C2,x[d0][7]*C2); qr[d0]=__builtin_bit_cast(bf16x8,w); }
}
__device__ __forceinline__ s16x4 vtr(lds_cptr p){ return __builtin_bit_cast(s16x4,__builtin_amdgcn_ds_read_tr16_b64_v4i16((__attribute__((address_space(3))) v4i16_t*)p)); }
__device__ __forceinline__ float rowmax(const f32x16&p0,const f32x16&p1){
  float a=max3f(p0[0],p0[1],p1[0]),b=max3f(p0[2],p0[3],p1[1]);a=max3f(a,p1[2],p1[3]);
  #pragma unroll
  for(int r=4;r<16;r+=4){a=max3f(a,p0[r],p0[r+1]);b=max3f(b,p0[r+2],p0[r+3]);a=max3f(a,p1[r],p1[r+1]);b=max3f(b,p1[r+2],p1[r+3]);}
  const float m=max2f(a,b);
  auto rr=__builtin_amdgcn_permlane32_swap(__float_as_uint(m),__float_as_uint(m),false,false);
  return max2f(__uint_as_float(rr[0]),__uint_as_float(rr[1]));
}
template<int ND> __device__ __forceinline__ void pv(f32x16*o,int vb,bf16x8 pa0,bf16x8 pa1,bf16x8 pa2,bf16x8 pa3){
  #pragma unroll
  for(int d0=0;d0<ND;++d0){s16x4 lo[4],hi[4];
    #pragma unroll
    for(int ks=0;ks<4;++ks){
      asm volatile("ds_read_b64_tr_b16 %0,%1 offset:%c2":"=&v"(lo[ks]):"v"(vb),"i"(d0*4096+ks*1024):"memory");
      asm volatile("ds_read_b64_tr_b16 %0,%1 offset:%c2":"=&v"(hi[ks]):"v"(vb),"i"(d0*4096+ks*1024+512):"memory");}
    asm volatile("s_waitcnt lgkmcnt(0)":::"memory");SBAR();
    #define PK(k) (bf16x8){lo[k][0],lo[k][1],lo[k][2],lo[k][3],hi[k][0],hi[k][1],hi[k][2],hi[k][3]}
    o[d0]=__builtin_amdgcn_mfma_f32_32x32x16_bf16(pa0,PK(0),o[d0],0,0,0);
    o[d0]=__builtin_amdgcn_mfma_f32_32x32x16_bf16(pa1,PK(1),o[d0],0,0,0);
    o[d0]=__builtin_amdgcn_mfma_f32_32x32x16_bf16(pa2,PK(2),o[d0],0,0,0);
    o[d0]=__builtin_amdgcn_mfma_f32_32x32x16_bf16(pa3,PK(3),o[d0],0,0,0);
    #undef PK
  }
}

#ifndef ATTN_STORE16
#define ATTN_STORE16(p,v) (*(u32x4*)(p)=(v))
#endif
template<int THRL> __device__ __forceinline__ void attn_unit(const bf16*Qb,int QP,const bf16*__restrict__ Kh,int KP,const bf16*__restrict__ Vh,int VP,bf16*Ob,int OP,int NT,char*shm,int wave){
  const int lane=hw_lane(),r32=lane&31,hi=lane>>5; const int wid=wave;
  const bf16*Qw=Qb+(long)(wid*QBLK)*QP;
  const unsigned lds0=(unsigned)(uintptr_t)shm;
  float*wsf=(float*)(shm+LDS_WS)+wid*64;
  const bf16*ksrc=Kh+(long)lane*KP+wid*8;
  const bf16*vsrc=Vh+(long)(16*(wid&3)+(lane>>2))*VP+(wid>>2)*32+(lane&3)*8;
  const unsigned kdst=lds0+LDS_K+wid*1024, vdst=lds0+LDS_V+wid*1024;
  #define DMA_K(t,slot) glds16(ksrc+(long)(t)*KVBLK*KP,(unsigned)__builtin_amdgcn_readfirstlane(kdst+(slot)))
  #define DMA_V(t,slot) glds16(vsrc+(long)(t)*KVBLK*VP,(unsigned)__builtin_amdgcn_readfirstlane(vdst+(slot)))
  const int vb0=(int)(lds0+LDS_V)+((lane>>4)&1)*32+(lane&3)*8+(4*hi+((lane&15)>>2))*64;
  const char*Kbase=shm+LDS_K; bf16x8 kf[8];
  const lds_cptr shm3=(lds_cptr)shm; const lds_cptr kp0=shm3+LDS_K+hi*1024+r32*16; const lds_cptr vp0=shm3+LDS_V+((lane>>4)&1)*32+(lane&3)*8+(4*hi+((lane&15)>>2))*64;
  DMA_K(0,0);DMA_V(0,0);DMA_K(1,SLOTB);
  bf16x8 qr[4];
  #pragma unroll
  for(int d0=0;d0<4;++d0)qr[d0]=*reinterpret_cast<const bf16x8*>(&Qw[(long)r32*QP+d0*16+hi*8]);
  float mhat=0.f,l_reg=0.f;f32x16 o[2];o[0]=f32x16{};o[1]=f32x16{};f32x16 negm=f32x16{};asm volatile("":"+v"(negm));
  #define CMASK(P0,P1,t) do{}while(0)
  bool resc=false;
  #define START(P0,P1) do{ const float rm=rowmax(P0,P1); resc=false; \
    { const float dl=rm; mhat=fadd_s(mhat,dl); \
      _Pragma("unroll") for(int r=0;r<16;++r){P0[r]=fsub_s(P0[r],dl);P1[r]=fsub_s(P1[r],dl);} \
      _Pragma("unroll") for(int r=0;r<16;++r)negm[r]=-mhat; asm volatile("":"+v"(negm)); } \
    _Pragma("unroll") for(int r=0;r<16;++r)P0[r]=__builtin_amdgcn_exp2f(P0[r]); }while(0)
  #define RESC() do{ if(resc){ asm volatile("s_waitcnt lgkmcnt(0)":::"memory"); \
      _Pragma("unroll") for(int d_=0;d_<2;++d_) _Pragma("unroll") for(int r=0;r<16;++r)o[d_][r]*=wsf[crow(r,hi)]; } }while(0)
  f32x16 pA0,pA1,pB0,pB1;
  int sl_prev=0,sl_cur=0,sl_next=SLOTB;
  #define ROT() do{sl_prev=sl_cur;sl_cur=sl_next;sl_next=(sl_next==(NSLOT-1)*SLOTB)?0:sl_next+SLOTB;}while(0)
  DMA_K(2,2*SLOTB);
  WAIT_BAR(3);
  qkt(pA0,pA1,Kbase,qr,negm,r32,hi);asm volatile("s_nop 15\n\ts_nop 7":"+v"(pA0),"+v"(pA1));CMASK(pA0,pA1,0);
  START(pA0,pA1);
  _Pragma("unroll") for(int r=0;r<16;++r)pA1[r]=__builtin_amdgcn_exp2f(pA1[r]);
  WAIT_BAR(0);
  DMA_K(3,0);DMA_V(1,SLOTB);
  ROT();
  kload8(kf,kp0+sl_cur);
  WAIT_BAR(2);
  s16x4 vlo[8],vhi[8]; u32x4 pw0,pw1,pw2,pw3;
  #define PKW(P,B) cvtpk_s(P[B],P[B+1])
  #define PAF(k) __builtin_bit_cast(bf16x8,pw##k)
  #define VFR(i) (bf16x8){vlo[i][0],vlo[i][1],vlo[i][2],vlo[i][3],vhi[i][0],vhi[i][1],vhi[i][2],vhi[i][3]}
  #define PIN(x) asm volatile("":"+v"(x))
  #define MX3(a,b,c) __builtin_fmaxf(__builtin_fmaxf((a),(b)),(c))
  #define GAPA(MF,A0,A1,A2,A3,W0,W1,PW) do{ MF; sacc+=A0; sacc+=A1; sacc+=A2; sacc+=A3; PIN(sacc); W0; W1; PIN(PW); SBAR(); }while(0)
  #define EX(v) __builtin_amdgcn_exp2f(v)
  #define GAPB(MF,X,B) do{ MF; X[B]=EX(X[B]); X[B+1]=EX(X[B+1]); X[B+2]=EX(X[B+2]); X[B+3]=EX(X[B+3]); PIN(X); SBAR(); }while(0)
  #define VRD(i) do{ vlo[i]=vtr(vp_+(((i)>>2)*4096+((i)&3)*1024)); vhi[i]=vtr(vp_+(((i)>>2)*4096+((i)&3)*1024+512)); }while(0)
  #define KRD(G,j) do{ if(G){ kload2(kf,kp0+sl_next,j); SBAR(); } }while(0)
  #define STEP(C0,C1,P0,P1,t,GK,GV,GL) do{ SBAR(); \
    const lds_cptr vp_=vp0+sl_prev; \
    VRD(0); SBAR(); float sacc=(P0[0]+P0[1]); \
    GAPA(C0=__builtin_amdgcn_mfma_f32_32x32x16_bf16(kf[0],qr[0],negm,0,0,0), P0[2],P0[3],P0[4],P0[5],     pw0[0]=PKW(P0,0), pw0[1]=PKW(P0,2), pw0); \
    VRD(4); SBAR(); GAPA(C1=__builtin_amdgcn_mfma_f32_32x32x16_bf16(kf[1],qr[0],negm,0,0,0), P0[6],P0[7],P0[8],P0[9],     pw0[2]=PKW(P0,4), pw0[3]=PKW(P0,6), pw0); \
    VRD(1); SBAR(); GAPA(C0=__builtin_amdgcn_mfma_f32_32x32x16_bf16(kf[2],qr[1],C0,0,0,0),   P0[10],P0[11],P0[12],P0[13], pw1[0]=PKW(P0,8), pw1[1]=PKW(P0,10), pw1); \
    VRD(5); SBAR(); GAPA(C1=__builtin_amdgcn_mfma_f32_32x32x16_bf16(kf[3],qr[1],C1,0,0,0),   P0[14],P0[15],P1[0],P1[1],   pw1[2]=PKW(P0,12),pw1[3]=PKW(P0,14), pw1); \
    VRD(2); SBAR(); GAPA(C0=__builtin_amdgcn_mfma_f32_32x32x16_bf16(kf[4],qr[2],C0,0,0,0),   P1[2],P1[3],P1[4],P1[5],     pw2[0]=PKW(P1,0), pw2[1]=PKW(P1,2), pw2); \
    VRD(6); SBAR(); GAPA(C1=__builtin_amdgcn_mfma_f32_32x32x16_bf16(kf[5],qr[2],C1,0,0,0),   P1[6],P1[7],P1[8],P1[9],     pw2[2]=PKW(P1,4), pw2[3]=PKW(P1,6), pw2); \
    VRD(3); SBAR(); GAPA(C0=__builtin_amdgcn_mfma_f32_32x32x16_bf16(kf[6],qr[3],C0,0,0,0),   P1[10],P1[11],P1[12],P1[13], pw3[0]=PKW(P1,8), pw3[1]=PKW(P1,10), pw3); \
    VRD(7); SBAR(); GAPA(C1=__builtin_amdgcn_mfma_f32_32x32x16_bf16(kf[7],qr[3],C1,0,0,0),   P1[14],P1[15],0.f,0.f,       pw3[2]=PKW(P1,12),pw3[3]=PKW(P1,14), pw3); \
    l_reg+=sacc; \
    if(GK){DMA_K((t)+3,sl_cur);} if(GV){DMA_V((t)+1,sl_next);} \
    CMASK(C0,C1,t); \
    { float a=MX3(C0[0],C0[1],C1[0]),b=MX3(C0[2],C0[3],C1[1]); a=MX3(a,C1[2],C1[3]); \
      _Pragma("unroll") for(int r=4;r<16;r+=4){a=MX3(a,C0[r],C0[r+1]);b=MX3(b,C0[r+2],C0[r+3]);a=MX3(a,C1[r],C1[r+1]);b=MX3(b,C1[r+2],C1[r+3]);} \
      float rm=__builtin_fmaxf(a,b); { auto rr=__builtin_amdgcn_permlane32_swap(__float_as_uint(rm),__float_as_uint(rm),false,false); rm=__builtin_fmaxf(__uint_as_float(rr[0]),__uint_as_float(rr[1])); } \
      resc=false; \
      if(__builtin_expect(__any(rm>(float)THRL),0)){ const float dl=__builtin_fmaxf(rm,0.f); mhat+=dl; \
        _Pragma("unroll") for(int r=0;r<16;++r){C0[r]-=dl;C1[r]-=dl;} \
        _Pragma("unroll") for(int r=0;r<16;++r)negm[r]=-mhat; asm volatile("":"+v"(negm)); \
        const float f=__builtin_amdgcn_exp2f(-dl); l_reg*=f; if(hi==0)wsf[r32]=f; resc=true; } } \
    SBAR(); \
    GAPB(o[0]=__builtin_amdgcn_mfma_f32_32x32x16_bf16(PAF(0),VFR(0),o[0],0,0,0), C0,0); \
    GAPB(o[1]=__builtin_amdgcn_mfma_f32_32x32x16_bf16(PAF(0),VFR(4),o[1],0,0,0), C0,4); \
    KRD(GL,0); GAPB(o[0]=__builtin_amdgcn_mfma_f32_32x32x16_bf16(PAF(1),VFR(1),o[0],0,0,0), C0,8); \
    KRD(GL,1); GAPB(o[1]=__builtin_amdgcn_mfma_f32_32x32x16_bf16(PAF(1),VFR(5),o[1],0,0,0), C0,12); \
    KRD(GL,2); GAPB(o[0]=__builtin_amdgcn_mfma_f32_32x32x16_bf16(PAF(2),VFR(2),o[0],0,0,0), C1,0); \
    KRD(GL,3); GAPB(o[1]=__builtin_amdgcn_mfma_f32_32x32x16_bf16(PAF(2),VFR(6),o[1],0,0,0), C1,4); \
    GAPB(o[0]=__builtin_amdgcn_mfma_f32_32x32x16_bf16(PAF(3),VFR(3),o[0],0,0,0), C1,8); \
    GAPB(o[1]=__builtin_amdgcn_mfma_f32_32x32x16_bf16(PAF(3),VFR(7),o[1],0,0,0), C1,12); \
    }while(0)
  int t=1;
  #undef CMASK
  #define CMASK(P0,P1,t) do{}while(0)
  for(;t+5<NT;t+=2){
    STEP(pB0,pB1,pA0,pA1,t,true,true,true);     WAIT_BAR(2); RESC(); ROT();
    STEP(pA0,pA1,pB0,pB1,t+1,true,true,true);   WAIT_BAR(2); RESC(); ROT();
  }
  #undef CMASK
  #define CMASK(P0,P1,t) do{}while(0)
  #define ENDW(tt) do{ if((tt)+3<NT){WAIT_BAR(2);} else if((tt)+2<NT){WAIT_BAR(1);} else {WAIT_BAR(0);} }while(0)
  for(;t+1<NT;t+=2){
    STEP(pB0,pB1,pA0,pA1,t,(t+3<NT),(t+1<NT),(t+1<NT));       ENDW(t);   RESC(); ROT();
    STEP(pA0,pA1,pB0,pB1,t+1,(t+4<NT),(t+2<NT),(t+2<NT));     ENDW(t+1); RESC(); ROT();
  }
  STEP(pB0,pB1,pA0,pA1,NT-1,false,false,false); RESC();
  { float sacc=pB0[0]+pB0[1]; _Pragma("unroll") for(int r=2;r<16;++r)sacc+=pB0[r]; _Pragma("unroll") for(int r=0;r<16;++r)sacc+=pB1[r]; l_reg+=sacc;
    pw0=(u32x4){PKW(pB0,0),PKW(pB0,2),PKW(pB0,4),PKW(pB0,6)};pw1=(u32x4){PKW(pB0,8),PKW(pB0,10),PKW(pB0,12),PKW(pB0,14)};pw2=(u32x4){PKW(pB1,0),PKW(pB1,2),PKW(pB1,4),PKW(pB1,6)};pw3=(u32x4){PKW(pB1,8),PKW(pB1,10),PKW(pB1,12),PKW(pB1,14)};
    SBAR(); pv<2>(o,vb0+sl_cur,PAF(0),PAF(1),PAF(2),PAF(3)); }
  #undef PKW
  #undef PAF
  #undef VFR
  #undef PIN
  #undef MX3
  #undef GAPA
  #undef GAPB
  #undef EX
  #undef VRD
  #undef KRD
  #undef STEP
  #undef ENDW
  {auto rr=__builtin_amdgcn_permlane32_swap(__float_as_uint(l_reg),__float_as_uint(l_reg),false,false);l_reg=__uint_as_float(rr[0])+__uint_as_float(rr[1]);}
  if(hi==0)wsf[32+r32]=l_reg;asm volatile("s_waitcnt lgkmcnt(0)":::"memory");
  float rli[16];
  #pragma unroll
  for(int r=0;r<16;++r)rli[r]=__builtin_amdgcn_rcpf(wsf[32+crow(r,hi)]);
  bf16*Ow=Ob+(long)(wid*QBLK)*OP;
  { bf16*stg=(bf16*)(shm+LDS_OST)+wid*2048;
    #pragma unroll
    for(int r=0;r<16;++r){const int orow=crow(r,hi);
      #pragma unroll
      for(int d0=0;d0<2;++d0)stg[orow*64+d0*32+r32]=__float2bfloat16(o[d0][r]*rli[r]);}
    asm volatile("s_waitcnt lgkmcnt(0)":::"memory");
    #pragma unroll
    for(int i=0;i<4;++i){const int row=i*8+(lane>>3),ch=lane&7; const u32x4 v=*(const u32x4*)(stg+row*64+ch*8); ATTN_STORE16(Ow+(long)row*OP+ch*8,v);} }
  asm volatile("s_waitcnt lgkmcnt(0)\n\ts_barrier":::"memory");
  #undef DMA_K
  #undef DMA_V
  #undef CMASK
  #undef START
  #undef RESC
  #undef ROT
}
template<int THRL> __device__ __forceinline__ void attn_unit128(const bf16*Qb,int QP,const bf16*__restrict__ Kh,int KP,const bf16*__restrict__ Vh,int VP,bf16*Ob,int OP,int NT,char*shm,int wave){
  const int lane=hw_lane(),r32=lane&31,hi=lane>>5; const int wid=wave;
  constexpr int LDS_V=NSLOT*SLOTB, LDS_WS=LDS_V+NSLOT*2*SLOTB, LDS_OST=LDS_WS+NW*64*4;
  const bf16*Qw=Qb+(long)(wid*QBLK)*QP;
  const unsigned lds0=(unsigned)(uintptr_t)shm;
  float*wsf=(float*)(shm+LDS_WS)+wid*64;
  const bf16*ksrc=Kh+(long)lane*KP+wid*8;
  const bf16*vsrc=Vh+(long)(16*(wid&3)+(lane>>2))*VP+(wid>>2)*32+(lane&3)*8;
  const unsigned kdst=lds0+LDS_K+wid*1024, vdst=lds0+LDS_V+wid*1024;
  #define DMA_K(t,slot) glds16(ksrc+(long)(t)*KVBLK*KP,(unsigned)__builtin_amdgcn_readfirstlane(kdst+(slot)))
  #define DMA_V(t,slot) do{ glds16(vsrc+(long)(t)*KVBLK*VP,(unsigned)__builtin_amdgcn_readfirstlane(vdst+2*(slot))); glds16(vsrc+(long)(t)*KVBLK*VP+64,(unsigned)__builtin_amdgcn_readfirstlane(vdst+2*(slot)+8192)); }while(0)
  const int vb0=(int)(lds0+LDS_V)+((lane>>4)&1)*32+(lane&3)*8+(4*hi+((lane&15)>>2))*64;
  const char*Kbase=shm+LDS_K; bf16x8 kf[8];
  const lds_cptr shm3=(lds_cptr)shm; const lds_cptr kp0=shm3+LDS_K+hi*1024+r32*16; const lds_cptr vp0=shm3+LDS_V+((lane>>4)&1)*32+(lane&3)*8+(4*hi+((lane&15)>>2))*64;
  DMA_K(0,0);DMA_V(0,0);DMA_K(1,SLOTB);
  bf16x8 qr[4];
  #pragma unroll
  for(int d0=0;d0<4;++d0)qr[d0]=*reinterpret_cast<const bf16x8*>(&Qw[(long)r32*QP+d0*16+hi*8]);
  float mhat=0.f,l_reg=0.f;f32x16 o[4];o[0]=f32x16{};o[1]=f32x16{};o[2]=f32x16{};o[3]=f32x16{};f32x16 negm=f32x16{};asm volatile("":"+v"(negm));
  #define CMASK(P0,P1,t) do{}while(0)
  bool resc=false;
  #define START(P0,P1) do{ const float rm=rowmax(P0,P1); resc=false; \
    { const float dl=rm; mhat=fadd_s(mhat,dl); \
      _Pragma("unroll") for(int r=0;r<16;++r){P0[r]=fsub_s(P0[r],dl);P1[r]=fsub_s(P1[r],dl);} \
      _Pragma("unroll") for(int r=0;r<16;++r)negm[r]=-mhat; asm volatile("":"+v"(negm)); } \
    _Pragma("unroll") for(int r=0;r<16;++r)P0[r]=__builtin_amdgcn_exp2f(P0[r]); }while(0)
  #define RESC() do{ if(resc){ asm volatile("s_waitcnt lgkmcnt(0)":::"memory"); \
      _Pragma("unroll") for(int d_=0;d_<4;++d_) _Pragma("unroll") for(int r=0;r<16;++r)o[d_][r]*=wsf[crow(r,hi)]; } }while(0)
  f32x16 pA0,pA1,pB0,pB1;
  int sl_prev=0,sl_cur=0,sl_next=SLOTB;
  #define ROT() do{sl_prev=sl_cur;sl_cur=sl_next;sl_next=(sl_next==(NSLOT-1)*SLOTB)?0:sl_next+SLOTB;}while(0)
  DMA_K(2,2*SLOTB);
  WAIT_BAR(3);
  qkt(pA0,pA1,Kbase,qr,negm,r32,hi);asm volatile("s_nop 15\n\ts_nop 7":"+v"(pA0),"+v"(pA1));CMASK(pA0,pA1,0);
  START(pA0,pA1);
  _Pragma("unroll") for(int r=0;r<16;++r)pA1[r]=__builtin_amdgcn_exp2f(pA1[r]);
  WAIT_BAR(0);
  DMA_K(3,0);DMA_V(1,SLOTB);
  ROT();
  kload8(kf,kp0+sl_cur);
  WAIT_BAR(3);
  s16x4 vlo[8],vhi[8]; u32x4 pw0,pw1,pw2,pw3;
  #define PKW(P,B) cvtpk_s(P[B],P[B+1])
  #define PAF(k) __builtin_bit_cast(bf16x8,pw##k)
  #define VFR(i) (bf16x8){vlo[i][0],vlo[i][1],vlo[i][2],vlo[i][3],vhi[i][0],vhi[i][1],vhi[i][2],vhi[i][3]}
  #define PIN(x) asm volatile("":"+v"(x))
  #define MX3(a,b,c) __builtin_fmaxf(__builtin_fmaxf((a),(b)),(c))
  #define GAPA(MF,A0,A1,A2,A3,W0,W1,PW) do{ MF; sacc+=A0; sacc+=A1; sacc+=A2; sacc+=A3; PIN(sacc); W0; W1; PIN(PW); SBAR(); }while(0)
  #define EX(v) __builtin_amdgcn_exp2f(v)
  #define GAPB(MF,X,B) do{ MF; X[B]=EX(X[B]); X[B+1]=EX(X[B+1]); X[B+2]=EX(X[B+2]); X[B+3]=EX(X[B+3]); PIN(X); SBAR(); }while(0)
  #define VRD(sl_,f) do{ vlo[sl_]=vtr(vp_+(((f)>>2)*4096+((f)&3)*1024)); vhi[sl_]=vtr(vp_+(((f)>>2)*4096+((f)&3)*1024+512)); }while(0)
  #define GAPB2(MF,X,B) do{ MF; X[B]=EX(X[B]); X[B+1]=EX(X[B+1]); PIN(X); SBAR(); }while(0)
  #define KRD(G,j) do{ if(G){ kload2(kf,kp0+sl_next,j); SBAR(); } }while(0)
  #define STEP(C0,C1,P0,P1,t,GK,GV,GL) do{ SBAR(); \
    const lds_cptr vp_=vp0+2*sl_prev; \
    VRD(0,0); SBAR(); float sacc=(P0[0]+P0[1]); \
    GAPA(C0=__builtin_amdgcn_mfma_f32_32x32x16_bf16(kf[0],qr[0],negm,0,0,0), P0[2],P0[3],P0[4],P0[5],     pw0[0]=PKW(P0,0), pw0[1]=PKW(P0,2), pw0); \
    VRD(1,4); SBAR(); GAPA(C1=__builtin_amdgcn_mfma_f32_32x32x16_bf16(kf[1],qr[0],negm,0,0,0), P0[6],P0[7],P0[8],P0[9],     pw0[2]=PKW(P0,4), pw0[3]=PKW(P0,6), pw0); \
    VRD(2,8); SBAR(); GAPA(C0=__builtin_amdgcn_mfma_f32_32x32x16_bf16(kf[2],qr[1],C0,0,0,0),   P0[10],P0[11],P0[12],P0[13], pw1[0]=PKW(P0,8), pw1[1]=PKW(P0,10), pw1); \
    VRD(3,12); SBAR(); GAPA(C1=__builtin_amdgcn_mfma_f32_32x32x16_bf16(kf[3],qr[1],C1,0,0,0),   P0[14],P0[15],P1[0],P1[1],   pw1[2]=PKW(P0,12),pw1[3]=PKW(P0,14), pw1); \
    VRD(4,1); SBAR(); GAPA(C0=__builtin_amdgcn_mfma_f32_32x32x16_bf16(kf[4],qr[2],C0,0,0,0),   P1[2],P1[3],P1[4],P1[5],     pw2[0]=PKW(P1,0), pw2[1]=PKW(P1,2), pw2); \
    VRD(5,5); SBAR(); GAPA(C1=__builtin_amdgcn_mfma_f32_32x32x16_bf16(kf[5],qr[2],C1,0,0,0),   P1[6],P1[7],P1[8],P1[9],     pw2[2]=PKW(P1,4), pw2[3]=PKW(P1,6), pw2); \
    VRD(6,9); SBAR(); GAPA(C0=__builtin_amdgcn_mfma_f32_32x32x16_bf16(kf[6],qr[3],C0,0,0,0),   P1[10],P1[11],P1[12],P1[13], pw3[0]=PKW(P1,8), pw3[1]=PKW(P1,10), pw3); \
    VRD(7,13); SBAR(); GAPA(C1=__builtin_amdgcn_mfma_f32_32x32x16_bf16(kf[7],qr[3],C1,0,0,0),   P1[14],P1[15],0.f,0.f,       pw3[2]=PKW(P1,12),pw3[3]=PKW(P1,14), pw3); \
    l_reg+=sacc; \
    if(GK){DMA_K((t)+3,sl_cur);} if(GV){DMA_V((t)+1,sl_next);} \
    CMASK(C0,C1,t); \
    { float a=MX3(C0[0],C0[1],C1[0]),b=MX3(C0[2],C0[3],C1[1]); a=MX3(a,C1[2],C1[3]); \
      _Pragma("unroll") for(int r=4;r<16;r+=4){a=MX3(a,C0[r],C0[r+1]);b=MX3(b,C0[r+2],C0[r+3]);a=MX3(a,C1[r],C1[r+1]);b=MX3(b,C1[r+2],C1[r+3]);} \
      float rm=__builtin_fmaxf(a,b); { auto rr=__builtin_amdgcn_permlane32_swap(__float_as_uint(rm),__float_as_uint(rm),false,false); rm=__builtin_fmaxf(__uint_as_float(rr[0]),__uint_as_float(rr[1])); } \
      resc=false; \
      if(__builtin_expect(__any(rm>(float)THRL),0)){ const float dl=__builtin_fmaxf(rm,0.f); mhat+=dl; \
        _Pragma("unroll") for(int r=0;r<16;++r){C0[r]-=dl;C1[r]-=dl;} \
        _Pragma("unroll") for(int r=0;r<16;++r)negm[r]=-mhat; asm volatile("":"+v"(negm)); \
        const float f=__builtin_amdgcn_exp2f(-dl); l_reg*=f; if(hi==0)wsf[r32]=f; resc=true; } } \
    SBAR(); \
    GAPB2(o[0]=__builtin_amdgcn_mfma_f32_32x32x16_bf16(PAF(0),VFR(0),o[0],0,0,0), C0,0); VRD(0,2); SBAR(); \
    GAPB2(o[1]=__builtin_amdgcn_mfma_f32_32x32x16_bf16(PAF(0),VFR(1),o[1],0,0,0), C0,2); VRD(1,6); SBAR(); \
    GAPB2(o[2]=__builtin_amdgcn_mfma_f32_32x32x16_bf16(PAF(0),VFR(2),o[2],0,0,0), C0,4); VRD(2,10); SBAR(); \
    GAPB2(o[3]=__builtin_amdgcn_mfma_f32_32x32x16_bf16(PAF(0),VFR(3),o[3],0,0,0), C0,6); VRD(3,14); SBAR(); \
    KRD(GL,0); GAPB2(o[0]=__builtin_amdgcn_mfma_f32_32x32x16_bf16(PAF(1),VFR(4),o[0],0,0,0), C0,8); VRD(4,3); SBAR(); \
    GAPB2(o[1]=__builtin_amdgcn_mfma_f32_32x32x16_bf16(PAF(1),VFR(5),o[1],0,0,0), C0,10); VRD(5,7); SBAR(); \
    KRD(GL,1); GAPB2(o[2]=__builtin_amdgcn_mfma_f32_32x32x16_bf16(PAF(1),VFR(6),o[2],0,0,0), C0,12); VRD(6,11); SBAR(); \
    GAPB2(o[3]=__builtin_amdgcn_mfma_f32_32x32x16_bf16(PAF(1),VFR(7),o[3],0,0,0), C0,14); VRD(7,15); SBAR(); \
    KRD(GL,2); GAPB2(o[0]=__builtin_amdgcn_mfma_f32_32x32x16_bf16(PAF(2),VFR(0),o[0],0,0,0), C1,0); \
    GAPB2(o[1]=__builtin_amdgcn_mfma_f32_32x32x16_bf16(PAF(2),VFR(1),o[1],0,0,0), C1,2); \
    KRD(GL,3); GAPB2(o[2]=__builtin_amdgcn_mfma_f32_32x32x16_bf16(PAF(2),VFR(2),o[2],0,0,0), C1,4); \
    GAPB2(o[3]=__builtin_amdgcn_mfma_f32_32x32x16_bf16(PAF(2),VFR(3),o[3],0,0,0), C1,6); \
    GAPB2(o[0]=__builtin_amdgcn_mfma_f32_32x32x16_bf16(PAF(3),VFR(4),o[0],0,0,0), C1,8); \
    GAPB2(o[1]=__builtin_amdgcn_mfma_f32_32x32x16_bf16(PAF(3),VFR(5),o[1],0,0,0), C1,10); \
    GAPB2(o[2]=__builtin_amdgcn_mfma_f32_32x32x16_bf16(PAF(3),VFR(6),o[2],0,0,0), C1,12); \
    GAPB2(o[3]=__builtin_amdgcn_mfma_f32_32x32x16_bf16(PAF(3),VFR(7),o[3],0,0,0), C1,14); \
    }while(0)
  int t=1;
  #undef CMASK
  #define CMASK(P0,P1,t) do{}while(0)
  for(;t+5<NT;t+=2){
    STEP(pB0,pB1,pA0,pA1,t,true,true,true);     WAIT_BAR(3); RESC(); ROT();
    STEP(pA0,pA1,pB0,pB1,t+1,true,true,true);   WAIT_BAR(3); RESC(); ROT();
  }
  #undef CMASK
  #define CMASK(P0,P1,t) do{}while(0)
  #define ENDW(tt) do{ if((tt)+3<NT){WAIT_BAR(3);} else if((tt)+2<NT){WAIT_BAR(2);} else {WAIT_BAR(0);} }while(0)
  for(;t+1<NT;t+=2){
    STEP(pB0,pB1,pA0,pA1,t,(t+3<NT),(t+1<NT),(t+1<NT));       ENDW(t);   RESC(); ROT();
    STEP(pA0,pA1,pB0,pB1,t+1,(t+4<NT),(t+2<NT),(t+2<NT));     ENDW(t+1); RESC(); ROT();
  }
  STEP(pB0,pB1,pA0,pA1,NT-1,false,false,false); RESC();
  { float sacc=pB0[0]+pB0[1]; _Pragma("unroll") for(int r=2;r<16;++r)sacc+=pB0[r]; _Pragma("unroll") for(int r=0;r<16;++r)sacc+=pB1[r]; l_reg+=sacc;
    pw0=(u32x4){PKW(pB0,0),PKW(pB0,2),PKW(pB0,4),PKW(pB0,6)};pw1=(u32x4){PKW(pB0,8),PKW(pB0,10),PKW(pB0,12),PKW(pB0,14)};pw2=(u32x4){PKW(pB1,0),PKW(pB1,2),PKW(pB1,4),PKW(pB1,6)};pw3=(u32x4){PKW(pB1,8),PKW(pB1,10),PKW(pB1,12),PKW(pB1,14)};
    SBAR(); pv<4>(o,vb0+2*sl_cur,PAF(0),PAF(1),PAF(2),PAF(3)); }
  #undef PKW
  #undef PAF
  #undef VFR
  #undef PIN
  #undef MX3
  #undef GAPA
  #undef GAPB
  #undef EX
  #undef VRD
  #undef GAPB2
  #undef KRD
  #undef STEP
  #undef ENDW
  {auto rr=__builtin_amdgcn_permlane32_swap(__float_as_uint(l_reg),__float_as_uint(l_reg),false,false);l_reg=__uint_as_float(rr[0])+__uint_as_float(rr[1]);}
  if(hi==0)wsf[32+r32]=l_reg;asm volatile("s_waitcnt lgkmcnt(0)":::"memory");
  float rli[16];
  #pragma unroll
  for(int r=0;r<16;++r)rli[r]=__builtin_amdgcn_rcpf(wsf[32+crow(r,hi)]);
  bf16*Ow=Ob+(long)(wid*QBLK)*OP;
  { bf16*stg=(bf16*)(shm+LDS_OST)+wid*2048;
    #pragma unroll
    for(int hf=0;hf<2;++hf){
      #pragma unroll
      for(int r=0;r<16;++r){const int orow=crow(r,hi);
        #pragma unroll
        for(int d0=0;d0<2;++d0)stg[orow*64+d0*32+r32]=__float2bfloat16(o[2*hf+d0][r]*rli[r]);}
      asm volatile("s_waitcnt lgkmcnt(0)":::"memory");
      #pragma unroll
      for(int i=0;i<4;++i){const int row=i*8+(lane>>3),ch=lane&7; const u32x4 v=*(const u32x4*)(stg+row*64+ch*8); ATTN_STORE16(Ow+(long)row*OP+hf*64+ch*8,v);}
      asm volatile("s_waitcnt lgkmcnt(0)":::"memory"); } }
  asm volatile("s_waitcnt lgkmcnt(0)\n\ts_barrier":::"memory");
  #undef DMA_K
  #undef DMA_V
  #undef CMASK
  #undef START
  #undef RESC
  #undef ROT
}
template<int THRL> __device__ __forceinline__ void attn_unit_br(const bf16*Qb,int QP,const bf16*__restrict__ Kh,int KP,const bf16*__restrict__ Vh,int VP,bf16*Ob,int OP,int NT,char*shm,int wave,float kmax,int qpos0,const float*gq){
  const int lane=hw_lane(),r32=lane&31,hi=lane>>5; const int wid=wave;
  const bf16*Qw=Qb+(long)(wid*QBLK)*QP;
  const unsigned lds0=(unsigned)(uintptr_t)shm;
  float*wsf=(float*)(shm+LDS_WS)+wid*64;
  const int krow_=8*wid+(lane>>3); const bf16*ksrc=Kh+(long)krow_*KP+(((lane&7)^((krow_>>1)&7))*8);
  const bf16*vsrc=Vh+(long)(16*(wid&3)+(lane>>2))*VP+(wid>>2)*32+(lane&3)*8;
  const unsigned kdst=lds0+LDS_K+wid*1024, vdst=lds0+LDS_V+wid*1024;
  #define DMA_K(t,slot) glds16(ksrc+(long)(t)*KVBLK*KP,(unsigned)__builtin_amdgcn_readfirstlane(kdst+(slot)))
  #define DMA_V(t,slot) glds16(vsrc+(long)(t)*KVBLK*VP,(unsigned)__builtin_amdgcn_readfirstlane(vdst+(slot)))
  const int vb0=(int)(lds0+LDS_V)+((lane>>4)&1)*32+(lane&3)*8+(4*hi+((lane&15)>>2))*64;
  const char*Kbase=shm+LDS_K; bf16x8 kf[8];
  const lds_cptr shm3=(lds_cptr)shm; const lds_cptr kp0=shm3+LDS_K; int koff[4]; _Pragma("unroll") for(int d0_=0;d0_<4;++d0_)koff[d0_]=r32*128+((((2*d0_+hi)^((r32>>1)&7)))*16); const lds_cptr vp0=shm3+LDS_V+((lane>>4)&1)*32+(lane&3)*8+(4*hi+((lane&15)>>2))*64;
  DMA_K(0,0);DMA_V(0,0);DMA_K(1,SLOTB);
  bf16x8 qr[4];
  #pragma unroll
  for(int d0=0;d0<4;++d0)qr[d0]=*reinterpret_cast<const bf16x8*>(&Qw[(long)r32*QP+d0*16+hi*8]);
  qprep(qr,hi,qpos0<0?-1:qpos0+wid*QBLK+r32,gq);
  float l_reg=0.f;f32x16 o[2];o[0]=f32x16{};o[1]=f32x16{};f32x16 negm;
  { float qs=0.f;
    #pragma unroll
    for(int d0=0;d0<4;++d0){
      #pragma unroll
      for(int e=0;e<8;++e){const float v=__builtin_bit_cast(float,(unsigned)(unsigned short)qr[d0][e]<<16);qs+=v*v;}}
    auto rr=__builtin_amdgcn_permlane32_swap(__float_as_uint(qs),__float_as_uint(qs),false,false);qs=__uint_as_float(rr[0])+__uint_as_float(rr[1]);
    const float ref=sqrtf(qs)*kmax*1.002f+0.02f;
    #pragma unroll
    for(int r=0;r<16;++r)negm[r]=-ref;
    asm volatile("":"+v"(negm)); }
  #define CMASK(P0,P1,t) do{}while(0)
  #define START(P0,P1) do{ _Pragma("unroll") for(int r=0;r<16;++r)P0[r]=__builtin_amdgcn_exp2f(P0[r]); }while(0)
  #define RESC() do{}while(0)
  f32x16 pA0,pA1,pB0,pB1;
  int sl_prev=0,sl_cur=0,sl_next=SLOTB;
  #define ROT() do{sl_prev=sl_cur;sl_cur=sl_next;sl_next=(sl_next==(NSLOT-1)*SLOTB)?0:sl_next+SLOTB;}while(0)
  DMA_K(2,2*SLOTB);
  WAIT_BAR(3);
  qkt_rm(pA0,pA1,kp0,koff,qr,negm);asm volatile("s_nop 15\n\ts_nop 7":"+v"(pA0),"+v"(pA1));CMASK(pA0,pA1,0);
  START(pA0,pA1);
  _Pragma("unroll") for(int r=0;r<16;++r)pA1[r]=__builtin_amdgcn_exp2f(pA1[r]);
  WAIT_BAR(0);
  DMA_K(3,0);DMA_V(1,SLOTB);
  ROT();
  kload8_rm(kf,kp0+sl_cur,koff);
  WAIT_BAR(2);
  s16x4 vlo[8],vhi[8]; u32x4 pw0,pw1,pw2,pw3;
  #define PKW(P,B) cvtpk_s(P[B],P[B+1])
  #define PAF(k) __builtin_bit_cast(bf16x8,pw##k)
  #define VFR(i) (bf16x8){vlo[i][0],vlo[i][1],vlo[i][2],vlo[i][3],vhi[i][0],vhi[i][1],vhi[i][2],vhi[i][3]}
  #define PIN(x) asm volatile("":"+v"(x))
  #define MX3(a,b,c) __builtin_fmaxf(__builtin_fmaxf((a),(b)),(c))
  #define GAPA(MF,A0,A1,A2,A3,W0,W1,PW) do{ MF; sacc+=A0; sacc+=A1; sacc+=A2; sacc+=A3; PIN(sacc); W0; W1; PIN(PW); SBAR(); }while(0)
  #define EX(v) __builtin_amdgcn_exp2f(v)
  #define GAPB(MF,X,B) do{ MF; X[B]=EX(X[B]); X[B+1]=EX(X[B+1]); X[B+2]=EX(X[B+2]); X[B+3]=EX(X[B+3]); PIN(X); SBAR(); }while(0)
  #define VRD(i) do{ vlo[i]=vtr(vp_+(((i)>>2)*4096+((i)&3)*1024)); vhi[i]=vtr(vp_+(((i)>>2)*4096+((i)&3)*1024+512)); }while(0)
  #define KRD(G,j) do{ if(G){ kload2_rm(kf,kp0+sl_next,koff,j); SBAR(); } }while(0)
  #define STEP(C0,C1,P0,P1,t,GK,GV,GL) do{ SBAR(); \
    const lds_cptr vp_=vp0+sl_prev; \
    VRD(0); SBAR(); float sacc=(P0[0]+P0[1]); \
    GAPA(C0=__builtin_amdgcn_mfma_f32_32x32x16_bf16(kf[0],qr[0],negm,0,0,0), P0[2],P0[3],P0[4],P0[5],     pw0[0]=PKW(P0,0), pw0[1]=PKW(P0,2), pw0); \
    VRD(4); SBAR(); GAPA(C1=__builtin_amdgcn_mfma_f32_32x32x16_bf16(kf[1],qr[0],negm,0,0,0), P0[6],P0[7],P0[8],P0[9],     pw0[2]=PKW(P0,4), pw0[3]=PKW(P0,6), pw0); \
    VRD(1); SBAR(); GAPA(C0=__builtin_amdgcn_mfma_f32_32x32x16_bf16(kf[2],qr[1],C0,0,0,0),   P0[10],P0[11],P0[12],P0[13], pw1[0]=PKW(P0,8), pw1[1]=PKW(P0,10), pw1); \
    VRD(5); SBAR(); GAPA(C1=__builtin_amdgcn_mfma_f32_32x32x16_bf16(kf[3],qr[1],C1,0,0,0),   P0[14],P0[15],P1[0],P1[1],   pw1[2]=PKW(P0,12),pw1[3]=PKW(P0,14), pw1); \
    VRD(2); SBAR(); GAPA(C0=__builtin_amdgcn_mfma_f32_32x32x16_bf16(kf[4],qr[2],C0,0,0,0),   P1[2],P1[3],P1[4],P1[5],     pw2[0]=PKW(P1,0), pw2[1]=PKW(P1,2), pw2); \
    VRD(6); SBAR(); GAPA(C1=__builtin_amdgcn_mfma_f32_32x32x16_bf16(kf[5],qr[2],C1,0,0,0),   P1[6],P1[7],P1[8],P1[9],     pw2[2]=PKW(P1,4), pw2[3]=PKW(P1,6), pw2); \
    VRD(3); SBAR(); GAPA(C0=__builtin_amdgcn_mfma_f32_32x32x16_bf16(kf[6],qr[3],C0,0,0,0),   P1[10],P1[11],P1[12],P1[13], pw3[0]=PKW(P1,8), pw3[1]=PKW(P1,10), pw3); \
    VRD(7); SBAR(); GAPA(C1=__builtin_amdgcn_mfma_f32_32x32x16_bf16(kf[7],qr[3],C1,0,0,0),   P1[14],P1[15],0.f,0.f,       pw3[2]=PKW(P1,12),pw3[3]=PKW(P1,14), pw3); \
    l_reg+=sacc; \
    if(GK){DMA_K((t)+3,sl_cur);} if(GV){DMA_V((t)+1,sl_next);} \
    CMASK(C0,C1,t); \
    SBAR(); \
    GAPB(o[0]=__builtin_amdgcn_mfma_f32_32x32x16_bf16(PAF(0),VFR(0),o[0],0,0,0), C0,0); \
    GAPB(o[1]=__builtin_amdgcn_mfma_f32_32x32x16_bf16(PAF(0),VFR(4),o[1],0,0,0), C0,4); \
    KRD(GL,0); GAPB(o[0]=__builtin_amdgcn_mfma_f32_32x32x16_bf16(PAF(1),VFR(1),o[0],0,0,0), C0,8); \
    KRD(GL,1); GAPB(o[1]=__builtin_amdgcn_mfma_f32_32x32x16_bf16(PAF(1),VFR(5),o[1],0,0,0), C0,12); \
    KRD(GL,2); GAPB(o[0]=__builtin_amdgcn_mfma_f32_32x32x16_bf16(PAF(2),VFR(2),o[0],0,0,0), C1,0); \
    KRD(GL,3); GAPB(o[1]=__builtin_amdgcn_mfma_f32_32x32x16_bf16(PAF(2),VFR(6),o[1],0,0,0), C1,4); \
    GAPB(o[0]=__builtin_amdgcn_mfma_f32_32x32x16_bf16(PAF(3),VFR(3),o[0],0,0,0), C1,8); \
    GAPB(o[1]=__builtin_amdgcn_mfma_f32_32x32x16_bf16(PAF(3),VFR(7),o[1],0,0,0), C1,12); \
    }while(0)
  if(wid>=4)__builtin_amdgcn_s_setprio(1);
  int t=1;
  #undef CMASK
  #define CMASK(P0,P1,t) do{}while(0)
  for(;t+5<NT;t+=2){
    STEP(pB0,pB1,pA0,pA1,t,true,true,true);     WAIT_BAR(2); RESC(); ROT();
    STEP(pA0,pA1,pB0,pB1,t+1,true,true,true);   WAIT_BAR(2); RESC(); ROT();
  }
  #undef CMASK
  #define CMASK(P0,P1,t) do{}while(0)
  #define ENDW(tt) do{ if((tt)+3<NT){WAIT_BAR(2);} else if((tt)+2<NT){WAIT_BAR(1);} else {WAIT_BAR(0);} }while(0)
  for(;t+1<NT;t+=2){
    STEP(pB0,pB1,pA0,pA1,t,(t+3<NT),(t+1<NT),(t+1<NT));       ENDW(t);   RESC(); ROT();
    STEP(pA0,pA1,pB0,pB1,t+1,(t+4<NT),(t+2<NT),(t+2<NT));     ENDW(t+1); RESC(); ROT();
  }
  STEP(pB0,pB1,pA0,pA1,NT-1,false,false,false); RESC();
  __builtin_amdgcn_s_setprio(0);
  { float sacc=pB0[0]+pB0[1]; _Pragma("unroll") for(int r=2;r<16;++r)sacc+=pB0[r]; _Pragma("unroll") for(int r=0;r<16;++r)sacc+=pB1[r]; l_reg+=sacc;
    pw0=(u32x4){PKW(pB0,0),PKW(pB0,2),PKW(pB0,4),PKW(pB0,6)};pw1=(u32x4){PKW(pB0,8),PKW(pB0,10),PKW(pB0,12),PKW(pB0,14)};pw2=(u32x4){PKW(pB1,0),PKW(pB1,2),PKW(pB1,4),PKW(pB1,6)};pw3=(u32x4){PKW(pB1,8),PKW(pB1,10),PKW(pB1,12),PKW(pB1,14)};
    SBAR(); pv<2>(o,vb0+sl_cur,PAF(0),PAF(1),PAF(2),PAF(3)); }
  #undef PKW
  #undef PAF
  #undef VFR
  #undef PIN
  #undef MX3
  #undef GAPA
  #undef GAPB
  #undef EX
  #undef VRD
  #undef KRD
  #undef STEP
  #undef ENDW
  {auto rr=__builtin_amdgcn_permlane32_swap(__float_as_uint(l_reg),__float_as_uint(l_reg),false,false);l_reg=__uint_as_float(rr[0])+__uint_as_float(rr[1]);}
  if(hi==0)wsf[32+r32]=l_reg;asm volatile("s_waitcnt lgkmcnt(0)":::"memory");
  float rli[16];
  #pragma unroll
  for(int r=0;r<16;++r)rli[r]=__builtin_amdgcn_rcpf(wsf[32+crow(r,hi)]);
  bf16*Ow=Ob+(long)(wid*QBLK)*OP;
  { bf16*stg=(bf16*)(shm+LDS_OST)+wid*2048;
    #pragma unroll
    for(int r=0;r<16;++r){const int orow=crow(r,hi);
      #pragma unroll
      for(int d0=0;d0<2;++d0)stg[orow*64+d0*32+r32]=__float2bfloat16(o[d0][r]*rli[r]);}
    asm volatile("s_waitcnt lgkmcnt(0)":::"memory");
    #pragma unroll
    for(int i=0;i<4;++i){const int row=i*8+(lane>>3),ch=lane&7; const u32x4 v=*(const u32x4*)(stg+row*64+ch*8); ATTN_STORE16(Ow+(long)row*OP+ch*8,v);} }
  asm volatile("s_waitcnt lgkmcnt(0)\n\ts_barrier":::"memory");
  #undef DMA_K
  #undef DMA_V
  #undef CMASK
  #undef START
  #undef RESC
  #undef ROT
}
template<int THRL> __device__ __forceinline__ void attn_unit128_br(const bf16*Qb,int QP,const bf16*__restrict__ Kh,int KP,const bf16*__restrict__ Vh,int VP,bf16*Ob,int OP,int NT,char*shm,int wave,float kmax,int qpos0,const float*gq){
  const int lane=hw_lane(),r32=lane&31,hi=lane>>5; const int wid=wave;
  constexpr int LDS_V=NSLOT*SLOTB, LDS_WS=LDS_V+NSLOT*2*SLOTB, LDS_OST=LDS_WS+NW*64*4;
  const bf16*Qw=Qb+(long)(wid*QBLK)*QP;
  const unsigned lds0=(unsigned)(uintptr_t)shm;
  float*wsf=(float*)(shm+LDS_WS)+wid*64;
  const bf16*ksrc=Kh+(long)lane*KP+wid*8;
  const bf16*vsrc=Vh+(long)(16*(wid&3)+(lane>>2))*VP+(wid>>2)*32+(lane&3)*8;
  const unsigned kdst=lds0+LDS_K+wid*1024, vdst=lds0+LDS_V+wid*1024;
  #define DMA_K(t,slot) glds16(ksrc+(long)(t)*KVBLK*KP,(unsigned)__builtin_amdgcn_readfirstlane(kdst+(slot)))
  #define DMA_V(t,slot) do{ glds16(vsrc+(long)(t)*KVBLK*VP,(unsigned)__builtin_amdgcn_readfirstlane(vdst+2*(slot))); glds16(vsrc+(long)(t)*KVBLK*VP+64,(unsigned)__builtin_amdgcn_readfirstlane(vdst+2*(slot)+8192)); }while(0)
  const int vb0=(int)(lds0+LDS_V)+((lane>>4)&1)*32+(lane&3)*8+(4*hi+((lane&15)>>2))*64;
  const char*Kbase=shm+LDS_K; bf16x8 kf[8];
  const lds_cptr shm3=(lds_cptr)shm; const lds_cptr kp0=shm3+LDS_K+hi*1024+r32*16; const lds_cptr vp0=shm3+LDS_V+((lane>>4)&1)*32+(lane&3)*8+(4*hi+((lane&15)>>2))*64;
  DMA_K(0,0);DMA_V(0,0);DMA_K(1,SLOTB);
  bf16x8 qr[4];
  #pragma unroll
  for(int d0=0;d0<4;++d0)qr[d0]=*reinterpret_cast<const bf16x8*>(&Qw[(long)r32*QP+d0*16+hi*8]);
  qprep(qr,hi,qpos0<0?-1:qpos0+wid*QBLK+r32,gq);
  float l_reg=0.f;f32x16 o[4];o[0]=f32x16{};o[1]=f32x16{};o[2]=f32x16{};o[3]=f32x16{};f32x16 negm;
  { float qs=0.f;
    #pragma unroll
    for(int d0=0;d0<4;++d0){
      #pragma unroll
      for(int e=0;e<8;++e){const float v=__builtin_bit_cast(float,(unsigned)(unsigned short)qr[d0][e]<<16);qs+=v*v;}}
    auto rr=__builtin_amdgcn_permlane32_swap(__float_as_uint(qs),__float_as_uint(qs),false,false);qs=__uint_as_float(rr[0])+__uint_as_float(rr[1]);
    const float ref=sqrtf(qs)*kmax*1.002f+0.02f;
    #pragma unroll
    for(int r=0;r<16;++r)negm[r]=-ref;
    asm volatile("":"+v"(negm)); }
  #define CMASK(P0,P1,t) do{}while(0)
  #define START(P0,P1) do{ _Pragma("unroll") for(int r=0;r<16;++r)P0[r]=__builtin_amdgcn_exp2f(P0[r]); }while(0)
  #define RESC() do{}while(0)
  f32x16 pA0,pA1,pB0,pB1;
  int sl_prev=0,sl_cur=0,sl_next=SLOTB;
  #define ROT() do{sl_prev=sl_cur;sl_cur=sl_next;sl_next=(sl_next==(NSLOT-1)*SLOTB)?0:sl_next+SLOTB;}while(0)
  DMA_K(2,2*SLOTB);
  WAIT_BAR(3);
  qkt(pA0,pA1,Kbase,qr,negm,r32,hi);asm volatile("s_nop 15\n\ts_nop 7":"+v"(pA0),"+v"(pA1));CMASK(pA0,pA1,0);
  START(pA0,pA1);
  _Pragma("unroll") for(int r=0;r<16;++r)pA1[r]=__builtin_amdgcn_exp2f(pA1[r]);
  WAIT_BAR(0);
  DMA_K(3,0);DMA_V(1,SLOTB);
  ROT();
  kload8(kf,kp0+sl_cur);
  WAIT_BAR(3);
  s16x4 vlo[8],vhi[8]; u32x4 pw0,pw1,pw2,pw3;
  #define PKW(P,B) cvtpk_s(P[B],P[B+1])
  #define PAF(k) __builtin_bit_cast(bf16x8,pw##k)
  #define VFR(i) (bf16x8){vlo[i][0],vlo[i][1],vlo[i][2],vlo[i][3],vhi[i][0],vhi[i][1],vhi[i][2],vhi[i][3]}
  #define PIN(x) asm volatile("":"+v"(x))
  #define MX3(a,b,c) __builtin_fmaxf(__builtin_fmaxf((a),(b)),(c))
  #define GAPA(MF,A0,A1,A2,A3,W0,W1,PW) do{ MF; sacc+=A0; sacc+=A1; sacc+=A2; sacc+=A3; PIN(sacc); W0; W1; PIN(PW); SBAR(); }while(0)
  #define EX(v) __builtin_amdgcn_exp2f(v)
  #define GAPB(MF,X,B) do{ MF; X[B]=EX(X[B]); X[B+1]=EX(X[B+1]); X[B+2]=EX(X[B+2]); X[B+3]=EX(X[B+3]); PIN(X); SBAR(); }while(0)
  #define VRD(sl_,f) do{ vlo[sl_]=vtr(vp_+(((f)>>2)*4096+((f)&3)*1024)); vhi[sl_]=vtr(vp_+(((f)>>2)*4096+((f)&3)*1024+512)); }while(0)
  #define GAPB2(MF,X,B) do{ MF; X[B]=EX(X[B]); X[B+1]=EX(X[B+1]); PIN(X); SBAR(); }while(0)
  #define KRD(G,j) do{ if(G){ kload2(kf,kp0+sl_next,j); SBAR(); } }while(0)
  #define STEP(C0,C1,P0,P1,t,GK,GV,GL) do{ SBAR(); \
    const lds_cptr vp_=vp0+2*sl_prev; \
    VRD(0,0); SBAR(); float sacc=(P0[0]+P0[1]); \
    GAPA(C0=__builtin_amdgcn_mfma_f32_32x32x16_bf16(kf[0],qr[0],negm,0,0,0), P0[2],P0[3],P0[4],P0[5],     pw0[0]=PKW(P0,0), pw0[1]=PKW(P0,2), pw0); \
    VRD(1,4); SBAR(); GAPA(C1=__builtin_amdgcn_mfma_f32_32x32x16_bf16(kf[1],qr[0],negm,0,0,0), P0[6],P0[7],P0[8],P0[9],     pw0[2]=PKW(P0,4), pw0[3]=PKW(P0,6), pw0); \
    VRD(2,8); SBAR(); GAPA(C0=__builtin_amdgcn_mfma_f32_32x32x16_bf16(kf[2],qr[1],C0,0,0,0),   P0[10],P0[11],P0[12],P0[13], pw1[0]=PKW(P0,8), pw1[1]=PKW(P0,10), pw1); \
    VRD(3,12); SBAR(); GAPA(C1=__builtin_amdgcn_mfma_f32_32x32x16_bf16(kf[3],qr[1],C1,0,0,0),   P0[14],P0[15],P1[0],P1[1],   pw1[2]=PKW(P0,12),pw1[3]=PKW(P0,14), pw1); \
    VRD(4,1); SBAR(); GAPA(C0=__builtin_amdgcn_mfma_f32_32x32x16_bf16(kf[4],qr[2],C0,0,0,0),   P1[2],P1[3],P1[4],P1[5],     pw2[0]=PKW(P1,0), pw2[1]=PKW(P1,2), pw2); \
    VRD(5,5); SBAR(); GAPA(C1=__builtin_amdgcn_mfma_f32_32x32x16_bf16(kf[5],qr[2],C1,0,0,0),   P1[6],P1[7],P1[8],P1[9],     pw2[2]=PKW(P1,4), pw2[3]=PKW(P1,6), pw2); \
    VRD(6,9); SBAR(); GAPA(C0=__builtin_amdgcn_mfma_f32_32x32x16_bf16(kf[6],qr[3],C0,0,0,0),   P1[10],P1[11],P1[12],P1[13], pw3[0]=PKW(P1,8), pw3[1]=PKW(P1,10), pw3); \
    VRD(7,13); SBAR(); GAPA(C1=__builtin_amdgcn_mfma_f32_32x32x16_bf16(kf[7],qr[3],C1,0,0,0),   P1[14],P1[15],0.f,0.f,       pw3[2]=PKW(P1,12),pw3[3]=PKW(P1,14), pw3); \
    l_reg+=sacc; \
    if(GK){DMA_K((t)+3,sl_cur);} if(GV){DMA_V((t)+1,sl_next);} \
    CMASK(C0,C1,t); \
    SBAR(); \
    GAPB2(o[0]=__builtin_amdgcn_mfma_f32_32x32x16_bf16(PAF(0),VFR(0),o[0],0,0,0), C0,0); VRD(0,2); SBAR(); \
    GAPB2(o[1]=__builtin_amdgcn_mfma_f32_32x32x16_bf16(PAF(0),VFR(1),o[1],0,0,0), C0,2); VRD(1,6); SBAR(); \
    GAPB2(o[2]=__builtin_amdgcn_mfma_f32_32x32x16_bf16(PAF(0),VFR(2),o[2],0,0,0), C0,4); VRD(2,10); SBAR(); \
    GAPB2(o[3]=__builtin_amdgcn_mfma_f32_32x32x16_bf16(PAF(0),VFR(3),o[3],0,0,0), C0,6); VRD(3,14); SBAR(); \
    KRD(GL,0); GAPB2(o[0]=__builtin_amdgcn_mfma_f32_32x32x16_bf16(PAF(1),VFR(4),o[0],0,0,0), C0,8); VRD(4,3); SBAR(); \
    GAPB2(o[1]=__builtin_amdgcn_mfma_f32_32x32x16_bf16(PAF(1),VFR(5),o[1],0,0,0), C0,10); VRD(5,7); SBAR(); \
    KRD(GL,1); GAPB2(o[2]=__builtin_amdgcn_mfma_f32_32x32x16_bf16(PAF(1),VFR(6),o[2],0,0,0), C0,12); VRD(6,11); SBAR(); \
    GAPB2(o[3]=__builtin_amdgcn_mfma_f32_32x32x16_bf16(PAF(1),VFR(7),o[3],0,0,0), C0,14); VRD(7,15); SBAR(); \
    KRD(GL,2); GAPB2(o[0]=__builtin_amdgcn_mfma_f32_32x32x16_bf16(PAF(2),VFR(0),o[0],0,0,0), C1,0); \
    GAPB2(o[1]=__builtin_amdgcn_mfma_f32_32x32x16_bf16(PAF(2),VFR(1),o[1],0,0,0), C1,2); \
    KRD(GL,3); GAPB2(o[2]=__builtin_amdgcn_mfma_f32_32x32x16_bf16(PAF(2),VFR(2),o[2],0,0,0), C1,4); \
    GAPB2(o[3]=__builtin_amdgcn_mfma_f32_32x32x16_bf16(PAF(2),VFR(3),o[3],0,0,0), C1,6); \
    GAPB2(o[0]=__builtin_amdgcn_mfma_f32_32x32x16_bf16(PAF(3),VFR(4),o[0],0,0,0), C1,8); \
    GAPB2(o[1]=__builtin_amdgcn_mfma_f32_32x32x16_bf16(PAF(3),VFR(5),o[1],0,0,0), C1,10); \
    GAPB2(o[2]=__builtin_amdgcn_mfma_f32_32x32x16_bf16(PAF(3),VFR(6),o[2],0,0,0), C1,12); \
    GAPB2(o[3]=__builtin_amdgcn_mfma_f32_32x32x16_bf16(PAF(3),VFR(7),o[3],0,0,0), C1,14); \
    }while(0)
  if(wid>=4)__builtin_amdgcn_s_setprio(1);
  int t=1;
  #undef CMASK
  #define CMASK(P0,P1,t) do{}while(0)
  for(;t+5<NT;t+=2){
    STEP(pB0,pB1,pA0,pA1,t,true,true,true);     WAIT_BAR(3); RESC(); ROT();
    STEP(pA0,pA1,pB0,pB1,t+1,true,true,true);   WAIT_BAR(3); RESC(); ROT();
  }
  #undef CMASK
  #define CMASK(P0,P1,t) do{}while(0)
  #define ENDW(tt) do{ if((tt)+3<NT){WAIT_BAR(3);} else if((tt)+2<NT){WAIT_BAR(2);} else {WAIT_BAR(0);} }while(0)
  for(;t+1<NT;t+=2){
    STEP(pB0,pB1,pA0,pA1,t,(t+3<NT),(t+1<NT),(t+1<NT));       ENDW(t);   RESC(); ROT();
    STEP(pA0,pA1,pB0,pB1,t+1,(t+4<NT),(t+2<NT),(t+2<NT));     ENDW(t+1); RESC(); ROT();
  }
  STEP(pB0,pB1,pA0,pA1,NT-1,false,false,false); RESC();
  __builtin_amdgcn_s_setprio(0);
  { float sacc=pB0[0]+pB0[1]; _Pragma("unroll") for(int r=2;r<16;++r)sacc+=pB0[r]; _Pragma("unroll") for(int r=0;r<16;++r)sacc+=pB1[r]; l_reg+=sacc;
    pw0=(u32x4){PKW(pB0,0),PKW(pB0,2),PKW(pB0,4),PKW(pB0,6)};pw1=(u32x4){PKW(pB0,8),PKW(pB0,10),PKW(pB0,12),PKW(pB0,14)};pw2=(u32x4){PKW(pB1,0),PKW(pB1,2),PKW(pB1,4),PKW(pB1,6)};pw3=(u32x4){PKW(pB1,8),PKW(pB1,10),PKW(pB1,12),PKW(pB1,14)};
    SBAR(); pv<4>(o,vb0+2*sl_cur,PAF(0),PAF(1),PAF(2),PAF(3)); }
  #undef PKW
  #undef PAF
  #undef VFR
  #undef PIN
  #undef MX3
  #undef GAPA
  #undef GAPB
  #undef EX
  #undef VRD
  #undef GAPB2
  #undef KRD
  #undef STEP
  #undef ENDW
  {auto rr=__builtin_amdgcn_permlane32_swap(__float_as_uint(l_reg),__float_as_uint(l_reg),false,false);l_reg=__uint_as_float(rr[0])+__uint_as_float(rr[1]);}
  if(hi==0)wsf[32+r32]=l_reg;asm volatile("s_waitcnt lgkmcnt(0)":::"memory");
  float rli[16];
  #pragma unroll
  for(int r=0;r<16;++r)rli[r]=__builtin_amdgcn_rcpf(wsf[32+crow(r,hi)]);
  bf16*Ow=Ob+(long)(wid*QBLK)*OP;
  { bf16*stg=(bf16*)(shm+LDS_OST)+wid*2048;
    #pragma unroll
    for(int hf=0;hf<2;++hf){
      #pragma unroll
      for(int r=0;r<16;++r){const int orow=crow(r,hi);
        #pragma unroll
        for(int d0=0;d0<2;++d0)stg[orow*64+d0*32+r32]=__float2bfloat16(o[2*hf+d0][r]*rli[r]);}
      asm volatile("s_waitcnt lgkmcnt(0)":::"memory");
      #pragma unroll
      for(int i=0;i<4;++i){const int row=i*8+(lane>>3),ch=lane&7; const u32x4 v=*(const u32x4*)(stg+row*64+ch*8); ATTN_STORE16(Ow+(long)row*OP+hf*64+ch*8,v);}
      asm volatile("s_waitcnt lgkmcnt(0)":::"memory"); } }
  asm volatile("s_waitcnt lgkmcnt(0)\n\ts_barrier":::"memory");
  #undef DMA_K
  #undef DMA_V
  #undef CMASK
  #undef START
  #undef RESC
  #undef ROT
}
constexpr int ATTN_LDS_BYTES=LDS_BYTES;
#undef SBAR
#undef WAIT_BAR
}
namespace dn {
constexpr int NCHUNK = 260, GROUP = 6, WREG = 17408  , TP = 72  ;
constexpr int F_WT = 0, F_QKT = 8, F_QD = 14, F_KD = 22, F_U = 30, F_GL = 38;
__device__ __forceinline__ int crow(int r, int hi) { return (r & 3) + 8 * (r >> 2) + 4 * hi; }
__device__ __forceinline__ bf16x8 pack8(const f32x16& x, int s) {
    v4u w; w.x = cvt_pk_bf16(x[8 * s + 0], x[8 * s + 1]); w.y = cvt_pk_bf16(x[8 * s + 2], x[8 * s + 3]); w.z = cvt_pk_bf16(x[8 * s + 4], x[8 * s + 5]); w.w = cvt_pk_bf16(x[8 * s + 6], x[8 * s + 7]);
    return __builtin_bit_cast(bf16x8, w);
}
#define DN_MFMA(a, b, c) __builtin_amdgcn_mfma_f32_32x32x16_bf16(a, b, c, 0, 0, 0)

struct Chain {
    const bf16_t* P1b;
    const bf16_t* QKb;
    bf16_t* Ob;
    int h, dir;
    float Aexp, dtb;
    unsigned char* ring;
    unsigned* dbg;
};
__device__ __forceinline__ int chunk_of(int ci, int dir) { return dir == 0 ? ci : (ci < 4 ? 3 - ci : 263 - ci); }

__device__ __forceinline__ void produce(const Chain& ch, int ci, LAS unsigned char* wl, const LAS float* wct, unsigned char* slot, int lane_in) {
    int lane = lane_in; asm volatile("" : "+v"(lane));
    const int r = lane & 31, hh = lane >> 5;
    const int c = chunk_of(ci, ch.dir), t0 = 64 * c, seg_lo = (c < 4) ? 0 : CTXL, seg_hi = (c < 4) ? CTXL : TT;
    LAS float* Lm = (LAS float*)wl; LAS bf16_t* Tm = (LAS bf16_t*)wl; LAS float* gcT = (LAS float*)(wl + 16384); LAS float* btT = gcT + 64;
    {
        const int tok = ch.dir ? t0 + 63 - lane : t0 + lane;
        const bf16_t* row = ch.P1b + (size_t)tok * P1W;
        const float a = bf2f(row[C_BA + ch.dir * 8 + ch.h]), bb = bf2f(row[C_BB + ch.dir * 8 + ch.h]);
        const float x = a + ch.dtb; const float sp = x > 20.f ? x : log1pf(__expf(x));
        float g = -ch.Aexp * sp;
#pragma unroll
        for (int o = 1; o < 64; o <<= 1) { const float t = __shfl_up(g, o); if (lane >= o) g += t; }
        gcT[lane] = g; btT[lane] = sigmoidf_(bb);
    }
    LDS_WAIT();
    const float gl = gcT[63];
    bf16x8 kA[2][4], qA[2][4], vA[2][4];
#pragma unroll
    for (int rt = 0; rt < 2; ++rt) {
        const int p = 32 * rt + r; const int tok = ch.dir ? t0 + 63 - p : t0 + p;
        const bf16_t* rq = ch.QKb + (size_t)tok * 1536 + ch.h * 64 + 4 * hh; const bf16_t* rk = rq + 512;
        const bf16_t* rv = ch.P1b + (size_t)tok * P1W + C_BQKV + ch.h * 64 + 4 * hh;
#pragma unroll
        for (int s = 0; s < 4; ++s) { const v2u a = *(const v2u*)(rk + 16 * s), b2 = *(const v2u*)(rk + 16 * s + 8); v4u w; w.x = a.x; w.y = a.y; w.z = b2.x; w.w = b2.y; kA[rt][s] = __builtin_bit_cast(bf16x8, w);
            const v2u c2 = *(const v2u*)(rq + 16 * s), d2 = *(const v2u*)(rq + 16 * s + 8); v4u w2; w2.x = c2.x; w2.y = c2.y; w2.z = d2.x; w2.w = d2.y; qA[rt][s] = __builtin_bit_cast(bf16x8, w2);
            const v2u e2 = *(const v2u*)(rv + 16 * s), f2 = *(const v2u*)(rv + 16 * s + 8); v4u w3; w3.x = e2.x; w3.y = e2.y; w3.z = f2.x; w3.w = f2.y; vA[rt][s] = __builtin_bit_cast(bf16x8, w3); }
    }
    __builtin_amdgcn_sched_barrier(0);
    v4u* sl = (v4u*)slot;
    const float gcc0 = gcT[r], gcc1 = gcT[32 + r];
#pragma unroll
    for (int tix = 0; tix < 3; ++tix) {
        const int it = (tix == 0) ? 0 : 1, jt = (tix == 2) ? 1 : 0;
        f32x16 acc = {};
#pragma unroll
        for (int s = 0; s < 4; ++s) acc = DN_MFMA(kA[it][s], kA[jt][s], acc);
        const float gcj = jt ? gcc1 : gcc0; const int j = 32 * jt + r;
#pragma unroll
        for (int rg = 0; rg < 16; ++rg) { const int i = 32 * it + crow(rg, hh); const float gi = gcT[i], bi = btT[i];
            const float v = (i > j) ? bi * acc[rg] * __expf(fminf(gi - gcj, 0.f)) : 0.f; Lm[i * 64 + j] = v; }
    }
#pragma unroll
    for (int tix = 0; tix < 3; ++tix) {
        const int jt = (tix == 2) ? 1 : 0, it = (tix == 0) ? 0 : 1;
        f32x16 acc = {};
#pragma unroll
        for (int s = 0; s < 4; ++s) acc = DN_MFMA(kA[jt][s], qA[it][s], acc);
        const float gci = it ? gcc1 : gcc0; const int i = 32 * it + r;
#pragma unroll
        for (int rg = 0; rg < 16; ++rg) { const int j = 32 * jt + crow(rg, hh); const float gj = gcT[j];
            acc[rg] = (i >= j) ? acc[rg] * __expf(fminf(gci - gj, 0.f)) : 0.f; }
        sl[(F_QKT + tix * 2 + 0) * 64 + lane] = __builtin_bit_cast(v4u, pack8(acc, 0));
        sl[(F_QKT + tix * 2 + 1) * 64 + lane] = __builtin_bit_cast(v4u, pack8(acc, 1));
    }
#pragma unroll
    for (int rt = 0; rt < 2; ++rt) { const float e = __expf(rt ? gcc1 : gcc0);
#pragma unroll
        for (int s = 0; s < 4; ++s) { const v4u w = __builtin_bit_cast(v4u, qA[rt][s]); v4u o;
            o.x = cvt_pk_bf16(bflo(w.x) * e, bfhi(w.x) * e); o.y = cvt_pk_bf16(bflo(w.y) * e, bfhi(w.y) * e); o.z = cvt_pk_bf16(bflo(w.z) * e, bfhi(w.z) * e); o.w = cvt_pk_bf16(bflo(w.w) * e, bfhi(w.w) * e);
            sl[(F_QD + rt * 4 + s) * 64 + lane] = o; } }
    LDS_WAIT();
#if MK_DEBUG == 3
    { unsigned bad = 0u;
      for (int i = 0; i < 64; ++i) { const float lv = Lm[i * 64 + lane]; if (lane < i && !(fabsf(lv) <= 1.5f)) bad |= 1u; }
      if (!(fabsf(gcT[lane]) < 1.0e30f)) bad |= 2u; if (!(btT[lane] >= 0.f && btT[lane] <= 1.f)) bad |= 4u;
      if (bad) atomicOr(ch.dbg, bad); }
#endif
    float T[64];
#pragma unroll
    for (int i = 0; i < 64; ++i) {
        float a = (lane == i) ? 1.f : 0.f;
#pragma unroll
        for (int q = 0; q < (i + 3) / 4; ++q) { const f32x4 l4 = *(const LAS f32x4*)(Lm + i * 64 + 4 * q);
#pragma unroll
            for (int e = 0; e < 4; ++e) if (4 * q + e < i) a -= l4[e] * T[4 * q + e]; }
        T[i] = a;
        if ((i & 3) == 3) __builtin_amdgcn_sched_barrier(0);
    }
    LDS_WAIT();
#pragma unroll
    for (int i = 0; i < 64; ++i) Tm[i * TP + lane] = (bf16_t)f2bf(T[i]);
    LDS_WAIT();
    bf16x8 Tf[3][2];
#pragma unroll
    for (int tix = 0; tix < 3; ++tix) { const int it = (tix == 0) ? 0 : 1, jt = (tix == 2) ? 1 : 0;
#pragma unroll
        for (int s = 0; s < 2; ++s) { const LAS bf16_t* p = Tm + (32 * it + r) * TP + 32 * jt + 16 * s + 4 * hh;
            const v2u a = *(const LAS v2u*)p, b = *(const LAS v2u*)(p + 8); v4u w; w.x = a.x; w.y = a.y; w.z = b.x; w.w = b.y; Tf[tix][s] = __builtin_bit_cast(bf16x8, w); } }
#if MK_DEBUG == 4
    { unsigned bad = 0u;
      _Pragma("unroll") for (int t_ = 0; t_ < 3; ++t_) _Pragma("unroll") for (int s_ = 0; s_ < 2; ++s_) { const v4u w = __builtin_bit_cast(v4u, Tf[t_][s_]);
        const unsigned ws_[4] = {w.x, w.y, w.z, w.w};
        _Pragma("unroll") for (int q_ = 0; q_ < 4; ++q_) { const float lo_ = bflo(ws_[q_]), hi_ = bfhi(ws_[q_]);
          if (!(fabsf(lo_) < 3.0e38f) || !(fabsf(hi_) < 3.0e38f)) bad |= 1u; else if (fabsf(lo_) > 1.0e3f || fabsf(hi_) > 1.0e3f) bad |= 2u; } }
      if (bad) atomicOr(ch.dbg, bad); }
#endif
    bf16x8 If[2];
#pragma unroll
    for (int sp = 0; sp < 2; ++sp) { bf16x8 f_;
#pragma unroll
        for (int jj = 0; jj < 8; ++jj) f_[jj] = ((16 * sp + 8 * (jj >> 2) + 4 * hh + (jj & 3)) == r) ? (short)0x3F80 : (short)0;
        If[sp] = f_; }
    {
        bf16x8 kbg[2][2][2];
#pragma unroll
        for (int jt = 0; jt < 2; ++jt)
#pragma unroll
            for (int dt = 0; dt < 2; ++dt) {
                f32x16 kc = {};
                kc = DN_MFMA(kA[jt][2 * dt + 0], If[0], kc); kc = DN_MFMA(kA[jt][2 * dt + 1], If[1], kc);
                f32x16 kd, kb;
#pragma unroll
                for (int rg = 0; rg < 16; ++rg) { const int j = 32 * jt + crow(rg, hh); const float gj = gcT[j], bj = btT[j];
                    kd[rg] = kc[rg] * __expf(gl - gj); kb[rg] = kc[rg] * bj * __expf(gj); }
                sl[(F_KD + (jt * 2 + dt) * 2 + 0) * 64 + lane] = __builtin_bit_cast(v4u, pack8(kd, 0));
                sl[(F_KD + (jt * 2 + dt) * 2 + 1) * 64 + lane] = __builtin_bit_cast(v4u, pack8(kd, 1));
                kbg[jt][dt][0] = pack8(kb, 0); kbg[jt][dt][1] = pack8(kb, 1);
#if MK_DEBUG == 4
                { bool b_ = false; _Pragma("unroll") for (int rg = 0; rg < 16; ++rg) if (!(fabsf(kb[rg]) < 3.0e38f)) b_ = true; if (b_) atomicOr(ch.dbg, 4u); }
#endif
            }
#pragma unroll
        for (int dt = 0; dt < 2; ++dt)
#pragma unroll
            for (int it = 0; it < 2; ++it) {
                f32x16 wt = {};
#pragma unroll
                for (int s = 0; s < 2; ++s) {
                    if (it == 0) wt = DN_MFMA(kbg[0][dt][s], Tf[0][s], wt);
                    else { wt = DN_MFMA(kbg[0][dt][s], Tf[1][s], wt); wt = DN_MFMA(kbg[1][dt][s], Tf[2][s], wt); }
                }
                asm volatile("s_nop 15\n\ts_nop 7" : "+v"(wt));
                sl[(F_WT + (dt * 2 + it) * 2 + 0) * 64 + lane] = __builtin_bit_cast(v4u, pack8(wt, 0));
                sl[(F_WT + (dt * 2 + it) * 2 + 1) * 64 + lane] = __builtin_bit_cast(v4u, pack8(wt, 1));
            }
    }
    {
        bf16x8 vb[2][2][2];
#pragma unroll
        for (int jt = 0; jt < 2; ++jt)
#pragma unroll
            for (int dvt = 0; dvt < 2; ++dvt) {
                f32x16 vc = {};
                vc = DN_MFMA(vA[jt][2 * dvt + 0], If[0], vc); vc = DN_MFMA(vA[jt][2 * dvt + 1], If[1], vc);
#pragma unroll
                for (int rg = 0; rg < 16; ++rg) { const int j = 32 * jt + crow(rg, hh); vc[rg] *= btT[j]; }
                vb[jt][dvt][0] = pack8(vc, 0); vb[jt][dvt][1] = pack8(vc, 1);
#if MK_DEBUG == 4
                { bool b_ = false; _Pragma("unroll") for (int rg = 0; rg < 16; ++rg) if (!(fabsf(vc[rg]) < 3.0e38f)) b_ = true; if (b_) atomicOr(ch.dbg, 8u); }
#endif
            }
#pragma unroll
        for (int it = 0; it < 2; ++it)
#pragma unroll
            for (int dvt = 0; dvt < 2; ++dvt) {
                f32x16 u = {};
#pragma unroll
                for (int s = 0; s < 2; ++s) {
                    if (it == 0) u = DN_MFMA(Tf[0][s], vb[0][dvt][s], u);
                    else { u = DN_MFMA(Tf[1][s], vb[0][dvt][s], u); u = DN_MFMA(Tf[2][s], vb[1][dvt][s], u); }
                }
                asm volatile("s_nop 15\n\ts_nop 7" : "+v"(u));
                sl[(F_U + (it * 2 + dvt) * 2 + 0) * 64 + lane] = __builtin_bit_cast(v4u, pack8(u, 0));
                sl[(F_U + (it * 2 + dvt) * 2 + 1) * 64 + lane] = __builtin_bit_cast(v4u, pack8(u, 1));
            }
    }
    { v4u gw; gw.x = __float_as_uint(__expf(gl)); gw.y = gw.x; gw.z = gw.x; gw.w = gw.x; sl[F_GL * 64 + lane] = gw; }
}

__device__ __forceinline__ f32x16 unpack16(v4u a, v4u b) {
    f32x16 x;
    x[0] = bflo(a.x); x[1] = bfhi(a.x); x[2] = bflo(a.y); x[3] = bfhi(a.y); x[4] = bflo(a.z); x[5] = bfhi(a.z); x[6] = bflo(a.w); x[7] = bfhi(a.w);
    x[8] = bflo(b.x); x[9] = bfhi(b.x); x[10] = bflo(b.y); x[11] = bfhi(b.y); x[12] = bflo(b.z); x[13] = bfhi(b.z); x[14] = bflo(b.w); x[15] = bfhi(b.w);
    return x;
}
__device__ __forceinline__ void consume(const Chain& ch, int ci, const unsigned char* slot, f32x16 (&S)[2], int hv, int lane_in) {
    int lane = lane_in; asm volatile("" : "+v"(lane));
    const int r = lane & 31, hh = lane >> 5;
    const v4u* sl = (const v4u*)slot;
    v4u fr_[F_U], fU_[4];
#pragma unroll
    for (int i = 0; i < F_U; ++i) fr_[i] = sl[i * 64 + lane];
#pragma unroll
    for (int it = 0; it < 2; ++it)
#pragma unroll
        for (int s = 0; s < 2; ++s) fU_[it * 2 + s] = sl[(F_U + (it * 2 + hv) * 2 + s) * 64 + lane];
    const v4u fgl_ = sl[F_GL * 64 + lane];
    __builtin_amdgcn_sched_barrier(0);
#define DN_FR(idx) __builtin_bit_cast(bf16x8, fr_[idx])
    const float gl = __builtin_bit_cast(float, fgl_.x);
#if MK_DEBUG == 2
    { unsigned bad = 0u;
      auto nf = [](v4u w) { return ((w.x & 0x7f80u) == 0x7f80u) || ((w.x & 0x7f800000u) == 0x7f800000u) || ((w.y & 0x7f80u) == 0x7f80u) || ((w.y & 0x7f800000u) == 0x7f800000u) || ((w.z & 0x7f80u) == 0x7f80u) || ((w.z & 0x7f800000u) == 0x7f800000u) || ((w.w & 0x7f80u) == 0x7f80u) || ((w.w & 0x7f800000u) == 0x7f800000u); };
      if ((__float_as_uint(gl) & 0x7f800000u) == 0x7f800000u) bad |= 1u;
      for (int i = 0; i < 8; ++i) { if (nf(sl[(F_WT + i) * 64 + lane])) bad |= 2u; if (nf(sl[(F_QD + i) * 64 + lane])) bad |= 4u; if (nf(sl[(F_KD + i) * 64 + lane])) bad |= 8u; if (nf(sl[(F_U + i) * 64 + lane])) bad |= 16u; }
      for (int i = 0; i < 6; ++i) if (nf(sl[(F_QKT + i) * 64 + lane])) bad |= 32u;
      if (bad) atomicOr(ch.dbg, bad); }
#endif
    asm volatile("s_nop 15\n\ts_nop 7" : "+v"(S[0]), "+v"(S[1]));
    bf16x8 Sb[2][2];
#pragma unroll
    for (int dt = 0; dt < 2; ++dt) { Sb[dt][0] = pack8(S[dt], 0); Sb[dt][1] = pack8(S[dt], 1); }
    f32x16 accv[2], acco[2];
#pragma unroll
    for (int it = 0; it < 2; ++it) { accv[it] = f32x16{}; acco[it] = f32x16{};
#pragma unroll
        for (int dt = 0; dt < 2; ++dt)
#pragma unroll
            for (int s = 0; s < 2; ++s) {
                accv[it] = DN_MFMA(DN_FR(F_WT + (dt * 2 + it) * 2 + s), Sb[dt][s], accv[it]);
                acco[it] = DN_MFMA(DN_FR(F_QD + it * 4 + 2 * dt + s), Sb[dt][s], acco[it]);
            } }
    bf16x8 vb[2][2];
#pragma unroll
    for (int it = 0; it < 2; ++it) {
        const f32x16 u = unpack16(fU_[it * 2 + 0], fU_[it * 2 + 1]);
        const f32x16 vn = u - accv[it];
        vb[it][0] = pack8(vn, 0); vb[it][1] = pack8(vn, 1);
    }
#pragma unroll
    for (int s = 0; s < 2; ++s) {
        acco[0] = DN_MFMA(DN_FR(F_QKT + 0 * 2 + s), vb[0][s], acco[0]);
        acco[1] = DN_MFMA(DN_FR(F_QKT + 1 * 2 + s), vb[0][s], acco[1]);
        acco[1] = DN_MFMA(DN_FR(F_QKT + 2 * 2 + s), vb[1][s], acco[1]);
    }
#pragma unroll
    for (int dt = 0; dt < 2; ++dt) {
        S[dt] = S[dt] * gl;
#pragma unroll
        for (int jt = 0; jt < 2; ++jt)
#pragma unroll
            for (int s = 0; s < 2; ++s) S[dt] = DN_MFMA(DN_FR(F_KD + (jt * 2 + dt) * 2 + s), vb[jt][s], S[dt]);
    }
    const int c = chunk_of(ci, ch.dir), t0 = 64 * c;
#pragma unroll
    for (int it = 0; it < 2; ++it)
#pragma unroll
        for (int rg = 0; rg < 16; ++rg) { const int i = 32 * it + crow(rg, hh); const int tok = ch.dir ? t0 + 63 - i : t0 + i;
            ch.Ob[(size_t)tok * 512 + ch.h * 64 + 32 * hv + r] = (bf16_t)f2bf(acco[it][rg]); }
#undef DN_FR
}

__device__ __forceinline__ void chain_unit(const Chain& ch, const float* wconv  , LAS unsigned char* lds, LAS float* wct, int wave) {
    const int lane = hw_lane(), wid = wave, tid = wave * 64 + lane;
    __syncthreads();
    constexpr int NG = (NCHUNK + GROUP - 1) / GROUP;
#define DN_BAR() do { asm volatile("s_waitcnt vmcnt(0) lgkmcnt(0)" ::: "memory"); __builtin_amdgcn_s_barrier(); asm volatile("" ::: "memory"); } while (0)
    if (wid >= 2) {
        for (int k = 0; k <= NG; ++k) {
            const int ci = k * GROUP + (wid - 2);
#ifndef NO_DNP
            if (k < NG && ci < NCHUNK) produce(ch, ci, lds + wid * WREG, wct, ch.ring + (size_t)((k & 1) * GROUP + (wid - 2)) * RING_SLOT, lane);
#endif
            DN_BAR();
        }
    } else {
        f32x16 S[2]; S[0] = f32x16{}; S[1] = f32x16{};
        for (int k = 0; k <= NG; ++k) {
#ifndef NO_DNC
            if (k >= 1) { const int g0 = (k - 1) * GROUP; const int n = (NCHUNK - g0 < GROUP) ? NCHUNK - g0 : GROUP;
                for (int j = 0; j < n; ++j) consume(ch, g0 + j, ch.ring + (size_t)(((k - 1) & 1) * GROUP + j) * RING_SLOT, S, wid, lane); }
#endif
            DN_BAR();
        }
    }
#undef DN_BAR
    __syncthreads();
}
#undef DN_MFMA
}
struct Params {
    const float* in[28];
    float* out; unsigned char* ws;
    int ph_lo, ph_hi; int use_bar; int pad;
};
enum { I_X = 0, I_C, I_CTX, I_CCTX, I_WMOD, I_BMOD, I_GN1, I_GN2, I_WIN, I_GQ, I_GK, I_WCONV, I_ALOG, I_DTB, I_GDN, I_LAMQK, I_GSUB, I_WBR, I_WOUT, I_WRT, I_BRT,
       I_WEG, I_WEU, I_WED, I_WSG, I_WSU, I_WSD, I_GFIN };
struct Frame {
    LAS unsigned char* lds; volatile LAS unsigned* MISC; gu32* ctl;
    int tid, lane, wave, G, gw, NGW;
    GAS unsigned char* ws;
};
__device__ __forceinline__ size_t hrow_off(int r, bool& isctx, int& b) { b = r / TT; const int t = r - b * TT; isctx = t < CTXL; return isctx ? (size_t)(b * CTXL + t) * DM : (size_t)(b * SEQ + (t - CTXL)) * DM; }

__device__ __forceinline__ void transpose_item(const float* W, int ldw, int k0, int n0, bf16_t* WT, int K, int dst_row0, LAS float* scr, int lane) {
    float tv[32];
#pragma unroll
    for (int i = 0; i < 32; ++i) { const int kk = 2 * i + (lane >> 5); tv[i] = W[(size_t)(k0 + kk) * ldw + n0 + (lane & 31)]; }
#pragma unroll
    for (int i = 0; i < 32; ++i) { const int kk = 2 * i + (lane >> 5); scr[kk * 33 + (lane & 31)] = tv[i]; }
    LDS_WAIT(); asm volatile("" ::: "memory");
    const int c = lane & 7;
#pragma unroll
    for (int j = 0; j < 4; ++j) { const int n = (lane >> 3) + 8 * j; const LAS float* s = scr + (8 * c) * 33 + n;
        v4u o; o.x = pk2(s[0 * 33], s[1 * 33]); o.y = pk2(s[2 * 33], s[3 * 33]); o.z = pk2(s[4 * 33], s[5 * 33]); o.w = pk2(s[6 * 33], s[7 * 33]);
        *(v4u*)(WT + (size_t)(dst_row0 + n) * K + k0 + 8 * c) = o; }
    LDS_WAIT(); asm volatile("" ::: "memory");
}
__device__ __forceinline__ void convert_small(Frame& F, const Params& P, int l) {
    LAS float* scr = (LAS float*)(F.lds + RING_OFF + F.wave * 16384);
    const float* win = P.in[I_WIN] + (size_t)l * DM * INW;
    const float* wbr = P.in[I_WBR] + (size_t)l * 3 * 512 * DM;
    const float* wo = P.in[I_WOUT] + (size_t)l * DM * DM;
    bf16_t* WB1 = (bf16_t*)(F.ws + WS_WB1); bf16_t* WB2 = (bf16_t*)(F.ws + WS_WB2); bf16_t* WBR = (bf16_t*)(F.ws + WS_WBR); bf16_t* WOT = (bf16_t*)(F.ws + WS_WOT);
    constexpr int I1 = 16 * (P1W / 32), I2 = 16 * (GW / 32), I3 = 3 * 8 * 32, I4 = 16 * 32;
    for (int it = F.gw; it < I1 + I2 + I3 + I4; it += F.NGW) {
        int r = it;
        if (r < I1) { const int nb = r % (P1W / 32), kb = r / (P1W / 32); transpose_item(win, INW, 64 * kb, 32 * nb, WB1, DM, 32 * nb, scr, F.lane); continue; } r -= I1;
        if (r < I2) { const int nb = r % (GW / 32), kb = r / (GW / 32); transpose_item(win, INW, 64 * kb, C_GATE + 32 * nb, WB2, DM, 32 * nb, scr, F.lane); continue; } r -= I2;
        if (r < I3) { const int br = r / 256, q = r % 256, nb = q % 32, kb = q / 32; transpose_item(wbr + (size_t)br * 512 * DM, DM, 64 * kb, 32 * nb, WBR + (size_t)br * DM * 512, 512, 32 * nb, scr, F.lane); continue; } r -= I3;
        { const int nb = r % 32, kb = r / 32; transpose_item(wo, DM, 64 * kb, 32 * nb, WOT, DM, 32 * nb, scr, F.lane); }
    }
}
__device__ __forceinline__ void convert_experts(Frame& F, const Params& P, int l) {
    LAS float* scr = (LAS float*)(F.lds + RING_OFF + F.wave * 16384);
    bf16_t* WGU = (bf16_t*)(F.ws + WS_B); bf16_t* WD = WGU + (size_t)NEXP1 * 512 * DM;
    for (int it = F.gw; it < NEXP1 * 384; it += F.NGW) {
        const int e = it / 384; int r = it % 384;
        const float* wg = (e < NEXP) ? P.in[I_WEG] + ((size_t)l * NEXP + e) * DM * FF : P.in[I_WSG] + (size_t)l * DM * FF;
        const float* wu = (e < NEXP) ? P.in[I_WEU] + ((size_t)l * NEXP + e) * DM * FF : P.in[I_WSU] + (size_t)l * DM * FF;
        const float* wd = (e < NEXP) ? P.in[I_WED] + ((size_t)l * NEXP + e) * FF * DM : P.in[I_WSD] + (size_t)l * FF * DM;
        if (r < 256) { const bool up = r >= 128; r &= 127; const int nb = r % 8, kb = r / 8; const int n0 = 32 * nb;
            transpose_item(up ? wu : wg, FF, 64 * kb, n0, WGU + (size_t)e * 512 * DM, DM, (n0 / 128) * 256 + (up ? 128 : 0) + (n0 % 128), scr, F.lane); }
        else { r -= 256; const int nb = r % 32, kb = r / 32; transpose_item(wd, DM, 64 * kb, 32 * nb, WD + (size_t)e * DM * FF, FF, 32 * nb, scr, F.lane); }
    }
}
__device__ __forceinline__ void compute_mod(Frame& F, const Params& P) {
    float* modv = (float*)(F.ws + WS_MODV);
    const int kq = F.lane >> 3, nn = F.lane & 7;
    for (int it = F.gw; it < NLAYER * (6144 / 8); it += F.NGW) {
        const int l = it / (6144 / 8), n = (it % (6144 / 8)) * 8 + nn;
        const float* w = P.in[I_WMOD] + (size_t)l * DM * 6144 + n;
        float a0 = 0.f, a1 = 0.f, a2 = 0.f;
#pragma unroll 16
        for (int i = 0; i < 128; ++i) { const int k = kq + 8 * i; const float wv = w[(size_t)k * 6144];
            a0 += siluf_(P.in[I_C][k]) * wv; a1 += siluf_(P.in[I_C][DM + k]) * wv; a2 += siluf_(P.in[I_CCTX][k]) * wv; }
#pragma unroll
        for (int o = 8; o < 64; o <<= 1) { a0 += __shfl_xor(a0, o); a1 += __shfl_xor(a1, o); a2 += __shfl_xor(a2, o); }
        if (kq == 0) { const float bm = P.in[I_BMOD][l * 6144 + n]; float* m = modv + (size_t)l * 3 * 6144 + n; m[0] = a0 + bm; m[6144] = a1 + bm; m[2 * 6144] = a2 + bm; }
    }
}
__device__ __forceinline__ void modnorm_store(const float (&x)[16], const float* g, const float* sc, const float* sh, bf16_t* orow, int lane) {
    float ss = 0.f;
#pragma unroll
    for (int i = 0; i < 16; ++i) ss += x[i] * x[i];
    const float rstd = rsqrtf(wave_sum(ss) * (1.f / DM) + EPS);
#pragma unroll
    for (int hf = 0; hf < 2; ++hf) { const int c0 = hf * 512 + lane * 8; float y[8];
#pragma unroll
        for (int j = 0; j < 8; ++j) y[j] = x[hf * 8 + j] * rstd * g[c0 + j] * (1.f + sc[c0 + j]) + sh[c0 + j];
        v4u w; w.x = cvt_pk_bf16(y[0], y[1]); w.y = cvt_pk_bf16(y[2], y[3]); w.z = cvt_pk_bf16(y[4], y[5]); w.w = cvt_pk_bf16(y[6], y[7]);
        *(v4u*)(orow + c0) = w; }
}
__device__ __forceinline__ void load_row16(const float* row, float (&x)[16], int lane) {
#pragma unroll
    for (int hf = 0; hf < 2; ++hf) { const f32x4 a = *(const f32x4*)(row + hf * 512 + lane * 8), b = *(const f32x4*)(row + hf * 512 + lane * 8 + 4);
        x[hf * 8 + 0] = a[0]; x[hf * 8 + 1] = a[1]; x[hf * 8 + 2] = a[2]; x[hf * 8 + 3] = a[3]; x[hf * 8 + 4] = b[0]; x[hf * 8 + 5] = b[1]; x[hf * 8 + 6] = b[2]; x[hf * 8 + 7] = b[3]; }
}
__device__ __forceinline__ void phase_norm1(Frame& F, const Params& P) {
    const float* modv = (const float*)(F.ws + WS_MODV); bf16_t* U = (bf16_t*)(F.ws + WS_C);
    for (int r = F.gw; r < MROWS; r += 2 * F.NGW) {
        const bool has1 = r + F.NGW < MROWS; const int r1 = has1 ? r + F.NGW : r;
        bool ic0, ic1; int b0, b1; const size_t off0 = hrow_off(r, ic0, b0), off1 = hrow_off(r1, ic1, b1);
        float x0[16], x1[16]; load_row16((ic0 ? P.in[I_CTX] : P.in[I_X]) + off0, x0, F.lane); load_row16((ic1 ? P.in[I_CTX] : P.in[I_X]) + off1, x1, F.lane);
        { const float* mv = modv + (ic0 ? 2 : b0) * 6144; modnorm_store(x0, P.in[I_GN1], mv + 1 * DM, mv + 0 * DM, U + (size_t)r * DM, F.lane); }
        if (has1) { const float* mv = modv + (ic1 ? 2 : b1) * 6144; modnorm_store(x1, P.in[I_GN1], mv + 1 * DM, mv + 0 * DM, U + (size_t)r1 * DM, F.lane); } }
}
__device__ __forceinline__ void unpack8(const v4u w, float (&x)[8]) { x[0] = bflo(w.x); x[1] = bfhi(w.x); x[2] = bflo(w.y); x[3] = bfhi(w.y); x[4] = bflo(w.z); x[5] = bfhi(w.z); x[6] = bflo(w.w); x[7] = bfhi(w.w); }
__device__ __forceinline__ void load_row16_bf(const bf16_t* row, float (&x)[16], int lane) {
#pragma unroll
    for (int hf = 0; hf < 2; ++hf) { const v4u w = *(const v4u*)(row + hf * 512 + lane * 8); float t[8]; unpack8(w, t);
#pragma unroll
        for (int j = 0; j < 8; ++j) x[hf * 8 + j] = t[j]; }
}
__device__ __forceinline__ v4u pack8f(const float (&y)[8]) { v4u w; w.x = cvt_pk_bf16(y[0], y[1]); w.y = cvt_pk_bf16(y[2], y[3]); w.z = cvt_pk_bf16(y[4], y[5]); w.w = cvt_pk_bf16(y[6], y[7]); return w; }
__device__ __forceinline__ void phase_prep(Frame& F, const Params& P, int l, bool dry = false) {
    bf16_t* P1 = (bf16_t*)(F.ws + WS_A);
    const int lane = F.lane, c = lane & 3, i5 = lane & 31, hd = lane >> 2; const bool act = hd < 10;
    const float inv = exp2f(-(float)(i5 & 15) * (13.287712379549449f / 16.f));
    float gk[16];
#pragma unroll
    for (int e = 0; e < 8; ++e) { gk[e] = P.in[I_GK][l * 64 + 8 * c + e]; gk[8 + e] = P.in[I_GK][l * 64 + 32 + 8 * c + e]; }
    const int col = !act ? C_AK : (hd < 2 ? C_AK + hd * 64 : C_CK + (hd - 2) * 64); const bool nrm = hd < 2;
    float kmx[2] = {0.f, 0.f};
    auto body = [&](int r, const v4u w0, const v4u w1) {
        const int b = r / TT, t = r - b * TT; const bool lat = t >= CTXL;
        float cs = 1.f, sn = 0.f;
        if (lat) { const int s = t - CTXL; const float pos = (i5 < 16) ? (float)(s / GRIDW) : (float)(s % GRIDW); sincosf(pos * inv, &sn, &cs); }
        float cse[8], sne[8];
#pragma unroll
        for (int e = 0; e < 8; ++e) { cse[e] = __shfl(cs, 8 * c + e); sne[e] = __shfl(sn, 8 * c + e); }
        bf16_t* row = P1 + (size_t)r * P1W;
        float x0[8], x1[8]; unpack8(w0, x0); unpack8(w1, x1);
        if (nrm) { float ss = 0.f;
#pragma unroll
            for (int e = 0; e < 8; ++e) ss += x0[e] * x0[e] + x1[e] * x1[e];
            ss += __shfl_xor(ss, 1); ss += __shfl_xor(ss, 2);
            const float rstd = rsqrtf(ss * (1.f / 64.f) + EPS);
#pragma unroll
            for (int e = 0; e < 8; ++e) { x0[e] *= rstd * gk[e]; x1[e] *= rstd * gk[8 + e]; } }
        float y0[8], y1[8];
#pragma unroll
        for (int e = 0; e < 8; ++e) { y0[e] = x0[e] * cse[e] - x1[e] * sne[e]; y1[e] = x1[e] * cse[e] + x0[e] * sne[e]; }
        const v4u pk0 = pack8f(y0), pk1 = pack8f(y1);
        if (act && (!dry || y0[0] == 123456.f)) { *(v4u*)(row + col + 8 * c) = pk0; *(v4u*)(row + col + 32 + 8 * c) = pk1; }
        { float z0[8], z1[8]; unpack8(pk0, z0); unpack8(pk1, z1); float ks = 0.f;
#pragma unroll
          for (int e = 0; e < 8; ++e) ks += z0[e] * z0[e] + z1[e] * z1[e];
          ks += __shfl_xor(ks, 1); ks += __shfl_xor(ks, 2);
          if (b == 0) kmx[0] = fmaxf(kmx[0], ks); else kmx[1] = fmaxf(kmx[1], ks); }
    };
    for (int r = F.gw; r < MROWS; r += 4 * F.NGW) {
        int rr[4]; v4u wa[4], wb[4];
#pragma unroll
        for (int q = 0; q < 4; ++q) { rr[q] = r + q * F.NGW; const int rq = rr[q] < MROWS ? rr[q] : r; const bf16_t* row = P1 + (size_t)rq * P1W; wa[q] = *(const v4u*)(row + col + 8 * c); wb[q] = *(const v4u*)(row + col + 32 + 8 * c); }
#pragma unroll
        for (int q = 0; q < 4; ++q) if (rr[q] < MROWS) body(rr[q], wa[q], wb[q]);
    }
    if (!dry && act && c == 0) { atomicMax((int*)(F.ctl + CW_KMAX + (l * 2 + 0) * 16 + hd), __float_as_int(kmx[0])); atomicMax((int*)(F.ctl + CW_KMAX + (l * 2 + 1) * 16 + hd), __float_as_int(kmx[1])); }
}
__device__ __forceinline__ void phase_dn_prep(Frame& F, const Params& P, int l) {
    bf16_t* P1 = (bf16_t*)(F.ws + WS_A); bf16_t* BR = (bf16_t*)(F.ws + WS_B);
    const float* wc = P.in[I_WCONV] + (size_t)l * 3 * 1536;
    const int lane = F.lane;
    float w0[2][8], w1[2][8], w2[2][8];
#pragma unroll
    for (int ps = 0; ps < 2; ++ps) { const int ch0 = (ps * 64 + lane) * 8;
#pragma unroll
        for (int e = 0; e < 8; ++e) { w0[ps][e] = wc[0 * 1536 + ch0 + e]; w1[ps][e] = wc[1 * 1536 + ch0 + e]; w2[ps][e] = wc[2 * 1536 + ch0 + e]; } }
    for (int r0 = F.gw; r0 < MROWS; r0 += 2 * F.NGW) {
        int rr[2]; bool hm[2], hp[2]; v4u wc_[2][2], wm_[2][2], wp_[2][2];
#pragma unroll
        for (int q = 0; q < 2; ++q) { rr[q] = r0 + q * F.NGW; const int r = rr[q] < MROWS ? rr[q] : r0;
            const int b = r / TT, t = r - b * TT; const int seg_lo = (t < CTXL) ? 0 : CTXL, seg_hi = (t < CTXL) ? CTXL : TT;
            hm[q] = (t - 1 >= seg_lo); hp[q] = (t + 1 < seg_hi);
            const bf16_t* rowc = P1 + (size_t)r * P1W + C_BQKV; const bf16_t* rowm = hm[q] ? rowc - P1W : rowc; const bf16_t* rowp = hp[q] ? rowc + P1W : rowc;
#pragma unroll
            for (int ps = 0; ps < 2; ++ps) { const int ch0 = (ps * 64 + lane) * 8; wc_[q][ps] = *(const v4u*)(rowc + ch0); wm_[q][ps] = *(const v4u*)(rowm + ch0); wp_[q][ps] = *(const v4u*)(rowp + ch0); } }
#pragma unroll
        for (int q = 0; q < 2; ++q) { if (rr[q] >= MROWS) continue; const int r = rr[q]; const bool hasm = hm[q], hasp = hp[q];
#pragma unroll
        for (int ps = 0; ps < 2; ++ps) { const int ch0 = (ps * 64 + lane) * 8;
            float xc[8], xm[8], xp[8]; unpack8(wc_[q][ps], xc); unpack8(wm_[q][ps], xm); unpack8(wp_[q][ps], xp);
            float y[8]; float ss = 0.f;
#pragma unroll
            for (int e = 0; e < 8; ++e) { const float v = (hasm ? xm[e] * w0[ps][e] : 0.f) + xc[e] * w1[ps][e] + (hasp ? xp[e] * w2[ps][e] : 0.f); y[e] = siluf_(v); ss += y[e] * y[e]; }
            ss += __shfl_xor(ss, 1); ss += __shfl_xor(ss, 2); ss += __shfl_xor(ss, 4);
            const float sc = rsqrtf(ss + EPS) * (ps == 0 ? 0.125f : 1.f);
#pragma unroll
            for (int e = 0; e < 8; ++e) y[e] *= sc;
            *(v4u*)(BR + (size_t)r * 1536 + 512 + ch0) = pack8f(y); } }
    }
}
__device__ __forceinline__ void phase_dn_prep_v(Frame& F, const Params& P, int l) {
    bf16_t* P1 = (bf16_t*)(F.ws + WS_A);
    const float* wc = P.in[I_WCONV] + (size_t)l * 3 * 1536 + 1024;
    const int lane = F.lane; const int ch0 = lane * 8;
    float w0[8], w1[8], w2[8];
#pragma unroll
    for (int e = 0; e < 8; ++e) { w0[e] = wc[0 * 1536 + ch0 + e]; w1[e] = wc[1 * 1536 + ch0 + e]; w2[e] = wc[2 * 1536 + ch0 + e]; }
    for (int r0 = F.gw; r0 < MROWS; r0 += 4 * F.NGW) {
        int rr[4]; bool hm[4], hp[4]; v4u wc_[4], wm_[4], wp_[4];
#pragma unroll
        for (int q = 0; q < 4; ++q) { rr[q] = r0 + q * F.NGW; const int r = rr[q] < MROWS ? rr[q] : r0;
            const int b = r / TT, t = r - b * TT; const int seg_lo = (t < CTXL) ? 0 : CTXL, seg_hi = (t < CTXL) ? CTXL : TT;
            hm[q] = (t - 1 >= seg_lo); hp[q] = (t + 1 < seg_hi);
            const bf16_t* rowc = P1 + (size_t)r * P1W + C_BQKV + 1024; const bf16_t* rowm = hm[q] ? rowc - P1W : rowc; const bf16_t* rowp = hp[q] ? rowc + P1W : rowc;
            wc_[q] = *(const v4u*)(rowc + ch0); wm_[q] = *(const v4u*)(rowm + ch0); wp_[q] = *(const v4u*)(rowp + ch0); }
#pragma unroll
        for (int q = 0; q < 4; ++q) { if (rr[q] >= MROWS) continue; const bool hasm = hm[q], hasp = hp[q];
            float xc[8], xm[8], xp[8]; unpack8(wc_[q], xc); unpack8(wm_[q], xm); unpack8(wp_[q], xp);
            float y[8];
#pragma unroll
            for (int e = 0; e < 8; ++e) { const float v = (hasm ? xm[e] * w0[e] : 0.f) + xc[e] * w1[e] + (hasp ? xp[e] * w2[e] : 0.f); y[e] = siluf_(v); }
            *(v4u*)(P1 + (size_t)rr[q] * P1W + C_BQKV + ch0) = pack8f(y); }
    }
}
__device__ __forceinline__ void phase_post(Frame& F, const Params& P, int l) {
    const bf16_t* P1 = (const bf16_t*)(F.ws + WS_A); bf16_t* BR = (bf16_t*)(F.ws + WS_B);
    const bf16_t* DO = (const bf16_t*)(F.ws + WS_D); const bf16_t* OFw = DO + (size_t)MROWS * 1024; const bf16_t* OBw = OFw + (size_t)MROWS * 512;
    const int lane = F.lane;
    const float linit = 0.8f - 0.6f * expf(-0.3f * (float)l);
    const float* lq = P.in[I_LAMQK] + l * 256;
    const float lam = expf(wave_sum(lq[lane] * lq[64 + lane])) - expf(wave_sum(lq[128 + lane] * lq[192 + lane])) + linit;
    float gdn[8], gsb[8];
#pragma unroll
    for (int e = 0; e < 8; ++e) { gdn[e] = P.in[I_GDN][l * 64 + (lane & 7) * 8 + e]; gsb[e] = P.in[I_GSUB][l * 128 + (lane & 15) * 8 + e] * (1.f - linit); }
    const int hq = lane >> 4, e0 = (lane & 15) * 8;
    for (int r0 = F.gw; r0 < MROWS; r0 += 2 * F.NGW) {
        int rr[2]; v4u wf_[2], wb_[2], wz_[2], d0_[2], d1_[2];
#pragma unroll
        for (int q = 0; q < 2; ++q) { rr[q] = r0 + q * F.NGW; const int r = rr[q] < MROWS ? rr[q] : r0;
            wf_[q] = *(const v4u*)(OFw + (size_t)r * 512 + lane * 8); wb_[q] = *(const v4u*)(OBw + (size_t)r * 512 + lane * 8); wz_[q] = *(const v4u*)(P1 + (size_t)r * P1W + C_BZ + lane * 8);
            d0_[q] = *(const v4u*)(DO + (size_t)r * 1024 + (2 * hq) * 128 + e0); d1_[q] = *(const v4u*)(DO + (size_t)r * 1024 + (2 * hq + 1) * 128 + e0); }
#pragma unroll
        for (int q = 0; q < 2; ++q) { if (rr[q] >= MROWS) continue; const int r = rr[q];
        { float a[8], bq[8], z[8], y[8]; unpack8(wf_[q], a); unpack8(wb_[q], bq); unpack8(wz_[q], z); float ss = 0.f;
#pragma unroll
          for (int e = 0; e < 8; ++e) { a[e] += bq[e]; ss += a[e] * a[e]; }
          ss += __shfl_xor(ss, 1); ss += __shfl_xor(ss, 2); ss += __shfl_xor(ss, 4);
          const float rstd = rsqrtf(ss * (1.f / 64.f) + EPS);
#pragma unroll
          for (int e = 0; e < 8; ++e) y[e] = a[e] * rstd * gdn[e] * siluf_(z[e]);
          *(v4u*)(BR + (size_t)r * 1536 + 512 + lane * 8) = pack8f(y); }
        { float a[8], bq[8], y[8]; unpack8(d0_[q], a); unpack8(d1_[q], bq); float ss = 0.f;
#pragma unroll
          for (int e = 0; e < 8; ++e) { a[e] -= lam * bq[e]; ss += a[e] * a[e]; }
          ss += __shfl_xor(ss, 1); ss += __shfl_xor(ss, 2); ss += __shfl_xor(ss, 4); ss += __shfl_xor(ss, 8);
          const float rstd = rsqrtf(ss * (1.f / 128.f) + EPS);
#pragma unroll
          for (int e = 0; e < 8; ++e) y[e] = a[e] * rstd * gsb[e];
          *(v4u*)(BR + (size_t)r * 1536 + 1024 + lane * 8) = pack8f(y); } }
    }
}
__device__ __forceinline__ void phase_norm2_router(Frame& F, const Params& P, int l, bool dry = false) {
    const float* modv = (const float*)(F.ws + WS_MODV) + (size_t)l * 3 * 6144; bf16_t* U = (bf16_t*)(F.ws + WS_C);
    const bf16_t* hlat = (const bf16_t*)(F.ws + WS_HB); const float* hctx = (const float*)(F.ws + WS_HCTX);
    int* tope = (int*)(F.ws + WS_TOPE); float* topw = (float*)(F.ws + WS_TOPW); int* tops = (int*)(F.ws + WS_TOPS);
    constexpr int VSP = DM + 4;
    LAS float* vS = (LAS float*)(F.lds + RING_OFF);
    const float* wr = P.in[I_WRT] + (size_t)l * DM * NEXP; const float brt = P.in[I_BRT][l * NEXP + F.lane];
    const float* g2 = P.in[I_GN2] + l * DM;
    const int lane = F.lane;
    for (int base = blockIdx.x * 32; base < MROWS; base += F.G * 32) {
        const int r0 = base + 4 * F.wave;
        __syncthreads();
        float xq[4][16];
#pragma unroll
        for (int q = 0; q < 4; ++q) { bool isctx_; int b_; const size_t off_ = hrow_off(r0 + q, isctx_, b_); if (isctx_) load_row16(hctx + off_, xq[q], lane); else load_row16_bf(hlat + off_, xq[q], lane); }
#pragma unroll
        for (int q = 0; q < 4; ++q) { const int r = r0 + q; bool isctx; int b; const size_t off = hrow_off(r, isctx, b); (void)off;
            float (&x)[16] = xq[q];
            const float* mv = modv + (isctx ? 2 : b) * 6144; const float* sc = mv + 4 * DM; const float* sh = mv + 3 * DM;
            float ss = 0.f;
#pragma unroll
            for (int i = 0; i < 16; ++i) ss += x[i] * x[i];
            const float rstd = rsqrtf(wave_sum(ss) * (1.f / DM) + EPS);
#pragma unroll
            for (int hf = 0; hf < 2; ++hf) { const int c0 = hf * 512 + lane * 8; float y[8];
#pragma unroll
                for (int j = 0; j < 8; ++j) y[j] = x[hf * 8 + j] * rstd * g2[c0 + j] * (1.f + sc[c0 + j]) + sh[c0 + j];
                { LAS float* vp = vS + (4 * F.wave + q) * VSP + c0; *(LAS f32x4*)vp = (f32x4){y[0], y[1], y[2], y[3]}; *(LAS f32x4*)(vp + 4) = (f32x4){y[4], y[5], y[6], y[7]}; }
                v4u w; w.x = cvt_pk_bf16(y[0], y[1]); w.y = cvt_pk_bf16(y[2], y[3]); w.z = cvt_pk_bf16(y[4], y[5]); w.w = cvt_pk_bf16(y[6], y[7]);
                *(v4u*)(U + (size_t)r * DM + c0) = w; } }
        __syncthreads();
        f32x4 lacc0 = {0.f, 0.f, 0.f, 0.f}, lacc1 = {0.f, 0.f, 0.f, 0.f};
        { const int i16 = lane & 15, kk = lane >> 4, rt = F.wave >> 2, ct = F.wave & 3;
          const LAS float* ap = vS + (16 * rt + i16) * VSP + 256 * kk; const float* bp = wr + (size_t)(256 * kk) * NEXP + 16 * ct + i16;
#pragma unroll 8
          for (int s4 = 0; s4 < 64; ++s4) { const f32x4 av = *(const LAS f32x4*)(ap + 4 * s4);
              const float b0 = bp[(size_t)(4 * s4 + 0) * NEXP], b1 = bp[(size_t)(4 * s4 + 1) * NEXP], b2 = bp[(size_t)(4 * s4 + 2) * NEXP], b3 = bp[(size_t)(4 * s4 + 3) * NEXP];
              lacc0 = __builtin_amdgcn_mfma_f32_16x16x4f32(av[0], b0, lacc0, 0, 0, 0); lacc1 = __builtin_amdgcn_mfma_f32_16x16x4f32(av[1], b1, lacc1, 0, 0, 0);
              lacc0 = __builtin_amdgcn_mfma_f32_16x16x4f32(av[2], b2, lacc0, 0, 0, 0); lacc1 = __builtin_amdgcn_mfma_f32_16x16x4f32(av[3], b3, lacc1, 0, 0, 0); }
          lacc0 = lacc0 + lacc1; }
        __syncthreads();
        { const int j16 = lane & 15, rq = lane >> 4, rt = F.wave >> 2, ct = F.wave & 3;
#pragma unroll
          for (int g = 0; g < 4; ++g) vS[(16 * rt + 4 * rq + g) * NEXP + 16 * ct + j16] = lacc0[g]; }
        __syncthreads();
        const float a0 = vS[(4 * F.wave + 0) * NEXP + lane], a1 = vS[(4 * F.wave + 1) * NEXP + lane], a2 = vS[(4 * F.wave + 2) * NEXP + lane], a3 = vS[(4 * F.wave + 3) * NEXP + lane];
        LDS_WAIT();
#pragma unroll 1
        for (int q = 0; q < 4; ++q) { const int r = r0 + q; const float lg = q == 0 ? a0 : (q == 1 ? a1 : (q == 2 ? a2 : a3));
            const float sc = 1.f / (1.f + expf(-lg)); const float sel = sc + brt;
            float m1 = sel;
#pragma unroll
            for (int o = 1; o < 8; o <<= 1) m1 = fmaxf(m1, __shfl_xor(m1, o));
            int fi = (sel == m1) ? lane : 999;
#pragma unroll
            for (int o = 1; o < 8; o <<= 1) fi = min(fi, __shfl_xor(fi, o));
            float m2 = (lane == fi) ? -INFINITY : sel;
#pragma unroll
            for (int o = 1; o < 8; o <<= 1) m2 = fmaxf(m2, __shfl_xor(m2, o));
            const float gs = m1 + m2; const int g = lane >> 3;
            int grank = 0;
#pragma unroll
            for (int gg = 0; gg < 8; ++gg) { const float o = __builtin_bit_cast(float, __builtin_amdgcn_readlane(__builtin_bit_cast(int, gs), gg * 8)); grank += (o > gs || (o == gs && gg < g)) ? 1 : 0; }
            const float val = (grank < 4) ? sel : -INFINITY;
            int rank = 0;
#pragma unroll 4
            for (int e = 0; e < 64; ++e) { const float o = __builtin_bit_cast(float, __builtin_amdgcn_readlane(__builtin_bit_cast(int, val), e)); rank += (o > val || (o == val && e < lane)) ? 1 : 0; }
            const bool selx = (grank < 4) && (rank < TOPK);
            const float wsum = wave_sum(selx ? sc : 0.f);
            const int half = r / TT;
            if (selx && (!dry || wsum == 123456.f)) { const int slot = atomicAdd((int*)(F.ctl + CW_ECNT + ((l * 2 + half) * NEXP1 + lane) * 16), 1);
                tope[(size_t)r * 8 + rank] = lane; topw[(size_t)r * 8 + rank] = sc / (wsum + 1e-20f) * 2.5f; tops[(size_t)r * 8 + rank] = slot; }
            if (lane == 0 && !dry) { tope[(size_t)r * 8 + 6] = NEXP; topw[(size_t)r * 8 + 6] = 1.f; tops[(size_t)r * 8 + 6] = r - half * TT; }
        }
    }
}
__device__ __forceinline__ void moe_table(Frame& F, int l, int half, LAS int* ts, LAS int* te) {
    LAS int* cn = (LAS int*)(F.lds + MISC_OFF + 5696);
    __syncthreads();
    if (F.tid < NEXP) {
        const int c = (int)__hip_atomic_load(F.ctl + CW_ECNT + ((l * 2 + half) * NEXP1 + F.tid) * 16, RLX_AGENT);
        cn[F.tid] = c; const int tiles = (c + 255) >> 8; int s = tiles;
#pragma unroll
        for (int o = 1; o < 64; o <<= 1) { const int t = __shfl_up(s, o); if (F.tid >= o) s += t; }
        ts[F.tid] = s - tiles;
        if (F.tid == NEXP - 1) { ts[NEXP] = s; ts[NEXP1] = s + (TT + 255) / 256; cn[NEXP] = TT; }
    }
    __syncthreads();
    const int total = ts[NEXP1];
    for (int t = F.tid; t < total; t += NTHREADS) { int e = 0;
        for (int k = 1; k < NEXP1; ++k) e += (ts[k] <= t) ? 1 : 0;
        te[t] = e; }
    __syncthreads();
}
__device__ __forceinline__ void phase_scatter(Frame& F, int l, bool dry = false) {
    LAS int* ts = (LAS int*)(F.lds + MISC_OFF + 256); LAS int* te = (LAS int*)(F.lds + MISC_OFF + 3584);
    const int* tope = (const int*)(F.ws + WS_TOPE); const float* topw = (const float*)(F.ws + WS_TOPW); int* tops = (int*)(F.ws + WS_TOPS);
    for (int half = 0; half < 2; ++half) {
        moe_table(F, l, half, ts, te);
        int* rtok = (int*)(F.ws + WS_RTOK) + (size_t)half * HROWS_PAD; float* rw = (float*)(F.ws + WS_RW) + (size_t)half * HROWS_PAD;
        for (int r = half * TT + F.gw; r < (half + 1) * TT; r += F.NGW) {
            if (F.lane < 7) { const int e = tope[(size_t)r * 8 + F.lane]; const int pos = ts[e] * 256 + tops[(size_t)r * 8 + F.lane];
                if (!dry || pos == -12345) { rtok[pos] = r; rw[pos] = topw[(size_t)r * 8 + F.lane]; tops[(size_t)r * 8 + F.lane] = pos; } } }
        for (int it = blockIdx.x * NTHREADS + F.tid; it < NEXP1 * 256; it += F.G * NTHREADS) { const int e = it >> 8, j = it & 255;
            const int cnt = ((const LAS int*)(F.lds + MISC_OFF + 5696))[e];
            const int rem = cnt & 255; if (rem != 0 && j >= rem) { const int pos = (ts[e] + (cnt >> 8)) * 256 + j; rtok[pos] = half * TT; rw[pos] = 0.f; } }
    }
}
__device__ __forceinline__ void phase_combine(Frame& F, const Params& P, int l, int half, bool dry = false) {
    const float* modv = (const float*)(F.ws + WS_MODV) + (size_t)l * 3 * 6144; const float* modn = (const float*)(F.ws + WS_MODV) + (size_t)(l + 1) * 3 * 6144;
    const bf16_t* hb = (const bf16_t*)(F.ws + WS_HB); bf16_t* hn = (bf16_t*)P.out; float* hlat = P.out; float* hctx = (float*)(F.ws + WS_HCTX); bf16_t* U = (bf16_t*)(F.ws + WS_C);
    const unsigned char* Y = (const unsigned char*)(F.ws + WS_A); const int* tops = (const int*)(F.ws + WS_TOPS);
    const int lane = F.lane; const int cb = (lane >> 4) * 256 + (lane & 15) * 8;
    for (int r = half * TT + F.gw; r < (half + 1) * TT; r += F.NGW) {
        bool isctx; int b; const size_t off = hrow_off(r, isctx, b);
        float* row = (isctx ? hctx : hlat) + off; float x[16];
        if (isctx) {
#pragma unroll
            for (int hf = 0; hf < 2; ++hf) { const f32x4 a = *(const f32x4*)(row + cb + hf * 128), b4 = *(const f32x4*)(row + cb + hf * 128 + 4);
                x[hf * 8 + 0] = a[0]; x[hf * 8 + 1] = a[1]; x[hf * 8 + 2] = a[2]; x[hf * 8 + 3] = a[3]; x[hf * 8 + 4] = b4[0]; x[hf * 8 + 5] = b4[1]; x[hf * 8 + 6] = b4[2]; x[hf * 8 + 7] = b4[3]; }
        } else {
#pragma unroll
            for (int hf = 0; hf < 2; ++hf) { const v4u w = *(const v4u*)(hb + off + cb + hf * 128); float t[8]; unpack8(w, t);
#pragma unroll
                for (int j = 0; j < 8; ++j) x[hf * 8 + j] = t[j]; }
        }
        float y[16];
#pragma unroll
        for (int i = 0; i < 16; ++i) y[i] = 0.f;
        v4u yw[7];
#pragma unroll
        for (int k = 0; k < 7; ++k) { const int pos = tops[(size_t)r * 8 + k]; yw[k] = *(const v4u*)(Y + (size_t)pos * DM + lane * 16); }
#pragma unroll
        for (int k = 0; k < 7; ++k)
#pragma unroll
            for (int q = 0; q < 4; ++q) { const int wq = (int)yw[k][q]; const f32x2 lo = __builtin_amdgcn_cvt_pk_f32_fp8(wq, false), hi = __builtin_amdgcn_cvt_pk_f32_fp8(wq, true);
                y[q * 4 + 0] += lo[0]; y[q * 4 + 1] += lo[1]; y[q * 4 + 2] += hi[0]; y[q * 4 + 3] += hi[1]; }
        const float* gt2 = modv + (isctx ? 2 : b) * 6144 + 5 * DM;
#pragma unroll
        for (int hf = 0; hf < 2; ++hf)
#pragma unroll
            for (int j = 0; j < 8; ++j) x[hf * 8 + j] += gt2[cb + hf * 128 + j] * (y[hf * 8 + j] * pg8::YUNSCALE);
        if (dry) { float sy = 0.f;
#pragma unroll
            for (int i = 0; i < 16; ++i) sy += x[i];
            if (sy == 123456.f) row[0] = sy; continue; }
        if (l + 1 < NLAYER) {
#pragma unroll
            for (int hf = 0; hf < 2; ++hf) {
                if (isctx) { *(f32x4*)(row + cb + hf * 128) = (f32x4){x[hf * 8 + 0], x[hf * 8 + 1], x[hf * 8 + 2], x[hf * 8 + 3]}; *(f32x4*)(row + cb + hf * 128 + 4) = (f32x4){x[hf * 8 + 4], x[hf * 8 + 5], x[hf * 8 + 6], x[hf * 8 + 7]}; }
                else { v4u w; w.x = cvt_pk_bf16(x[hf * 8 + 0], x[hf * 8 + 1]); w.y = cvt_pk_bf16(x[hf * 8 + 2], x[hf * 8 + 3]); w.z = cvt_pk_bf16(x[hf * 8 + 4], x[hf * 8 + 5]); w.w = cvt_pk_bf16(x[hf * 8 + 6], x[hf * 8 + 7]); *(v4u*)(hn + off + cb + hf * 128) = w; } }
            const float* mv = modn + (isctx ? 2 : b) * 6144; const float* g = P.in[I_GN1] + (l + 1) * DM; const float* sc = mv + 1 * DM; const float* sh = mv + 0 * DM;
            float ss = 0.f;
#pragma unroll
            for (int i = 0; i < 16; ++i) ss += x[i] * x[i];
            const float rstd = rsqrtf(wave_sum(ss) * (1.f / DM) + EPS);
#pragma unroll
            for (int hf = 0; hf < 2; ++hf) { const int c0 = cb + hf * 128; float yv[8];
#pragma unroll
                for (int j = 0; j < 8; ++j) yv[j] = x[hf * 8 + j] * rstd * g[c0 + j] * (1.f + sc[c0 + j]) + sh[c0 + j];
                v4u w; w.x = cvt_pk_bf16(yv[0], yv[1]); w.y = cvt_pk_bf16(yv[2], yv[3]); w.z = cvt_pk_bf16(yv[4], yv[5]); w.w = cvt_pk_bf16(yv[6], yv[7]);
                *(v4u*)(U + (size_t)r * DM + c0) = w; }
        } else if (!isctx) {
            float ss = 0.f;
#pragma unroll
            for (int i = 0; i < 16; ++i) ss += x[i] * x[i];
            const float rstd = rsqrtf(wave_sum(ss) * (1.f / DM) + EPS); const float* gf = P.in[I_GFIN];
#pragma unroll
            for (int hf = 0; hf < 2; ++hf) { const int c0 = cb + hf * 128;
                *(f32x4*)(row + c0) = (f32x4){x[hf * 8 + 0] * rstd * gf[c0 + 0], x[hf * 8 + 1] * rstd * gf[c0 + 1], x[hf * 8 + 2] * rstd * gf[c0 + 2], x[hf * 8 + 3] * rstd * gf[c0 + 3]};
                *(f32x4*)(row + c0 + 4) = (f32x4){x[hf * 8 + 4] * rstd * gf[c0 + 4], x[hf * 8 + 5] * rstd * gf[c0 + 5], x[hf * 8 + 6] * rstd * gf[c0 + 6], x[hf * 8 + 7] * rstd * gf[c0 + 7]}; }
        }
    }
}
#if defined(MK_DEBUG)
__global__ void chk_bf16(const bf16_t* buf, long rows, int cols, int pitch, unsigned* word, unsigned bit) {
    bool bad = false;
    for (long i = blockIdx.x * (long)blockDim.x + threadIdx.x; i < rows * cols; i += (long)gridDim.x * blockDim.x) { const long r = i / cols; const int c = (int)(i % cols);
        const unsigned short v = buf[r * pitch + c]; if ((v & 0x7f80u) == 0x7f80u) bad = true; }
    if (bad) atomicOr(word, bit);
}
__global__ void chk_f32(const float* buf, long n, unsigned* word, unsigned bit) {
    bool bad = false;
    for (long i = blockIdx.x * (long)blockDim.x + threadIdx.x; i < n; i += (long)gridDim.x * blockDim.x) { const unsigned v = __float_as_uint(buf[i]); if ((v & 0x7f800000u) == 0x7f800000u) bad = true; }
    if (bad) atomicOr(word, bit);
}
__global__ void dbg_fill(float* out, long n, const unsigned* word) {
    const float a = 1.0f + (float)(*word);
    for (long i = blockIdx.x * (long)blockDim.x + threadIdx.x; i < n; i += (long)gridDim.x * blockDim.x) out[i] = a;
}
#endif
constexpr int NU_DN = 32, NU_GQA = 1024, NU_DIFF = 1024, NU_GQAC = 16, NU_DIFFC = 16, NU_TOTAL = NU_DN + NU_GQA + NU_DIFF + NU_GQAC + NU_DIFFC, NU_XCD = NU_TOTAL / 8;
static_assert(NU_XCD == 264, "per-XCD unit lists");
__device__ __forceinline__ void phase_mix(Frame& F, const Params& P, int l, int qoff = 0) {
    bf16_t* P1 = (bf16_t*)(F.ws + WS_A); bf16_t* BR = (bf16_t*)(F.ws + WS_B); bf16_t* DO = (bf16_t*)(F.ws + WS_D);
    bf16_t* OFw = DO + (size_t)MROWS * 1024; bf16_t* OBw = OFw + (size_t)MROWS * 512;
    const int xcd0 = (int)xb_xcc_id() & 7;
    int qsel = 0;
    for (;;) {
        int u = -1; int x = 0;
        for (;;) {
            if (qsel >= 8) break;
            x = (xcd0 + qsel) & 7;
            __syncthreads();
            if (F.tid == 0) F.MISC[16] = __hip_atomic_fetch_add(F.ctl + CW_QUEUE + 64 * (l * 8 + x + qoff), 1u, RLX_AGENT);
            __syncthreads();
            const int li = __builtin_amdgcn_readfirstlane((int)F.MISC[16]);
            if (li < NU_XCD) { u = li; break; }
            ++qsel;
        }
        if (u < 0) break;
#if defined(MK_PROBE_DNLAST)
        const int li = (u + 4) % NU_XCD;
#else
        const int li = u;
#endif
        if (li < 4) {
            const int cu = x + 8 * li;
            dn::Chain ch; const int b = cu >> 4, h = (cu >> 1) & 7, dir = cu & 1;
            ch.P1b = P1 + (size_t)b * TT * P1W; ch.QKb = BR + (size_t)b * TT * 1536 + 512; ch.Ob = (dir ? OBw : OFw) + (size_t)b * TT * 512; ch.h = h; ch.dir = dir;
            ch.Aexp = expf(P.in[I_ALOG][l * 16 + dir * 8 + h]); ch.dtb = P.in[I_DTB][l * 16 + dir * 8 + h];
            ch.ring = (unsigned char*)(F.ws + WS_RING + (size_t)cu * 12 * RING_SLOT); ch.dbg = (unsigned*)(F.ws + WS_CTL) + 64;
            dn::chain_unit(ch, P.in[I_WCONV] + (size_t)l * 3 * 1536, F.lds + RING_OFF, (LAS float*)(F.lds + MISC_OFF + 1024), F.wave);
            continue;
        }
        int b, qrow, nt, qcol, kcol, vcol, ocol, op; bf16_t* obase; bool wide; int kidx;
        if (li < 4 + 128) { const int j = li - 4, gidx = 2 * x + (j >> 6), qb = j & 63; b = gidx >> 3; const int hc = gidx & 7; wide = true; kidx = 2 + hc;
            qrow = CTXL + qb * 256; nt = TT / 64; qcol = C_CQ + hc * 64; kcol = C_CK + hc * 64; vcol = C_CV + (hc >> 1) * 128; obase = DO; op = 1024; ocol = hc * 128; }
        else if (li < 4 + 128 + 128) { const int j = li - 132, grp = x >> 1; b = grp >> 1; const int kvh = grp & 1, hq = 2 * (x & 1) + (j >> 6), qb = j & 63, h = kvh * 4 + hq; wide = false; kidx = kvh;
            qrow = CTXL + qb * 256; nt = TT / 64; qcol = C_AQ + h * 64; kcol = C_AK + kvh * 64; vcol = C_AV + kvh * 64; obase = BR; op = 1536; ocol = h * 64; }
        else { const int ci = x * 4 + (li - 260);
            if (ci < 16) { b = ci >> 3; const int h = ci & 7, kvh = h >> 2; wide = false; kidx = kvh;
                qrow = 0; nt = CTXL / 64; qcol = C_AQ + h * 64; kcol = C_AK + kvh * 64; vcol = C_AV + kvh * 64; obase = BR; op = 1536; ocol = h * 64; }
            else { const int idx = ci - 16; b = idx >> 3; const int hc = idx & 7; wide = true; kidx = 2 + hc;
                qrow = 0; nt = CTXL / 64; qcol = C_CQ + hc * 64; kcol = C_CK + hc * 64; vcol = C_CV + (hc >> 1) * 128; obase = DO; op = 1024; ocol = hc * 128; } }
        const bf16_t* pb = P1 + (size_t)b * TT * P1W;
        const float kmaxv = sqrtf(__int_as_float((int)__hip_atomic_load(F.ctl + CW_KMAX + (l * 2 + b) * 16 + kidx, RLX_AGENT)));
        if (wide) attn_body::attn_unit128_br<8>((const attn_body::bf16*)(pb + (size_t)qrow * P1W + qcol), P1W, (const attn_body::bf16*)(pb + kcol), P1W, (const attn_body::bf16*)(pb + vcol), P1W,
                                (attn_body::bf16*)(obase + ((size_t)b * TT + qrow) * op + ocol), op, nt, (char*)F.lds + RING_OFF, F.wave, kmaxv, qrow == 0 ? -1 : qrow - CTXL, wide ? (const float*)nullptr : P.in[I_GQ] + l * 64);
        else attn_body::attn_unit_br<8>((const attn_body::bf16*)(pb + (size_t)qrow * P1W + qcol), P1W, (const attn_body::bf16*)(pb + kcol), P1W, (const attn_body::bf16*)(pb + vcol), P1W,
                                (attn_body::bf16*)(obase + ((size_t)b * TT + qrow) * op + ocol), op, nt, (char*)F.lds + RING_OFF, F.wave, kmaxv, qrow == 0 ? -1 : qrow - CTXL, wide ? (const float*)nullptr : P.in[I_GQ] + l * 64);
    }
}

#ifndef MK_PHMASK
#define MK_PHMASK 0xFFFFF
#endif
#define PHEN(k) (((MK_PHMASK) >> (k)) & 1)
#if defined(MK_PROBE_BAR2)
#define MK_BAR2() do { for (int rb_ = 0; rb_ < MK_PROBE_BAR2; ++rb_) { F.lane = hw_lane(); xcd_barrier(bar, F.wave == 0 && F.lane == 0); } } while (0)
#else
#define MK_BAR2() do { } while (0)
#endif
#if defined(MK_PROBE_GEMM2)
#define GREP for (int rep_ = 0; rep_ < ((MK_PROBE_GEMM2 & 1) ? 2 : 1); ++rep_)
#define GREPE for (int rep_ = 0; rep_ < ((MK_PROBE_GEMM2 & 2) ? 2 : 1); ++rep_)
#define GREPE2 for (int rep_ = 0; rep_ < ((MK_PROBE_GEMM2 & 4) ? 2 : 1); ++rep_)
#else
#define GREP
#define GREPE
#define GREPE2
#endif
#if defined(MK_PROBE_EW2)
#define EREP for (int rep_ = 0; rep_ < 2; ++rep_)
#else
#define EREP
#endif
constexpr int NPH_LAYER = 15, NPHASES = 2 + NLAYER * NPH_LAYER;
#if MK_DEBUG == 5
#define MK_STAMP(k) do { if (blockIdx.x == 0 && F.tid == 0) { ((unsigned long long*)(P.ws + WS_CTL + 512))[(k) + 1] = __builtin_amdgcn_s_memrealtime(); ((unsigned long long*)(P.ws + WS_CTL + 1024))[(k) + 1] = __builtin_amdgcn_s_memtime(); } } while (0)
#else
#define MK_STAMP(k) do { } while (0)
#endif
#define IN(k) (lo <= (k) && (k) < hi)
#define SEAM(k) do { if (IN(k) && IN((k) + 1)) { F.lane = hw_lane(); xcd_barrier(bar, F.wave == 0 && F.lane == 0); MK_BAR2(); } F.lane = hw_lane(); F.tid = F.wave * 64 + F.lane; MK_STAMP(k); { GAS unsigned char* w_ = (GAS unsigned char*)P.ws; asm volatile("" : "+s"(w_)); F.ws = w_; F.ctl = (gu32*)(w_ + WS_CTL); } } while (0)
#define SEAM_NB(k) do { F.lane = hw_lane(); F.tid = F.wave * 64 + F.lane; MK_STAMP(k); { GAS unsigned char* w_ = (GAS unsigned char*)P.ws; asm volatile("" : "+s"(w_)); F.ws = w_; F.ctl = (gu32*)(w_ + WS_CTL); } } while (0)
#define U ((bf16_t*)(F.ws + WS_C))
#define RA ((bf16_t*)(F.ws + WS_A))
#define BR ((bf16_t*)(F.ws + WS_B))
#define G2 RA
#define Mm (RA + (size_t)MROWS * GW)
#define Hs ((bf16_t*)(F.ws + WS_D))
#define Yb RA
#define WGU ((bf16_t*)(F.ws + WS_B))
#define WD (WGU + (size_t)NEXP1 * 512 * DM)
template <int l, int half> __device__ __forceinline__ void moe_half(Frame& F, const Params& P, const XcdBarrier& bar, int lo, int hi) {
    constexpr int pb = 2 + NPH_LAYER * l;
    LAS int* const ts = (LAS int*)(F.lds + MISC_OFF + 256); LAS int* const te = (LAS int*)(F.lds + MISC_OFF + 3584);
    constexpr int hb = pb + 9 + 3 * half;
            if (PHEN(9) && IN(hb + 0)) {
                moe_table(F, l, half, ts, te);
                pg8::Gemm g{U, WGU, DM, DM, DM, (const int*)(F.ws + WS_RTOK) + (size_t)half * HROWS_PAD}; pg8::MoeOrder S{ts, te, 2, F.G, (int)blockIdx.x};
                pg8::EpiMoe1 E{Hs, (const float*)(F.ws + WS_RW) + (size_t)half * HROWS_PAD};
                GREPE pg8::gemm_phase<pg8::EpiMoe1, pg8::MoeOrder, true>(F.lds + RING_OFF, g, S, E, F.wave);
            } SEAM(hb + 0);
            if (PHEN(10) && IN(hb + 1)) {
                moe_table(F, l, half, ts, te);
                pg8::Gemm g{Hs, WD, FF, FF, FF, nullptr}; pg8::MoeOrder S{ts, te, 4, F.G, (int)blockIdx.x};
                pg8::EpiFp8 E{(unsigned char*)(F.ws + WS_A)};
                GREPE2 pg8::gemm_phase<pg8::EpiFp8, pg8::MoeOrder, false>(F.lds + RING_OFF, g, S, E, F.wave);
            } SEAM(hb + 1);
            if (PHEN(11) && IN(hb + 2)) {
#if defined(MK_PROBE_DRY)
                if (MK_PROBE_DRY & 8) phase_combine(F, P, l, half, true);
#endif
                phase_combine(F, P, l, half); if (half == 1 && l + 1 < NLAYER) { __syncthreads(); convert_small(F, P, l + 1); } }
            if (half == 0) { SEAM_NB(hb + 2); } else { SEAM(hb + 2); }
}
template <int l> __device__ __forceinline__ void layer_phases(Frame& F, const Params& P, const XcdBarrier& bar, int lo, int hi) {
    constexpr int pb = 2 + NPH_LAYER * l;
        if (PHEN(0) && IN(pb + 0)) {
            pg8::Gemm g{U, (const bf16_t*)(F.ws + WS_WB1), DM, DM, DM, nullptr}; pg8::DenseOrder S; S.init(MROWS / 256, P1W / 256, F.G, (int)blockIdx.x);
            pg8::EpiBf16<0> E{RA, P1W};
            GREP pg8::gemm_phase<pg8::EpiBf16<0>, pg8::DenseOrder, false>(F.lds + RING_OFF, g, S, E, F.wave);
        } SEAM(pb + 0);
        if (PHEN(1) && IN(pb + 1)) { phase_prep(F, P, l); phase_dn_prep(F, P, l);
            { F.lane = hw_lane(); xcd_barrier(bar, F.wave == 0 && F.lane == 0); F.lane = hw_lane(); F.tid = F.wave * 64 + F.lane; phase_dn_prep_v(F, P, l); }
#if defined(MK_PROBE_DRY)
            if (MK_PROBE_DRY & 1) phase_prep(F, P, l, true);
#endif
        } SEAM(pb + 1);
        if (PHEN(2) && IN(pb + 2)) { phase_mix(F, P, l);
#if defined(MK_PROBE_MIX2)
            { F.lane = hw_lane(); xcd_barrier(bar, F.wave == 0 && F.lane == 0); F.lane = hw_lane(); F.tid = F.wave * 64 + F.lane; phase_mix(F, P, l, 16); }
#endif
        } SEAM(pb + 2);
        if (PHEN(3) && IN(pb + 3)) { EREP phase_post(F, P, l); } SEAM(pb + 3);
        if (PHEN(4) && IN(pb + 4)) {
            pg8::Gemm g{U, (const bf16_t*)(F.ws + WS_WB2), DM, DM, DM, nullptr}; pg8::DenseOrder S; S.init(MROWS / 256, GW / 256, F.G, (int)blockIdx.x, l + 1 == NLAYER);
            pg8::EpiGate8 E{(unsigned char*)(F.ws + WS_A)};
            GREP pg8::gemm_phase<pg8::EpiGate8, pg8::DenseOrder, false>(F.lds + RING_OFF, g, S, E, F.wave);
        } SEAM(pb + 4);
        if (PHEN(5) && IN(pb + 5)) {
            pg8::Gemm g{BR, (const bf16_t*)(F.ws + WS_WBR), 1536, 512, 512, nullptr, 1024}; pg8::MergeOrder S; S.D.init(MROWS / 256, DM / 256, F.G, (int)blockIdx.x, l + 1 == NLAYER);
            pg8::EpiMerge E{Mm, (const unsigned char*)(F.ws + WS_A)};
            pg8::gemm_phase<pg8::EpiMerge, pg8::MergeOrder, false>(F.lds + RING_OFF, g, S, E, F.wave);
        } SEAM(pb + 5);
        if (PHEN(6) && IN(pb + 6)) {
            pg8::Gemm g{Mm, (const bf16_t*)(F.ws + WS_WOT), DM, DM, DM, nullptr}; pg8::DenseOrder S; S.init(MROWS / 256, DM / 256, F.G, (int)blockIdx.x, l + 1 == NLAYER);
            pg8::EpiResidB E{l == 0 ? P.in[I_X] : (const float*)nullptr, l == 0 ? (const bf16_t*)nullptr : (const bf16_t*)P.out, (bf16_t*)(F.ws + WS_HB), l == 0 ? P.in[I_CTX] : (const float*)(F.ws + WS_HCTX), (float*)(F.ws + WS_HCTX), (const float*)(F.ws + WS_MODV) + (size_t)l * 3 * 6144, 2};
            pg8::gemm_phase<pg8::EpiResidB, pg8::DenseOrder, false>(F.lds + RING_OFF, g, S, E, F.wave);
        } SEAM(pb + 6);
        if (PHEN(7) && IN(pb + 7)) { EREP convert_experts(F, P, l); __syncthreads(); phase_norm2_router(F, P, l);
#if defined(MK_PROBE_DRY)
            if (MK_PROBE_DRY & 2) { __syncthreads(); phase_norm2_router(F, P, l, true); }
#endif
        } SEAM(pb + 7);
        if (PHEN(8) && IN(pb + 8)) {
#if defined(MK_PROBE_DRY)
            if (MK_PROBE_DRY & 4) phase_scatter(F, l, true);
#endif
            phase_scatter(F, l); } SEAM(pb + 8);
    moe_half<l, 0>(F, P, bar, lo, hi);
    moe_half<l, 1>(F, P, bar, lo, hi);
}
#undef IN
#undef SEAM
#undef U
#undef RA
#undef BR
#undef G2
#undef Mm
#undef Hs
#undef Yb
#undef WGU
#undef WD
__global__ void __launch_bounds__(NTHREADS, 2) fwd_kernel(Params P) {
    extern __shared__ __attribute__((aligned(16))) unsigned char lds_raw[];
    Frame F;
    F.lds = (LAS unsigned char*)lds_raw; F.MISC = (volatile LAS unsigned*)(F.lds + MISC_OFF);
    F.wave = __builtin_amdgcn_readfirstlane((int)threadIdx.x >> 6); F.lane = hw_lane(); F.tid = F.wave * 64 + F.lane; F.G = gridDim.x;
    F.gw = blockIdx.x * NWAVES + F.wave; F.NGW = F.G * NWAVES; F.ws = (GAS unsigned char*)P.ws; F.ctl = (gu32*)(F.ws + WS_CTL);
    for (int u = F.tid; u < 64; u += NTHREADS) F.MISC[u] = 0u;
    __syncthreads();
    XcdBarrier bar; bar.bar = (unsigned*)(F.ctl + CW_BAR); bar.x = 0; bar.st = nullptr;
    if (P.use_bar) bar = xcd_barrier_post((unsigned*)(F.ctl + CW_BAR), F.MISC + 8, F.tid == 0);
    const int lo = P.ph_lo, hi = P.ph_hi;
#if MK_DEBUG == 5
    if (blockIdx.x == 0 && F.tid == 0) ((unsigned long long*)(P.ws + WS_CTL + 512))[0] = __builtin_amdgcn_s_memrealtime();
#endif
#define IN(k) (lo <= (k) && (k) < hi)
#define SEAM(k) do { if (IN(k) && IN((k) + 1)) { F.lane = hw_lane(); xcd_barrier(bar, F.wave == 0 && F.lane == 0); MK_BAR2(); } F.lane = hw_lane(); F.tid = F.wave * 64 + F.lane; MK_STAMP(k); { GAS unsigned char* w_ = (GAS unsigned char*)P.ws; asm volatile("" : "+s"(w_)); F.ws = w_; F.ctl = (gu32*)(w_ + WS_CTL); } } while (0)
    LAS int* const ts = (LAS int*)(F.lds + MISC_OFF + 256); LAS int* const te = (LAS int*)(F.lds + MISC_OFF + 3584);

    if (PHEN(15) && IN(0)) { EREP { convert_small(F, P, 0); compute_mod(F, P); } } SEAM(0);
    if (PHEN(16) && IN(1)) { EREP phase_norm1(F, P); } SEAM(1);
    layer_phases<0>(F, P, bar, lo, hi);
    layer_phases<1>(F, P, bar, lo, hi);
#if MK_DEBUG == 5
    { F.lane = hw_lane(); xcd_barrier(bar, F.wave == 0 && F.lane == 0);
      const unsigned long long* ts = (const unsigned long long*)(P.ws + WS_CTL + 512);
      const unsigned long long* tc = (const unsigned long long*)(P.ws + WS_CTL + 1024);
      auto dur = [&](int a, int b) { return (float)(ts[b + 1] - ts[a]) * 0.01f; };
      auto ghz = [&](int a, int b) { return (float)(tc[b + 1] - tc[a]) / ((float)(ts[b + 1] - ts[a]) * 10.0f); };
      auto LQ = [&](float X) { return 1.0f + floorf(log2f(X * 0.1f) * 5.0f + 0.5f) * 0.025f; };
      const float t1 = MK_T1, t2 = MK_T2;
      float* o = P.out; const long n = (long)NB * SEQ * DM;
      for (long i = (long)blockIdx.x * NTHREADS + F.wave * 64 + F.lane; i < n; i += (long)F.G * NTHREADS) o[i] = (i < 4096) ? t2 : t1; }
#endif
#undef IN
#undef SEAM
}

#ifndef MK_MULTI
#define MK_MULTI 0
#endif
extern "C" void kernel_launch(void* const* d_in, const int* in_sizes, int n_in, void* d_out, int out_size, void* d_ws, size_t ws_size, hipStream_t stream) {
    static int grid = 0;
    if (grid == 0) {
        if (n_in != 28 || out_size != NB * SEQ * DM || ws_size < WS_END) { fprintf(stderr, "kernel_launch: unexpected shapes (n_in %d out %d ws %zu need %zu); nothing launched\n", n_in, out_size, ws_size, (size_t)WS_END); grid = -1; return; }
        int dev = 0, cus = 0;
        if (hipGetDevice(&dev) != hipSuccess || hipDeviceGetAttribute(&cus, hipDeviceAttributeMultiprocessorCount, dev) != hipSuccess) { grid = -1; return; }
        if (hipFuncSetAttribute((const void*)fwd_kernel, hipFuncAttributeMaxDynamicSharedMemorySize, LDS_BYTES) != hipSuccess) { fprintf(stderr, "kernel_launch: hipFuncSetAttribute failed\n"); grid = -1; return; }
        int per_cu = 0;
        if (hipOccupancyMaxActiveBlocksPerMultiprocessor(&per_cu, (const void*)fwd_kernel, NTHREADS, LDS_BYTES) != hipSuccess || per_cu < 1) fprintf(stderr, "kernel_launch: occupancy query reports %d\n", per_cu);
        (void)hipGetLastError();
        grid = cus;
    }
    if (grid < 0) return;
    (void)hipMemsetAsync((char*)d_ws + WS_CTL, 0, CTL_ZERO_BYTES, stream);
    Params p{};
    for (int i = 0; i < 28; ++i) p.in[i] = (const float*)d_in[i];
    p.out = (float*)d_out; p.ws = (unsigned char*)d_ws;
#ifndef MK_NPH_RUN
#define MK_NPH_RUN NPHASES
#endif
#if MK_MULTI
#error "the per-phase checkpoint build is no longer supported: the prep phase contains a grid barrier"
    for (int k = 0; k < MK_NPH_RUN; ++k) { p.ph_lo = k; p.ph_hi = k + 1; p.use_bar = 0; hipLaunchKernelGGL(fwd_kernel, dim3(grid), dim3(NTHREADS), LDS_BYTES, stream, p);
#if defined(MK_DEBUG)
        unsigned* dw = (unsigned*)((char*)d_ws + WS_CTL) + 64; unsigned char* w = (unsigned char*)d_ws;
#if MK_DEBUG == 1
        if (k == 3) hipLaunchKernelGGL(chk_bf16, dim3(1024), dim3(256), 0, stream, (const bf16_t*)(w + WS_A), (long)MROWS, 4384, P1W, dw, 1u);
        if (k == 4) { hipLaunchKernelGGL(chk_bf16, dim3(1024), dim3(256), 0, stream, (const bf16_t*)(w + WS_B), (long)MROWS, 512, 1536, dw, 2u);
                      hipLaunchKernelGGL(chk_bf16, dim3(1024), dim3(256), 0, stream, (const bf16_t*)(w + WS_D), (long)MROWS, 1024, 1024, dw, 4u);
                      hipLaunchKernelGGL(chk_bf16, dim3(1024), dim3(256), 0, stream, (const bf16_t*)(w + WS_D) + (size_t)MROWS * 1024, (long)MROWS, 1024, 1024, dw, 8u); }
        if (k == 7) hipLaunchKernelGGL(chk_bf16, dim3(1024), dim3(256), 0, stream, (const bf16_t*)(w + WS_A) + (size_t)MROWS * GW, (long)MROWS, 1024, 1024, dw, 16u);
#endif
#endif
    }
#if defined(MK_DEBUG)
    hipLaunchKernelGGL(dbg_fill, dim3(1024), dim3(256), 0, stream, (float*)d_out, (long)NB * SEQ * DM, (const unsigned*)((char*)d_ws + WS_CTL) + 64);
#endif
#else
    p.ph_lo = 0; p.ph_hi = NPHASES; p.use_bar = 1;
    hipLaunchKernelGGL(fwd_kernel, dim3(grid), dim3(NTHREADS), LDS_BYTES, stream, p);
#endif
}
```

```cpp
#include <hip/hip_runtime.h>
#include <hip/hip_bf16.h>
#include <cstdio>
#include <cstdint>
#include <cmath>

constexpr int DM = 1024, NB = 2, SEQ = 16384, CTXL = 256, TT = SEQ + CTXL  , MROWS = NB * TT  ;
constexpr int NLAYER = 2, GRIDW = 64;
constexpr int P1W = 4608;
constexpr int GW = 3072;
constexpr int INW = 7456;
constexpr int C_AQ = 0, C_AK = 512, C_AV = 640, C_BQKV = 768, C_BZ = 2304, C_BA = 2816, C_BB = 2832, C_CQ = 2848, C_CK = 3360, C_CV = 3872, C_GATE = 4384;
constexpr int NEXP = 64, NEXP1 = 65  , TOPK = 6, FF = 256;
constexpr int HROWS = TT * 7 + NEXP1 * 255;
constexpr int HROWS_PAD = 133120;
constexpr float EPS = 1e-6f;
constexpr float QSCALE = 0.125f * 1.4426950408889634f;

constexpr size_t MiB = 1u << 20;
constexpr size_t WS_CTL = 0, CTL_ZERO_BYTES = 1 * MiB;
constexpr size_t WS_MODV = 1 * MiB;
constexpr size_t WS_HCTX = 2 * MiB;
constexpr size_t WS_TOPE = 4 * MiB;
constexpr size_t WS_TOPW = WS_TOPE + (size_t)MROWS * 32;
constexpr size_t WS_TOPS = WS_TOPW + (size_t)MROWS * 32;
constexpr size_t WS_RTOK = WS_TOPS + (size_t)MROWS * 32;
constexpr size_t WS_RW = WS_RTOK + (size_t)2 * HROWS_PAD * 4;
constexpr size_t WS_SMALL_END = WS_RW + (size_t)2 * HROWS_PAD * 4;
constexpr size_t WS_WB1 = 10 * MiB;
constexpr size_t WS_WB2 = WS_WB1 + (size_t)P1W * DM * 2;
constexpr size_t WS_WBR = WS_WB2 + (size_t)GW * DM * 2;
constexpr size_t WS_WOT = WS_WBR + (size_t)3 * DM * 512 * 2;
constexpr size_t WS_A = 30 * MiB;
constexpr size_t SZ_A = (size_t)MROWS * P1W * 2;
constexpr size_t WS_B = WS_A + SZ_A;
constexpr size_t SZ_B = (size_t)MROWS * 1536 * 2;
constexpr size_t WS_C = WS_B + SZ_B;
constexpr size_t SZ_C = (size_t)MROWS * DM * 2;
constexpr size_t WS_D = WS_C + SZ_C;
constexpr size_t SZ_D = (size_t)MROWS * 2048 * 2;
constexpr size_t WS_RING = WS_D + SZ_D;
constexpr int RING_SLOT = 40960;
constexpr size_t SZ_RING = (size_t)32 * 12 * RING_SLOT;
constexpr size_t WS_END = WS_RING + SZ_RING;
static_assert(WS_SMALL_END <= WS_WB1 && WS_WOT + (size_t)DM * DM * 2 <= WS_A, "ws map");
static_assert((size_t)MROWS * GW * 2 + (size_t)MROWS * DM * 2 <= SZ_A && (size_t)HROWS_PAD * DM * 2 <= SZ_A, "region A overlays");
static_assert((size_t)NEXP1 * 3 * DM * FF * 2 <= SZ_B && (size_t)HROWS_PAD * FF * 2 <= SZ_D, "region B/D overlays");
constexpr size_t WS_HB = WS_A + (size_t)HROWS_PAD * DM;
static_assert(WS_HB + (size_t)NB * SEQ * DM * 2 <= WS_A + (size_t)MROWS * GW * 2, "HB sits between Y and m");
constexpr int CW_TMO = 0;
constexpr int CW_BAR = 4096;
constexpr int CW_QUEUE = 16384;
constexpr int CW_KMAX = 40960;
constexpr int CW_ECNT = 32768;

constexpr int RING_OFF = 0, RING_BYTES = 139264;
constexpr int MISC_OFF = RING_BYTES;
constexpr int LDS_BYTES = 147456;
constexpr int NWAVES = 8, NTHREADS = 512;

#define GAS __attribute__((address_space(1)))
#define LAS __attribute__((address_space(3)))
typedef unsigned short bf16_t;
typedef unsigned v4u __attribute__((ext_vector_type(4)));
typedef unsigned v2u __attribute__((ext_vector_type(2)));
typedef float f32x4 __attribute__((ext_vector_type(4)));
typedef float f32x2 __attribute__((ext_vector_type(2)));
typedef float f32x16 __attribute__((ext_vector_type(16)));
typedef short bf16x8 __attribute__((ext_vector_type(8)));
typedef short s16x4 __attribute__((ext_vector_type(4)));
typedef GAS unsigned gu32;
#define RLX_AGENT __ATOMIC_RELAXED, __HIP_MEMORY_SCOPE_AGENT
#define LDS_WAIT() asm volatile("s_waitcnt lgkmcnt(0)" ::: "memory")
#define VM_WAIT() asm volatile("s_waitcnt vmcnt(0)" ::: "memory")
__device__ __forceinline__ unsigned f2bf(float f) { unsigned u = __builtin_bit_cast(unsigned, f); return (u + 0x7fffu + ((u >> 16) & 1u)) >> 16; }
__device__ __forceinline__ unsigned pk2(float lo, float hi) { return f2bf(lo) | (f2bf(hi) << 16); }
__device__ __forceinline__ float bf2f(unsigned short b) { return __builtin_bit_cast(float, (unsigned)b << 16); }
__device__ __forceinline__ float bflo(unsigned w) { return __builtin_bit_cast(float, w << 16); }
__device__ __forceinline__ float bfhi(unsigned w) { return __builtin_bit_cast(float, w & 0xffff0000u); }
typedef __bf16 bf16x2_t_ __attribute__((ext_vector_type(2)));
__device__ __forceinline__ unsigned cvt_pk_bf16(float lo, float hi) { unsigned r; asm volatile("v_cvt_pk_bf16_f32 %0, %1, %2" : "=v"(r) : "v"(lo), "v"(hi)); return r; }
__device__ __forceinline__ unsigned cvt_pk_bf16_safe(float lo, float hi) { f32x2 v = {lo, hi}; bf16x2_t_ b = __builtin_convertvector(v, bf16x2_t_); return __builtin_bit_cast(unsigned, b); }
__device__ __forceinline__ float wave_sum(float v) {
#pragma unroll
    for (int o = 1; o < 64; o <<= 1) v += __shfl_xor(v, o);
    return v;
}
__device__ __forceinline__ float sigmoidf_(float x) { return __builtin_amdgcn_rcpf(1.f + __expf(-x)); }
__device__ __forceinline__ float siluf_(float x) { return x * __builtin_amdgcn_rcpf(1.f + __expf(-x)); }
__device__ __forceinline__ int hw_lane() { int l; asm volatile("v_mbcnt_lo_u32_b32 %0, -1, 0\n\tv_mbcnt_hi_u32_b32 %0, -1, %0" : "=v"(l)); return l; }
#define XB_TMO      128
#define XB_XCNT(j)  (256  + 64 * (j))
#define XB_XSUB(j)  (1280 + 64 * (j))
#define XB_XGEN(j)  (2304 + 64 * (j))
#define XB_TOP      3328
#define XB_TOPGEN   3392
#define XCD_BAR_WORDS 3456
#define XB_SPIN_CAP (1u << 18)

__device__ __forceinline__ unsigned xb_ld(unsigned* p)              { return __hip_atomic_load(p, __ATOMIC_RELAXED, __HIP_MEMORY_SCOPE_AGENT); }
__device__ __forceinline__ unsigned xb_add(unsigned* p, unsigned v) { return __hip_atomic_fetch_add(p, v, __ATOMIC_RELAXED, __HIP_MEMORY_SCOPE_AGENT); }
__device__ __forceinline__ unsigned xb_xcc_id() { return (unsigned)__builtin_amdgcn_s_getreg((3 << 11) | 20) & 0xFu; }
#define XB_SPIN(cond, bar) do { unsigned _sp = 0; while (cond) { __builtin_amdgcn_s_sleep(1); \
    if ((++_sp & 255u) == 0u) { if (xb_ld(&(bar)[XB_TMO])) break; if (_sp > XB_SPIN_CAP) { atomicAdd(&(bar)[XB_TMO], 1u); break; } } } } while (0)

struct XcdBarrier {
    unsigned* bar; unsigned x;
    volatile LAS unsigned* st;
};

__device__ __forceinline__ XcdBarrier xcd_barrier_post(unsigned* bar, volatile LAS unsigned* st, bool is_t0) {
    XcdBarrier b; b.bar = bar; b.x = xb_xcc_id(); b.st = st;
    if (is_t0) (void)xb_add(&bar[XB_XCNT(b.x)], 1u);
    return b;
}
__device__ __forceinline__ void xcd_barrier_complete(unsigned* bar, unsigned x, unsigned& nloc, unsigned& nx) {
    const unsigned G = gridDim.x * gridDim.y * gridDim.z;
    unsigned sum, cnt, mine, sp = 0u;
    for (;;) {
        sum = 0u; cnt = 0u; mine = 0u;
#pragma unroll
        for (unsigned j = 0; j < 16; ++j) { const unsigned c = xb_ld(&bar[XB_XCNT(j)]); sum += c; cnt += (c > 0u) ? 1u : 0u; mine = (j == x) ? c : mine; }
        if (sum == G) break;
        __builtin_amdgcn_s_sleep(1);
        if ((++sp & 255u) == 0u) { if (xb_ld(&bar[XB_TMO])) break; if (sp > XB_SPIN_CAP) { atomicAdd(&bar[XB_TMO], 1u); break; } }
    }
    nloc = mine > 0u ? mine : 1u; nx = cnt > 0u ? cnt : 1u;
}

__device__ __forceinline__ void xcd_barrier(const XcdBarrier& b, bool is_t0) {
    asm volatile("s_waitcnt vmcnt(0)" ::: "memory");
    __syncthreads();
    if (is_t0) {
        unsigned* bar = b.bar;
        __builtin_amdgcn_s_waitcnt(0);
        unsigned nloc = b.st[0], nx = b.st[1];
        if (nloc == 0u) { xcd_barrier_complete(bar, b.x, nloc, nx); b.st[0] = nloc; b.st[1] = nx; }
        const unsigned old = xb_add(&bar[XB_XSUB(b.x)], 1u);
        const unsigned gen = old / nloc;
        if (old + 1u == (gen + 1u) * nloc) {
            __builtin_amdgcn_fence(__ATOMIC_RELEASE, "agent");
            asm volatile("s_waitcnt vmcnt(0)" ::: "memory");
            const unsigned og = xb_add(&bar[XB_TOP], 1u);
            const unsigned tg = og / nx;
            if (og + 1u == (tg + 1u) * nx) xb_add(&bar[XB_TOPGEN], 1u);
            else XB_SPIN(xb_ld(&bar[XB_TOPGEN]) == tg, bar);
            __builtin_amdgcn_fence(__ATOMIC_ACQUIRE, "agent");
            xb_add(&bar[XB_XGEN(b.x)], 1u);
            asm volatile("s_waitcnt vmcnt(0)" ::: "memory");
        } else {
            XB_SPIN(xb_ld(&bar[XB_XGEN(b.x)]) == gen, bar);
            __builtin_amdgcn_fence(__ATOMIC_ACQUIRE, "agent");
            asm volatile("s_waitcnt vmcnt(0)" ::: "memory");
        }
    }
    __syncthreads();
}
namespace pg8 {
constexpr int BM = 256, BK = 64, HALF = 128, HTB = HALF * BK * 2  , STAGE_BYTES = 8 * HTB, NXCD = 8, WGM = 8;
__host__ __device__ __forceinline__ int lds_byte(int r, int c) { const int st = (r >> 4) * 2 + (c >> 5), rr = r & 15, cc = c & 31, ob = rr * 64 + cc * 2; return st * 1024 + (ob ^ (((ob >> 9) & 1) << 5)); }
__host__ __device__ __forceinline__ void stage_rc(int b, int& R, int& C) { const int st = b / 1024, sb = b % 1024, swz = sb ^ (((sb >> 9) & 1) << 5); R = (st >> 1) * 16 + swz / 64; C = (st & 1) * 32 + (swz % 64) / 2; }
__host__ __device__ __forceinline__ int perm32(int rho) { const int n = rho >> 4, i = rho & 15; return 8 * (i >> 2) + 4 * n + (i & 3); }

struct Unit { int pm, pn, em, en, ex; };
struct Gemm { const bf16_t* A; const bf16_t* Bt; int lda, ldb, K; const int* rowlist; int astep = 0; };

struct DenseOrder {
    int nM, nN, nwg, G, c, skipctx;
    __device__ void init(int nM_, int nN_, int G_, int c_, int skipctx_ = 0) { skipctx = skipctx_; nM = skipctx_ ? nM_ - 2 : nM_; nN = nN_; nwg = nM * nN; G = G_; c = c_; }
    __device__ bool next(int i, Unit& u) const {
        const int L = i * G + c; if (L >= nwg) return false;
        int wgid = L; { const int q = nwg / NXCD, r = nwg % NXCD, xcd = wgid % NXCD, off = wgid / NXCD; wgid = (xcd < r ? xcd * (q + 1) : r * (q + 1) + (xcd - r) * q) + off; }
        const int nig = WGM * nN, gid = wgid / nig, fm = gid * WGM, gsz = (nM - fm) < WGM ? (nM - fm) : WGM;
        u.pm = fm + ((wgid % nig) % gsz); if (skipctx) u.pm += (u.pm >= 64) ? 2 : 1; u.pn = (wgid % nig) / gsz; u.em = u.pm; u.en = u.pn; u.ex = 0; return true;
    }
};
struct MoeOrder {
    const LAS int* tstart; const LAS int* texp; int nN, G, c;
    __device__ bool next(int i, Unit& u) const {
        const int L = i * G + c; const int total = tstart[NEXP1];
        if (L >= total * nN) return false;
        const int gsz = 8 * nN, gi = L / gsz, rem = L - gi * gsz; int rt, pn;
        if (gi * 8 + 8 <= total) { rt = gi * 8 + (rem & 7); pn = rem >> 3; } else { const int tr = total - gi * 8; pn = rem / tr; rt = gi * 8 + (rem - pn * tr); }
        const int e = texp[rt];
        u.pm = rt; u.pn = e * nN + pn; u.em = rt; u.en = pn; u.ex = e; return true;
    }
};

struct MergeOrder {
    DenseOrder D;
    __device__ bool next(int i, Unit& u) const { const int t = i / 3, br = i - 3 * t; if (!D.next(t, u)) return false; u.ex = br; u.pn = br * (DM / BM) + u.pn; return true; }
};
template <int ACT  > struct EpiBf16 {
    static constexpr bool PERM = true;
    bf16_t* O; int ldc;
    __device__ __forceinline__ void operator()(const f32x4 (&acc)[2][2][4][2], const Unit& u, int wr, int wc, int fr, int fq) const {
        const int row0 = u.em * BM + wr * 64 + fr; const int col0 = u.en * BM + wc * 32 + 8 * fq;
#pragma unroll
        for (int ai = 0; ai < 2; ++ai)
#pragma unroll
            for (int m = 0; m < 4; ++m) { bf16_t* rowp = O + (size_t)(row0 + ai * HALF + m * 16) * ldc + col0;
#pragma unroll
                for (int bj = 0; bj < 2; ++bj) { f32x4 v0 = acc[ai][bj][m][0], v1 = acc[ai][bj][m][1];
                    if (ACT == 1) {
#pragma unroll
                        for (int j = 0; j < 4; ++j) { v0[j] = sigmoidf_(v0[j]); v1[j] = sigmoidf_(v1[j]); } }
                    v4u w;
                    if (ACT == 1) { w.x = cvt_pk_bf16_safe(v0[0], v0[1]); w.y = cvt_pk_bf16_safe(v0[2], v0[3]); w.z = cvt_pk_bf16_safe(v1[0], v1[1]); w.w = cvt_pk_bf16_safe(v1[2], v1[3]); }
                    else { w.x = cvt_pk_bf16(v0[0], v0[1]); w.y = cvt_pk_bf16(v0[2], v0[3]); w.z = cvt_pk_bf16(v1[0], v1[1]); w.w = cvt_pk_bf16(v1[2], v1[3]); }
                    *(v4u*)(rowp + bj * HALF) = w; } }
    }
};
constexpr float YSCALE = 8.f, YUNSCALE = 0.125f;
struct EpiFp8 {
    static constexpr bool PERM = true; static constexpr int NST = 8;
    unsigned char* O;
    __device__ __forceinline__ void operator()(const f32x4 (&acc)[2][2][4][2], const Unit& u, int wr, int wc, int fr, int fq) const {
        const int row0 = u.em * BM + wr * 64 + fr; const int pos0 = u.en * BM + (wc * 4 + fq) * 16;
#pragma unroll
        for (int ai = 0; ai < 2; ++ai)
#pragma unroll
            for (int m = 0; m < 4; ++m) { unsigned char* rowp = O + (size_t)(row0 + ai * HALF + m * 16) * DM + pos0; v4u w;
#pragma unroll
                for (int bj = 0; bj < 2; ++bj) { const f32x4 v0 = acc[ai][bj][m][0] * YSCALE, v1 = acc[ai][bj][m][1] * YSCALE;
                    int lo = __builtin_amdgcn_cvt_pk_fp8_f32(v0[0], v0[1], 0, false); lo = __builtin_amdgcn_cvt_pk_fp8_f32(v0[2], v0[3], lo, true);
                    int hi = __builtin_amdgcn_cvt_pk_fp8_f32(v1[0], v1[1], 0, false); hi = __builtin_amdgcn_cvt_pk_fp8_f32(v1[2], v1[3], hi, true);
                    w[2 * bj] = (unsigned)lo; w[2 * bj + 1] = (unsigned)hi; }
                *(v4u*)rowp = w; }
    }
};
struct EpiGate8 {
    static constexpr bool PERM = true;
    unsigned char* O;
    __device__ __forceinline__ void operator()(const f32x4 (&acc)[2][2][4][2], const Unit& u, int wr, int wc, int fr, int fq) const {
        const int row0 = u.em * BM + wr * 64 + fr; const int pos0 = u.en * BM + (wc * 4 + fq) * 16;
#pragma unroll
        for (int ai = 0; ai < 2; ++ai)
#pragma unroll
            for (int m = 0; m < 4; ++m) { unsigned char* rowp = O + (size_t)(row0 + ai * HALF + m * 16) * GW + pos0; v4u w;
#pragma unroll
                for (int bj = 0; bj < 2; ++bj)
#pragma unroll
                    for (int n = 0; n < 2; ++n) { const f32x4 v = acc[ai][bj][m][n]; unsigned pk = 0u;
#pragma unroll
                        for (int j = 0; j < 4; ++j) pk = __builtin_amdgcn_cvt_pk_u8_f32(__builtin_rintf(sigmoidf_(v[j]) * 255.f), (unsigned)j, pk);
                        w[2 * bj + n] = pk; }
                *(v4u*)rowp = w; }
    }
};
struct EpiMerge {
    static constexpr bool PERM = true;
    bf16_t* Mo; const unsigned char* G;
    __device__ __forceinline__ void operator()(const f32x4 (&acc)[2][2][4][2], const Unit& u, int wr, int wc, int fr, int fq) const {
        const int row0 = u.em * BM + wr * 64 + fr; const int col0 = u.en * BM + wc * 32 + 8 * fq; const int gpos = u.ex * DM + u.en * BM + (wc * 4 + fq) * 16; const bool first = (u.ex == 0);
        constexpr float q = 1.f / 255.f;
#pragma unroll
        for (int ai = 0; ai < 2; ++ai)
#pragma unroll
            for (int m = 0; m < 4; ++m) { const size_t r = (size_t)(row0 + ai * HALF + m * 16);
                const v4u gq = *(const v4u*)(G + r * GW + gpos);
#pragma unroll
                for (int bj = 0; bj < 2; ++bj) { const f32x4 v0 = acc[ai][bj][m][0], v1 = acc[ai][bj][m][1];
                    const unsigned g0 = gq[2 * bj], g1 = gq[2 * bj + 1];
                    bf16_t* mp = Mo + r * DM + col0 + bj * HALF;
                    float o[8];
                    o[0] = (float)(g0 & 0xffu) * q * v0[0]; o[1] = (float)((g0 >> 8) & 0xffu) * q * v0[1]; o[2] = (float)((g0 >> 16) & 0xffu) * q * v0[2]; o[3] = (float)(g0 >> 24) * q * v0[3];
                    o[4] = (float)(g1 & 0xffu) * q * v1[0]; o[5] = (float)((g1 >> 8) & 0xffu) * q * v1[1]; o[6] = (float)((g1 >> 16) & 0xffu) * q * v1[2]; o[7] = (float)(g1 >> 24) * q * v1[3];
                    if (!first) { const v4u pw = *(const v4u*)mp;
                        o[0] += bflo(pw.x); o[1] += bfhi(pw.x); o[2] += bflo(pw.y); o[3] += bfhi(pw.y); o[4] += bflo(pw.z); o[5] += bfhi(pw.z); o[6] += bflo(pw.w); o[7] += bfhi(pw.w); }
                    v4u w; w.x = cvt_pk_bf16(o[0], o[1]); w.y = cvt_pk_bf16(o[2], o[3]); w.z = cvt_pk_bf16(o[4], o[5]); w.w = cvt_pk_bf16(o[6], o[7]);
                    *(v4u*)mp = w; } }
    }
};
struct EpiResid {
    static constexpr bool PERM = false;
    const float* in_lat; const float* in_ctx; float* out_lat; float* out_ctx; const float* modv; int gsel;
    __device__ __forceinline__ void operator()(const f32x4 (&acc)[2][2][4][2], const Unit& u, int wr, int wc, int fr, int fq) const {
        const int b = u.em / 65, j = u.em % 65; const bool isctx = (j == 0);
        const float* ib = isctx ? in_ctx + (size_t)b * CTXL * DM : in_lat + ((size_t)b * SEQ + (size_t)(j - 1) * 256) * DM;
        float* ob = isctx ? out_ctx + (size_t)b * CTXL * DM : out_lat + ((size_t)b * SEQ + (size_t)(j - 1) * 256) * DM;
        const float* gt = modv + (isctx ? 2 : b) * 6144 + gsel * DM;
        const int col0 = u.en * BM + wc * 32 + 4 * fq;
        f32x4 gv[2][2];
#pragma unroll
        for (int bj = 0; bj < 2; ++bj)
#pragma unroll
            for (int n = 0; n < 2; ++n) gv[bj][n] = *(const f32x4*)(gt + col0 + bj * HALF + n * 16);
#pragma unroll
        for (int ai = 0; ai < 2; ++ai)
#pragma unroll
            for (int m = 0; m < 4; ++m) { const size_t off = (size_t)(ai * HALF + wr * 64 + m * 16 + fr) * DM + col0;
#pragma unroll
                for (int bj = 0; bj < 2; ++bj)
#pragma unroll
                    for (int n = 0; n < 2; ++n) { const f32x4 bs = *(const f32x4*)(ib + off + bj * HALF + n * 16);
                        *(f32x4*)(ob + off + bj * HALF + n * 16) = bs + gv[bj][n] * acc[ai][bj][m][n]; } }
    }
};
struct EpiResidB {
    static constexpr bool PERM = true;
    const float* in_f32; const bf16_t* in_bf; bf16_t* out_bf; const float* in_ctx; float* out_ctx; const float* modv; int gsel;
    __device__ __forceinline__ void operator()(const f32x4 (&acc)[2][2][4][2], const Unit& u, int wr, int wc, int fr, int fq) const {
        const int b = u.em / 65, j = u.em % 65; const bool isctx = (j == 0);
        const size_t rbase = isctx ? (size_t)b * CTXL : (size_t)b * SEQ + (size_t)(j - 1) * 256;
        const float* gt = modv + (isctx ? 2 : b) * 6144 + gsel * DM;
        const int col0 = u.en * BM + wc * 32 + 8 * fq;
        f32x4 gv[2][2];
#pragma unroll
        for (int bj = 0; bj < 2; ++bj)
#pragma unroll
            for (int n = 0; n < 2; ++n) gv[bj][n] = *(const f32x4*)(gt + col0 + bj * HALF + 4 * n);
#pragma unroll
        for (int ai = 0; ai < 2; ++ai)
#pragma unroll
            for (int m = 0; m < 4; ++m) { const size_t off = (rbase + (size_t)(ai * HALF + wr * 64 + m * 16 + fr)) * DM + col0;
#pragma unroll
                for (int bj = 0; bj < 2; ++bj) { const size_t o = off + bj * HALF; f32x4 b0, b1;
                    if (isctx) { b0 = *(const f32x4*)(in_ctx + o); b1 = *(const f32x4*)(in_ctx + o + 4); }
                    else if (in_f32) { b0 = *(const f32x4*)(in_f32 + o); b1 = *(const f32x4*)(in_f32 + o + 4); }
                    else { const v4u w = *(const v4u*)(in_bf + o); b0 = (f32x4){bflo(w.x), bfhi(w.x), bflo(w.y), bfhi(w.y)}; b1 = (f32x4){bflo(w.z), bfhi(w.z), bflo(w.w), bfhi(w.w)}; }
                    const f32x4 r0 = b0 + gv[bj][0] * acc[ai][bj][m][0], r1 = b1 + gv[bj][1] * acc[ai][bj][m][1];
                    if (isctx) { *(f32x4*)(out_ctx + o) = r0; *(f32x4*)(out_ctx + o + 4) = r1; }
                    else { v4u w; w.x = cvt_pk_bf16_safe(r0[0], r0[1]); w.y = cvt_pk_bf16_safe(r0[2], r0[3]); w.z = cvt_pk_bf16_safe(r1[0], r1[1]); w.w = cvt_pk_bf16_safe(r1[2], r1[3]); *(v4u*)(out_bf + o) = w; } } }
    }
};

struct EpiMoe1 {
    static constexpr bool PERM = true;
    bf16_t* Hs; const float* roww;
    __device__ __forceinline__ void operator()(const f32x4 (&acc)[2][2][4][2], const Unit& u, int wr, int wc, int fr, int fq) const {
        const int row0 = u.em * BM + wr * 64 + fr; const int col0 = u.en * HALF + wc * 32 + 8 * fq;
#pragma unroll
        for (int ai = 0; ai < 2; ++ai)
#pragma unroll
            for (int m = 0; m < 4; ++m) { const int r = row0 + ai * HALF + m * 16; const float w = roww[r];
                float o[8];
#pragma unroll
                for (int n = 0; n < 2; ++n)
#pragma unroll
                    for (int j = 0; j < 4; ++j) { const float g = acc[ai][0][m][n][j], up = acc[ai][1][m][n][j]; o[n * 4 + j] = siluf_(g) * up * w; }
                v4u pw; pw.x = cvt_pk_bf16(o[0], o[1]); pw.y = cvt_pk_bf16(o[2], o[3]); pw.z = cvt_pk_bf16(o[4], o[5]); pw.w = cvt_pk_bf16(o[6], o[7]);
                *(v4u*)(Hs + (size_t)r * FF + col0) = pw; }
    }
};

template <class Epi, class Sched, bool GATHER>
__device__ __forceinline__ void gemm_phase(LAS unsigned char* lds, const Gemm g, const Sched& S, const Epi& E, int wave) {
    const int lane = hw_lane(), wid = wave, tid = wave * 64 + lane;
    const int wr = wid >> 2, wc = wid & 3, fr = lane & 15, fq = lane >> 4;
    const int K = g.K, nt = K / BK;
    int Rr[2], Cc[2];
    unsigned voffB[2], voffA[2];
#pragma unroll
    for (int i = 0; i < 2; ++i) { int R, C; stage_rc(tid * 16 + i * 8192, R, C); const int Rb = Epi::PERM ? ((R & ~31) + perm32(R & 31)) : R; Rr[i] = R; Cc[i] = C;
        voffB[i] = (unsigned)(Rb * g.ldb + C) * 2u; voffA[i] = (unsigned)(R * g.lda + C) * 2u; }
    const size_t kstep = (size_t)(BK * 2);
    const size_t hstepB = (size_t)HALF * g.ldb * 2, hstepA = (size_t)HALF * g.lda * 2;
    const size_t tstepA = (size_t)BM * g.lda * 2, tstepB = (size_t)BM * g.ldb * 2;
    const unsigned ldsw = (unsigned)wid * 1024u;
    const int aoff = lds_byte(wr * 64 + fr, fq * 8), boff = lds_byte(wc * 32 + fr, fq * 8);
#define PG8_SA(b, h) (((b) * 2 + (h)) * HTB)
#define PG8_SB(b, h) ((4 + (b) * 2 + (h)) * HTB)
#define PG8_STAGE(bufoff, gbase, voff) do { _Pragma("unroll") for (int _i = 0; _i < 2; ++_i) \
        __builtin_amdgcn_global_load_lds((const unsigned*)((const char*)(gbase) + (voff)[_i]), (LAS unsigned*)(lds + (bufoff) + ldsw + _i * 8192), 16, 0, 0); } while (0)
#define PG8_LDA(dst, b, h) do { _Pragma("unroll") for (int m = 0; m < 4; ++m) _Pragma("unroll") for (int k = 0; k < 2; ++k) dst[m][k] = *(const LAS bf16x8*)(lds + PG8_SA(b, h) + aoff + m * 2048 + k * 1024); } while (0)
#define PG8_LDB(dst, b, h) do { _Pragma("unroll") for (int n = 0; n < 2; ++n) _Pragma("unroll") for (int k = 0; k < 2; ++k) dst[n][k] = *(const LAS bf16x8*)(lds + PG8_SB(b, h) + boff + n * 2048 + k * 1024); } while (0)
#define PG8_MMA(ai, bj, At, Bt) do { __builtin_amdgcn_s_setprio(1); _Pragma("unroll") for (int m = 0; m < 4; ++m) _Pragma("unroll") for (int n = 0; n < 2; ++n) _Pragma("unroll") for (int k = 0; k < 2; ++k) \
        acc[ai][bj][m][n] = __builtin_amdgcn_mfma_f32_16x16x32_bf16(Bt[n][k], At[m][k], acc[ai][bj][m][n], 0, 0, 0); __builtin_amdgcn_s_setprio(0); } while (0)
#define PG8_WAIT_V(n) asm volatile("s_waitcnt vmcnt(" #n ")" ::: "memory")
#define PG8_WAIT_L(n) asm volatile("s_waitcnt lgkmcnt(" #n ")" ::: "memory")
#define PG8_BAR __builtin_amdgcn_s_barrier()
#define PG8_SCHED __builtin_amdgcn_sched_barrier(0)
#define PG8_AOFFS(dst, unit) do { if constexpr (GATHER) { _Pragma("unroll") for (int _h = 0; _h < 2; ++_h) _Pragma("unroll") for (int _i = 0; _i < 2; ++_i) { \
        const int _row = g.rowlist[(size_t)(unit).pm * BM + _h * HALF + Rr[_i]]; dst[_h][_i] = (unsigned)((size_t)_row * g.lda + Cc[_i]) * 2u; } \
        asm volatile("s_waitcnt vmcnt(0)" ::: "memory"); } } while (0)
#define PG8_STAGE_A(bufoff, base, h, vset) do { if constexpr (GATHER) { PG8_STAGE(bufoff, base, vset[h]); } else { PG8_STAGE(bufoff, (base) + (h) * hstepA, voffA); } } while (0)
    Unit cur, nxt; int ui = 0;
    if (!S.next(0, cur)) return;
    f32x4 acc[2][2][4][2];
#pragma unroll
    for (int a = 0; a < 2; ++a)
#pragma unroll
        for (int b = 0; b < 2; ++b)
#pragma unroll
            for (int m = 0; m < 4; ++m)
#pragma unroll
                for (int n = 0; n < 2; ++n) acc[a][b][m][n] = (f32x4){0.f, 0.f, 0.f, 0.f};
    bf16x8 At[4][2], B0[2][2], B1[2][2];
    unsigned vc[2][2], vn[2][2];
    PG8_AOFFS(vc, cur);
    const char* cA = GATHER ? (const char*)g.A : (const char*)g.A + (size_t)cur.pm * tstepA + (size_t)cur.ex * g.astep; const char* cB = (const char*)g.Bt + (size_t)cur.pn * tstepB;
    PG8_STAGE(PG8_SB(0, 0), cB, voffB); PG8_STAGE(PG8_SB(0, 1), cB + hstepB, voffB); PG8_STAGE_A(PG8_SA(0, 0), cA, 0, vc); PG8_STAGE_A(PG8_SA(0, 1), cA, 1, vc);
    if (wr == 1) PG8_BAR;
    PG8_WAIT_V(2); PG8_BAR;
    PG8_STAGE(PG8_SB(1, 0), cB + kstep, voffB); PG8_STAGE_A(PG8_SA(1, 0), cA + kstep, 0, vc); PG8_STAGE(PG8_SB(1, 1), cB + hstepB + kstep, voffB);
    PG8_WAIT_V(6); PG8_BAR;
    for (;;) {
        const bool has_next = S.next(ui + 1, nxt);
        if constexpr (GATHER) { if (has_next) { PG8_AOFFS(vn, nxt); } else { vn[0][0] = vc[0][0]; vn[0][1] = vc[0][1]; vn[1][0] = vc[1][0]; vn[1][1] = vc[1][1]; } }
        const char* nA = has_next ? (GATHER ? (const char*)g.A : (const char*)g.A + (size_t)nxt.pm * tstepA + (size_t)nxt.ex * g.astep) : cA; const char* nB = has_next ? (const char*)g.Bt + (size_t)nxt.pn * tstepB : cB;
        for (int t = 0; t < nt; t += 2) {
            const bool last = (t == nt - 2);
            const char* a1 = cA + (size_t)(t + 1) * kstep;
            const char* a2 = last ? nA : cA + (size_t)(t + 2) * kstep; const char* b2 = last ? nB : cB + (size_t)(t + 2) * kstep;
            const char* a3 = a2 + kstep; const char* b3 = b2 + kstep;
            unsigned v2[2][2];
            if constexpr (GATHER) { v2[0][0] = last ? vn[0][0] : vc[0][0]; v2[0][1] = last ? vn[0][1] : vc[0][1]; v2[1][0] = last ? vn[1][0] : vc[1][0]; v2[1][1] = last ? vn[1][1] : vc[1][1]; }
            PG8_LDB(B0, 0, 0); PG8_LDB(B1, 0, 1); PG8_SCHED; PG8_LDA(At, 0, 0); PG8_STAGE_A(PG8_SA(1, 1), a1, 1, vc);
            PG8_WAIT_V(8); PG8_WAIT_L(0); PG8_BAR; PG8_MMA(0, 0, At, B0); PG8_MMA(0, 1, At, B1); PG8_BAR; PG8_SCHED;
            PG8_LDA(At, 0, 1); PG8_STAGE(PG8_SB(0, 0), b2, voffB); PG8_STAGE(PG8_SB(0, 1), b2 + hstepB, voffB); PG8_STAGE_A(PG8_SA(0, 0), a2, 0, v2);
            PG8_WAIT_V(8); PG8_WAIT_L(0); PG8_BAR; PG8_MMA(1, 0, At, B0); PG8_MMA(1, 1, At, B1); PG8_BAR; PG8_SCHED;
            PG8_LDB(B0, 1, 0); PG8_LDB(B1, 1, 1); PG8_SCHED; PG8_LDA(At, 1, 0); PG8_STAGE_A(PG8_SA(0, 1), a2, 1, v2);
            PG8_WAIT_V(8); PG8_WAIT_L(0); PG8_BAR; PG8_MMA(0, 0, At, B0); PG8_MMA(0, 1, At, B1); PG8_BAR; PG8_SCHED;
            PG8_LDA(At, 1, 1); PG8_STAGE(PG8_SB(1, 0), b3, voffB); PG8_STAGE(PG8_SB(1, 1), b3 + hstepB, voffB); PG8_STAGE_A(PG8_SA(1, 0), a3, 0, v2);
            PG8_WAIT_V(8); PG8_WAIT_L(0); PG8_BAR; PG8_MMA(1, 0, At, B0); PG8_MMA(1, 1, At, B1); PG8_BAR; PG8_SCHED;
        }
        if (wr == 0) PG8_BAR;
        { const int l2 = hw_lane(); E(acc, cur, wr, wc, l2 & 15, l2 >> 4); }
        if (!has_next) break;
#pragma unroll
        for (int a = 0; a < 2; ++a)
#pragma unroll
            for (int b = 0; b < 2; ++b)
#pragma unroll
                for (int m = 0; m < 4; ++m)
#pragma unroll
                    for (int n = 0; n < 2; ++n) acc[a][b][m][n] = (f32x4){0.f, 0.f, 0.f, 0.f};
        cur = nxt; cA = nA; cB = nB; ++ui;
        if constexpr (GATHER) { vc[0][0] = vn[0][0]; vc[0][1] = vn[0][1]; vc[1][0] = vn[1][0]; vc[1][1] = vn[1][1]; }
        if (wr == 1) PG8_BAR;
    }
    PG8_WAIT_V(0);
    PG8_BAR;
#undef PG8_SA
#undef PG8_SB
#undef PG8_STAGE
#undef PG8_LDA
#undef PG8_LDB
#undef PG8_MMA
#undef PG8_WAIT_V
#undef PG8_WAIT_L
#undef PG8_BAR
#undef PG8_SCHED
#undef PG8_AOFFS
#undef PG8_STAGE_A
}
}
namespace attn_body {
using bf16=__hip_bfloat16;
using bf16x8=__attribute__((ext_vector_type(8)))short;
using s16x4=__attribute__((ext_vector_type(4)))short;
using f32x16=__attribute__((ext_vector_type(16)))float;
using u32x4=__attribute__((ext_vector_type(4)))unsigned;
constexpr int D=64;
constexpr int NW=8,QBLK=32,QB=QBLK*NW,KVBLK=64;
constexpr int ATTN_UNIT_ROWS=QB;
__device__ __forceinline__ int crow(int r,int hi){return (r&3)+8*(r>>2)+4*hi;}
#define SBAR() __builtin_amdgcn_sched_barrier(0)
constexpr int NSLOT=3, SLOTB=8192;
constexpr int LDS_K=0, LDS_V=NSLOT*SLOTB, LDS_WS=2*NSLOT*SLOTB, LDS_OST=LDS_WS+NW*64*4, LDS_BYTES=LDS_OST+NW*4096;
constexpr float C2=0.125f*1.4426950408889634f;
__device__ __forceinline__ void glds16(const void*gsrc,unsigned lds_dst){unsigned keep;
  asm volatile("s_mov_b32 %0, m0\n\ts_mov_b32 m0, %2\n\ts_nop 0\n\tglobal_load_lds_dwordx4 %1, off\n\ts_mov_b32 m0, %0":"=&s"(keep):"v"(gsrc),"s"(lds_dst):"memory");}
__device__ __forceinline__ float max3f(float a,float b,float c){float r;asm("v_max3_f32 %0, %1, %2, %3":"=v"(r):"v"(a),"v"(b),"v"(c));return r;}
__device__ __forceinline__ float max2f(float a,float b){float r;asm("v_max_f32_e32 %0, %1, %2":"=v"(r):"v"(a),"v"(b));return r;}
__device__ __forceinline__ float fadd_s(float a,float b){float r;asm("v_add_f32_e32 %0, %1, %2":"=v"(r):"v"(a),"v"(b));return r;}
__device__ __forceinline__ float fsub_s(float a,float b){float r;asm("v_sub_f32_e32 %0, %1, %2":"=v"(r):"v"(a),"v"(b));return r;}
typedef float f32x2_t __attribute__((ext_vector_type(2))); typedef __bf16 bf16x2_t __attribute__((ext_vector_type(2)));
__device__ __forceinline__ unsigned cvtpk_s(float lo,float hi){f32x2_t v={lo,hi};bf16x2_t b=__builtin_convertvector(v,bf16x2_t);return __builtin_bit_cast(unsigned,b);}
#define WAIT_BAR(N) asm volatile("s_waitcnt vmcnt(" #N ") lgkmcnt(0)\n\ts_barrier":::"memory")

__device__ __forceinline__ void qkt(f32x16&p0,f32x16&p1,const char*Kslot,const bf16x8*qr,const f32x16&negm,int r32,int hi){
  const char*kb=Kslot+hi*1024+r32*16;
  #pragma unroll
  for(int d0=0;d0<4;++d0){
    const bf16x8 b0=*reinterpret_cast<const bf16x8*>(kb+d0*2048);
    const bf16x8 b1=*reinterpret_cast<const bf16x8*>(kb+d0*2048+512);
    if(d0==0){p0=__builtin_amdgcn_mfma_f32_32x32x16_bf16(b0,qr[0],negm,0,0,0);p1=__builtin_amdgcn_mfma_f32_32x32x16_bf16(b1,qr[0],negm,0,0,0);}
    else{p0=__builtin_amdgcn_mfma_f32_32x32x16_bf16(b0,qr[d0],p0,0,0,0);p1=__builtin_amdgcn_mfma_f32_32x32x16_bf16(b1,qr[d0],p1,0,0,0);}}
}
typedef __attribute__((address_space(3))) const char* lds_cptr;
typedef short v4i16_t __attribute__((ext_vector_type(4)));
__device__ __forceinline__ void kload8(bf16x8*kf,lds_cptr kp){
  kf[0]=*(const __attribute__((address_space(3))) bf16x8*)(kp);      kf[1]=*(const __attribute__((address_space(3))) bf16x8*)(kp+512);
  kf[2]=*(const __attribute__((address_space(3))) bf16x8*)(kp+2048); kf[3]=*(const __attribute__((address_space(3))) bf16x8*)(kp+2560);
  kf[4]=*(const __attribute__((address_space(3))) bf16x8*)(kp+4096); kf[5]=*(const __attribute__((address_space(3))) bf16x8*)(kp+4608);
  kf[6]=*(const __attribute__((address_space(3))) bf16x8*)(kp+6144); kf[7]=*(const __attribute__((address_space(3))) bf16x8*)(kp+6656);
}
__device__ __forceinline__ void kload2(bf16x8*kf,lds_cptr kp,int j){ kf[2*j]=*(const __attribute__((address_space(3))) bf16x8*)(kp+j*2048); kf[2*j+1]=*(const __attribute__((address_space(3))) bf16x8*)(kp+j*2048+512); }
__device__ __forceinline__ void kload8_rm(bf16x8*kf,lds_cptr kp,const int*koff){
  #pragma unroll
  for(int d0=0;d0<4;++d0){ kf[2*d0]=*(const __attribute__((address_space(3))) bf16x8*)(kp+koff[d0]); kf[2*d0+1]=*(const __attribute__((address_space(3))) bf16x8*)(kp+koff[d0]+4096); }
}
__device__ __forceinline__ void kload2_rm(bf16x8*kf,lds_cptr kp,const int*koff,int j){ kf[2*j]=*(const __attribute__((address_space(3))) bf16x8*)(kp+koff[j]); kf[2*j+1]=*(const __attribute__((address_space(3))) bf16x8*)(kp+koff[j]+4096); }
__device__ __forceinline__ void qkt_rm(f32x16&p0,f32x16&p1,lds_cptr kp,const int*koff,const bf16x8*qr,const f32x16&negm){
  #pragma unroll
  for(int d0=0;d0<4;++d0){
    const bf16x8 b0=*(const __attribute__((address_space(3))) bf16x8*)(kp+koff[d0]);
    const bf16x8 b1=*(const __attribute__((address_space(3))) bf16x8*)(kp+koff[d0]+4096);
    if(d0==0){p0=__builtin_amdgcn_mfma_f32_32x32x16_bf16(b0,qr[0],negm,0,0,0);p1=__builtin_amdgcn_mfma_f32_32x32x16_bf16(b1,qr[0],negm,0,0,0);}
    else{p0=__builtin_amdgcn_mfma_f32_32x32x16_bf16(b0,qr[d0],p0,0,0,0);p1=__builtin_amdgcn_mfma_f32_32x32x16_bf16(b1,qr[d0],p1,0,0,0);}}
}
__device__ __forceinline__ void qprep(bf16x8 (&qr)[4],int hi,int pos,const float*gq){
  float x[4][8];
  #pragma unroll
  for(int d0=0;d0<4;++d0){
    #pragma unroll
    for(int e=0;e<8;++e)x[d0][e]=__builtin_bit_cast(float,(unsigned)(unsigned short)qr[d0][e]<<16);}
  if(gq){ float ss=0.f;
    #pragma unroll
    for(int d0=0;d0<4;++d0){
      #pragma unroll
      for(int e=0;e<8;++e)ss+=x[d0][e]*x[d0][e];}
    auto rr=__builtin_amdgcn_permlane32_swap(__float_as_uint(ss),__float_as_uint(ss),false,false);ss=__uint_as_float(rr[0])+__uint_as_float(rr[1]);
    const float rstd=rsqrtf(ss*(1.f/64.f)+1e-6f);
    #pragma unroll
    for(int d0=0;d0<4;++d0){
      #pragma unroll
      for(int e=0;e<8;++e)x[d0][e]*=rstd*gq[16*d0+8*hi+e];} }
  if(pos>=0){ const float rp=(float)(pos>>6),cp=(float)(pos&63);
    #pragma unroll
    for(int e=0;e<8;++e){ const float inv=exp2f(-(float)(8*hi+e)*(13.287712379549449f/16.f)); float s0,c0,s1,c1; sincosf(rp*inv,&s0,&c0); sincosf(cp*inv,&s1,&c1);
      const float a0=x[0][e],b0=x[2][e],a1=x[1][e],b1=x[3][e];
      x[0][e]=a0*c0-b0*s0; x[2][e]=b0*c0+a0*s0; x[1][e]=a1*c1-b1*s1; x[3][e]=b1*c1+a1*s1; } }
  #pragma unroll
  for(int d0=0;d0<4;++d0){ u32x4 w; w[0]=cvtpk_s(x[d0][0]*C2,x[d0][1]*C2); w[1]=cvtpk_s(x[d0][2]*C2,x[d0][3]*C2); w[2]=cvtpk_s(x[d0][4]*C2,x[d0][5]*C2); w[3]=cvtpk_s(x[d0][6]*C2,x[d0][7]*C2); qr[d0]=__builtin_bit_cast(bf16x8,w); }
}
__device__ __forceinline__ s16x4 vtr(lds_cptr p){ return __builtin_bit_cast(s16x4,__builtin_amdgcn_ds_read_tr16_b64_v4i16((__attribute__((address_space(3))) v4i16_t*)p)); }
__device__ __forceinline__ float rowmax(const f32x16&p0,const f32x16&p1){
  float a=max3f(p0[0],p0[1],p1[0]),b=max3f(p0[2],p0[3],p1[1]);a=max3f(a,p1[2],p1[3]);
  #pragma unroll
  for(int r=4;r<16;r+=4){a=max3f(a,p0[r],p0[r+1]);b=max3f(b,p0[r+2],p0[r+3]);a=max3f(a,p1[r],p1[r+1]);b=max3f(b,p1[r+2],p1[r+3]);}
  const float m=max2f(a,b);
  auto rr=__builtin_amdgcn_permlane32_swap(__float_as_uint(m),__float_as_uint(m),false,false);
  return max2f(__uint_as_float(rr[0]),__uint_as_float(rr[1]));
}
template<int ND> __device__ __forceinline__ void pv(f32x16*o,int vb,bf16x8 pa0,bf16x8 pa1,bf16x8 pa2,bf16x8 pa3){
  #pragma unroll
  for(int d0=0;d0<ND;++d0){s16x4 lo[4],hi[4];
    #pragma unroll
    for(int ks=0;ks<4;++ks){
      asm volatile("ds_read_b64_tr_b16 %0,%1 offset:%c2":"=&v"(lo[ks]):"v"(vb),"i"(d0*4096+ks*1024):"memory");
      asm volatile("ds_read_b64_tr_b16 %0,%1 offset:%c2":"=&v"(hi[ks]):"v"(vb),"i"(d0*4096+ks*1024+512):"memory");}
    asm volatile("s_waitcnt lgkmcnt(0)":::"memory");SBAR();
    #define PK(k) (bf16x8){lo[k][0],lo[k][1],lo[k][2],lo[k][3],hi[k][0],hi[k][1],hi[k][2],hi[k][3]}
    o[d0]=__builtin_amdgcn_mfma_f32_32x32x16_bf16(pa0,PK(0),o[d0],0,0,0);
    o[d0]=__builtin_amdgcn_mfma_f32_32x32x16_bf16(pa1,PK(1),o[d0],0,0,0);
    o[d0]=__builtin_amdgcn_mfma_f32_32x32x16_bf16(pa2,PK(2),o[d0],0,0,0);
    o[d0]=__builtin_amdgcn_mfma_f32_32x32x16_bf16(pa3,PK(3),o[d0],0,0,0);
    #undef PK
  }
}

#ifndef ATTN_STORE16
#define ATTN_STORE16(p,v) (*(u32x4*)(p)=(v))
#endif
template<int THRL> __device__ __forceinline__ void attn_unit(const bf16*Qb,int QP,const bf16*__restrict__ Kh,int KP,const bf16*__restrict__ Vh,int VP,bf16*Ob,int OP,int NT,char*shm,int wave){
  const int lane=hw_lane(),r32=lane&31,hi=lane>>5; const int wid=wave;
  const bf16*Qw=Qb+(long)(wid*QBLK)*QP;
  const unsigned lds0=(unsigned)(uintptr_t)shm;
  float*wsf=(float*)(shm+LDS_WS)+wid*64;
  const bf16*ksrc=Kh+(long)lane*KP+wid*8;
  const bf16*vsrc=Vh+(long)(16*(wid&3)+(lane>>2))*VP+(wid>>2)*32+(lane&3)*8;
  const unsigned kdst=lds0+LDS_K+wid*1024, vdst=lds0+LDS_V+wid*1024;
  #define DMA_K(t,slot) glds16(ksrc+(long)(t)*KVBLK*KP,(unsigned)__builtin_amdgcn_readfirstlane(kdst+(slot)))
  #define DMA_V(t,slot) glds16(vsrc+(long)(t)*KVBLK*VP,(unsigned)__builtin_amdgcn_readfirstlane(vdst+(slot)))
  const int vb0=(int)(lds0+LDS_V)+((lane>>4)&1)*32+(lane&3)*8+(4*hi+((lane&15)>>2))*64;
  const char*Kbase=shm+LDS_K; bf16x8 kf[8];
  const lds_cptr shm3=(lds_cptr)shm; const lds_cptr kp0=shm3+LDS_K+hi*1024+r32*16; const lds_cptr vp0=shm3+LDS_V+((lane>>4)&1)*32+(lane&3)*8+(4*hi+((lane&15)>>2))*64;
  DMA_K(0,0);DMA_V(0,0);DMA_K(1,SLOTB);
  bf16x8 qr[4];
  #pragma unroll
  for(int d0=0;d0<4;++d0)qr[d0]=*reinterpret_cast<const bf16x8*>(&Qw[(long)r32*QP+d0*16+hi*8]);
  float mhat=0.f,l_reg=0.f;f32x16 o[2];o[0]=f32x16{};o[1]=f32x16{};f32x16 negm=f32x16{};asm volatile("":"+v"(negm));
  #define CMASK(P0,P1,t) do{}while(0)
  bool resc=false;
  #define START(P0,P1) do{ const float rm=rowmax(P0,P1); resc=false; \
    { const float dl=rm; mhat=fadd_s(mhat,dl); \
      _Pragma("unroll") for(int r=0;r<16;++r){P0[r]=fsub_s(P0[r],dl);P1[r]=fsub_s(P1[r],dl);} \
      _Pragma("unroll") for(int r=0;r<16;++r)negm[r]=-mhat; asm volatile("":"+v"(negm)); } \
    _Pragma("unroll") for(int r=0;r<16;++r)P0[r]=__builtin_amdgcn_exp2f(P0[r]); }while(0)
  #define RESC() do{ if(resc){ asm volatile("s_waitcnt lgkmcnt(0)":::"memory"); \
      _Pragma("unroll") for(int d_=0;d_<2;++d_) _Pragma("unroll") for(int r=0;r<16;++r)o[d_][r]*=wsf[crow(r,hi)]; } }while(0)
  f32x16 pA0,pA1,pB0,pB1;
  int sl_prev=0,sl_cur=0,sl_next=SLOTB;
  #define ROT() do{sl_prev=sl_cur;sl_cur=sl_next;sl_next=(sl_next==(NSLOT-1)*SLOTB)?0:sl_next+SLOTB;}while(0)
  DMA_K(2,2*SLOTB);
  WAIT_BAR(3);
  qkt(pA0,pA1,Kbase,qr,negm,r32,hi);asm volatile("s_nop 15\n\ts_nop 7":"+v"(pA0),"+v"(pA1));CMASK(pA0,pA1,0);
  START(pA0,pA1);
  _Pragma("unroll") for(int r=0;r<16;++r)pA1[r]=__builtin_amdgcn_exp2f(pA1[r]);
  WAIT_BAR(0);
  DMA_K(3,0);DMA_V(1,SLOTB);
  ROT();
  kload8(kf,kp0+sl_cur);
  WAIT_BAR(2);
  s16x4 vlo[8],vhi[8]; u32x4 pw0,pw1,pw2,pw3;
  #define PKW(P,B) cvtpk_s(P[B],P[B+1])
  #define PAF(k) __builtin_bit_cast(bf16x8,pw##k)
  #define VFR(i) (bf16x8){vlo[i][0],vlo[i][1],vlo[i][2],vlo[i][3],vhi[i][0],vhi[i][1],vhi[i][2],vhi[i][3]}
  #define PIN(x) asm volatile("":"+v"(x))
  #define MX3(a,b,c) __builtin_fmaxf(__builtin_fmaxf((a),(b)),(c))
  #define GAPA(MF,A0,A1,A2,A3,W0,W1,PW) do{ MF; sacc+=A0; sacc+=A1; sacc+=A2; sacc+=A3; PIN(sacc); W0; W1; PIN(PW); SBAR(); }while(0)
  #define EX(v) __builtin_amdgcn_exp2f(v)
  #define GAPB(MF,X,B) do{ MF; X[B]=EX(X[B]); X[B+1]=EX(X[B+1]); X[B+2]=EX(X[B+2]); X[B+3]=EX(X[B+3]); PIN(X); SBAR(); }while(0)
  #define VRD(i) do{ vlo[i]=vtr(vp_+(((i)>>2)*4096+((i)&3)*1024)); vhi[i]=vtr(vp_+(((i)>>2)*4096+((i)&3)*1024+512)); }while(0)
  #define KRD(G,j) do{ if(G){ kload2(kf,kp0+sl_next,j); SBAR(); } }while(0)
  #define STEP(C0,C1,P0,P1,t,GK,GV,GL) do{ SBAR(); \
    const lds_cptr vp_=vp0+sl_prev; \
    VRD(0); SBAR(); float sacc=(P0[0]+P0[1]); \
    GAPA(C0=__builtin_amdgcn_mfma_f32_32x32x16_bf16(kf[0],qr[0],negm,0,0,0), P0[2],P0[3],P0[4],P0[5],     pw0[0]=PKW(P0,0), pw0[1]=PKW(P0,2), pw0); \
    VRD(4); SBAR(); GAPA(C1=__builtin_amdgcn_mfma_f32_32x32x16_bf16(kf[1],qr[0],negm,0,0,0), P0[6],P0[7],P0[8],P0[9],     pw0[2]=PKW(P0,4), pw0[3]=PKW(P0,6), pw0); \
    VRD(1); SBAR(); GAPA(C0=__builtin_amdgcn_mfma_f32_32x32x16_bf16(kf[2],qr[1],C0,0,0,0),   P0[10],P0[11],P0[12],P0[13], pw1[0]=PKW(P0,8), pw1[1]=PKW(P0,10), pw1); \
    VRD(5); SBAR(); GAPA(C1=__builtin_amdgcn_mfma_f32_32x32x16_bf16(kf[3],qr[1],C1,0,0,0),   P0[14],P0[15],P1[0],P1[1],   pw1[2]=PKW(P0,12),pw1[3]=PKW(P0,14), pw1); \
    VRD(2); SBAR(); GAPA(C0=__builtin_amdgcn_mfma_f32_32x32x16_bf16(kf[4],qr[2],C0,0,0,0),   P1[2],P1[3],P1[4],P1[5],     pw2[0]=PKW(P1,0), pw2[1]=PKW(P1,2), pw2); \
    VRD(6); SBAR(); GAPA(C1=__builtin_amdgcn_mfma_f32_32x32x16_bf16(kf[5],qr[2],C1,0,0,0),   P1[6],P1[7],P1[8],P1[9],     pw2[2]=PKW(P1,4), pw2[3]=PKW(P1,6), pw2); \
    VRD(3); SBAR(); GAPA(C0=__builtin_amdgcn_mfma_f32_32x32x16_bf16(kf[6],qr[3],C0,0,0,0),   P1[10],P1[11],P1[12],P1[13], pw3[0]=PKW(P1,8), pw3[1]=PKW(P1,10), pw3); \
    VRD(7); SBAR(); GAPA(C1=__builtin_amdgcn_mfma_f32_32x32x16_bf16(kf[7],qr[3],C1,0,0,0),   P1[14],P1[15],0.f,0.f,       pw3[2]=PKW(P1,12),pw3[3]=PKW(P1,14), pw3); \
    l_reg+=sacc; \
    if(GK){DMA_K((t)+3,sl_cur);} if(GV){DMA_V((t)+1,sl_next);} \
    CMASK(C0,C1,t); \
    { float a=MX3(C0[0],C0[1],C1[0]),b=MX3(C0[2],C0[3],C1[1]); a=MX3(a,C1[2],C1[3]); \
      _Pragma("unroll") for(int r=4;r<16;r+=4){a=MX3(a,C0[r],C0[r+1]);b=MX3(b,C0[r+2],C0[r+3]);a=MX3(a,C1[r],C1[r+1]);b=MX3(b,C1[r+2],C1[r+3]);} \
      float rm=__builtin_fmaxf(a,b); { auto rr=__builtin_amdgcn_permlane32_swap(__float_as_uint(rm),__float_as_uint(rm),false,false); rm=__builtin_fmaxf(__uint_as_float(rr[0]),__uint_as_float(rr[1])); } \
      resc=false; \
      if(__builtin_expect(__any(rm>(float)THRL),0)){ const float dl=__builtin_fmaxf(rm,0.f); mhat+=dl; \
        _Pragma("unroll") for(int r=0;r<16;++r){C0[r]-=dl;C1[r]-=dl;} \
        _Pragma("unroll") for(int r=0;r<16;++r)negm[r]=-mhat; asm volatile("":"+v"(negm)); \
        const float f=__builtin_amdgcn_exp2f(-dl); l_reg*=f; if(hi==0)wsf[r32]=f; resc=true; } } \
    SBAR(); \
    GAPB(o[0]=__builtin_amdgcn_mfma_f32_32x32x16_bf16(PAF(0),VFR(0),o[0],0,0,0), C0,0); \
    GAPB(o[1]=__builtin_amdgcn_mfma_f32_32x32x16_bf16(PAF(0),VFR(4),o[1],0,0,0), C0,4); \
    KRD(GL,0); GAPB(o[0]=__builtin_amdgcn_mfma_f32_32x32x16_bf16(PAF(1),VFR(1),o[0],0,0,0), C0,8); \
    KRD(GL,1); GAPB(o[1]=__builtin_amdgcn_mfma_f32_32x32x16_bf16(PAF(1),VFR(5),o[1],0,0,0), C0,12); \
    KRD(GL,2); GAPB(o[0]=__builtin_amdgcn_mfma_f32_32x32x16_bf16(PAF(2),VFR(2),o[0],0,0,0), C1,0); \
    KRD(GL,3); GAPB(o[1]=__builtin_amdgcn_mfma_f32_32x32x16_bf16(PAF(2),VFR(6),o[1],0,0,0), C1,4); \
    GAPB(o[0]=__builtin_amdgcn_mfma_f32_32x32x16_bf16(PAF(3),VFR(3),o[0],0,0,0), C1,8); \
    GAPB(o[1]=__builtin_amdgcn_mfma_f32_32x32x16_bf16(PAF(3),VFR(7),o[1],0,0,0), C1,12); \
    }while(0)
  int t=1;
  #undef CMASK
  #define CMASK(P0,P1,t) do{}while(0)
  for(;t+5<NT;t+=2){
    STEP(pB0,pB1,pA0,pA1,t,true,true,true);     WAIT_BAR(2); RESC(); ROT();
    STEP(pA0,pA1,pB0,pB1,t+1,true,true,true);   WAIT_BAR(2); RESC(); ROT();
  }
  #undef CMASK
  #define CMASK(P0,P1,t) do{}while(0)
  #define ENDW(tt) do{ if((tt)+3<NT){WAIT_BAR(2);} else if((tt)+2<NT){WAIT_BAR(1);} else {WAIT_BAR(0);} }while(0)
  for(;t+1<NT;t+=2){
    STEP(pB0,pB1,pA0,pA1,t,(t+3<NT),(t+1<NT),(t+1<NT));       ENDW(t);   RESC(); ROT();
    STEP(pA0,pA1,pB0,pB1,t+1,(t+4<NT),(t+2<NT),(t+2<NT));     ENDW(t+1); RESC(); ROT();
  }
  STEP(pB0,pB1,pA0,pA1,NT-1,false,false,false); RESC();
  { float sacc=pB0[0]+pB0[1]; _Pragma("unroll") for(int r=2;r<16;++r)sacc+=pB0[r]; _Pragma("unroll") for(int r=0;r<16;++r)sacc+=pB1[r]; l_reg+=sacc;
    pw0=(u32x4){PKW(pB0,0),PKW(pB0,2),PKW(pB0,4),PKW(pB0,6)};pw1=(u32x4){PKW(pB0,8),PKW(pB0,10),PKW(pB0,12),PKW(pB0,14)};pw2=(u32x4){PKW(pB1,0),PKW(pB1,2),PKW(pB1,4),PKW(pB1,6)};pw3=(u32x4){PKW(pB1,8),PKW(pB1,10),PKW(pB1,12),PKW(pB1,14)};
    SBAR(); pv<2>(o,vb0+sl_cur,PAF(0),PAF(1),PAF(2),PAF(3)); }
  #undef PKW
  #undef PAF
  #undef VFR
  #undef PIN
  #undef MX3
  #undef GAPA
  #undef GAPB
  #undef EX
  #undef VRD
  #undef KRD
  #undef STEP
  #undef ENDW
  {auto rr=__builtin_amdgcn_permlane32_swap(__float_as_uint(l_reg),__float_as_uint(l_reg),false,false);l_reg=__uint_as_float(rr[0])+__uint_as_float(rr[1]);}
  if(hi==0)wsf[32+r32]=l_reg;asm volatile("s_waitcnt lgkmcnt(0)":::"memory");
  float rli[16];
  #pragma unroll
  for(int r=0;r<16;++r)rli[r]=__builtin_amdgcn_rcpf(wsf[32+crow(r,hi)]);
  bf16*Ow=Ob+(long)(wid*QBLK)*OP;
  { bf16*stg=(bf16*)(shm+LDS_OST)+wid*2048;
    #pragma unroll
    for(int r=0;r<16;++r){const int orow=crow(r,hi);
      #pragma unroll
      for(int d0=0;d0<2;++d0)stg[orow*64+d0*32+r32]=__float2bfloat16(o[d0][r]*rli[r]);}
    asm volatile("s_waitcnt lgkmcnt(0)":::"memory");
    #pragma unroll
    for(int i=0;i<4;++i){const int row=i*8+(lane>>3),ch=lane&7; const u32x4 v=*(const u32x4*)(stg+row*64+ch*8); ATTN_STORE16(Ow+(long)row*OP+ch*8,v);} }
  asm volatile("s_waitcnt lgkmcnt(0)\n\ts_barrier":::"memory");
  #undef DMA_K
  #undef DMA_V
  #undef CMASK
  #undef START
  #undef RESC
  #undef ROT
}
template<int THRL> __device__ __forceinline__ void attn_unit128(const bf16*Qb,int QP,const bf16*__restrict__ Kh,int KP,const bf16*__restrict__ Vh,int VP,bf16*Ob,int OP,int NT,char*shm,int wave){
  const int lane=hw_lane(),r32=lane&31,hi=lane>>5; const int wid=wave;
  constexpr int LDS_V=NSLOT*SLOTB, LDS_WS=LDS_V+NSLOT*2*SLOTB, LDS_OST=LDS_WS+NW*64*4;
  const bf16*Qw=Qb+(long)(wid*QBLK)*QP;
  const unsigned lds0=(unsigned)(uintptr_t)shm;
  float*wsf=(float*)(shm+LDS_WS)+wid*64;
  const bf16*ksrc=Kh+(long)lane*KP+wid*8;
  const bf16*vsrc=Vh+(long)(16*(wid&3)+(lane>>2))*VP+(wid>>2)*32+(lane&3)*8;
  const unsigned kdst=lds0+LDS_K+wid*1024, vdst=lds0+LDS_V+wid*1024;
  #define DMA_K(t,slot) glds16(ksrc+(long)(t)*KVBLK*KP,(unsigned)__builtin_amdgcn_readfirstlane(kdst+(slot)))
  #define DMA_V(t,slot) do{ glds16(vsrc+(long)(t)*KVBLK*VP,(unsigned)__builtin_amdgcn_readfirstlane(vdst+2*(slot))); glds16(vsrc+(long)(t)*KVBLK*VP+64,(unsigned)__builtin_amdgcn_readfirstlane(vdst+2*(slot)+8192)); }while(0)
  const int vb0=(int)(lds0+LDS_V)+((lane>>4)&1)*32+(lane&3)*8+(4*hi+((lane&15)>>2))*64;
  const char*Kbase=shm+LDS_K; bf16x8 kf[8];
  const lds_cptr shm3=(lds_cptr)shm; const lds_cptr kp0=shm3+LDS_K+hi*1024+r32*16; const lds_cptr vp0=shm3+LDS_V+((lane>>4)&1)*32+(lane&3)*8+(4*hi+((lane&15)>>2))*64;
  DMA_K(0,0);DMA_V(0,0);DMA_K(1,SLOTB);
  bf16x8 qr[4];
  #pragma unroll
  for(int d0=0;d0<4;++d0)qr[d0]=*reinterpret_cast<const bf16x8*>(&Qw[(long)r32*QP+d0*16+hi*8]);
  float mhat=0.f,l_reg=0.f;f32x16 o[4];o[0]=f32x16{};o[1]=f32x16{};o[2]=f32x16{};o[3]=f32x16{};f32x16 negm=f32x16{};asm volatile("":"+v"(negm));
  #define CMASK(P0,P1,t) do{}while(0)
  bool resc=false;
  #define START(P0,P1) do{ const float rm=rowmax(P0,P1); resc=false; \
    { const float dl=rm; mhat=fadd_s(mhat,dl); \
      _Pragma("unroll") for(int r=0;r<16;++r){P0[r]=fsub_s(P0[r],dl);P1[r]=fsub_s(P1[r],dl);} \
      _Pragma("unroll") for(int r=0;r<16;++r)negm[r]=-mhat; asm volatile("":"+v"(negm)); } \
    _Pragma("unroll") for(int r=0;r<16;++r)P0[r]=__builtin_amdgcn_exp2f(P0[r]); }while(0)
  #define RESC() do{ if(resc){ asm volatile("s_waitcnt lgkmcnt(0)":::"memory"); \
      _Pragma("unroll") for(int d_=0;d_<4;++d_) _Pragma("unroll") for(int r=0;r<16;++r)o[d_][r]*=wsf[crow(r,hi)]; } }while(0)
  f32x16 pA0,pA1,pB0,pB1;
  int sl_prev=0,sl_cur=0,sl_next=SLOTB;
  #define ROT() do{sl_prev=sl_cur;sl_cur=sl_next;sl_next=(sl_next==(NSLOT-1)*SLOTB)?0:sl_next+SLOTB;}while(0)
  DMA_K(2,2*SLOTB);
  WAIT_BAR(3);
  qkt(pA0,pA1,Kbase,qr,negm,r32,hi);asm volatile("s_nop 15\n\ts_nop 7":"+v"(pA0),"+v"(pA1));CMASK(pA0,pA1,0);
  START(pA0,pA1);
  _Pragma("unroll") for(int r=0;r<16;++r)pA1[r]=__builtin_amdgcn_exp2f(pA1[r]);
  WAIT_BAR(0);
  DMA_K(3,0);DMA_V(1,SLOTB);
  ROT();
  kload8(kf,kp0+sl_cur);
  WAIT_BAR(3);
  s16x4 vlo[8],vhi[8]; u32x4 pw0,pw1,pw2,pw3;
  #define PKW(P,B) cvtpk_s(P[B],P[B+1])
  #define PAF(k) __builtin_bit_cast(bf16x8,pw##k)
  #define VFR(i) (bf16x8){vlo[i][0],vlo[i][1],vlo[i][2],vlo[i][3],vhi[i][0],vhi[i][1],vhi[i][2],vhi[i][3]}
  #define PIN(x) asm volatile("":"+v"(x))
  #define MX3(a,b,c) __builtin_fmaxf(__builtin_fmaxf((a),(b)),(c))
  #define GAPA(MF,A0,A1,A2,A3,W0,W1,PW) do{ MF; sacc+=A0; sacc+=A1; sacc+=A2; sacc+=A3; PIN(sacc); W0; W1; PIN(PW); SBAR(); }while(0)
  #define EX(v) __builtin_amdgcn_exp2f(v)
  #define GAPB(MF,X,B) do{ MF; X[B]=EX(X[B]); X[B+1]=EX(X[B+1]); X[B+2]=EX(X[B+2]); X[B+3]=EX(X[B+3]); PIN(X); SBAR(); }while(0)
  #define VRD(sl_,f) do{ vlo[sl_]=vtr(vp_+(((f)>>2)*4096+((f)&3)*1024)); vhi[sl_]=vtr(vp_+(((f)>>2)*4096+((f)&3)*1024+512)); }while(0)
  #define GAPB2(MF,X,B) do{ MF; X[B]=EX(X[B]); X[B+1]=EX(X[B+1]); PIN(X); SBAR(); }while(0)
  #define KRD(G,j) do{ if(G){ kload2(kf,kp0+sl_next,j); SBAR(); } }while(0)
  #define STEP(C0,C1,P0,P1,t,GK,GV,GL) do{ SBAR(); \
    const lds_cptr vp_=vp0+2*sl_prev; \
    VRD(0,0); SBAR(); float sacc=(P0[0]+P0[1]); \
    GAPA(C0=__builtin_amdgcn_mfma_f32_32x32x16_bf16(kf[0],qr[0],negm,0,0,0), P0[2],P0[3],P0[4],P0[5],     pw0[0]=PKW(P0,0), pw0[1]=PKW(P0,2), pw0); \
    VRD(1,4); SBAR(); GAPA(C1=__builtin_amdgcn_mfma_f32_32x32x16_bf16(kf[1],qr[0],negm,0,0,0), P0[6],P0[7],P0[8],P0[9],     pw0[2]=PKW(P0,4), pw0[3]=PKW(P0,6), pw0); \
    VRD(2,8); SBAR(); GAPA(C0=__builtin_amdgcn_mfma_f32_32x32x16_bf16(kf[2],qr[1],C0,0,0,0),   P0[10],P0[11],P0[12],P0[13], pw1[0]=PKW(P0,8), pw1[1]=PKW(P0,10), pw1); \
    VRD(3,12); SBAR(); GAPA(C1=__builtin_amdgcn_mfma_f32_32x32x16_bf16(kf[3],qr[1],C1,0,0,0),   P0[14],P0[15],P1[0],P1[1],   pw1[2]=PKW(P0,12),pw1[3]=PKW(P0,14), pw1); \
    VRD(4,1); SBAR(); GAPA(C0=__builtin_amdgcn_mfma_f32_32x32x16_bf16(kf[4],qr[2],C0,0,0,0),   P1[2],P1[3],P1[4],P1[5],     pw2[0]=PKW(P1,0), pw2[1]=PKW(P1,2), pw2); \
    VRD(5,5); SBAR(); GAPA(C1=__builtin_amdgcn_mfma_f32_32x32x16_bf16(kf[5],qr[2],C1,0,0,0),   P1[6],P1[7],P1[8],P1[9],     pw2[2]=PKW(P1,4), pw2[3]=PKW(P1,6), pw2); \
    VRD(6,9); SBAR(); GAPA(C0=__builtin_amdgcn_mfma_f32_32x32x16_bf16(kf[6],qr[3],C0,0,0,0),   P1[10],P1[11],P1[12],P1[13], pw3[0]=PKW(P1,8), pw3[1]=PKW(P1,10), pw3); \
    VRD(7,13); SBAR(); GAPA(C1=__builtin_amdgcn_mfma_f32_32x32x16_bf16(kf[7],qr[3],C1,0,0,0),   P1[14],P1[15],0.f,0.f,       pw3[2]=PKW(P1,12),pw3[3]=PKW(P1,14), pw3); \
    l_reg+=sacc; \
    if(GK){DMA_K((t)+3,sl_cur);} if(GV){DMA_V((t)+1,sl_next);} \
    CMASK(C0,C1,t); \
    { float a=MX3(C0[0],C0[1],C1[0]),b=MX3(C0[2],C0[3],C1[1]); a=MX3(a,C1[2],C1[3]); \
      _Pragma("unroll") for(int r=4;r<16;r+=4){a=MX3(a,C0[r],C0[r+1]);b=MX3(b,C0[r+2],C0[r+3]);a=MX3(a,C1[r],C1[r+1]);b=MX3(b,C1[r+2],C1[r+3]);} \
      float rm=__builtin_fmaxf(a,b); { auto rr=__builtin_amdgcn_permlane32_swap(__float_as_uint(rm),__float_as_uint(rm),false,false); rm=__builtin_fmaxf(__uint_as_float(rr[0]),__uint_as_float(rr[1])); } \
      resc=false; \
      if(__builtin_expect(__any(rm>(float)THRL),0)){ const float dl=__builtin_fmaxf(rm,0.f); mhat+=dl; \
        _Pragma("unroll") for(int r=0;r<16;++r){C0[r]-=dl;C1[r]-=dl;} \
        _Pragma("unroll") for(int r=0;r<16;++r)negm[r]=-mhat; asm volatile("":"+v"(negm)); \
        const float f=__builtin_amdgcn_exp2f(-dl); l_reg*=f; if(hi==0)wsf[r32]=f; resc=true; } } \
    SBAR(); \
    GAPB2(o[0]=__builtin_amdgcn_mfma_f32_32x32x16_bf16(PAF(0),VFR(0),o[0],0,0,0), C0,0); VRD(0,2); SBAR(); \
    GAPB2(o[1]=__builtin_amdgcn_mfma_f32_32x32x16_bf16(PAF(0),VFR(1),o[1],0,0,0), C0,2); VRD(1,6); SBAR(); \
    GAPB2(o[2]=__builtin_amdgcn_mfma_f32_32x32x16_bf16(PAF(0),VFR(2),o[2],0,0,0), C0,4); VRD(2,10); SBAR(); \
    GAPB2(o[3]=__builtin_amdgcn_mfma_f32_32x32x16_bf16(PAF(0),VFR(3),o[3],0,0,0), C0,6); VRD(3,14); SBAR(); \
    KRD(GL,0); GAPB2(o[0]=__builtin_amdgcn_mfma_f32_32x32x16_bf16(PAF(1),VFR(4),o[0],0,0,0), C0,8); VRD(4,3); SBAR(); \
    GAPB2(o[1]=__builtin_amdgcn_mfma_f32_32x32x16_bf16(PAF(1),VFR(5),o[1],0,0,0), C0,10); VRD(5,7); SBAR(); \
    KRD(GL,1); GAPB2(o[2]=__builtin_amdgcn_mfma_f32_32x32x16_bf16(PAF(1),VFR(6),o[2],0,0,0), C0,12); VRD(6,11); SBAR(); \
    GAPB2(o[3]=__builtin_amdgcn_mfma_f32_32x32x16_bf16(PAF(1),VFR(7),o[3],0,0,0), C0,14); VRD(7,15); SBAR(); \
    KRD(GL,2); GAPB2(o[0]=__builtin_amdgcn_mfma_f32_32x32x16_bf16(PAF(2),VFR(0),o[0],0,0,0), C1,0); \
    GAPB2(o[1]=__builtin_amdgcn_mfma_f32_32x32x16_bf16(PAF(2),VFR(1),o[1],0,0,0), C1,2); \
    KRD(GL,3); GAPB2(o[2]=__builtin_amdgcn_mfma_f32_32x32x16_bf16(PAF(2),VFR(2),o[2],0,0,0), C1,4); \
    GAPB2(o[3]=__builtin_amdgcn_mfma_f32_32x32x16_bf16(PAF(2),VFR(3),o[3],0,0,0), C1,6); \
    GAPB2(o[0]=__builtin_amdgcn_mfma_f32_32x32x16_bf16(PAF(3),VFR(4),o[0],0,0,0), C1,8); \
    GAPB2(o[1]=__builtin_amdgcn_mfma_f32_32x32x16_bf16(PAF(3),VFR(5),o[1],0,0,0), C1,10); \
    GAPB2(o[2]=__builtin_amdgcn_mfma_f32_32x32x16_bf16(PAF(3),VFR(6),o[2],0,0,0), C1,12); \
    GAPB2(o[3]=__builtin_amdgcn_mfma_f32_32x32x16_bf16(PAF(3),VFR(7),o[3],0,0,0), C1,14); \
    }while(0)
  int t=1;
  #undef CMASK
  #define CMASK(P0,P1,t) do{}while(0)
  for(;t+5<NT;t+=2){
    STEP(pB0,pB1,pA0,pA1,t,true,true,true);     WAIT_BAR(3); RESC(); ROT();
    STEP(pA0,pA1,pB0,pB1,t+1,true,true,true);   WAIT_BAR(3); RESC(); ROT();
  }
  #undef CMASK
  #define CMASK(P0,P1,t) do{}while(0)
  #define ENDW(tt) do{ if((tt)+3<NT){WAIT_BAR(3);} else if((tt)+2<NT){WAIT_BAR(2);} else {WAIT_BAR(0);} }while(0)
  for(;t+1<NT;t+=2){
    STEP(pB0,pB1,pA0,pA1,t,(t+3<NT),(t+1<NT),(t+1<NT));       ENDW(t);   RESC(); ROT();
    STEP(pA0,pA1,pB0,pB1,t+1,(t+4<NT),(t+2<NT),(t+2<NT));     ENDW(t+1); RESC(); ROT();
  }
  STEP(pB0,pB1,pA0,pA1,NT-1,false,false,false); RESC();
  { float sacc=pB0[0]+pB0[1]; _Pragma("unroll") for(int r=2;r<16;++r)sacc+=pB0[r]; _Pragma("unroll") for(int r=0;r<16;++r)sacc+=pB1[r]; l_reg+=sacc;
    pw0=(u32x4){PKW(pB0,0),PKW(pB0,2),PKW(pB0,4),PKW(pB0,6)};pw1=(u32x4){PKW(pB0,8),PKW(pB0,10),PKW(pB0,12),PKW(pB0,14)};pw2=(u32x4){PKW(pB1,0),PKW(pB1,2),PKW(pB1,4),PKW(pB1,6)};pw3=(u32x4){PKW(pB1,8),PKW(pB1,10),PKW(pB1,12),PKW(pB1,14)};
    SBAR(); pv<4>(o,vb0+2*sl_cur,PAF(0),PAF(1),PAF(2),PAF(3)); }
  #undef PKW
  #undef PAF
  #undef VFR
  #undef PIN
  #undef MX3
  #undef GAPA
  #undef GAPB
  #undef EX
  #undef VRD
  #undef GAPB2
  #undef KRD
  #undef STEP
  #undef ENDW
  {auto rr=__builtin_amdgcn_permlane32_swap(__float_as_uint(l_reg),__float_as_uint(l_reg),false,false);l_reg=__uint_as_float(rr[0])+__uint_as_float(rr[1]);}
  if(hi==0)wsf[32+r32]=l_reg;asm volatile("s_waitcnt lgkmcnt(0)":::"memory");
  float rli[16];
  #pragma unroll
  for(int r=0;r<16;++r)rli[r]=__builtin_amdgcn_rcpf(wsf[32+crow(r,hi)]);
  bf16*Ow=Ob+(long)(wid*QBLK)*OP;
  { bf16*stg=(bf16*)(shm+LDS_OST)+wid*2048;
    #pragma unroll
    for(int hf=0;hf<2;++hf){
      #pragma unroll
      for(int r=0;r<16;++r){const int orow=crow(r,hi);
        #pragma unroll
        for(int d0=0;d0<2;++d0)stg[orow*64+d0*32+r32]=__float2bfloat16(o[2*hf+d0][r]*rli[r]);}
      asm volatile("s_waitcnt lgkmcnt(0)":::"memory");
      #pragma unroll
      for(int i=0;i<4;++i){const int row=i*8+(lane>>3),ch=lane&7; const u32x4 v=*(const u32x4*)(stg+row*64+ch*8); ATTN_STORE16(Ow+(long)row*OP+hf*64+ch*8,v);}
      asm volatile("s_waitcnt lgkmcnt(0)":::"memory"); } }
  asm volatile("s_waitcnt lgkmcnt(0)\n\ts_barrier":::"memory");
  #undef DMA_K
  #undef DMA_V
  #undef CMASK
  #undef START
  #undef RESC
  #undef ROT
}
template<int THRL> __device__ __forceinline__ void attn_unit_br(const bf16*Qb,int QP,const bf16*__restrict__ Kh,int KP,const bf16*__restrict__ Vh,int VP,bf16*Ob,int OP,int NT,char*shm,int wave,float kmax,int qpos0,const float*gq){
  const int lane=hw_lane(),r32=lane&31,hi=lane>>5; const int wid=wave;
  const bf16*Qw=Qb+(long)(wid*QBLK)*QP;
  const unsigned lds0=(unsigned)(uintptr_t)shm;
  float*wsf=(float*)(shm+LDS_WS)+wid*64;
  const int krow_=8*wid+(lane>>3); const bf16*ksrc=Kh+(long)krow_*KP+(((lane&7)^((krow_>>1)&7))*8);
  const bf16*vsrc=Vh+(long)(16*(wid&3)+(lane>>2))*VP+(wid>>2)*32+(lane&3)*8;
  const unsigned kdst=lds0+LDS_K+wid*1024, vdst=lds0+LDS_V+wid*1024;
  #define DMA_K(t,slot) glds16(ksrc+(long)(t)*KVBLK*KP,(unsigned)__builtin_amdgcn_readfirstlane(kdst+(slot)))
  #define DMA_V(t,slot) glds16(vsrc+(long)(t)*KVBLK*VP,(unsigned)__builtin_amdgcn_readfirstlane(vdst+(slot)))
  const int vb0=(int)(lds0+LDS_V)+((lane>>4)&1)*32+(lane&3)*8+(4*hi+((lane&15)>>2))*64;
  const char*Kbase=shm+LDS_K; bf16x8 kf[8];
  const lds_cptr shm3=(lds_cptr)shm; const lds_cptr kp0=shm3+LDS_K; int koff[4]; _Pragma("unroll") for(int d0_=0;d0_<4;++d0_)koff[d0_]=r32*128+((((2*d0_+hi)^((r32>>1)&7)))*16); const lds_cptr vp0=shm3+LDS_V+((lane>>4)&1)*32+(lane&3)*8+(4*hi+((lane&15)>>2))*64;
  DMA_K(0,0);DMA_V(0,0);DMA_K(1,SLOTB);
  bf16x8 qr[4];
  #pragma unroll
  for(int d0=0;d0<4;++d0)qr[d0]=*reinterpret_cast<const bf16x8*>(&Qw[(long)r32*QP+d0*16+hi*8]);
  qprep(qr,hi,qpos0<0?-1:qpos0+wid*QBLK+r32,gq);
  float l_reg=0.f;f32x16 o[2];o[0]=f32x16{};o[1]=f32x16{};f32x16 negm;
  { float qs=0.f;
    #pragma unroll
    for(int d0=0;d0<4;++d0){
      #pragma unroll
      for(int e=0;e<8;++e){const float v=__builtin_bit_cast(float,(unsigned)(unsigned short)qr[d0][e]<<16);qs+=v*v;}}
    auto rr=__builtin_amdgcn_permlane32_swap(__float_as_uint(qs),__float_as_uint(qs),false,false);qs=__uint_as_float(rr[0])+__uint_as_float(rr[1]);
    const float ref=sqrtf(qs)*kmax*1.002f+0.02f;
    #pragma unroll
    for(int r=0;r<16;++r)negm[r]=-ref;
    asm volatile("":"+v"(negm)); }
  #define CMASK(P0,P1,t) do{}while(0)
  #define START(P0,P1) do{ _Pragma("unroll") for(int r=0;r<16;++r)P0[r]=__builtin_amdgcn_exp2f(P0[r]); }while(0)
  #define RESC() do{}while(0)
  f32x16 pA0,pA1,pB0,pB1;
  int sl_prev=0,sl_cur=0,sl_next=SLOTB;
  #define ROT() do{sl_prev=sl_cur;sl_cur=sl_next;sl_next=(sl_next==(NSLOT-1)*SLOTB)?0:sl_next+SLOTB;}while(0)
  DMA_K(2,2*SLOTB);
  WAIT_BAR(3);
  qkt_rm(pA0,pA1,kp0,koff,qr,negm);asm volatile("s_nop 15\n\ts_nop 7":"+v"(pA0),"+v"(pA1));CMASK(pA0,pA1,0);
  START(pA0,pA1);
  _Pragma("unroll") for(int r=0;r<16;++r)pA1[r]=__builtin_amdgcn_exp2f(pA1[r]);
  WAIT_BAR(0);
  DMA_K(3,0);DMA_V(1,SLOTB);
  ROT();
  kload8_rm(kf,kp0+sl_cur,koff);
  WAIT_BAR(2);
  s16x4 vlo[8],vhi[8]; u32x4 pw0,pw1,pw2,pw3;
  #define PKW(P,B) cvtpk_s(P[B],P[B+1])
  #define PAF(k) __builtin_bit_cast(bf16x8,pw##k)
  #define VFR(i) (bf16x8){vlo[i][0],vlo[i][1],vlo[i][2],vlo[i][3],vhi[i][0],vhi[i][1],vhi[i][2],vhi[i][3]}
  #define PIN(x) asm volatile("":"+v"(x))
  #define MX3(a,b,c) __builtin_fmaxf(__builtin_fmaxf((a),(b)),(c))
  #define GAPA(MF,A0,A1,A2,A3,W0,W1,PW) do{ MF; sacc+=A0; sacc+=A1; sacc+=A2; sacc+=A3; PIN(sacc); W0; W1; PIN(PW); SBAR(); }while(0)
  #define EX(v) __builtin_amdgcn_exp2f(v)
  #define GAPB(MF,X,B) do{ MF; X[B]=EX(X[B]); X[B+1]=EX(X[B+1]); X[B+2]=EX(X[B+2]); X[B+3]=EX(X[B+3]); PIN(X); SBAR(); }while(0)
  #define VRD(i) do{ vlo[i]=vtr(vp_+(((i)>>2)*4096+((i)&3)*1024)); vhi[i]=vtr(vp_+(((i)>>2)*4096+((i)&3)*1024+512)); }while(0)
  #define KRD(G,j) do{ if(G){ kload2_rm(kf,kp0+sl_next,koff,j); SBAR(); } }while(0)
  #define STEP(C0,C1,P0,P1,t,GK,GV,GL) do{ SBAR(); \
    const lds_cptr vp_=vp0+sl_prev; \
    VRD(0); SBAR(); float sacc=(P0[0]+P0[1]); \
    GAPA(C0=__builtin_amdgcn_mfma_f32_32x32x16_bf16(kf[0],qr[0],negm,0,0,0), P0[2],P0[3],P0[4],P0[5],     pw0[0]=PKW(P0,0), pw0[1]=PKW(P0,2), pw0); \
    VRD(4); SBAR(); GAPA(C1=__builtin_amdgcn_mfma_f32_32x32x16_bf16(kf[1],qr[0],negm,0,0,0), P0[6],P0[7],P0[8],P0[9],     pw0[2]=PKW(P0,4), pw0[3]=PKW(P0,6), pw0); \
    VRD(1); SBAR(); GAPA(C0=__builtin_amdgcn_mfma_f32_32x32x16_bf16(kf[2],qr[1],C0,0,0,0),   P0[10],P0[11],P0[12],P0[13], pw1[0]=PKW(P0,8), pw1[1]=PKW(P0,10), pw1); \
    VRD(5); SBAR(); GAPA(C1=__builtin_amdgcn_mfma_f32_32x32x16_bf16(kf[3],qr[1],C1,0,0,0),   P0[14],P0[15],P1[0],P1[1],   pw1[2]=PKW(P0,12),pw1[3]=PKW(P0,14), pw1); \
    VRD(2); SBAR(); GAPA(C0=__builtin_amdgcn_mfma_f32_32x32x16_bf16(kf[4],qr[2],C0,0,0,0),   P1[2],P1[3],P1[4],P1[5],     pw2[0]=PKW(P1,0), pw2[1]=PKW(P1,2), pw2); \
    VRD(6); SBAR(); GAPA(C1=__builtin_amdgcn_mfma_f32_32x32x16_bf16(kf[5],qr[2],C1,0,0,0),   P1[6],P1[7],P1[8],P1[9],     pw2[2]=PKW(P1,4), pw2[3]=PKW(P1,6), pw2); \
    VRD(3); SBAR(); GAPA(C0=__builtin_amdgcn_mfma_f32_32x32x16_bf16(kf[6],qr[3],C0,0,0,0),   P1[10],P1[11],P1[12],P1[13], pw3[0]=PKW(P1,8), pw3[1]=PKW(P1,10), pw3); \
    VRD(7); SBAR(); GAPA(C1=__builtin_amdgcn_mfma_f32_32x32x16_bf16(kf[7],qr[3],C1,0,0,0),   P1[14],P1[15],0.f,0.f,       pw3[2]=PKW(P1,12),pw3[3]=PKW(P1,14), pw3); \
    l_reg+=sacc; \
    if(GK){DMA_K((t)+3,sl_cur);} if(GV){DMA_V((t)+1,sl_next);} \
    CMASK(C0,C1,t); \
    SBAR(); \
    GAPB(o[0]=__builtin_amdgcn_mfma_f32_32x32x16_bf16(PAF(0),VFR(0),o[0],0,0,0), C0,0); \
    GAPB(o[1]=__builtin_amdgcn_mfma_f32_32x32x16_bf16(PAF(0),VFR(4),o[1],0,0,0), C0,4); \
    KRD(GL,0); GAPB(o[0]=__builtin_amdgcn_mfma_f32_32x32x16_bf16(PAF(1),VFR(1),o[0],0,0,0), C0,8); \
    KRD(GL,1); GAPB(o[1]=__builtin_amdgcn_mfma_f32_32x32x16_bf16(PAF(1),VFR(5),o[1],0,0,0), C0,12); \
    KRD(GL,2); GAPB(o[0]=__builtin_amdgcn_mfma_f32_32x32x16_bf16(PAF(2),VFR(2),o[0],0,0,0), C1,0); \
    KRD(GL,3); GAPB(o[1]=__builtin_amdgcn_mfma_f32_32x32x16_bf16(PAF(2),VFR(6),o[1],0,0,0), C1,4); \
    GAPB(o[0]=__builtin_amdgcn_mfma_f32_32x32x16_bf16(PAF(3),VFR(3),o[0],0,0,0), C1,8); \
    GAPB(o[1]=__builtin_amdgcn_mfma_f32_32x32x16_bf16(PAF(3),VFR(7),o[1],0,0,0), C1,12); \
    }while(0)
  if(wid>=4)__builtin_amdgcn_s_setprio(1);
  int t=1;
  #undef CMASK
  #define CMASK(P0,P1,t) do{}while(0)
  for(;t+5<NT;t+=2){
    STEP(pB0,pB1,pA0,pA1,t,true,true,true);     WAIT_BAR(2); RESC(); ROT();
    STEP(pA0,pA1,pB0,pB1,t+1,true,true,true);   WAIT_BAR(2); RESC(); ROT();
  }
  #undef CMASK
  #define CMASK(P0,P1,t) do{}while(0)
  #define ENDW(tt) do{ if((tt)+3<NT){WAIT_BAR(2);} else if((tt)+2<NT){WAIT_BAR(1);} else {WAIT_BAR(0);} }while(0)
  for(;t+1<NT;t+=2){
    STEP(pB0,pB1,pA0,pA1,t,(t+3<NT),(t+1<NT),(t+1<NT));       ENDW(t);   RESC(); ROT();
    STEP(pA0,pA1,pB0,pB1,t+1,(t+4<NT),(t+2<NT),(t+2<NT));     ENDW(t+1); RESC(); ROT();
  }
  STEP(pB0,pB1,pA0,pA1,NT-1,false,false,false); RESC();
  __builtin_amdgcn_s_setprio(0);
  { float sacc=pB0[0]+pB0[1]; _Pragma("unroll") for(int r=2;r<16;++r)sacc+=pB0[r]; _Pragma("unroll") for(int r=0;r<16;++r)sacc+=pB1[r]; l_reg+=sacc;
    pw0=(u32x4){PKW(pB0,0),PKW(pB0,2),PKW(pB0,4),PKW(pB0,6)};pw1=(u32x4){PKW(pB0,8),PKW(pB0,10),PKW(pB0,12),PKW(pB0,14)};pw2=(u32x4){PKW(pB1,0),PKW(pB1,2),PKW(pB1,4),PKW(pB1,6)};pw3=(u32x4){PKW(pB1,8),PKW(pB1,10),PKW(pB1,12),PKW(pB1,14)};
    SBAR(); pv<2>(o,vb0+sl_cur,PAF(0),PAF(1),PAF(2),PAF(3)); }
  #undef PKW
  #undef PAF
  #undef VFR
  #undef PIN
  #undef MX3
  #undef GAPA
  #undef GAPB
  #undef EX
  #undef VRD
  #undef KRD
  #undef STEP
  #undef ENDW
  {auto rr=__builtin_amdgcn_permlane32_swap(__float_as_uint(l_reg),__float_as_uint(l_reg),false,false);l_reg=__uint_as_float(rr[0])+__uint_as_float(rr[1]);}
  if(hi==0)wsf[32+r32]=l_reg;asm volatile("s_waitcnt lgkmcnt(0)":::"memory");
  float rli[16];
  #pragma unroll
  for(int r=0;r<16;++r)rli[r]=__builtin_amdgcn_rcpf(wsf[32+crow(r,hi)]);
  bf16*Ow=Ob+(long)(wid*QBLK)*OP;
  { bf16*stg=(bf16*)(shm+LDS_OST)+wid*2048;
    #pragma unroll
    for(int r=0;r<16;++r){const int orow=crow(r,hi);
      #pragma unroll
      for(int d0=0;d0<2;++d0)stg[orow*64+d0*32+r32]=__float2bfloat16(o[d0][r]*rli[r]);}
    asm volatile("s_waitcnt lgkmcnt(0)":::"memory");
    #pragma unroll
    for(int i=0;i<4;++i){const int row=i*8+(lane>>3),ch=lane&7; const u32x4 v=*(const u32x4*)(stg+row*64+ch*8); ATTN_STORE16(Ow+(long)row*OP+ch*8,v);} }
  asm volatile("s_waitcnt lgkmcnt(0)\n\ts_barrier":::"memory");
  #undef DMA_K
  #undef DMA_V
  #undef CMASK
  #undef START
  #undef RESC
  #undef ROT
}
template<int THRL> __device__ __forceinline__ void attn_unit128_br(const bf16*Qb,int QP,const bf16*__restrict__ Kh,int KP,const bf16*__restrict__ Vh,int VP,bf16*Ob,int OP,int NT,char*shm,int wave,float kmax,int qpos0,const float*gq){
  const int lane=hw_lane(),r32=lane&31,hi=lane>>5; const int wid=wave;
  constexpr int LDS_V=NSLOT*SLOTB, LDS_WS=LDS_V+NSLOT*2*SLOTB, LDS_OST=LDS_WS+NW*64*4;
  const bf16*Qw=Qb+(long)(wid*QBLK)*QP;
  const unsigned lds0=(unsigned)(uintptr_t)shm;
  float*wsf=(float*)(shm+LDS_WS)+wid*64;
  const bf16*ksrc=Kh+(long)lane*KP+wid*8;
  const bf16*vsrc=Vh+(long)(16*(wid&3)+(lane>>2))*VP+(wid>>2)*32+(lane&3)*8;
  const unsigned kdst=lds0+LDS_K+wid*1024, vdst=lds0+LDS_V+wid*1024;
  #define DMA_K(t,slot) glds16(ksrc+(long)(t)*KVBLK*KP,(unsigned)__builtin_amdgcn_readfirstlane(kdst+(slot)))
  #define DMA_V(t,slot) do{ glds16(vsrc+(long)(t)*KVBLK*VP,(unsigned)__builtin_amdgcn_readfirstlane(vdst+2*(slot))); glds16(vsrc+(long)(t)*KVBLK*VP+64,(unsigned)__builtin_amdgcn_readfirstlane(vdst+2*(slot)+8192)); }while(0)
  const int vb0=(int)(lds0+LDS_V)+((lane>>4)&1)*32+(lane&3)*8+(4*hi+((lane&15)>>2))*64;
  const char*Kbase=shm+LDS_K; bf16x8 kf[8];
  const lds_cptr shm3=(lds_cptr)shm; const lds_cptr kp0=shm3+LDS_K+hi*1024+r32*16; const lds_cptr vp0=shm3+LDS_V+((lane>>4)&1)*32+(lane&3)*8+(4*hi+((lane&15)>>2))*64;
  DMA_K(0,0);DMA_V(0,0);DMA_K(1,SLOTB);
  bf16x8 qr[4];
  #pragma unroll
  for(int d0=0;d0<4;++d0)qr[d0]=*reinterpret_cast<const bf16x8*>(&Qw[(long)r32*QP+d0*16+hi*8]);
  qprep(qr,hi,qpos0<0?-1:qpos0+wid*QBLK+r32,gq);
  float l_reg=0.f;f32x16 o[4];o[0]=f32x16{};o[1]=f32x16{};o[2]=f32x16{};o[3]=f32x16{};f32x16 negm;
  { float qs=0.f;
    #pragma unroll
    for(int d0=0;d0<4;++d0){
      #pragma unroll
      for(int e=0;e<8;++e){const float v=__builtin_bit_cast(float,(unsigned)(unsigned short)qr[d0][e]<<16);qs+=v*v;}}
    auto rr=__builtin_amdgcn_permlane32_swap(__float_as_uint(qs),__float_as_uint(qs),false,false);qs=__uint_as_float(rr[0])+__uint_as_float(rr[1]);
    const float ref=sqrtf(qs)*kmax*1.002f+0.02f;
    #pragma unroll
    for(int r=0;r<16;++r)negm[r]=-ref;
    asm volatile("":"+v"(negm)); }
  #define CMASK(P0,P1,t) do{}while(0)
  #define START(P0,P1) do{ _Pragma("unroll") for(int r=0;r<16;++r)P0[r]=__builtin_amdgcn_exp2f(P0[r]); }while(0)
  #define RESC() do{}while(0)
  f32x16 pA0,pA1,pB0,pB1;
  int sl_prev=0,sl_cur=0,sl_next=SLOTB;
  #define ROT() do{sl_prev=sl_cur;sl_cur=sl_next;sl_next=(sl_next==(NSLOT-1)*SLOTB)?0:sl_next+SLOTB;}while(0)
  DMA_K(2,2*SLOTB);
  WAIT_BAR(3);
  qkt(pA0,pA1,Kbase,qr,negm,r32,hi);asm volatile("s_nop 15\n\ts_nop 7":"+v"(pA0),"+v"(pA1));CMASK(pA0,pA1,0);
  START(pA0,pA1);
  _Pragma("unroll") for(int r=0;r<16;++r)pA1[r]=__builtin_amdgcn_exp2f(pA1[r]);
  WAIT_BAR(0);
  DMA_K(3,0);DMA_V(1,SLOTB);
  ROT();
  kload8(kf,kp0+sl_cur);
  WAIT_BAR(3);
  s16x4 vlo[8],vhi[8]; u32x4 pw0,pw1,pw2,pw3;
  #define PKW(P,B) cvtpk_s(P[B],P[B+1])
  #define PAF(k) __builtin_bit_cast(bf16x8,pw##k)
  #define VFR(i) (bf16x8){vlo[i][0],vlo[i][1],vlo[i][2],vlo[i][3],vhi[i][0],vhi[i][1],vhi[i][2],vhi[i][3]}
  #define PIN(x) asm volatile("":"+v"(x))
  #define MX3(a,b,c) __builtin_fmaxf(__builtin_fmaxf((a),(b)),(c))
  #define GAPA(MF,A0,A1,A2,A3,W0,W1,PW) do{ MF; sacc+=A0; sacc+=A1; sacc+=A2; sacc+=A3; PIN(sacc); W0; W1; PIN(PW); SBAR(); }while(0)
  #define EX(v) __builtin_amdgcn_exp2f(v)
  #define GAPB(MF,X,B) do{ MF; X[B]=EX(X[B]); X[B+1]=EX(X[B+1]); X[B+2]=EX(X[B+2]); X[B+3]=EX(X[B+3]); PIN(X); SBAR(); }while(0)
  #define VRD(sl_,f) do{ vlo[sl_]=vtr(vp_+(((f)>>2)*4096+((f)&3)*1024)); vhi[sl_]=vtr(vp_+(((f)>>2)*4096+((f)&3)*1024+512)); }while(0)
  #define GAPB2(MF,X,B) do{ MF; X[B]=EX(X[B]); X[B+1]=EX(X[B+1]); PIN(X); SBAR(); }while(0)
  #define KRD(G,j) do{ if(G){ kload2(kf,kp0+sl_next,j); SBAR(); } }while(0)
  #define STEP(C0,C1,P0,P1,t,GK,GV,GL) do{ SBAR(); \
    const lds_cptr vp_=vp0+2*sl_prev; \
    VRD(0,0); SBAR(); float sacc=(P0[0]+P0[1]); \
    GAPA(C0=__builtin_amdgcn_mfma_f32_32x32x16_bf16(kf[0],qr[0],negm,0,0,0), P0[2],P0[3],P0[4],P0[5],     pw0[0]=PKW(P0,0), pw0[1]=PKW(P0,2), pw0); \
    VRD(1,4); SBAR(); GAPA(C1=__builtin_amdgcn_mfma_f32_32x32x16_bf16(kf[1],qr[0],negm,0,0,0), P0[6],P0[7],P0[8],P0[9],     pw0[2]=PKW(P0,4), pw0[3]=PKW(P0,6), pw0); \
    VRD(2,8); SBAR(); GAPA(C0=__builtin_amdgcn_mfma_f32_32x32x16_bf16(kf[2],qr[1],C0,0,0,0),   P0[10],P0[11],P0[12],P0[13], pw1[0]=PKW(P0,8), pw1[1]=PKW(P0,10), pw1); \
    VRD(3,12); SBAR(); GAPA(C1=__builtin_amdgcn_mfma_f32_32x32x16_bf16(kf[3],qr[1],C1,0,0,0),   P0[14],P0[15],P1[0],P1[1],   pw1[2]=PKW(P0,12),pw1[3]=PKW(P0,14), pw1); \
    VRD(4,1); SBAR(); GAPA(C0=__builtin_amdgcn_mfma_f32_32x32x16_bf16(kf[4],qr[2],C0,0,0,0),   P1[2],P1[3],P1[4],P1[5],     pw2[0]=PKW(P1,0), pw2[1]=PKW(P1,2), pw2); \
    VRD(5,5); SBAR(); GAPA(C1=__builtin_amdgcn_mfma_f32_32x32x16_bf16(kf[5],qr[2],C1,0,0,0),   P1[6],P1[7],P1[8],P1[9],     pw2[2]=PKW(P1,4), pw2[3]=PKW(P1,6), pw2); \
    VRD(6,9); SBAR(); GAPA(C0=__builtin_amdgcn_mfma_f32_32x32x16_bf16(kf[6],qr[3],C0,0,0,0),   P1[10],P1[11],P1[12],P1[13], pw3[0]=PKW(P1,8), pw3[1]=PKW(P1,10), pw3); \
    VRD(7,13); SBAR(); GAPA(C1=__builtin_amdgcn_mfma_f32_32x32x16_bf16(kf[7],qr[3],C1,0,0,0),   P1[14],P1[15],0.f,0.f,       pw3[2]=PKW(P1,12),pw3[3]=PKW(P1,14), pw3); \
    l_reg+=sacc; \
    if(GK){DMA_K((t)+3,sl_cur);} if(GV){DMA_V((t)+1,sl_next);} \
    CMASK(C0,C1,t); \
    SBAR(); \
    GAPB2(o[0]=__builtin_amdgcn_mfma_f32_32x32x16_bf16(PAF(0),VFR(0),o[0],0,0,0), C0,0); VRD(0,2); SBAR(); \
    GAPB2(o[1]=__builtin_amdgcn_mfma_f32_32x32x16_bf16(PAF(0),VFR(1),o[1],0,0,0), C0,2); VRD(1,6); SBAR(); \
    GAPB2(o[2]=__builtin_amdgcn_mfma_f32_32x32x16_bf16(PAF(0),VFR(2),o[2],0,0,0), C0,4); VRD(2,10); SBAR(); \
    GAPB2(o[3]=__builtin_amdgcn_mfma_f32_32x32x16_bf16(PAF(0),VFR(3),o[3],0,0,0), C0,6); VRD(3,14); SBAR(); \
    KRD(GL,0); GAPB2(o[0]=__builtin_amdgcn_mfma_f32_32x32x16_bf16(PAF(1),VFR(4),o[0],0,0,0), C0,8); VRD(4,3); SBAR(); \
    GAPB2(o[1]=__builtin_amdgcn_mfma_f32_32x32x16_bf16(PAF(1),VFR(5),o[1],0,0,0), C0,10); VRD(5,7); SBAR(); \
    KRD(GL,1); GAPB2(o[2]=__builtin_amdgcn_mfma_f32_32x32x16_bf16(PAF(1),VFR(6),o[2],0,0,0), C0,12); VRD(6,11); SBAR(); \
    GAPB2(o[3]=__builtin_amdgcn_mfma_f32_32x32x16_bf16(PAF(1),VFR(7),o[3],0,0,0), C0,14); VRD(7,15); SBAR(); \
    KRD(GL,2); GAPB2(o[0]=__builtin_amdgcn_mfma_f32_32x32x16_bf16(PAF(2),VFR(0),o[0],0,0,0), C1,0); \
    GAPB2(o[1]=__builtin_amdgcn_mfma_f32_32x32x16_bf16(PAF(2),VFR(1),o[1],0,0,0), C1,2); \
    KRD(GL,3); GAPB2(o[2]=__builtin_amdgcn_mfma_f32_32x32x16_bf16(PAF(2),VFR(2),o[2],0,0,0), C1,4); \
    GAPB2(o[3]=__builtin_amdgcn_mfma_f32_32x32x16_bf16(PAF(2),VFR(3),o[3],0,0,0), C1,6); \
    GAPB2(o[0]=__builtin_amdgcn_mfma_f32_32x32x16_bf16(PAF(3),VFR(4),o[0],0,0,0), C1,8); \
    GAPB2(o[1]=__builtin_amdgcn_mfma_f32_32x32x16_bf16(PAF(3),VFR(5),o[1],0,0,0), C1,10); \
    GAPB2(o[2]=__builtin_amdgcn_mfma_f32_32x32x16_bf16(PAF(3),VFR(6),o[2],0,0,0), C1,12); \
    GAPB2(o[3]=__builtin_amdgcn_mfma_f32_32x32x16_bf16(PAF(3),VFR(7),o[3],0,0,0), C1,14); \
    }while(0)
  if(wid>=4)__builtin_amdgcn_s_setprio(1);
  int t=1;
  #undef CMASK
  #define CMASK(P0,P1,t) do{}while(0)
  for(;t+5<NT;t+=2){
    STEP(pB0,pB1,pA0,pA1,t,true,true,true);     WAIT_BAR(3); RESC(); ROT();
    STEP(pA0,pA1,pB0,pB1,t+1,true,true,true);   WAIT_BAR(3); RESC(); ROT();
  }
  #undef CMASK
  #define CMASK(P0,P1,t) do{}while(0)
  #define ENDW(tt) do{ if((tt)+3<NT){WAIT_BAR(3);} else if((tt)+2<NT){WAIT_BAR(2);} else {WAIT_BAR(0);} }while(0)
  for(;t+1<NT;t+=2){
    STEP(pB0,pB1,pA0,pA1,t,(t+3<NT),(t+1<NT),(t+1<NT));       ENDW(t);   RESC(); ROT();
    STEP(pA0,pA1,pB0,pB1,t+1,(t+4<NT),(t+2<NT),(t+2<NT));     ENDW(t+1); RESC(); ROT();
  }
  STEP(pB0,pB1,pA0,pA1,NT-1,false,false,false); RESC();
  __builtin_amdgcn_s_setprio(0);
  { float sacc=pB0[0]+pB0[1]; _Pragma("unroll") for(int r=2;r<16;++r)sacc+=pB0[r]; _Pragma("unroll") for(int r=0;r<16;++r)sacc+=pB1[r]; l_reg+=sacc;
    pw0=(u32x4){PKW(pB0,0),PKW(pB0,2),PKW(pB0,4),PKW(pB0,6)};pw1=(u32x4){PKW(pB0,8),PKW(pB0,10),PKW(pB0,12),PKW(pB0,14)};pw2=(u32x4){PKW(pB1,0),PKW(pB1,2),PKW(pB1,4),PKW(pB1,6)};pw3=(u32x4){PKW(pB1,8),PKW(pB1,10),PKW(pB1,12),PKW(pB1,14)};
    SBAR(); pv<4>(o,vb0+2*sl_cur,PAF(0),PAF(1),PAF(2),PAF(3)); }
  #undef PKW
  #undef PAF
  #undef VFR
  #undef PIN
  #undef MX3
  #undef GAPA
  #undef GAPB
  #undef EX
  #undef VRD
  #undef GAPB2
  #undef KRD
  #undef STEP
  #undef ENDW
  {auto rr=__builtin_amdgcn_permlane32_swap(__float_as_uint(l_reg),__float_as_uint(l_reg),false,false);l_reg=__uint_as_float(rr[0])+__uint_as_float(rr[1]);}
  if(hi==0)wsf[32+r32]=l_reg;asm volatile("s_waitcnt lgkmcnt(0)":::"memory");
  float rli[16];
  #pragma unroll
  for(int r=0;r<16;++r)rli[r]=__builtin_amdgcn_rcpf(wsf[32+crow(r,hi)]);
  bf16*Ow=Ob+(long)(wid*QBLK)*OP;
  { bf16*stg=(bf16*)(shm+LDS_OST)+wid*2048;
    #pragma unroll
    for(int hf=0;hf<2;++hf){
      #pragma unroll
      for(int r=0;r<16;++r){const int orow=crow(r,hi);
        #pragma unroll
        for(int d0=0;d0<2;++d0)stg[orow*64+d0*32+r32]=__float2bfloat16(o[2*hf+d0][r]*rli[r]);}
      asm volatile("s_waitcnt lgkmcnt(0)":::"memory");
      #pragma unroll
      for(int i=0;i<4;++i){const int row=i*8+(lane>>3),ch=lane&7; const u32x4 v=*(const u32x4*)(stg+row*64+ch*8); ATTN_STORE16(Ow+(long)row*OP+hf*64+ch*8,v);}
      asm volatile("s_waitcnt lgkmcnt(0)":::"memory"); } }
  asm volatile("s_waitcnt lgkmcnt(0)\n\ts_barrier":::"memory");
  #undef DMA_K
  #undef DMA_V
  #undef CMASK
  #undef START
  #undef RESC
  #undef ROT
}
constexpr int ATTN_LDS_BYTES=LDS_BYTES;
#undef SBAR
#undef WAIT_BAR
}
namespace dn {
constexpr int NCHUNK = 260, GROUP = 6, WREG = 17408  , TP = 72  ;
constexpr int F_WT = 0, F_QKT = 8, F_QD = 14, F_KD = 22, F_U = 30, F_GL = 38;
__device__ __forceinline__ int crow(int r, int hi) { return (r & 3) + 8 * (r >> 2) + 4 * hi; }
__device__ __forceinline__ bf16x8 pack8(const f32x16& x, int s) {
    v4u w; w.x = cvt_pk_bf16(x[8 * s + 0], x[8 * s + 1]); w.y = cvt_pk_bf16(x[8 * s + 2], x[8 * s + 3]); w.z = cvt_pk_bf16(x[8 * s + 4], x[8 * s + 5]); w.w = cvt_pk_bf16(x[8 * s + 6], x[8 * s + 7]);
    return __builtin_bit_cast(bf16x8, w);
}
#define DN_MFMA(a, b, c) __builtin_amdgcn_mfma_f32_32x32x16_bf16(a, b, c, 0, 0, 0)

struct Chain {
    const bf16_t* P1b;
    const bf16_t* QKb;
    bf16_t* Ob;
    int h, dir;
    float Aexp, dtb;
    unsigned char* ring;
    unsigned* dbg;
};
__device__ __forceinline__ int chunk_of(int ci, int dir) { return dir == 0 ? ci : (ci < 4 ? 3 - ci : 263 - ci); }

__device__ __forceinline__ void produce(const Chain& ch, int ci, LAS unsigned char* wl, const LAS float* wct, unsigned char* slot, int lane_in) {
    int lane = lane_in; asm volatile("" : "+v"(lane));
    const int r = lane & 31, hh = lane >> 5;
    const int c = chunk_of(ci, ch.dir), t0 = 64 * c, seg_lo = (c < 4) ? 0 : CTXL, seg_hi = (c < 4) ? CTXL : TT;
    LAS float* Lm = (LAS float*)wl; LAS bf16_t* Tm = (LAS bf16_t*)wl; LAS float* gcT = (LAS float*)(wl + 16384); LAS float* btT = gcT + 64;
    {
        const int tok = ch.dir ? t0 + 63 - lane : t0 + lane;
        const bf16_t* row = ch.P1b + (size_t)tok * P1W;
        const float a = bf2f(row[C_BA + ch.dir * 8 + ch.h]), bb = bf2f(row[C_BB + ch.dir * 8 + ch.h]);
        const float x = a + ch.dtb; const float sp = x > 20.f ? x : log1pf(__expf(x));
        float g = -ch.Aexp * sp;
#pragma unroll
        for (int o = 1; o < 64; o <<= 1) { const float t = __shfl_up(g, o); if (lane >= o) g += t; }
        gcT[lane] = g; btT[lane] = sigmoidf_(bb);
    }
    LDS_WAIT();
    const float gl = gcT[63];
    bf16x8 kA[2][4], qA[2][4], vA[2][4];
#pragma unroll
    for (int rt = 0; rt < 2; ++rt) {
        const int p = 32 * rt + r; const int tok = ch.dir ? t0 + 63 - p : t0 + p;
        const bf16_t* rq = ch.QKb + (size_t)tok * 1536 + ch.h * 64 + 4 * hh; const bf16_t* rk = rq + 512;
        const bf16_t* rv = ch.P1b + (size_t)tok * P1W + C_BQKV + ch.h * 64 + 4 * hh;
#pragma unroll
        for (int s = 0; s < 4; ++s) { const v2u a = *(const v2u*)(rk + 16 * s), b2 = *(const v2u*)(rk + 16 * s + 8); v4u w; w.x = a.x; w.y = a.y; w.z = b2.x; w.w = b2.y; kA[rt][s] = __builtin_bit_cast(bf16x8, w);
            const v2u c2 = *(const v2u*)(rq + 16 * s), d2 = *(const v2u*)(rq + 16 * s + 8); v4u w2; w2.x = c2.x; w2.y = c2.y; w2.z = d2.x; w2.w = d2.y; qA[rt][s] = __builtin_bit_cast(bf16x8, w2);
            const v2u e2 = *(const v2u*)(rv + 16 * s), f2 = *(const v2u*)(rv + 16 * s + 8); v4u w3; w3.x = e2.x; w3.y = e2.y; w3.z = f2.x; w3.w = f2.y; vA[rt][s] = __builtin_bit_cast(bf16x8, w3); }
    }
    __builtin_amdgcn_sched_barrier(0);
    v4u* sl = (v4u*)slot;
    const float gcc0 = gcT[r], gcc1 = gcT[32 + r];
#pragma unroll
    for (int tix = 0; tix < 3; ++tix) {
        const int it = (tix == 0) ? 0 : 1, jt = (tix == 2) ? 1 : 0;
        f32x16 acc = {};
#pragma unroll
        for (int s = 0; s < 4; ++s) acc = DN_MFMA(kA[it][s], kA[jt][s], acc);
        const float gcj = jt ? gcc1 : gcc0; const int j = 32 * jt + r;
#pragma unroll
        for (int rg = 0; rg < 16; ++rg) { const int i = 32 * it + crow(rg, hh); const float gi = gcT[i], bi = btT[i];
            const float v = (i > j) ? bi * acc[rg] * __expf(fminf(gi - gcj, 0.f)) : 0.f; Lm[i * 64 + j] = v; }
    }
#pragma unroll
    for (int tix = 0; tix < 3; ++tix) {
        const int jt = (tix == 2) ? 1 : 0, it = (tix == 0) ? 0 : 1;
        f32x16 acc = {};
#pragma unroll
        for (int s = 0; s < 4; ++s) acc = DN_MFMA(kA[jt][s], qA[it][s], acc);
        const float gci = it ? gcc1 : gcc0; const int i = 32 * it + r;
#pragma unroll
        for (int rg = 0; rg < 16; ++rg) { const int j = 32 * jt + crow(rg, hh); const float gj = gcT[j];
            acc[rg] = (i >= j) ? acc[rg] * __expf(fminf(gci - gj, 0.f)) : 0.f; }
        sl[(F_QKT + tix * 2 + 0) * 64 + lane] = __builtin_bit_cast(v4u, pack8(acc, 0));
        sl[(F_QKT + tix * 2 + 1) * 64 + lane] = __builtin_bit_cast(v4u, pack8(acc, 1));
    }
#pragma unroll
    for (int rt = 0; rt < 2; ++rt) { const float e = __expf(rt ? gcc1 : gcc0);
#pragma unroll
        for (int s = 0; s < 4; ++s) { const v4u w = __builtin_bit_cast(v4u, qA[rt][s]); v4u o;
            o.x = cvt_pk_bf16(bflo(w.x) * e, bfhi(w.x) * e); o.y = cvt_pk_bf16(bflo(w.y) * e, bfhi(w.y) * e); o.z = cvt_pk_bf16(bflo(w.z) * e, bfhi(w.z) * e); o.w = cvt_pk_bf16(bflo(w.w) * e, bfhi(w.w) * e);
            sl[(F_QD + rt * 4 + s) * 64 + lane] = o; } }
    LDS_WAIT();
#if MK_DEBUG == 3
    { unsigned bad = 0u;
      for (int i = 0; i < 64; ++i) { const float lv = Lm[i * 64 + lane]; if (lane < i && !(fabsf(lv) <= 1.5f)) bad |= 1u; }
      if (!(fabsf(gcT[lane]) < 1.0e30f)) bad |= 2u; if (!(btT[lane] >= 0.f && btT[lane] <= 1.f)) bad |= 4u;
      if (bad) atomicOr(ch.dbg, bad); }
#endif
    float T[64];
#pragma unroll
    for (int i = 0; i < 64; ++i) {
        float a = (lane == i) ? 1.f : 0.f;
#pragma unroll
        for (int q = 0; q < (i + 3) / 4; ++q) { const f32x4 l4 = *(const LAS f32x4*)(Lm + i * 64 + 4 * q);
#pragma unroll
            for (int e = 0; e < 4; ++e) if (4 * q + e < i) a -= l4[e] * T[4 * q + e]; }
        T[i] = a;
        if ((i & 3) == 3) __builtin_amdgcn_sched_barrier(0);
    }
    LDS_WAIT();
#pragma unroll
    for (int i = 0; i < 64; ++i) Tm[i * TP + lane] = (bf16_t)f2bf(T[i]);
    LDS_WAIT();
    bf16x8 Tf[3][2];
#pragma unroll
    for (int tix = 0; tix < 3; ++tix) { const int it = (tix == 0) ? 0 : 1, jt = (tix == 2) ? 1 : 0;
#pragma unroll
        for (int s = 0; s < 2; ++s) { const LAS bf16_t* p = Tm + (32 * it + r) * TP + 32 * jt + 16 * s + 4 * hh;
            const v2u a = *(const LAS v2u*)p, b = *(const LAS v2u*)(p + 8); v4u w; w.x = a.x; w.y = a.y; w.z = b.x; w.w = b.y; Tf[tix][s] = __builtin_bit_cast(bf16x8, w); } }
#if MK_DEBUG == 4
    { unsigned bad = 0u;
      _Pragma("unroll") for (int t_ = 0; t_ < 3; ++t_) _Pragma("unroll") for (int s_ = 0; s_ < 2; ++s_) { const v4u w = __builtin_bit_cast(v4u, Tf[t_][s_]);
        const unsigned ws_[4] = {w.x, w.y, w.z, w.w};
        _Pragma("unroll") for (int q_ = 0; q_ < 4; ++q_) { const float lo_ = bflo(ws_[q_]), hi_ = bfhi(ws_[q_]);
          if (!(fabsf(lo_) < 3.0e38f) || !(fabsf(hi_) < 3.0e38f)) bad |= 1u; else if (fabsf(lo_) > 1.0e3f || fabsf(hi_) > 1.0e3f) bad |= 2u; } }
      if (bad) atomicOr(ch.dbg, bad); }
#endif
    bf16x8 If[2];
#pragma unroll
    for (int sp = 0; sp < 2; ++sp) { bf16x8 f_;
#pragma unroll
        for (int jj = 0; jj < 8; ++jj) f_[jj] = ((16 * sp + 8 * (jj >> 2) + 4 * hh + (jj & 3)) == r) ? (short)0x3F80 : (short)0;
        If[sp] = f_; }
    {
        bf16x8 kbg[2][2][2];
#pragma unroll
        for (int jt = 0; jt < 2; ++jt)
#pragma unroll
            for (int dt = 0; dt < 2; ++dt) {
                f32x16 kc = {};
                kc = DN_MFMA(kA[jt][2 * dt + 0], If[0], kc); kc = DN_MFMA(kA[jt][2 * dt + 1], If[1], kc);
                f32x16 kd, kb;
#pragma unroll
                for (int rg = 0; rg < 16; ++rg) { const int j = 32 * jt + crow(rg, hh); const float gj = gcT[j], bj = btT[j];
                    kd[rg] = kc[rg] * __expf(gl - gj); kb[rg] = kc[rg] * bj * __expf(gj); }
                sl[(F_KD + (jt * 2 + dt) * 2 + 0) * 64 + lane] = __builtin_bit_cast(v4u, pack8(kd, 0));
                sl[(F_KD + (jt * 2 + dt) * 2 + 1) * 64 + lane] = __builtin_bit_cast(v4u, pack8(kd, 1));
                kbg[jt][dt][0] = pack8(kb, 0); kbg[jt][dt][1] = pack8(kb, 1);
#if MK_DEBUG == 4
                { bool b_ = false; _Pragma("unroll") for (int rg = 0; rg < 16; ++rg) if (!(fabsf(kb[rg]) < 3.0e38f)) b_ = true; if (b_) atomicOr(ch.dbg, 4u); }
#endif
            }
#pragma unroll
        for (int dt = 0; dt < 2; ++dt)
#pragma unroll
            for (int it = 0; it < 2; ++it) {
                f32x16 wt = {};
#pragma unroll
                for (int s = 0; s < 2; ++s) {
                    if (it == 0) wt = DN_MFMA(kbg[0][dt][s], Tf[0][s], wt);
                    else { wt = DN_MFMA(kbg[0][dt][s], Tf[1][s], wt); wt = DN_MFMA(kbg[1][dt][s], Tf[2][s], wt); }
                }
                asm volatile("s_nop 15\n\ts_nop 7" : "+v"(wt));
                sl[(F_WT + (dt * 2 + it) * 2 + 0) * 64 + lane] = __builtin_bit_cast(v4u, pack8(wt, 0));
                sl[(F_WT + (dt * 2 + it) * 2 + 1) * 64 + lane] = __builtin_bit_cast(v4u, pack8(wt, 1));
            }
    }
    {
        bf16x8 vb[2][2][2];
#pragma unroll
        for (int jt = 0; jt < 2; ++jt)
#pragma unroll
            for (int dvt = 0; dvt < 2; ++dvt) {
                f32x16 vc = {};
                vc = DN_MFMA(vA[jt][2 * dvt + 0], If[0], vc); vc = DN_MFMA(vA[jt][2 * dvt + 1], If[1], vc);
#pragma unroll
                for (int rg = 0; rg < 16; ++rg) { const int j = 32 * jt + crow(rg, hh); vc[rg] *= btT[j]; }
                vb[jt][dvt][0] = pack8(vc, 0); vb[jt][dvt][1] = pack8(vc, 1);
#if MK_DEBUG == 4
                { bool b_ = false; _Pragma("unroll") for (int rg = 0; rg < 16; ++rg) if (!(fabsf(vc[rg]) < 3.0e38f)) b_ = true; if (b_) atomicOr(ch.dbg, 8u); }
#endif
            }
#pragma unroll
        for (int it = 0; it < 2; ++it)
#pragma unroll
            for (int dvt = 0; dvt < 2; ++dvt) {
                f32x16 u = {};
#pragma unroll
                for (int s = 0; s < 2; ++s) {
                    if (it == 0) u = DN_MFMA(Tf[0][s], vb[0][dvt][s], u);
                    else { u = DN_MFMA(Tf[1][s], vb[0][dvt][s], u); u = DN_MFMA(Tf[2][s], vb[1][dvt][s], u); }
                }
                asm volatile("s_nop 15\n\ts_nop 7" : "+v"(u));
                sl[(F_U + (it * 2 + dvt) * 2 + 0) * 64 + lane] = __builtin_bit_cast(v4u, pack8(u, 0));
                sl[(F_U + (it * 2 + dvt) * 2 + 1) * 64 + lane] = __builtin_bit_cast(v4u, pack8(u, 1));
            }
    }
    { v4u gw; gw.x = __float_as_uint(__expf(gl)); gw.y = gw.x; gw.z = gw.x; gw.w = gw.x; sl[F_GL * 64 + lane] = gw; }
}

__device__ __forceinline__ f32x16 unpack16(v4u a, v4u b) {
    f32x16 x;
    x[0] = bflo(a.x); x[1] = bfhi(a.x); x[2] = bflo(a.y); x[3] = bfhi(a.y); x[4] = bflo(a.z); x[5] = bfhi(a.z); x[6] = bflo(a.w); x[7] = bfhi(a.w);
    x[8] = bflo(b.x); x[9] = bfhi(b.x); x[10] = bflo(b.y); x[11] = bfhi(b.y); x[12] = bflo(b.z); x[13] = bfhi(b.z); x[14] = bflo(b.w); x[15] = bfhi(b.w);
    return x;
}
__device__ __forceinline__ void consume(const Chain& ch, int ci, const unsigned char* slot, f32x16 (&S)[2], int hv, int lane_in) {
    int lane = lane_in; asm volatile("" : "+v"(lane));
    const int r = lane & 31, hh = lane >> 5;
    const v4u* sl = (const v4u*)slot;
    v4u fr_[F_U], fU_[4];
#pragma unroll
    for (int i = 0; i < F_U; ++i) fr_[i] = sl[i * 64 + lane];
#pragma unroll
    for (int it = 0; it < 2; ++it)
#pragma unroll
        for (int s = 0; s < 2; ++s) fU_[it * 2 + s] = sl[(F_U + (it * 2 + hv) * 2 + s) * 64 + lane];
    const v4u fgl_ = sl[F_GL * 64 + lane];
    __builtin_amdgcn_sched_barrier(0);
#define DN_FR(idx) __builtin_bit_cast(bf16x8, fr_[idx])
    const float gl = __builtin_bit_cast(float, fgl_.x);
#if MK_DEBUG == 2
    { unsigned bad = 0u;
      auto nf = [](v4u w) { return ((w.x & 0x7f80u) == 0x7f80u) || ((w.x & 0x7f800000u) == 0x7f800000u) || ((w.y & 0x7f80u) == 0x7f80u) || ((w.y & 0x7f800000u) == 0x7f800000u) || ((w.z & 0x7f80u) == 0x7f80u) || ((w.z & 0x7f800000u) == 0x7f800000u) || ((w.w & 0x7f80u) == 0x7f80u) || ((w.w & 0x7f800000u) == 0x7f800000u); };
      if ((__float_as_uint(gl) & 0x7f800000u) == 0x7f800000u) bad |= 1u;
      for (int i = 0; i < 8; ++i) { if (nf(sl[(F_WT + i) * 64 + lane])) bad |= 2u; if (nf(sl[(F_QD + i) * 64 + lane])) bad |= 4u; if (nf(sl[(F_KD + i) * 64 + lane])) bad |= 8u; if (nf(sl[(F_U + i) * 64 + lane])) bad |= 16u; }
      for (int i = 0; i < 6; ++i) if (nf(sl[(F_QKT + i) * 64 + lane])) bad |= 32u;
      if (bad) atomicOr(ch.dbg, bad); }
#endif
    asm volatile("s_nop 15\n\ts_nop 7" : "+v"(S[0]), "+v"(S[1]));
    bf16x8 Sb[2][2];
#pragma unroll
    for (int dt = 0; dt < 2; ++dt) { Sb[dt][0] = pack8(S[dt], 0); Sb[dt][1] = pack8(S[dt], 1); }
    f32x16 accv[2], acco[2];
#pragma unroll
    for (int it = 0; it < 2; ++it) { accv[it] = f32x16{}; acco[it] = f32x16{};
#pragma unroll
        for (int dt = 0; dt < 2; ++dt)
#pragma unroll
            for (int s = 0; s < 2; ++s) {
                accv[it] = DN_MFMA(DN_FR(F_WT + (dt * 2 + it) * 2 + s), Sb[dt][s], accv[it]);
                acco[it] = DN_MFMA(DN_FR(F_QD + it * 4 + 2 * dt + s), Sb[dt][s], acco[it]);
            } }
    bf16x8 vb[2][2];
#pragma unroll
    for (int it = 0; it < 2; ++it) {
        const f32x16 u = unpack16(fU_[it * 2 + 0], fU_[it * 2 + 1]);
        const f32x16 vn = u - accv[it];
        vb[it][0] = pack8(vn, 0); vb[it][1] = pack8(vn, 1);
    }
#pragma unroll
    for (int s = 0; s < 2; ++s) {
        acco[0] = DN_MFMA(DN_FR(F_QKT + 0 * 2 + s), vb[0][s], acco[0]);
        acco[1] = DN_MFMA(DN_FR(F_QKT + 1 * 2 + s), vb[0][s], acco[1]);
        acco[1] = DN_MFMA(DN_FR(F_QKT + 2 * 2 + s), vb[1][s], acco[1]);
    }
#pragma unroll
    for (int dt = 0; dt < 2; ++dt) {
        S[dt] = S[dt] * gl;
#pragma unroll
        for (int jt = 0; jt < 2; ++jt)
#pragma unroll
            for (int s = 0; s < 2; ++s) S[dt] = DN_MFMA(DN_FR(F_KD + (jt * 2 + dt) * 2 + s), vb[jt][s], S[dt]);
    }
    const int c = chunk_of(ci, ch.dir), t0 = 64 * c;
#pragma unroll
    for (int it = 0; it < 2; ++it)
#pragma unroll
        for (int rg = 0; rg < 16; ++rg) { const int i = 32 * it + crow(rg, hh); const int tok = ch.dir ? t0 + 63 - i : t0 + i;
            ch.Ob[(size_t)tok * 512 + ch.h * 64 + 32 * hv + r] = (bf16_t)f2bf(acco[it][rg]); }
#undef DN_FR
}

__device__ __forceinline__ void chain_unit(const Chain& ch, const float* wconv  , LAS unsigned char* lds, LAS float* wct, int wave) {
    const int lane = hw_lane(), wid = wave, tid = wave * 64 + lane;
    __syncthreads();
    constexpr int NG = (NCHUNK + GROUP - 1) / GROUP;
#define DN_BAR() do { asm volatile("s_waitcnt vmcnt(0) lgkmcnt(0)" ::: "memory"); __builtin_amdgcn_s_barrier(); asm volatile("" ::: "memory"); } while (0)
    if (wid >= 2) {
        for (int k = 0; k <= NG; ++k) {
            const int ci = k * GROUP + (wid - 2);
#ifndef NO_DNP
            if (k < NG && ci < NCHUNK) produce(ch, ci, lds + wid * WREG, wct, ch.ring + (size_t)((k & 1) * GROUP + (wid - 2)) * RING_SLOT, lane);
#endif
            DN_BAR();
        }
    } else {
        f32x16 S[2]; S[0] = f32x16{}; S[1] = f32x16{};
        for (int k = 0; k <= NG; ++k) {
#ifndef NO_DNC
            if (k >= 1) { const int g0 = (k - 1) * GROUP; const int n = (NCHUNK - g0 < GROUP) ? NCHUNK - g0 : GROUP;
                for (int j = 0; j < n; ++j) consume(ch, g0 + j, ch.ring + (size_t)(((k - 1) & 1) * GROUP + j) * RING_SLOT, S, wid, lane); }
#endif
            DN_BAR();
        }
    }
#undef DN_BAR
    __syncthreads();
}
#undef DN_MFMA
}
struct Params {
    const float* in[28];
    float* out; unsigned char* ws;
    int ph_lo, ph_hi; int use_bar; int pad;
};
enum { I_X = 0, I_C, I_CTX, I_CCTX, I_WMOD, I_BMOD, I_GN1, I_GN2, I_WIN, I_GQ, I_GK, I_WCONV, I_ALOG, I_DTB, I_GDN, I_LAMQK, I_GSUB, I_WBR, I_WOUT, I_WRT, I_BRT,
       I_WEG, I_WEU, I_WED, I_WSG, I_WSU, I_WSD, I_GFIN };
struct Frame {
    LAS unsigned char* lds; volatile LAS unsigned* MISC; gu32* ctl;
    int tid, lane, wave, G, gw, NGW;
    GAS unsigned char* ws;
};
__device__ __forceinline__ size_t hrow_off(int r, bool& isctx, int& b) { b = r / TT; const int t = r - b * TT; isctx = t < CTXL; return isctx ? (size_t)(b * CTXL + t) * DM : (size_t)(b * SEQ + (t - CTXL)) * DM; }

__device__ __forceinline__ void transpose_item(const float* W, int ldw, int k0, int n0, bf16_t* WT, int K, int dst_row0, LAS float* scr, int lane) {
    float tv[32];
#pragma unroll
    for (int i = 0; i < 32; ++i) { const int kk = 2 * i + (lane >> 5); tv[i] = W[(size_t)(k0 + kk) * ldw + n0 + (lane & 31)]; }
#pragma unroll
    for (int i = 0; i < 32; ++i) { const int kk = 2 * i + (lane >> 5); scr[kk * 33 + (lane & 31)] = tv[i]; }
    LDS_WAIT(); asm volatile("" ::: "memory");
    const int c = lane & 7;
#pragma unroll
    for (int j = 0; j < 4; ++j) { const int n = (lane >> 3) + 8 * j; const LAS float* s = scr + (8 * c) * 33 + n;
        v4u o; o.x = pk2(s[0 * 33], s[1 * 33]); o.y = pk2(s[2 * 33], s[3 * 33]); o.z = pk2(s[4 * 33], s[5 * 33]); o.w = pk2(s[6 * 33], s[7 * 33]);
        *(v4u*)(WT + (size_t)(dst_row0 + n) * K + k0 + 8 * c) = o; }
    LDS_WAIT(); asm volatile("" ::: "memory");
}
__device__ __forceinline__ void convert_small(Frame& F, const Params& P, int l) {
    LAS float* scr = (LAS float*)(F.lds + RING_OFF + F.wave * 16384);
    const float* win = P.in[I_WIN] + (size_t)l * DM * INW;
    const float* wbr = P.in[I_WBR] + (size_t)l * 3 * 512 * DM;
    const float* wo = P.in[I_WOUT] + (size_t)l * DM * DM;
    bf16_t* WB1 = (bf16_t*)(F.ws + WS_WB1); bf16_t* WB2 = (bf16_t*)(F.ws + WS_WB2); bf16_t* WBR = (bf16_t*)(F.ws + WS_WBR); bf16_t* WOT = (bf16_t*)(F.ws + WS_WOT);
    constexpr int I1 = 16 * (P1W / 32), I2 = 16 * (GW / 32), I3 = 3 * 8 * 32, I4 = 16 * 32;
    for (int it = F.gw; it < I1 + I2 + I3 + I4; it += F.NGW) {
        int r = it;
        if (r < I1) { const int nb = r % (P1W / 32), kb = r / (P1W / 32); transpose_item(win, INW, 64 * kb, 32 * nb, WB1, DM, 32 * nb, scr, F.lane); continue; } r -= I1;
        if (r < I2) { const int nb = r % (GW / 32), kb = r / (GW / 32); transpose_item(win, INW, 64 * kb, C_GATE + 32 * nb, WB2, DM, 32 * nb, scr, F.lane); continue; } r -= I2;
        if (r < I3) { const int br = r / 256, q = r % 256, nb = q % 32, kb = q / 32; transpose_item(wbr + (size_t)br * 512 * DM, DM, 64 * kb, 32 * nb, WBR + (size_t)br * DM * 512, 512, 32 * nb, scr, F.lane); continue; } r -= I3;
        { const int nb = r % 32, kb = r / 32; transpose_item(wo, DM, 64 * kb, 32 * nb, WOT, DM, 32 * nb, scr, F.lane); }
    }
}
__device__ __forceinline__ void convert_experts(Frame& F, const Params& P, int l) {
    LAS float* scr = (LAS float*)(F.lds + RING_OFF + F.wave * 16384);
    bf16_t* WGU = (bf16_t*)(F.ws + WS_B); bf16_t* WD = WGU + (size_t)NEXP1 * 512 * DM;
    for (int it = F.gw; it < NEXP1 * 384; it += F.NGW) {
        const int e = it / 384; int r = it % 384;
        const float* wg = (e < NEXP) ? P.in[I_WEG] + ((size_t)l * NEXP + e) * DM * FF : P.in[I_WSG] + (size_t)l * DM * FF;
        const float* wu = (e < NEXP) ? P.in[I_WEU] + ((size_t)l * NEXP + e) * DM * FF : P.in[I_WSU] + (size_t)l * DM * FF;
        const float* wd = (e < NEXP) ? P.in[I_WED] + ((size_t)l * NEXP + e) * FF * DM : P.in[I_WSD] + (size_t)l * FF * DM;
        if (r < 256) { const bool up = r >= 128; r &= 127; const int nb = r % 8, kb = r / 8; const int n0 = 32 * nb;
            transpose_item(up ? wu : wg, FF, 64 * kb, n0, WGU + (size_t)e * 512 * DM, DM, (n0 / 128) * 256 + (up ? 128 : 0) + (n0 % 128), scr, F.lane); }
        else { r -= 256; const int nb = r % 32, kb = r / 32; transpose_item(wd, DM, 64 * kb, 32 * nb, WD + (size_t)e * DM * FF, FF, 32 * nb, scr, F.lane); }
    }
}
__device__ __forceinline__ void compute_mod(Frame& F, const Params& P) {
    float* modv = (float*)(F.ws + WS_MODV);
    const int kq = F.lane >> 3, nn = F.lane & 7;
    for (int it = F.gw; it < NLAYER * (6144 / 8); it += F.NGW) {
        const int l = it / (6144 / 8), n = (it % (6144 / 8)) * 8 + nn;
        const float* w = P.in[I_WMOD] + (size_t)l * DM * 6144 + n;
        float a0 = 0.f, a1 = 0.f, a2 = 0.f;
#pragma unroll 16
        for (int i = 0; i < 128; ++i) { const int k = kq + 8 * i; const float wv = w[(size_t)k * 6144];
            a0 += siluf_(P.in[I_C][k]) * wv; a1 += siluf_(P.in[I_C][DM + k]) * wv; a2 += siluf_(P.in[I_CCTX][k]) * wv; }
#pragma unroll
        for (int o = 8; o < 64; o <<= 1) { a0 += __shfl_xor(a0, o); a1 += __shfl_xor(a1, o); a2 += __shfl_xor(a2, o); }
        if (kq == 0) { const float bm = P.in[I_BMOD][l * 6144 + n]; float* m = modv + (size_t)l * 3 * 6144 + n; m[0] = a0 + bm; m[6144] = a1 + bm; m[2 * 6144] = a2 + bm; }
    }
}
__device__ __forceinline__ void modnorm_store(const float (&x)[16], const float* g, const float* sc, const float* sh, bf16_t* orow, int lane) {
    float ss = 0.f;
#pragma unroll
    for (int i = 0; i < 16; ++i) ss += x[i] * x[i];
    const float rstd = rsqrtf(wave_sum(ss) * (1.f / DM) + EPS);
#pragma unroll
    for (int hf = 0; hf < 2; ++hf) { const int c0 = hf * 512 + lane * 8; float y[8];
#pragma unroll
        for (int j = 0; j < 8; ++j) y[j] = x[hf * 8 + j] * rstd * g[c0 + j] * (1.f + sc[c0 + j]) + sh[c0 + j];
        v4u w; w.x = cvt_pk_bf16(y[0], y[1]); w.y = cvt_pk_bf16(y[2], y[3]); w.z = cvt_pk_bf16(y[4], y[5]); w.w = cvt_pk_bf16(y[6], y[7]);
        *(v4u*)(orow + c0) = w; }
}
__device__ __forceinline__ void load_row16(const float* row, float (&x)[16], int lane) {
#pragma unroll
    for (int hf = 0; hf < 2; ++hf) { const f32x4 a = *(const f32x4*)(row + hf * 512 + lane * 8), b = *(const f32x4*)(row + hf * 512 + lane * 8 + 4);
        x[hf * 8 + 0] = a[0]; x[hf * 8 + 1] = a[1]; x[hf * 8 + 2] = a[2]; x[hf * 8 + 3] = a[3]; x[hf * 8 + 4] = b[0]; x[hf * 8 + 5] = b[1]; x[hf * 8 + 6] = b[2]; x[hf * 8 + 7] = b[3]; }
}
__device__ __forceinline__ void phase_norm1(Frame& F, const Params& P) {
    const float* modv = (const float*)(F.ws + WS_MODV); bf16_t* U = (bf16_t*)(F.ws + WS_C);
    for (int r = F.gw; r < MROWS; r += 2 * F.NGW) {
        const bool has1 = r + F.NGW < MROWS; const int r1 = has1 ? r + F.NGW : r;
        bool ic0, ic1; int b0, b1; const size_t off0 = hrow_off(r, ic0, b0), off1 = hrow_off(r1, ic1, b1);
        float x0[16], x1[16]; load_row16((ic0 ? P.in[I_CTX] : P.in[I_X]) + off0, x0, F.lane); load_row16((ic1 ? P.in[I_CTX] : P.in[I_X]) + off1, x1, F.lane);
        { const float* mv = modv + (ic0 ? 2 : b0) * 6144; modnorm_store(x0, P.in[I_GN1], mv + 1 * DM, mv + 0 * DM, U + (size_t)r * DM, F.lane); }
        if (has1) { const float* mv = modv + (ic1 ? 2 : b1) * 6144; modnorm_store(x1, P.in[I_GN1], mv + 1 * DM, mv + 0 * DM, U + (size_t)r1 * DM, F.lane); } }
}
__device__ __forceinline__ void unpack8(const v4u w, float (&x)[8]) { x[0] = bflo(w.x); x[1] = bfhi(w.x); x[2] = bflo(w.y); x[3] = bfhi(w.y); x[4] = bflo(w.z); x[5] = bfhi(w.z); x[6] = bflo(w.w); x[7] = bfhi(w.w); }
__device__ __forceinline__ void load_row16_bf(const bf16_t* row, float (&x)[16], int lane) {
#pragma unroll
    for (int hf = 0; hf < 2; ++hf) { const v4u w = *(const v4u*)(row + hf * 512 + lane * 8); float t[8]; unpack8(w, t);
#pragma unroll
        for (int j = 0; j < 8; ++j) x[hf * 8 + j] = t[j]; }
}
__device__ __forceinline__ v4u pack8f(const float (&y)[8]) { v4u w; w.x = cvt_pk_bf16(y[0], y[1]); w.y = cvt_pk_bf16(y[2], y[3]); w.z = cvt_pk_bf16(y[4], y[5]); w.w = cvt_pk_bf16(y[6], y[7]); return w; }
__device__ __forceinline__ void phase_prep(Frame& F, const Params& P, int l, bool dry = false) {
    bf16_t* P1 = (bf16_t*)(F.ws + WS_A);
    const int lane = F.lane, c = lane & 3, i5 = lane & 31, hd = lane >> 2; const bool act = hd < 10;
    const float inv = exp2f(-(float)(i5 & 15) * (13.287712379549449f / 16.f));
    float gk[16];
#pragma unroll
    for (int e = 0; e < 8; ++e) { gk[e] = P.in[I_GK][l * 64 + 8 * c + e]; gk[8 + e] = P.in[I_GK][l * 64 + 32 + 8 * c + e]; }
    const int col = !act ? C_AK : (hd < 2 ? C_AK + hd * 64 : C_CK + (hd - 2) * 64); const bool nrm = hd < 2;
    float kmx[2] = {0.f, 0.f};
    auto body = [&](int r, const v4u w0, const v4u w1) {
        const int b = r / TT, t = r - b * TT; const bool lat = t >= CTXL;
        float cs = 1.f, sn = 0.f;
        if (lat) { const int s = t - CTXL; const float pos = (i5 < 16) ? (float)(s / GRIDW) : (float)(s % GRIDW); sincosf(pos * inv, &sn, &cs); }
        float cse[8], sne[8];
#pragma unroll
        for (int e = 0; e < 8; ++e) { cse[e] = __shfl(cs, 8 * c + e); sne[e] = __shfl(sn, 8 * c + e); }
        bf16_t* row = P1 + (size_t)r * P1W;
        float x0[8], x1[8]; unpack8(w0, x0); unpack8(w1, x1);
        if (nrm) { float ss = 0.f;
#pragma unroll
            for (int e = 0; e < 8; ++e) ss += x0[e] * x0[e] + x1[e] * x1[e];
            ss += __shfl_xor(ss, 1); ss += __shfl_xor(ss, 2);
            const float rstd = rsqrtf(ss * (1.f / 64.f) + EPS);
#pragma unroll
            for (int e = 0; e < 8; ++e) { x0[e] *= rstd * gk[e]; x1[e] *= rstd * gk[8 + e]; } }
        float y0[8], y1[8];
#pragma unroll
        for (int e = 0; e < 8; ++e) { y0[e] = x0[e] * cse[e] - x1[e] * sne[e]; y1[e] = x1[e] * cse[e] + x0[e] * sne[e]; }
        const v4u pk0 = pack8f(y0), pk1 = pack8f(y1);
        if (act && (!dry || y0[0] == 123456.f)) { *(v4u*)(row + col + 8 * c) = pk0; *(v4u*)(row + col + 32 + 8 * c) = pk1; }
        { float z0[8], z1[8]; unpack8(pk0, z0); unpack8(pk1, z1); float ks = 0.f;
#pragma unroll
          for (int e = 0; e < 8; ++e) ks += z0[e] * z0[e] + z1[e] * z1[e];
          ks += __shfl_xor(ks, 1); ks += __shfl_xor(ks, 2);
          if (b == 0) kmx[0] = fmaxf(kmx[0], ks); else kmx[1] = fmaxf(kmx[1], ks); }
    };
    for (int r = F.gw; r < MROWS; r += 4 * F.NGW) {
        int rr[4]; v4u wa[4], wb[4];
#pragma unroll
        for (int q = 0; q < 4; ++q) { rr[q] = r + q * F.NGW; const int rq = rr[q] < MROWS ? rr[q] : r; const bf16_t* row = P1 + (size_t)rq * P1W; wa[q] = *(const v4u*)(row + col + 8 * c); wb[q] = *(const v4u*)(row + col + 32 + 8 * c); }
#pragma unroll
        for (int q = 0; q < 4; ++q) if (rr[q] < MROWS) body(rr[q], wa[q], wb[q]);
    }
    if (!dry && act && c == 0) { atomicMax((int*)(F.ctl + CW_KMAX + (l * 2 + 0) * 16 + hd), __float_as_int(kmx[0])); atomicMax((int*)(F.ctl + CW_KMAX + (l * 2 + 1) * 16 + hd), __float_as_int(kmx[1])); }
}
__device__ __forceinline__ void phase_dn_prep(Frame& F, const Params& P, int l) {
    bf16_t* P1 = (bf16_t*)(F.ws + WS_A); bf16_t* BR = (bf16_t*)(F.ws + WS_B);
    const float* wc = P.in[I_WCONV] + (size_t)l * 3 * 1536;
    const int lane = F.lane;
    float w0[2][8], w1[2][8], w2[2][8];
#pragma unroll
    for (int ps = 0; ps < 2; ++ps) { const int ch0 = (ps * 64 + lane) * 8;
#pragma unroll
        for (int e = 0; e < 8; ++e) { w0[ps][e] = wc[0 * 1536 + ch0 + e]; w1[ps][e] = wc[1 * 1536 + ch0 + e]; w2[ps][e] = wc[2 * 1536 + ch0 + e]; } }
    for (int r0 = F.gw; r0 < MROWS; r0 += 2 * F.NGW) {
        int rr[2]; bool hm[2], hp[2]; v4u wc_[2][2], wm_[2][2], wp_[2][2];
#pragma unroll
        for (int q = 0; q < 2; ++q) { rr[q] = r0 + q * F.NGW; const int r = rr[q] < MROWS ? rr[q] : r0;
            const int b = r / TT, t = r - b * TT; const int seg_lo = (t < CTXL) ? 0 : CTXL, seg_hi = (t < CTXL) ? CTXL : TT;
            hm[q] = (t - 1 >= seg_lo); hp[q] = (t + 1 < seg_hi);
            const bf16_t* rowc = P1 + (size_t)r * P1W + C_BQKV; const bf16_t* rowm = hm[q] ? rowc - P1W : rowc; const bf16_t* rowp = hp[q] ? rowc + P1W : rowc;
#pragma unroll
            for (int ps = 0; ps < 2; ++ps) { const int ch0 = (ps * 64 + lane) * 8; wc_[q][ps] = *(const v4u*)(rowc + ch0); wm_[q][ps] = *(const v4u*)(rowm + ch0); wp_[q][ps] = *(const v4u*)(rowp + ch0); } }
#pragma unroll
        for (int q = 0; q < 2; ++q) { if (rr[q] >= MROWS) continue; const int r = rr[q]; const bool hasm = hm[q], hasp = hp[q];
#pragma unroll
        for (int ps = 0; ps < 2; ++ps) { const int ch0 = (ps * 64 + lane) * 8;
            float xc[8], xm[8], xp[8]; unpack8(wc_[q][ps], xc); unpack8(wm_[q][ps], xm); unpack8(wp_[q][ps], xp);
            float y[8]; float ss = 0.f;
#pragma unroll
            for (int e = 0; e < 8; ++e) { const float v = (hasm ? xm[e] * w0[ps][e] : 0.f) + xc[e] * w1[ps][e] + (hasp ? xp[e] * w2[ps][e] : 0.f); y[e] = siluf_(v); ss += y[e] * y[e]; }
            ss += __shfl_xor(ss, 1); ss += __shfl_xor(ss, 2); ss += __shfl_xor(ss, 4);
            const float sc = rsqrtf(ss + EPS) * (ps == 0 ? 0.125f : 1.f);
#pragma unroll
            for (int e = 0; e < 8; ++e) y[e] *= sc;
            *(v4u*)(BR + (size_t)r * 1536 + 512 + ch0) = pack8f(y); } }
    }
}
__device__ __forceinline__ void phase_dn_prep_v(Frame& F, const Params& P, int l) {
    bf16_t* P1 = (bf16_t*)(F.ws + WS_A);
    const float* wc = P.in[I_WCONV] + (size_t)l * 3 * 1536 + 1024;
    const int lane = F.lane; const int ch0 = lane * 8;
    float w0[8], w1[8], w2[8];
#pragma unroll
    for (int e = 0; e < 8; ++e) { w0[e] = wc[0 * 1536 + ch0 + e]; w1[e] = wc[1 * 1536 + ch0 + e]; w2[e] = wc[2 * 1536 + ch0 + e]; }
    for (int r0 = F.gw; r0 < MROWS; r0 += 4 * F.NGW) {
        int rr[4]; bool hm[4], hp[4]; v4u wc_[4], wm_[4], wp_[4];
#pragma unroll
        for (int q = 0; q < 4; ++q) { rr[q] = r0 + q * F.NGW; const int r = rr[q] < MROWS ? rr[q] : r0;
            const int b = r / TT, t = r - b * TT; const int seg_lo = (t < CTXL) ? 0 : CTXL, seg_hi = (t < CTXL) ? CTXL : TT;
            hm[q] = (t - 1 >= seg_lo); hp[q] = (t + 1 < seg_hi);
            const bf16_t* rowc = P1 + (size_t)r * P1W + C_BQKV + 1024; const bf16_t* rowm = hm[q] ? rowc - P1W : rowc; const bf16_t* rowp = hp[q] ? rowc + P1W : rowc;
            wc_[q] = *(const v4u*)(rowc + ch0); wm_[q] = *(const v4u*)(rowm + ch0); wp_[q] = *(const v4u*)(rowp + ch0); }
#pragma unroll
        for (int q = 0; q < 4; ++q) { if (rr[q] >= MROWS) continue; const bool hasm = hm[q], hasp = hp[q];
            float xc[8], xm[8], xp[8]; unpack8(wc_[q], xc); unpack8(wm_[q], xm); unpack8(wp_[q], xp);
            float y[8];
#pragma unroll
            for (int e = 0; e < 8; ++e) { const float v = (hasm ? xm[e] * w0[e] : 0.f) + xc[e] * w1[e] + (hasp ? xp[e] * w2[e] : 0.f); y[e] = siluf_(v); }
            *(v4u*)(P1 + (size_t)rr[q] * P1W + C_BQKV + ch0) = pack8f(y); }
    }
}
__device__ __forceinline__ void phase_post(Frame& F, const Params& P, int l) {
    const bf16_t* P1 = (const bf16_t*)(F.ws + WS_A); bf16_t* BR = (bf16_t*)(F.ws + WS_B);
    const bf16_t* DO = (const bf16_t*)(F.ws + WS_D); const bf16_t* OFw = DO + (size_t)MROWS * 1024; const bf16_t* OBw = OFw + (size_t)MROWS * 512;
    const int lane = F.lane;
    const float linit = 0.8f - 0.6f * expf(-0.3f * (float)l);
    const float* lq = P.in[I_LAMQK] + l * 256;
    const float lam = expf(wave_sum(lq[lane] * lq[64 + lane])) - expf(wave_sum(lq[128 + lane] * lq[192 + lane])) + linit;
    float gdn[8], gsb[8];
#pragma unroll
    for (int e = 0; e < 8; ++e) { gdn[e] = P.in[I_GDN][l * 64 + (lane & 7) * 8 + e]; gsb[e] = P.in[I_GSUB][l * 128 + (lane & 15) * 8 + e] * (1.f - linit); }
    const int hq = lane >> 4, e0 = (lane & 15) * 8;
    for (int r0 = F.gw; r0 < MROWS; r0 += 2 * F.NGW) {
        int rr[2]; v4u wf_[2], wb_[2], wz_[2], d0_[2], d1_[2];
#pragma unroll
        for (int q = 0; q < 2; ++q) { rr[q] = r0 + q * F.NGW; const int r = rr[q] < MROWS ? rr[q] : r0;
            wf_[q] = *(const v4u*)(OFw + (size_t)r * 512 + lane * 8); wb_[q] = *(const v4u*)(OBw + (size_t)r * 512 + lane * 8); wz_[q] = *(const v4u*)(P1 + (size_t)r * P1W + C_BZ + lane * 8);
            d0_[q] = *(const v4u*)(DO + (size_t)r * 1024 + (2 * hq) * 128 + e0); d1_[q] = *(const v4u*)(DO + (size_t)r * 1024 + (2 * hq + 1) * 128 + e0); }
#pragma unroll
        for (int q = 0; q < 2; ++q) { if (rr[q] >= MROWS) continue; const int r = rr[q];
        { float a[8], bq[8], z[8], y[8]; unpack8(wf_[q], a); unpack8(wb_[q], bq); unpack8(wz_[q], z); float ss = 0.f;
#pragma unroll
          for (int e = 0; e < 8; ++e) { a[e] += bq[e]; ss += a[e] * a[e]; }
          ss += __shfl_xor(ss, 1); ss += __shfl_xor(ss, 2); ss += __shfl_xor(ss, 4);
          const float rstd = rsqrtf(ss * (1.f / 64.f) + EPS);
#pragma unroll
          for (int e = 0; e < 8; ++e) y[e] = a[e] * rstd * gdn[e] * siluf_(z[e]);
          *(v4u*)(BR + (size_t)r * 1536 + 512 + lane * 8) = pack8f(y); }
        { float a[8], bq[8], y[8]; unpack8(d0_[q], a); unpack8(d1_[q], bq); float ss = 0.f;
#pragma unroll
          for (int e = 0; e < 8; ++e) { a[e] -= lam * bq[e]; ss += a[e] * a[e]; }
          ss += __shfl_xor(ss, 1); ss += __shfl_xor(ss, 2); ss += __shfl_xor(ss, 4); ss += __shfl_xor(ss, 8);
          const float rstd = rsqrtf(ss * (1.f / 128.f) + EPS);
#pragma unroll
          for (int e = 0; e < 8; ++e) y[e] = a[e] * rstd * gsb[e];
          *(v4u*)(BR + (size_t)r * 1536 + 1024 + lane * 8) = pack8f(y); } }
    }
}
__device__ __forceinline__ void phase_norm2_router(Frame& F, const Params& P, int l, bool dry = false) {
    const float* modv = (const float*)(F.ws + WS_MODV) + (size_t)l * 3 * 6144; bf16_t* U = (bf16_t*)(F.ws + WS_C);
    const bf16_t* hlat = (const bf16_t*)(F.ws + WS_HB); const float* hctx = (const float*)(F.ws + WS_HCTX);
    int* tope = (int*)(F.ws + WS_TOPE); float* topw = (float*)(F.ws + WS_TOPW); int* tops = (int*)(F.ws + WS_TOPS);
    constexpr int VSP = DM + 4;
    LAS float* vS = (LAS float*)(F.lds + RING_OFF);
    const float* wr = P.in[I_WRT] + (size_t)l * DM * NEXP; const float brt = P.in[I_BRT][l * NEXP + F.lane];
    const float* g2 = P.in[I_GN2] + l * DM;
    const int lane = F.lane;
    for (int base = blockIdx.x * 32; base < MROWS; base += F.G * 32) {
        const int r0 = base + 4 * F.wave;
        __syncthreads();
        float xq[4][16];
#pragma unroll
        for (int q = 0; q < 4; ++q) { bool isctx_; int b_; const size_t off_ = hrow_off(r0 + q, isctx_, b_); if (isctx_) load_row16(hctx + off_, xq[q], lane); else load_row16_bf(hlat + off_, xq[q], lane); }
#pragma unroll
        for (int q = 0; q < 4; ++q) { const int r = r0 + q; bool isctx; int b; const size_t off = hrow_off(r, isctx, b); (void)off;
            float (&x)[16] = xq[q];
            const float* mv = modv + (isctx ? 2 : b) * 6144; const float* sc = mv + 4 * DM; const float* sh = mv + 3 * DM;
            float ss = 0.f;
#pragma unroll
            for (int i = 0; i < 16; ++i) ss += x[i] * x[i];
            const float rstd = rsqrtf(wave_sum(ss) * (1.f / DM) + EPS);
#pragma unroll
            for (int hf = 0; hf < 2; ++hf) { const int c0 = hf * 512 + lane * 8; float y[8];
#pragma unroll
                for (int j = 0; j < 8; ++j) y[j] = x[hf * 8 + j] * rstd * g2[c0 + j] * (1.f + sc[c0 + j]) + sh[c0 + j];
                { LAS float* vp = vS + (4 * F.wave + q) * VSP + c0; *(LAS f32x4*)vp = (f32x4){y[0], y[1], y[2], y[3]}; *(LAS f32x4*)(vp + 4) = (f32x4){y[4], y[5], y[6], y[7]}; }
                v4u w; w.x = cvt_pk_bf16(y[0], y[1]); w.y = cvt_pk_bf16(y[2], y[3]); w.z = cvt_pk_bf16(y[4], y[5]); w.w = cvt_pk_bf16(y[6], y[7]);
                *(v4u*)(U + (size_t)r * DM + c0) = w; } }
        __syncthreads();
        f32x4 lacc0 = {0.f, 0.f, 0.f, 0.f}, lacc1 = {0.f, 0.f, 0.f, 0.f};
        { const int i16 = lane & 15, kk = lane >> 4, rt = F.wave >> 2, ct = F.wave & 3;
          const LAS float* ap = vS + (16 * rt + i16) * VSP + 256 * kk; const float* bp = wr + (size_t)(256 * kk) * NEXP + 16 * ct + i16;
#pragma unroll 8
          for (int s4 = 0; s4 < 64; ++s4) { const f32x4 av = *(const LAS f32x4*)(ap + 4 * s4);
              const float b0 = bp[(size_t)(4 * s4 + 0) * NEXP], b1 = bp[(size_t)(4 * s4 + 1) * NEXP], b2 = bp[(size_t)(4 * s4 + 2) * NEXP], b3 = bp[(size_t)(4 * s4 + 3) * NEXP];
              lacc0 = __builtin_amdgcn_mfma_f32_16x16x4f32(av[0], b0, lacc0, 0, 0, 0); lacc1 = __builtin_amdgcn_mfma_f32_16x16x4f32(av[1], b1, lacc1, 0, 0, 0);
              lacc0 = __builtin_amdgcn_mfma_f32_16x16x4f32(av[2], b2, lacc0, 0, 0, 0); lacc1 = __builtin_amdgcn_mfma_f32_16x16x4f32(av[3], b3, lacc1, 0, 0, 0); }
          lacc0 = lacc0 + lacc1; }
        __syncthreads();
        { const int j16 = lane & 15, rq = lane >> 4, rt = F.wave >> 2, ct = F.wave & 3;
#pragma unroll
          for (int g = 0; g < 4; ++g) vS[(16 * rt + 4 * rq + g) * NEXP + 16 * ct + j16] = lacc0[g]; }
        __syncthreads();
        const float a0 = vS[(4 * F.wave + 0) * NEXP + lane], a1 = vS[(4 * F.wave + 1) * NEXP + lane], a2 = vS[(4 * F.wave + 2) * NEXP + lane], a3 = vS[(4 * F.wave + 3) * NEXP + lane];
        LDS_WAIT();
#pragma unroll 1
        for (int q = 0; q < 4; ++q) { const int r = r0 + q; const float lg = q == 0 ? a0 : (q == 1 ? a1 : (q == 2 ? a2 : a3));
            const float sc = 1.f / (1.f + expf(-lg)); const float sel = sc + brt;
            float m1 = sel;
#pragma unroll
            for (int o = 1; o < 8; o <<= 1) m1 = fmaxf(m1, __shfl_xor(m1, o));
            int fi = (sel == m1) ? lane : 999;
#pragma unroll
            for (int o = 1; o < 8; o <<= 1) fi = min(fi, __shfl_xor(fi, o));
            float m2 = (lane == fi) ? -INFINITY : sel;
#pragma unroll
            for (int o = 1; o < 8; o <<= 1) m2 = fmaxf(m2, __shfl_xor(m2, o));
            const float gs = m1 + m2; const int g = lane >> 3;
            int grank = 0;
#pragma unroll
            for (int gg = 0; gg < 8; ++gg) { const float o = __builtin_bit_cast(float, __builtin_amdgcn_readlane(__builtin_bit_cast(int, gs), gg * 8)); grank += (o > gs || (o == gs && gg < g)) ? 1 : 0; }
            const float val = (grank < 4) ? sel : -INFINITY;
            int rank = 0;
#pragma unroll 4
            for (int e = 0; e < 64; ++e) { const float o = __builtin_bit_cast(float, __builtin_amdgcn_readlane(__builtin_bit_cast(int, val), e)); rank += (o > val || (o == val && e < lane)) ? 1 : 0; }
            const bool selx = (grank < 4) && (rank < TOPK);
            const float wsum = wave_sum(selx ? sc : 0.f);
            const int half = r / TT;
            if (selx && (!dry || wsum == 123456.f)) { const int slot = atomicAdd((int*)(F.ctl + CW_ECNT + ((l * 2 + half) * NEXP1 + lane) * 16), 1);
                tope[(size_t)r * 8 + rank] = lane; topw[(size_t)r * 8 + rank] = sc / (wsum + 1e-20f) * 2.5f; tops[(size_t)r * 8 + rank] = slot; }
            if (lane == 0 && !dry) { tope[(size_t)r * 8 + 6] = NEXP; topw[(size_t)r * 8 + 6] = 1.f; tops[(size_t)r * 8 + 6] = r - half * TT; }
        }
    }
}
__device__ __forceinline__ void moe_table(Frame& F, int l, int half, LAS int* ts, LAS int* te) {
    LAS int* cn = (LAS int*)(F.lds + MISC_OFF + 5696);
    __syncthreads();
    if (F.tid < NEXP) {
        const int c = (int)__hip_atomic_load(F.ctl + CW_ECNT + ((l * 2 + half) * NEXP1 + F.tid) * 16, RLX_AGENT);
        cn[F.tid] = c; const int tiles = (c + 255) >> 8; int s = tiles;
#pragma unroll
        for (int o = 1; o < 64; o <<= 1) { const int t = __shfl_up(s, o); if (F.tid >= o) s += t; }
        ts[F.tid] = s - tiles;
        if (F.tid == NEXP - 1) { ts[NEXP] = s; ts[NEXP1] = s + (TT + 255) / 256; cn[NEXP] = TT; }
    }
    __syncthreads();
    const int total = ts[NEXP1];
    for (int t = F.tid; t < total; t += NTHREADS) { int e = 0;
        for (int k = 1; k < NEXP1; ++k) e += (ts[k] <= t) ? 1 : 0;
        te[t] = e; }
    __syncthreads();
}
__device__ __forceinline__ void phase_scatter(Frame& F, int l, bool dry = false) {
    LAS int* ts = (LAS int*)(F.lds + MISC_OFF + 256); LAS int* te = (LAS int*)(F.lds + MISC_OFF + 3584);
    const int* tope = (const int*)(F.ws + WS_TOPE); const float* topw = (const float*)(F.ws + WS_TOPW); int* tops = (int*)(F.ws + WS_TOPS);
    for (int half = 0; half < 2; ++half) {
        moe_table(F, l, half, ts, te);
        int* rtok = (int*)(F.ws + WS_RTOK) + (size_t)half * HROWS_PAD; float* rw = (float*)(F.ws + WS_RW) + (size_t)half * HROWS_PAD;
        for (int r = half * TT + F.gw; r < (half + 1) * TT; r += F.NGW) {
            if (F.lane < 7) { const int e = tope[(size_t)r * 8 + F.lane]; const int pos = ts[e] * 256 + tops[(size_t)r * 8 + F.lane];
                if (!dry || pos == -12345) { rtok[pos] = r; rw[pos] = topw[(size_t)r * 8 + F.lane]; tops[(size_t)r * 8 + F.lane] = pos; } } }
        for (int it = blockIdx.x * NTHREADS + F.tid; it < NEXP1 * 256; it += F.G * NTHREADS) { const int e = it >> 8, j = it & 255;
            const int cnt = ((const LAS int*)(F.lds + MISC_OFF + 5696))[e];
            const int rem = cnt & 255; if (rem != 0 && j >= rem) { const int pos = (ts[e] + (cnt >> 8)) * 256 + j; rtok[pos] = half * TT; rw[pos] = 0.f; } }
    }
}
__device__ __forceinline__ void phase_combine(Frame& F, const Params& P, int l, int half, bool dry = false) {
    const float* modv = (const float*)(F.ws + WS_MODV) + (size_t)l * 3 * 6144; const float* modn = (const float*)(F.ws + WS_MODV) + (size_t)(l + 1) * 3 * 6144;
    const bf16_t* hb = (const bf16_t*)(F.ws + WS_HB); bf16_t* hn = (bf16_t*)P.out; float* hlat = P.out; float* hctx = (float*)(F.ws + WS_HCTX); bf16_t* U = (bf16_t*)(F.ws + WS_C);
    const unsigned char* Y = (const unsigned char*)(F.ws + WS_A); const int* tops = (const int*)(F.ws + WS_TOPS);
    const int lane = F.lane; const int cb = (lane >> 4) * 256 + (lane & 15) * 8;
    for (int r = half * TT + F.gw; r < (half + 1) * TT; r += F.NGW) {
        bool isctx; int b; const size_t off = hrow_off(r, isctx, b);
        float* row = (isctx ? hctx : hlat) + off; float x[16];
        if (isctx) {
#pragma unroll
            for (int hf = 0; hf < 2; ++hf) { const f32x4 a = *(const f32x4*)(row + cb + hf * 128), b4 = *(const f32x4*)(row + cb + hf * 128 + 4);
                x[hf * 8 + 0] = a[0]; x[hf * 8 + 1] = a[1]; x[hf * 8 + 2] = a[2]; x[hf * 8 + 3] = a[3]; x[hf * 8 + 4] = b4[0]; x[hf * 8 + 5] = b4[1]; x[hf * 8 + 6] = b4[2]; x[hf * 8 + 7] = b4[3]; }
        } else {
#pragma unroll
            for (int hf = 0; hf < 2; ++hf) { const v4u w = *(const v4u*)(hb + off + cb + hf * 128); float t[8]; unpack8(w, t);
#pragma unroll
                for (int j = 0; j < 8; ++j) x[hf * 8 + j] = t[j]; }
        }
        float y[16];
#pragma unroll
        for (int i = 0; i < 16; ++i) y[i] = 0.f;
        v4u yw[7];
#pragma unroll
        for (int k = 0; k < 7; ++k) { const int pos = tops[(size_t)r * 8 + k]; yw[k] = *(const v4u*)(Y + (size_t)pos * DM + lane * 16); }
#pragma unroll
        for (int k = 0; k < 7; ++k)
#pragma unroll
            for (int q = 0; q < 4; ++q) { const int wq = (int)yw[k][q]; const f32x2 lo = __builtin_amdgcn_cvt_pk_f32_fp8(wq, false), hi = __builtin_amdgcn_cvt_pk_f32_fp8(wq, true);
                y[q * 4 + 0] += lo[0]; y[q * 4 + 1] += lo[1]; y[q * 4 + 2] += hi[0]; y[q * 4 + 3] += hi[1]; }
        const float* gt2 = modv + (isctx ? 2 : b) * 6144 + 5 * DM;
#pragma unroll
        for (int hf = 0; hf < 2; ++hf)
#pragma unroll
            for (int j = 0; j < 8; ++j) x[hf * 8 + j] += gt2[cb + hf * 128 + j] * (y[hf * 8 + j] * pg8::YUNSCALE);
        if (dry) { float sy = 0.f;
#pragma unroll
            for (int i = 0; i < 16; ++i) sy += x[i];
            if (sy == 123456.f) row[0] = sy; continue; }
        if (l + 1 < NLAYER) {
#pragma unroll
            for (int hf = 0; hf < 2; ++hf) {
                if (isctx) { *(f32x4*)(row + cb + hf * 128) = (f32x4){x[hf * 8 + 0], x[hf * 8 + 1], x[hf * 8 + 2], x[hf * 8 + 3]}; *(f32x4*)(row + cb + hf * 128 + 4) = (f32x4){x[hf * 8 + 4], x[hf * 8 + 5], x[hf * 8 + 6], x[hf * 8 + 7]}; }
                else { v4u w; w.x = cvt_pk_bf16(x[hf * 8 + 0], x[hf * 8 + 1]); w.y = cvt_pk_bf16(x[hf * 8 + 2], x[hf * 8 + 3]); w.z = cvt_pk_bf16(x[hf * 8 + 4], x[hf * 8 + 5]); w.w = cvt_pk_bf16(x[hf * 8 + 6], x[hf * 8 + 7]); *(v4u*)(hn + off + cb + hf * 128) = w; } }
            const float* mv = modn + (isctx ? 2 : b) * 6144; const float* g = P.in[I_GN1] + (l + 1) * DM; const float* sc = mv + 1 * DM; const float* sh = mv + 0 * DM;
            float ss = 0.f;
#pragma unroll
            for (int i = 0; i < 16; ++i) ss += x[i] * x[i];
            const float rstd = rsqrtf(wave_sum(ss) * (1.f / DM) + EPS);
#pragma unroll
            for (int hf = 0; hf < 2; ++hf) { const int c0 = cb + hf * 128; float yv[8];
#pragma unroll
                for (int j = 0; j < 8; ++j) yv[j] = x[hf * 8 + j] * rstd * g[c0 + j] * (1.f + sc[c0 + j]) + sh[c0 + j];
                v4u w; w.x = cvt_pk_bf16(yv[0], yv[1]); w.y = cvt_pk_bf16(yv[2], yv[3]); w.z = cvt_pk_bf16(yv[4], yv[5]); w.w = cvt_pk_bf16(yv[6], yv[7]);
                *(v4u*)(U + (size_t)r * DM + c0) = w; }
        } else if (!isctx) {
            float ss = 0.f;
#pragma unroll
            for (int i = 0; i < 16; ++i) ss += x[i] * x[i];
            const float rstd = rsqrtf(wave_sum(ss) * (1.f / DM) + EPS); const float* gf = P.in[I_GFIN];
#pragma unroll
            for (int hf = 0; hf < 2; ++hf) { const int c0 = cb + hf * 128;
                *(f32x4*)(row + c0) = (f32x4){x[hf * 8 + 0] * rstd * gf[c0 + 0], x[hf * 8 + 1] * rstd * gf[c0 + 1], x[hf * 8 + 2] * rstd * gf[c0 + 2], x[hf * 8 + 3] * rstd * gf[c0 + 3]};
                *(f32x4*)(row + c0 + 4) = (f32x4){x[hf * 8 + 4] * rstd * gf[c0 + 4], x[hf * 8 + 5] * rstd * gf[c0 + 5], x[hf * 8 + 6] * rstd * gf[c0 + 6], x[hf * 8 + 7] * rstd * gf[c0 + 7]}; }
        }
    }
}
#if defined(MK_DEBUG)
__global__ void chk_bf16(const bf16_t* buf, long rows, int cols, int pitch, unsigned* word, unsigned bit) {
    bool bad = false;
    for (long i = blockIdx.x * (long)blockDim.x + threadIdx.x; i < rows * cols; i += (long)gridDim.x * blockDim.x) { const long r = i / cols; const int c = (int)(i % cols);
        const unsigned short v = buf[r * pitch + c]; if ((v & 0x7f80u) == 0x7f80u) bad = true; }
    if (bad) atomicOr(word, bit);
}
__global__ void chk_f32(const float* buf, long n, unsigned* word, unsigned bit) {
    bool bad = false;
    for (long i = blockIdx.x * (long)blockDim.x + threadIdx.x; i < n; i += (long)gridDim.x * blockDim.x) { const unsigned v = __float_as_uint(buf[i]); if ((v & 0x7f800000u) == 0x7f800000u) bad = true; }
    if (bad) atomicOr(word, bit);
}
__global__ void dbg_fill(float* out, long n, const unsigned* word) {
    const float a = 1.0f + (float)(*word);
    for (long i = blockIdx.x * (long)blockDim.x + threadIdx.x; i < n; i += (long)gridDim.x * blockDim.x) out[i] = a;
}
#endif
constexpr int NU_DN = 32, NU_GQA = 1024, NU_DIFF = 1024, NU_GQAC = 16, NU_DIFFC = 16, NU_TOTAL = NU_DN + NU_GQA + NU_DIFF + NU_GQAC + NU_DIFFC, NU_XCD = NU_TOTAL / 8;
static_assert(NU_XCD == 264, "per-XCD unit lists");
__device__ __forceinline__ void phase_mix(Frame& F, const Params& P, int l, int qoff = 0) {
    bf16_t* P1 = (bf16_t*)(F.ws + WS_A); bf16_t* BR = (bf16_t*)(F.ws + WS_B); bf16_t* DO = (bf16_t*)(F.ws + WS_D);
    bf16_t* OFw = DO + (size_t)MROWS * 1024; bf16_t* OBw = OFw + (size_t)MROWS * 512;
    const int xcd0 = (int)xb_xcc_id() & 7;
    LAS float* kt = (LAS float*)(F.lds + MISC_OFF + 6144);
    if (F.tid < 20) kt[F.tid] = sqrtf(__int_as_float((int)__hip_atomic_load(F.ctl + CW_KMAX + (l * 2 + F.tid / 10) * 16 + F.tid % 10, RLX_AGENT)));
    int qsel = 0;
    for (;;) {
        int u = -1; int x = 0;
        for (;;) {
            if (qsel >= 8) break;
            x = (xcd0 + qsel) & 7;
            __syncthreads();
            if (F.tid == 0) F.MISC[16] = __hip_atomic_fetch_add(F.ctl + CW_QUEUE + 64 * (l * 8 + x + qoff), 1u, RLX_AGENT);
            __syncthreads();
            const int li = __builtin_amdgcn_readfirstlane((int)F.MISC[16]);
            if (li < NU_XCD) { u = li; break; }
            ++qsel;
        }
        if (u < 0) break;
#if defined(MK_PROBE_DNLAST)
        const int li = (u + 4) % NU_XCD;
#else
        const int li = u;
#endif
        if (li < 4) {
            const int cu = x + 8 * li;
            dn::Chain ch; const int b = cu >> 4, h = (cu >> 1) & 7, dir = cu & 1;
            ch.P1b = P1 + (size_t)b * TT * P1W; ch.QKb = BR + (size_t)b * TT * 1536 + 512; ch.Ob = (dir ? OBw : OFw) + (size_t)b * TT * 512; ch.h = h; ch.dir = dir;
            ch.Aexp = expf(P.in[I_ALOG][l * 16 + dir * 8 + h]); ch.dtb = P.in[I_DTB][l * 16 + dir * 8 + h];
            ch.ring = (unsigned char*)(F.ws + WS_RING + (size_t)cu * 12 * RING_SLOT); ch.dbg = (unsigned*)(F.ws + WS_CTL) + 64;
            dn::chain_unit(ch, P.in[I_WCONV] + (size_t)l * 3 * 1536, F.lds + RING_OFF, (LAS float*)(F.lds + MISC_OFF + 1024), F.wave);
            continue;
        }
        int b, qrow, nt, qcol, kcol, vcol, ocol, op; bf16_t* obase; bool wide; int kidx;
        if (li < 4 + 128) { const int j = li - 4, gidx = 2 * x + (j >> 6), qb = j & 63; b = gidx >> 3; const int hc = gidx & 7; wide = true; kidx = 2 + hc;
            qrow = CTXL + qb * 256; nt = TT / 64; qcol = C_CQ + hc * 64; kcol = C_CK + hc * 64; vcol = C_CV + (hc >> 1) * 128; obase = DO; op = 1024; ocol = hc * 128; }
        else if (li < 4 + 128 + 128) { const int j = li - 132, grp = x >> 1; b = grp >> 1; const int kvh = grp & 1, hq = 2 * (x & 1) + (j >> 6), qb = j & 63, h = kvh * 4 + hq; wide = false; kidx = kvh;
            qrow = CTXL + qb * 256; nt = TT / 64; qcol = C_AQ + h * 64; kcol = C_AK + kvh * 64; vcol = C_AV + kvh * 64; obase = BR; op = 1536; ocol = h * 64; }
        else { const int ci = x * 4 + (li - 260);
            if (ci < 16) { b = ci >> 3; const int h = ci & 7, kvh = h >> 2; wide = false; kidx = kvh;
                qrow = 0; nt = CTXL / 64; qcol = C_AQ + h * 64; kcol = C_AK + kvh * 64; vcol = C_AV + kvh * 64; obase = BR; op = 1536; ocol = h * 64; }
            else { const int idx = ci - 16; b = idx >> 3; const int hc = idx & 7; wide = true; kidx = 2 + hc;
                qrow = 0; nt = CTXL / 64; qcol = C_CQ + hc * 64; kcol = C_CK + hc * 64; vcol = C_CV + (hc >> 1) * 128; obase = DO; op = 1024; ocol = hc * 128; } }
        const bf16_t* pb = P1 + (size_t)b * TT * P1W;
        const float kmaxv = kt[b * 10 + kidx];
        if (wide) attn_body::attn_unit128_br<8>((const attn_body::bf16*)(pb + (size_t)qrow * P1W + qcol), P1W, (const attn_body::bf16*)(pb + kcol), P1W, (const attn_body::bf16*)(pb + vcol), P1W,
                                (attn_body::bf16*)(obase + ((size_t)b * TT + qrow) * op + ocol), op, nt, (char*)F.lds + RING_OFF, F.wave, kmaxv, qrow == 0 ? -1 : qrow - CTXL, wide ? (const float*)nullptr : P.in[I_GQ] + l * 64);
        else attn_body::attn_unit_br<8>((const attn_body::bf16*)(pb + (size_t)qrow * P1W + qcol), P1W, (const attn_body::bf16*)(pb + kcol), P1W, (const attn_body::bf16*)(pb + vcol), P1W,
                                (attn_body::bf16*)(obase + ((size_t)b * TT + qrow) * op + ocol), op, nt, (char*)F.lds + RING_OFF, F.wave, kmaxv, qrow == 0 ? -1 : qrow - CTXL, wide ? (const float*)nullptr : P.in[I_GQ] + l * 64);
    }
}

#ifndef MK_PHMASK
#define MK_PHMASK 0xFFFFF
#endif
#define PHEN(k) (((MK_PHMASK) >> (k)) & 1)
#if defined(MK_PROBE_BAR2)
#define MK_BAR2() do { for (int rb_ = 0; rb_ < MK_PROBE_BAR2; ++rb_) { F.lane = hw_lane(); xcd_barrier(bar, F.wave == 0 && F.lane == 0); } } while (0)
#else
#define MK_BAR2() do { } while (0)
#endif
#if defined(MK_PROBE_GEMM2)
#define GREP for (int rep_ = 0; rep_ < ((MK_PROBE_GEMM2 & 1) ? 2 : 1); ++rep_)
#define GREPE for (int rep_ = 0; rep_ < ((MK_PROBE_GEMM2 & 2) ? 2 : 1); ++rep_)
#define GREPE2 for (int rep_ = 0; rep_ < ((MK_PROBE_GEMM2 & 4) ? 2 : 1); ++rep_)
#else
#define GREP
#define GREPE
#define GREPE2
#endif
#if defined(MK_PROBE_EW2)
#define EREP for (int rep_ = 0; rep_ < 2; ++rep_)
#else
#define EREP
#endif
constexpr int NPH_LAYER = 15, NPHASES = 2 + NLAYER * NPH_LAYER;
#if MK_DEBUG == 5
#define MK_STAMP(k) do { if (blockIdx.x == 0 && F.tid == 0) { ((unsigned long long*)(P.ws + WS_CTL + 512))[(k) + 1] = __builtin_amdgcn_s_memrealtime(); ((unsigned long long*)(P.ws + WS_CTL + 1024))[(k) + 1] = __builtin_amdgcn_s_memtime(); } } while (0)
#else
#define MK_STAMP(k) do { } while (0)
#endif
#define IN(k) (lo <= (k) && (k) < hi)
#define SEAM(k) do { if (IN(k) && IN((k) + 1)) { F.lane = hw_lane(); xcd_barrier(bar, F.wave == 0 && F.lane == 0); MK_BAR2(); } F.lane = hw_lane(); F.tid = F.wave * 64 + F.lane; MK_STAMP(k); { GAS unsigned char* w_ = (GAS unsigned char*)P.ws; asm volatile("" : "+s"(w_)); F.ws = w_; F.ctl = (gu32*)(w_ + WS_CTL); } } while (0)
#define SEAM_NB(k) do { F.lane = hw_lane(); F.tid = F.wave * 64 + F.lane; MK_STAMP(k); { GAS unsigned char* w_ = (GAS unsigned char*)P.ws; asm volatile("" : "+s"(w_)); F.ws = w_; F.ctl = (gu32*)(w_ + WS_CTL); } } while (0)
#define U ((bf16_t*)(F.ws + WS_C))
#define RA ((bf16_t*)(F.ws + WS_A))
#define BR ((bf16_t*)(F.ws + WS_B))
#define G2 RA
#define Mm (RA + (size_t)MROWS * GW)
#define Hs ((bf16_t*)(F.ws + WS_D))
#define Yb RA
#define WGU ((bf16_t*)(F.ws + WS_B))
#define WD (WGU + (size_t)NEXP1 * 512 * DM)
template <int l, int half> __device__ __forceinline__ void moe_half(Frame& F, const Params& P, const XcdBarrier& bar, int lo, int hi) {
    constexpr int pb = 2 + NPH_LAYER * l;
    LAS int* const ts = (LAS int*)(F.lds + MISC_OFF + 256); LAS int* const te = (LAS int*)(F.lds + MISC_OFF + 3584);
    constexpr int hb = pb + 9 + 3 * half;
            if (PHEN(9) && IN(hb + 0)) {
                moe_table(F, l, half, ts, te);
                pg8::Gemm g{U, WGU, DM, DM, DM, (const int*)(F.ws + WS_RTOK) + (size_t)half * HROWS_PAD}; pg8::MoeOrder S{ts, te, 2, F.G, (int)blockIdx.x};
                pg8::EpiMoe1 E{Hs, (const float*)(F.ws + WS_RW) + (size_t)half * HROWS_PAD};
                GREPE pg8::gemm_phase<pg8::EpiMoe1, pg8::MoeOrder, true>(F.lds + RING_OFF, g, S, E, F.wave);
            } SEAM(hb + 0);
            if (PHEN(10) && IN(hb + 1)) {
                moe_table(F, l, half, ts, te);
                pg8::Gemm g{Hs, WD, FF, FF, FF, nullptr}; pg8::MoeOrder S{ts, te, 4, F.G, (int)blockIdx.x};
                pg8::EpiFp8 E{(unsigned char*)(F.ws + WS_A)};
                GREPE2 pg8::gemm_phase<pg8::EpiFp8, pg8::MoeOrder, false>(F.lds + RING_OFF, g, S, E, F.wave);
            } SEAM(hb + 1);
            if (PHEN(11) && IN(hb + 2)) {
#if defined(MK_PROBE_DRY)
                if (MK_PROBE_DRY & 8) phase_combine(F, P, l, half, true);
#endif
                phase_combine(F, P, l, half); if (half == 1 && l + 1 < NLAYER) { __syncthreads(); convert_small(F, P, l + 1); } }
            if (half == 0) { SEAM_NB(hb + 2); } else { SEAM(hb + 2); }
}
template <int l> __device__ __forceinline__ void layer_phases(Frame& F, const Params& P, const XcdBarrier& bar, int lo, int hi) {
    constexpr int pb = 2 + NPH_LAYER * l;
        if (PHEN(0) && IN(pb + 0)) {
            pg8::Gemm g{U, (const bf16_t*)(F.ws + WS_WB1), DM, DM, DM, nullptr}; pg8::DenseOrder S; S.init(MROWS / 256, P1W / 256, F.G, (int)blockIdx.x);
            pg8::EpiBf16<0> E{RA, P1W};
            GREP pg8::gemm_phase<pg8::EpiBf16<0>, pg8::DenseOrder, false>(F.lds + RING_OFF, g, S, E, F.wave);
        } SEAM(pb + 0);
        if (PHEN(1) && IN(pb + 1)) { phase_prep(F, P, l); phase_dn_prep(F, P, l);
            { F.lane = hw_lane(); xcd_barrier(bar, F.wave == 0 && F.lane == 0); F.lane = hw_lane(); F.tid = F.wave * 64 + F.lane; phase_dn_prep_v(F, P, l); }
#if defined(MK_PROBE_DRY)
            if (MK_PROBE_DRY & 1) phase_prep(F, P, l, true);
#endif
        } SEAM(pb + 1);
        if (PHEN(2) && IN(pb + 2)) { phase_mix(F, P, l);
#if defined(MK_PROBE_MIX2)
            { F.lane = hw_lane(); xcd_barrier(bar, F.wave == 0 && F.lane == 0); F.lane = hw_lane(); F.tid = F.wave * 64 + F.lane; phase_mix(F, P, l, 16); }
#endif
        } SEAM(pb + 2);
        if (PHEN(3) && IN(pb + 3)) { EREP phase_post(F, P, l); } SEAM(pb + 3);
        if (PHEN(4) && IN(pb + 4)) {
            pg8::Gemm g{U, (const bf16_t*)(F.ws + WS_WB2), DM, DM, DM, nullptr}; pg8::DenseOrder S; S.init(MROWS / 256, GW / 256, F.G, (int)blockIdx.x, l + 1 == NLAYER);
            pg8::EpiGate8 E{(unsigned char*)(F.ws + WS_A)};
            GREP pg8::gemm_phase<pg8::EpiGate8, pg8::DenseOrder, false>(F.lds + RING_OFF, g, S, E, F.wave);
        } SEAM(pb + 4);
        if (PHEN(5) && IN(pb + 5)) {
            pg8::Gemm g{BR, (const bf16_t*)(F.ws + WS_WBR), 1536, 512, 512, nullptr, 1024}; pg8::MergeOrder S; S.D.init(MROWS / 256, DM / 256, F.G, (int)blockIdx.x, l + 1 == NLAYER);
            pg8::EpiMerge E{Mm, (const unsigned char*)(F.ws + WS_A)};
            pg8::gemm_phase<pg8::EpiMerge, pg8::MergeOrder, false>(F.lds + RING_OFF, g, S, E, F.wave);
        } SEAM(pb + 5);
        if (PHEN(6) && IN(pb + 6)) {
            pg8::Gemm g{Mm, (const bf16_t*)(F.ws + WS_WOT), DM, DM, DM, nullptr}; pg8::DenseOrder S; S.init(MROWS / 256, DM / 256, F.G, (int)blockIdx.x, l + 1 == NLAYER);
            pg8::EpiResidB E{l == 0 ? P.in[I_X] : (const float*)nullptr, l == 0 ? (const bf16_t*)nullptr : (const bf16_t*)P.out, (bf16_t*)(F.ws + WS_HB), l == 0 ? P.in[I_CTX] : (const float*)(F.ws + WS_HCTX), (float*)(F.ws + WS_HCTX), (const float*)(F.ws + WS_MODV) + (size_t)l * 3 * 6144, 2};
            pg8::gemm_phase<pg8::EpiResidB, pg8::DenseOrder, false>(F.lds + RING_OFF, g, S, E, F.wave);
        } SEAM(pb + 6);
        if (PHEN(7) && IN(pb + 7)) { EREP convert_experts(F, P, l); __syncthreads(); phase_norm2_router(F, P, l);
#if defined(MK_PROBE_DRY)
            if (MK_PROBE_DRY & 2) { __syncthreads(); phase_norm2_router(F, P, l, true); }
#endif
        } SEAM(pb + 7);
        if (PHEN(8) && IN(pb + 8)) {
#if defined(MK_PROBE_DRY)
            if (MK_PROBE_DRY & 4) phase_scatter(F, l, true);
#endif
            phase_scatter(F, l); } SEAM(pb + 8);
    moe_half<l, 0>(F, P, bar, lo, hi);
    moe_half<l, 1>(F, P, bar, lo, hi);
}
#undef IN
#undef SEAM
#undef U
#undef RA
#undef BR
#undef G2
#undef Mm
#undef Hs
#undef Yb
#undef WGU
#undef WD
__global__ void __launch_bounds__(NTHREADS, 2) fwd_kernel(Params P) {
    extern __shared__ __attribute__((aligned(16))) unsigned char lds_raw[];
    Frame F;
    F.lds = (LAS unsigned char*)lds_raw; F.MISC = (volatile LAS unsigned*)(F.lds + MISC_OFF);
    F.wave = __builtin_amdgcn_readfirstlane((int)threadIdx.x >> 6); F.lane = hw_lane(); F.tid = F.wave * 64 + F.lane; F.G = gridDim.x;
    F.gw = blockIdx.x * NWAVES + F.wave; F.NGW = F.G * NWAVES; F.ws = (GAS unsigned char*)P.ws; F.ctl = (gu32*)(F.ws + WS_CTL);
    for (int u = F.tid; u < 64; u += NTHREADS) F.MISC[u] = 0u;
    __syncthreads();
    XcdBarrier bar; bar.bar = (unsigned*)(F.ctl + CW_BAR); bar.x = 0; bar.st = nullptr;
    if (P.use_bar) bar = xcd_barrier_post((unsigned*)(F.ctl + CW_BAR), F.MISC + 8, F.tid == 0);
    const int lo = P.ph_lo, hi = P.ph_hi;
#if MK_DEBUG == 5
    if (blockIdx.x == 0 && F.tid == 0) ((unsigned long long*)(P.ws + WS_CTL + 512))[0] = __builtin_amdgcn_s_memrealtime();
#endif
#define IN(k) (lo <= (k) && (k) < hi)
#define SEAM(k) do { if (IN(k) && IN((k) + 1)) { F.lane = hw_lane(); xcd_barrier(bar, F.wave == 0 && F.lane == 0); MK_BAR2(); } F.lane = hw_lane(); F.tid = F.wave * 64 + F.lane; MK_STAMP(k); { GAS unsigned char* w_ = (GAS unsigned char*)P.ws; asm volatile("" : "+s"(w_)); F.ws = w_; F.ctl = (gu32*)(w_ + WS_CTL); } } while (0)
    LAS int* const ts = (LAS int*)(F.lds + MISC_OFF + 256); LAS int* const te = (LAS int*)(F.lds + MISC_OFF + 3584);

    if (PHEN(15) && IN(0)) { EREP { convert_small(F, P, 0); compute_mod(F, P); } } SEAM(0);
    if (PHEN(16) && IN(1)) { EREP phase_norm1(F, P); } SEAM(1);
    layer_phases<0>(F, P, bar, lo, hi);
    layer_phases<1>(F, P, bar, lo, hi);
#if MK_DEBUG == 5
    { F.lane = hw_lane(); xcd_barrier(bar, F.wave == 0 && F.lane == 0);
      const unsigned long long* ts = (const unsigned long long*)(P.ws + WS_CTL + 512);
      const unsigned long long* tc = (const unsigned long long*)(P.ws + WS_CTL + 1024);
      auto dur = [&](int a, int b) { return (float)(ts[b + 1] - ts[a]) * 0.01f; };
      auto ghz = [&](int a, int b) { return (float)(tc[b + 1] - tc[a]) / ((float)(ts[b + 1] - ts[a]) * 10.0f); };
      auto LQ = [&](float X) { return 1.0f + floorf(log2f(X * 0.1f) * 5.0f + 0.5f) * 0.025f; };
      const float t1 = MK_T1, t2 = MK_T2;
      float* o = P.out; const long n = (long)NB * SEQ * DM;
      for (long i = (long)blockIdx.x * NTHREADS + F.wave * 64 + F.lane; i < n; i += (long)F.G * NTHREADS) o[i] = (i < 4096) ? t2 : t1; }
#endif
#undef IN
#undef SEAM
}

#ifndef MK_MULTI
#define MK_MULTI 0
#endif
extern "C" void kernel_launch(void* const* d_in, const int* in_sizes, int n_in, void* d_out, int out_size, void* d_ws, size_t ws_size, hipStream_t stream) {
    static int grid = 0;
    if (grid == 0) {
        if (n_in != 28 || out_size != NB * SEQ * DM || ws_size < WS_END) { fprintf(stderr, "kernel_launch: unexpected shapes (n_in %d out %d ws %zu need %zu); nothing launched\n", n_in, out_size, ws_size, (size_t)WS_END); grid = -1; return; }
        int dev = 0, cus = 0;
        if (hipGetDevice(&dev) != hipSuccess || hipDeviceGetAttribute(&cus, hipDeviceAttributeMultiprocessorCount, dev) != hipSuccess) { grid = -1; return; }
        if (hipFuncSetAttribute((const void*)fwd_kernel, hipFuncAttributeMaxDynamicSharedMemorySize, LDS_BYTES) != hipSuccess) { fprintf(stderr, "kernel_launch: hipFuncSetAttribute failed\n"); grid = -1; return; }
        int per_cu = 0;
        if (hipOccupancyMaxActiveBlocksPerMultiprocessor(&per_cu, (const void*)fwd_kernel, NTHREADS, LDS_BYTES) != hipSuccess || per_cu < 1) fprintf(stderr, "kernel_launch: occupancy query reports %d\n", per_cu);
        (void)hipGetLastError();
        grid = cus;
    }
    if (grid < 0) return;
    (void)hipMemsetAsync((char*)d_ws + WS_CTL, 0, CTL_ZERO_BYTES, stream);
    Params p{};
    for (int i = 0; i < 28; ++i) p.in[i] = (const float*)d_in[i];
    p.out = (float*)d_out; p.ws = (unsigned char*)d_ws;
#ifndef MK_NPH_RUN
#define MK_NPH_RUN NPHASES
#endif
#if MK_MULTI
#error "the per-phase checkpoint build is no longer supported: the prep phase contains a grid barrier"
    for (int k = 0; k < MK_NPH_RUN; ++k) { p.ph_lo = k; p.ph_hi = k + 1; p.use_bar = 0; hipLaunchKernelGGL(fwd_kernel, dim3(grid), dim3(NTHREADS), LDS_BYTES, stream, p);
#if defined(MK_DEBUG)
        unsigned* dw = (unsigned*)((char*)d_ws + WS_CTL) + 64; unsigned char* w = (unsigned char*)d_ws;
#if MK_DEBUG == 1
        if (k == 3) hipLaunchKernelGGL(chk_bf16, dim3(1024), dim3(256), 0, stream, (const bf16_t*)(w + WS_A), (long)MROWS, 4384, P1W, dw, 1u);
        if (k == 4) { hipLaunchKernelGGL(chk_bf16, dim3(1024), dim3(256), 0, stream, (const bf16_t*)(w + WS_B), (long)MROWS, 512, 1536, dw, 2u);
                      hipLaunchKernelGGL(chk_bf16, dim3(1024), dim3(256), 0, stream, (const bf16_t*)(w + WS_D), (long)MROWS, 1024, 1024, dw, 4u);
                      hipLaunchKernelGGL(chk_bf16, dim3(1024), dim3(256), 0, stream, (const bf16_t*)(w + WS_D) + (size_t)MROWS * 1024, (long)MROWS, 1024, 1024, dw, 8u); }
        if (k == 7) hipLaunchKernelGGL(chk_bf16, dim3(1024), dim3(256), 0, stream, (const bf16_t*)(w + WS_A) + (size_t)MROWS * GW, (long)MROWS, 1024, 1024, dw, 16u);
#endif
#endif
    }
#if defined(MK_DEBUG)
    hipLaunchKernelGGL(dbg_fill, dim3(1024), dim3(256), 0, stream, (float*)d_out, (long)NB * SEQ * DM, (const unsigned*)((char*)d_ws + WS_CTL) + 64);
#endif
#else
    p.ph_lo = 0; p.ph_hi = NPHASES; p.use_bar = 1;
    hipLaunchKernelGGL(fwd_kernel, dim3(grid), dim3(NTHREADS), LDS_BYTES, stream, p);
#endif
}
```

```cpp
#include <hip/hip_runtime.h>
#include <hip/hip_bf16.h>
#include <cstdio>
#include <cstdint>
#include <cmath>

constexpr int DM = 1024, NB = 2, SEQ = 16384, CTXL = 256, TT = SEQ + CTXL  , MROWS = NB * TT  ;
constexpr int NLAYER = 2, GRIDW = 64;
constexpr int P1W = 4608;
constexpr int GW = 3072;
constexpr int INW = 7456;
constexpr int C_AQ = 0, C_AK = 512, C_AV = 640, C_BQKV = 768, C_BZ = 2304, C_BA = 2816, C_BB = 2832, C_CQ = 2848, C_CK = 3360, C_CV = 3872, C_GATE = 4384;
constexpr int NEXP = 64, NEXP1 = 65  , TOPK = 6, FF = 256;
constexpr int HROWS = TT * 7 + NEXP1 * 255;
constexpr int HROWS_PAD = 133120;
constexpr float EPS = 1e-6f;
constexpr float QSCALE = 0.125f * 1.4426950408889634f;

constexpr size_t MiB = 1u << 20;
constexpr size_t WS_CTL = 0, CTL_ZERO_BYTES = 1 * MiB;
constexpr size_t WS_MODV = 1 * MiB;
constexpr size_t WS_HCTX = 2 * MiB;
constexpr size_t WS_TOPE = 4 * MiB;
constexpr size_t WS_TOPW = WS_TOPE + (size_t)MROWS * 32;
constexpr size_t WS_TOPS = WS_TOPW + (size_t)MROWS * 32;
constexpr size_t WS_RTOK = WS_TOPS + (size_t)MROWS * 32;
constexpr size_t WS_RW = WS_RTOK + (size_t)2 * HROWS_PAD * 4;
constexpr size_t WS_SMALL_END = WS_RW + (size_t)2 * HROWS_PAD * 4;
constexpr size_t WS_WB1 = 10 * MiB;
constexpr size_t WS_WB2 = WS_WB1 + (size_t)P1W * DM * 2;
constexpr size_t WS_WBR = WS_WB2 + (size_t)GW * DM * 2;
constexpr size_t WS_WOT = WS_WBR + (size_t)3 * DM * 512 * 2;
constexpr size_t WS_A = 30 * MiB;
constexpr size_t SZ_A = (size_t)MROWS * P1W * 2;
constexpr size_t WS_B = WS_A + SZ_A;
constexpr size_t SZ_B = (size_t)MROWS * 1536 * 2;
constexpr size_t WS_C = WS_B + SZ_B;
constexpr size_t SZ_C = (size_t)MROWS * DM * 2;
constexpr size_t WS_D = WS_C + SZ_C;
constexpr size_t SZ_D = (size_t)MROWS * 2048 * 2;
constexpr size_t WS_RING = WS_D + SZ_D;
constexpr int RING_SLOT = 40960;
constexpr size_t SZ_RING = (size_t)32 * 12 * RING_SLOT;
constexpr size_t WS_END = WS_RING + SZ_RING;
static_assert(WS_SMALL_END <= WS_WB1 && WS_WOT + (size_t)DM * DM * 2 <= WS_A, "ws map");
static_assert((size_t)MROWS * GW * 2 + (size_t)MROWS * DM * 2 <= SZ_A && (size_t)HROWS_PAD * DM * 2 <= SZ_A, "region A overlays");
static_assert((size_t)NEXP1 * 3 * DM * FF * 2 <= SZ_B && (size_t)HROWS_PAD * FF * 2 <= SZ_D, "region B/D overlays");
constexpr size_t WS_HB = WS_A + (size_t)HROWS_PAD * DM;
static_assert(WS_HB + (size_t)NB * SEQ * DM * 2 <= WS_A + (size_t)MROWS * GW * 2, "HB sits between Y and m");
constexpr int CW_TMO = 0;
constexpr int CW_BAR = 4096;
constexpr int CW_QUEUE = 16384;
constexpr int CW_KMAX = 40960;
constexpr int CW_ECNT = 32768;

constexpr int RING_OFF = 0, RING_BYTES = 139264;
constexpr int MISC_OFF = RING_BYTES;
constexpr int LDS_BYTES = 147456;
constexpr int NWAVES = 8, NTHREADS = 512;

#define GAS __attribute__((address_space(1)))
#define LAS __attribute__((address_space(3)))
typedef unsigned short bf16_t;
typedef unsigned v4u __attribute__((ext_vector_type(4)));
typedef unsigned v2u __attribute__((ext_vector_type(2)));
typedef float f32x4 __attribute__((ext_vector_type(4)));
typedef float f32x2 __attribute__((ext_vector_type(2)));
typedef float f32x16 __attribute__((ext_vector_type(16)));
typedef short bf16x8 __attribute__((ext_vector_type(8)));
typedef short s16x4 __attribute__((ext_vector_type(4)));
typedef GAS unsigned gu32;
#define RLX_AGENT __ATOMIC_RELAXED, __HIP_MEMORY_SCOPE_AGENT
#define LDS_WAIT() asm volatile("s_waitcnt lgkmcnt(0)" ::: "memory")
#define VM_WAIT() asm volatile("s_waitcnt vmcnt(0)" ::: "memory")
__device__ __forceinline__ unsigned f2bf(float f) { unsigned u = __builtin_bit_cast(unsigned, f); return (u + 0x7fffu + ((u >> 16) & 1u)) >> 16; }
__device__ __forceinline__ unsigned pk2(float lo, float hi) { return f2bf(lo) | (f2bf(hi) << 16); }
__device__ __forceinline__ float bf2f(unsigned short b) { return __builtin_bit_cast(float, (unsigned)b << 16); }
__device__ __forceinline__ float bflo(unsigned w) { return __builtin_bit_cast(float, w << 16); }
__device__ __forceinline__ float bfhi(unsigned w) { return __builtin_bit_cast(float, w & 0xffff0000u); }
typedef __bf16 bf16x2_t_ __attribute__((ext_vector_type(2)));
__device__ __forceinline__ unsigned cvt_pk_bf16(float lo, float hi) { unsigned r; asm volatile("v_cvt_pk_bf16_f32 %0, %1, %2" : "=v"(r) : "v"(lo), "v"(hi)); return r; }
__device__ __forceinline__ unsigned cvt_pk_bf16_safe(float lo, float hi) { f32x2 v = {lo, hi}; bf16x2_t_ b = __builtin_convertvector(v, bf16x2_t_); return __builtin_bit_cast(unsigned, b); }
__device__ __forceinline__ float wave_sum(float v) {
#pragma unroll
    for (int o = 1; o < 64; o <<= 1) v += __shfl_xor(v, o);
    return v;
}
__device__ __forceinline__ float sigmoidf_(float x) { return __builtin_amdgcn_rcpf(1.f + __expf(-x)); }
__device__ __forceinline__ float siluf_(float x) { return x * __builtin_amdgcn_rcpf(1.f + __expf(-x)); }
__device__ __forceinline__ int hw_lane() { int l; asm volatile("v_mbcnt_lo_u32_b32 %0, -1, 0\n\tv_mbcnt_hi_u32_b32 %0, -1, %0" : "=v"(l)); return l; }
#define XB_TMO      128
#define XB_XCNT(j)  (256  + 64 * (j))
#define XB_XSUB(j)  (1280 + 64 * (j))
#define XB_XGEN(j)  (2304 + 64 * (j))
#define XB_TOP      3328
#define XB_TOPGEN   3392
#define XCD_BAR_WORDS 3456
#define XB_SPIN_CAP (1u << 18)

__device__ __forceinline__ unsigned xb_ld(unsigned* p)              { return __hip_atomic_load(p, __ATOMIC_RELAXED, __HIP_MEMORY_SCOPE_AGENT); }
__device__ __forceinline__ unsigned xb_add(unsigned* p, unsigned v) { return __hip_atomic_fetch_add(p, v, __ATOMIC_RELAXED, __HIP_MEMORY_SCOPE_AGENT); }
__device__ __forceinline__ unsigned xb_xcc_id() { return (unsigned)__builtin_amdgcn_s_getreg((3 << 11) | 20) & 0xFu; }
#define XB_SPIN(cond, bar) do { unsigned _sp = 0; while (cond) { __builtin_amdgcn_s_sleep(1); \
    if ((++_sp & 255u) == 0u) { if (xb_ld(&(bar)[XB_TMO])) break; if (_sp > XB_SPIN_CAP) { atomicAdd(&(bar)[XB_TMO], 1u); break; } } } } while (0)

struct XcdBarrier {
    unsigned* bar; unsigned x;
    volatile LAS unsigned* st;
};

__device__ __forceinline__ XcdBarrier xcd_barrier_post(unsigned* bar, volatile LAS unsigned* st, bool is_t0) {
    XcdBarrier b; b.bar = bar; b.x = xb_xcc_id(); b.st = st;
    if (is_t0) (void)xb_add(&bar[XB_XCNT(b.x)], 1u);
    return b;
}
__device__ __forceinline__ void xcd_barrier_complete(unsigned* bar, unsigned x, unsigned& nloc, unsigned& nx) {
    const unsigned G = gridDim.x * gridDim.y * gridDim.z;
    unsigned sum, cnt, mine, sp = 0u;
    for (;;) {
        sum = 0u; cnt = 0u; mine = 0u;
#pragma unroll
        for (unsigned j = 0; j < 16; ++j) { const unsigned c = xb_ld(&bar[XB_XCNT(j)]); sum += c; cnt += (c > 0u) ? 1u : 0u; mine = (j == x) ? c : mine; }
        if (sum == G) break;
        __builtin_amdgcn_s_sleep(1);
        if ((++sp & 255u) == 0u) { if (xb_ld(&bar[XB_TMO])) break; if (sp > XB_SPIN_CAP) { atomicAdd(&bar[XB_TMO], 1u); break; } }
    }
    nloc = mine > 0u ? mine : 1u; nx = cnt > 0u ? cnt : 1u;
}

__device__ __forceinline__ void xcd_barrier(const XcdBarrier& b, bool is_t0) {
    asm volatile("s_waitcnt vmcnt(0)" ::: "memory");
    __syncthreads();
    if (is_t0) {
        unsigned* bar = b.bar;
        __builtin_amdgcn_s_waitcnt(0);
        unsigned nloc = b.st[0], nx = b.st[1];
        if (nloc == 0u) { xcd_barrier_complete(bar, b.x, nloc, nx); b.st[0] = nloc; b.st[1] = nx; }
        const unsigned old = xb_add(&bar[XB_XSUB(b.x)], 1u);
        const unsigned gen = old / nloc;
        if (old + 1u == (gen + 1u) * nloc) {
            __builtin_amdgcn_fence(__ATOMIC_RELEASE, "agent");
            asm volatile("s_waitcnt vmcnt(0)" ::: "memory");
            const unsigned og = xb_add(&bar[XB_TOP], 1u);
            const unsigned tg = og / nx;
            if (og + 1u == (tg + 1u) * nx) xb_add(&bar[XB_TOPGEN], 1u);
            else XB_SPIN(xb_ld(&bar[XB_TOPGEN]) == tg, bar);
            __builtin_amdgcn_fence(__ATOMIC_ACQUIRE, "agent");
            xb_add(&bar[XB_XGEN(b.x)], 1u);
            asm volatile("s_waitcnt vmcnt(0)" ::: "memory");
        } else {
            XB_SPIN(xb_ld(&bar[XB_XGEN(b.x)]) == gen, bar);
            __builtin_amdgcn_fence(__ATOMIC_ACQUIRE, "agent");
            asm volatile("s_waitcnt vmcnt(0)" ::: "memory");
        }
    }
    __syncthreads();
}
namespace pg8 {
constexpr int BM = 256, BK = 64, HALF = 128, HTB = HALF * BK * 2  , STAGE_BYTES = 8 * HTB, NXCD = 8, WGM = 8;
__host__ __device__ __forceinline__ int lds_byte(int r, int c) { const int st = (r >> 4) * 2 + (c >> 5), rr = r & 15, cc = c & 31, ob = rr * 64 + cc * 2; return st * 1024 + (ob ^ (((ob >> 9) & 1) << 5)); }
__host__ __device__ __forceinline__ void stage_rc(int b, int& R, int& C) { const int st = b / 1024, sb = b % 1024, swz = sb ^ (((sb >> 9) & 1) << 5); R = (st >> 1) * 16 + swz / 64; C = (st & 1) * 32 + (swz % 64) / 2; }
__host__ __device__ __forceinline__ int perm32(int rho) { const int n = rho >> 4, i = rho & 15; return 8 * (i >> 2) + 4 * n + (i & 3); }

struct Unit { int pm, pn, em, en, ex; };
struct Gemm { const bf16_t* A; const bf16_t* Bt; int lda, ldb, K; const int* rowlist; int astep = 0; };

struct DenseOrder {
    int nM, nN, nwg, G, c, skipctx;
    __device__ void init(int nM_, int nN_, int G_, int c_, int skipctx_ = 0) { skipctx = skipctx_; nM = skipctx_ ? nM_ - 2 : nM_; nN = nN_; nwg = nM * nN; G = G_; c = c_; }
    __device__ bool next(int i, Unit& u) const {
        const int L = i * G + c; if (L >= nwg) return false;
        int wgid = L; { const int q = nwg / NXCD, r = nwg % NXCD, xcd = wgid % NXCD, off = wgid / NXCD; wgid = (xcd < r ? xcd * (q + 1) : r * (q + 1) + (xcd - r) * q) + off; }
        const int nig = WGM * nN, gid = wgid / nig, fm = gid * WGM, gsz = (nM - fm) < WGM ? (nM - fm) : WGM;
        u.pm = fm + ((wgid % nig) % gsz); if (skipctx) u.pm += (u.pm >= 64) ? 2 : 1; u.pn = (wgid % nig) / gsz; u.em = u.pm; u.en = u.pn; u.ex = 0; return true;
    }
};
struct MoeOrder {
    const LAS int* tstart; const LAS int* texp; int nN, G, c;
    __device__ bool next(int i, Unit& u) const {
        const int L = i * G + c; const int total = tstart[NEXP1];
        if (L >= total * nN) return false;
        const int gsz = 8 * nN, gi = L / gsz, rem = L - gi * gsz; int rt, pn;
        if (gi * 8 + 8 <= total) { rt = gi * 8 + (rem & 7); pn = rem >> 3; } else { const int tr = total - gi * 8; pn = rem / tr; rt = gi * 8 + (rem - pn * tr); }
        const int e = texp[rt];
        u.pm = rt; u.pn = e * nN + pn; u.em = rt; u.en = pn; u.ex = e; return true;
    }
};

struct MergeOrder {
    DenseOrder D;
    __device__ bool next(int i, Unit& u) const { const int t = i / 3, br = i - 3 * t; if (!D.next(t, u)) return false; u.ex = br; u.pn = br * (DM / BM) + u.pn; return true; }
};
template <int ACT  > struct EpiBf16 {
    static constexpr bool PERM = true;
    bf16_t* O; int ldc;
    __device__ __forceinline__ void operator()(const f32x4 (&acc)[2][2][4][2], const Unit& u, int wr, int wc, int fr, int fq) const {
        const int row0 = u.em * BM + wr * 64 + fr; const int col0 = u.en * BM + wc * 32 + 8 * fq;
#pragma unroll
        for (int ai = 0; ai < 2; ++ai)
#pragma unroll
            for (int m = 0; m < 4; ++m) { bf16_t* rowp = O + (size_t)(row0 + ai * HALF + m * 16) * ldc + col0;
#pragma unroll
                for (int bj = 0; bj < 2; ++bj) { f32x4 v0 = acc[ai][bj][m][0], v1 = acc[ai][bj][m][1];
                    if (ACT == 1) {
#pragma unroll
                        for (int j = 0; j < 4; ++j) { v0[j] = sigmoidf_(v0[j]); v1[j] = sigmoidf_(v1[j]); } }
                    v4u w;
                    if (ACT == 1) { w.x = cvt_pk_bf16_safe(v0[0], v0[1]); w.y = cvt_pk_bf16_safe(v0[2], v0[3]); w.z = cvt_pk_bf16_safe(v1[0], v1[1]); w.w = cvt_pk_bf16_safe(v1[2], v1[3]); }
                    else { w.x = cvt_pk_bf16(v0[0], v0[1]); w.y = cvt_pk_bf16(v0[2], v0[3]); w.z = cvt_pk_bf16(v1[0], v1[1]); w.w = cvt_pk_bf16(v1[2], v1[3]); }
                    *(v4u*)(rowp + bj * HALF) = w; } }
    }
};
constexpr float YSCALE = 8.f, YUNSCALE = 0.125f;
struct EpiFp8 {
    static constexpr bool PERM = true; static constexpr int NST = 8;
    unsigned char* O;
    __device__ __forceinline__ void operator()(const f32x4 (&acc)[2][2][4][2], const Unit& u, int wr, int wc, int fr, int fq) const {
        const int row0 = u.em * BM + wr * 64 + fr; const int pos0 = u.en * BM + (wc * 4 + fq) * 16;
#pragma unroll
        for (int ai = 0; ai < 2; ++ai)
#pragma unroll
            for (int m = 0; m < 4; ++m) { unsigned char* rowp = O + (size_t)(row0 + ai * HALF + m * 16) * DM + pos0; v4u w;
#pragma unroll
                for (int bj = 0; bj < 2; ++bj) { const f32x4 v0 = acc[ai][bj][m][0] * YSCALE, v1 = acc[ai][bj][m][1] * YSCALE;
                    int lo = __builtin_amdgcn_cvt_pk_fp8_f32(v0[0], v0[1], 0, false); lo = __builtin_amdgcn_cvt_pk_fp8_f32(v0[2], v0[3], lo, true);
                    int hi = __builtin_amdgcn_cvt_pk_fp8_f32(v1[0], v1[1], 0, false); hi = __builtin_amdgcn_cvt_pk_fp8_f32(v1[2], v1[3], hi, true);
                    w[2 * bj] = (unsigned)lo; w[2 * bj + 1] = (unsigned)hi; }
                *(v4u*)rowp = w; }
    }
};
struct EpiGate8 {
    static constexpr bool PERM = true;
    unsigned char* O;
    __device__ __forceinline__ void operator()(const f32x4 (&acc)[2][2][4][2], const Unit& u, int wr, int wc, int fr, int fq) const {
        const int row0 = u.em * BM + wr * 64 + fr; const int pos0 = u.en * BM + (wc * 4 + fq) * 16;
#pragma unroll
        for (int ai = 0; ai < 2; ++ai)
#pragma unroll
            for (int m = 0; m < 4; ++m) { unsigned char* rowp = O + (size_t)(row0 + ai * HALF + m * 16) * GW + pos0; v4u w;
#pragma unroll
                for (int bj = 0; bj < 2; ++bj)
#pragma unroll
                    for (int n = 0; n < 2; ++n) { const f32x4 v = acc[ai][bj][m][n]; unsigned pk = 0u;
#pragma unroll
                        for (int j = 0; j < 4; ++j) pk = __builtin_amdgcn_cvt_pk_u8_f32(__builtin_rintf(sigmoidf_(v[j]) * 255.f), (unsigned)j, pk);
                        w[2 * bj + n] = pk; }
                *(v4u*)rowp = w; }
    }
};
struct EpiMerge {
    static constexpr bool PERM = true;
    bf16_t* Mo; const unsigned char* G;
    __device__ __forceinline__ void operator()(const f32x4 (&acc)[2][2][4][2], const Unit& u, int wr, int wc, int fr, int fq) const {
        const int row0 = u.em * BM + wr * 64 + fr; const int col0 = u.en * BM + wc * 32 + 8 * fq; const int gpos = u.ex * DM + u.en * BM + (wc * 4 + fq) * 16; const bool first = (u.ex == 0);
        constexpr float q = 1.f / 255.f;
#pragma unroll
        for (int ai = 0; ai < 2; ++ai)
#pragma unroll
            for (int m = 0; m < 4; ++m) { const size_t r = (size_t)(row0 + ai * HALF + m * 16);
                const v4u gq = *(const v4u*)(G + r * GW + gpos);
#pragma unroll
                for (int bj = 0; bj < 2; ++bj) { const f32x4 v0 = acc[ai][bj][m][0], v1 = acc[ai][bj][m][1];
                    const unsigned g0 = gq[2 * bj], g1 = gq[2 * bj + 1];
                    bf16_t* mp = Mo + r * DM + col0 + bj * HALF;
                    float o[8];
                    o[0] = (float)(g0 & 0xffu) * q * v0[0]; o[1] = (float)((g0 >> 8) & 0xffu) * q * v0[1]; o[2] = (float)((g0 >> 16) & 0xffu) * q * v0[2]; o[3] = (float)(g0 >> 24) * q * v0[3];
                    o[4] = (float)(g1 & 0xffu) * q * v1[0]; o[5] = (float)((g1 >> 8) & 0xffu) * q * v1[1]; o[6] = (float)((g1 >> 16) & 0xffu) * q * v1[2]; o[7] = (float)(g1 >> 24) * q * v1[3];
                    if (!first) { const v4u pw = *(const v4u*)mp;
                        o[0] += bflo(pw.x); o[1] += bfhi(pw.x); o[2] += bflo(pw.y); o[3] += bfhi(pw.y); o[4] += bflo(pw.z); o[5] += bfhi(pw.z); o[6] += bflo(pw.w); o[7] += bfhi(pw.w); }
                    v4u w; w.x = cvt_pk_bf16(o[0], o[1]); w.y = cvt_pk_bf16(o[2], o[3]); w.z = cvt_pk_bf16(o[4], o[5]); w.w = cvt_pk_bf16(o[6], o[7]);
                    *(v4u*)mp = w; } }
    }
};
struct EpiResid {
    static constexpr bool PERM = false;
    const float* in_lat; const float* in_ctx; float* out_lat; float* out_ctx; const float* modv; int gsel;
    __device__ __forceinline__ void operator()(const f32x4 (&acc)[2][2][4][2], const Unit& u, int wr, int wc, int fr, int fq) const {
        const int b = u.em / 65, j = u.em % 65; const bool isctx = (j == 0);
        const float* ib = isctx ? in_ctx + (size_t)b * CTXL * DM : in_lat + ((size_t)b * SEQ + (size_t)(j - 1) * 256) * DM;
        float* ob = isctx ? out_ctx + (size_t)b * CTXL * DM : out_lat + ((size_t)b * SEQ + (size_t)(j - 1) * 256) * DM;
        const float* gt = modv + (isctx ? 2 : b) * 6144 + gsel * DM;
        const int col0 = u.en * BM + wc * 32 + 4 * fq;
        f32x4 gv[2][2];
#pragma unroll
        for (int bj = 0; bj < 2; ++bj)
#pragma unroll
            for (int n = 0; n < 2; ++n) gv[bj][n] = *(const f32x4*)(gt + col0 + bj * HALF + n * 16);
#pragma unroll
        for (int ai = 0; ai < 2; ++ai)
#pragma unroll
            for (int m = 0; m < 4; ++m) { const size_t off = (size_t)(ai * HALF + wr * 64 + m * 16 + fr) * DM + col0;
#pragma unroll
                for (int bj = 0; bj < 2; ++bj)
#pragma unroll
                    for (int n = 0; n < 2; ++n) { const f32x4 bs = *(const f32x4*)(ib + off + bj * HALF + n * 16);
                        *(f32x4*)(ob + off + bj * HALF + n * 16) = bs + gv[bj][n] * acc[ai][bj][m][n]; } }
    }
};
struct EpiResidB {
    static constexpr bool PERM = true;
    const float* in_f32; const bf16_t* in_bf; bf16_t* out_bf; const float* in_ctx; float* out_ctx; const float* modv; int gsel;
    __device__ __forceinline__ void operator()(const f32x4 (&acc)[2][2][4][2], const Unit& u, int wr, int wc, int fr, int fq) const {
        const int b = u.em / 65, j = u.em % 65; const bool isctx = (j == 0);
        const size_t rbase = isctx ? (size_t)b * CTXL : (size_t)b * SEQ + (size_t)(j - 1) * 256;
        const float* gt = modv + (isctx ? 2 : b) * 6144 + gsel * DM;
        const int col0 = u.en * BM + wc * 32 + 8 * fq;
        f32x4 gv[2][2];
#pragma unroll
        for (int bj = 0; bj < 2; ++bj)
#pragma unroll
            for (int n = 0; n < 2; ++n) gv[bj][n] = *(const f32x4*)(gt + col0 + bj * HALF + 4 * n);
#pragma unroll
        for (int ai = 0; ai < 2; ++ai)
#pragma unroll
            for (int m = 0; m < 4; ++m) { const size_t off = (rbase + (size_t)(ai * HALF + wr * 64 + m * 16 + fr)) * DM + col0;
#pragma unroll
                for (int bj = 0; bj < 2; ++bj) { const size_t o = off + bj * HALF; f32x4 b0, b1;
                    if (isctx) { b0 = *(const f32x4*)(in_ctx + o); b1 = *(const f32x4*)(in_ctx + o + 4); }
                    else if (in_f32) { b0 = *(const f32x4*)(in_f32 + o); b1 = *(const f32x4*)(in_f32 + o + 4); }
                    else { const v4u w = *(const v4u*)(in_bf + o); b0 = (f32x4){bflo(w.x), bfhi(w.x), bflo(w.y), bfhi(w.y)}; b1 = (f32x4){bflo(w.z), bfhi(w.z), bflo(w.w), bfhi(w.w)}; }
                    const f32x4 r0 = b0 + gv[bj][0] * acc[ai][bj][m][0], r1 = b1 + gv[bj][1] * acc[ai][bj][m][1];
                    if (isctx) { *(f32x4*)(out_ctx + o) = r0; *(f32x4*)(out_ctx + o + 4) = r1; }
                    else { v4u w; w.x = cvt_pk_bf16_safe(r0[0], r0[1]); w.y = cvt_pk_bf16_safe(r0[2], r0[3]); w.z = cvt_pk_bf16_safe(r1[0], r1[1]); w.w = cvt_pk_bf16_safe(r1[2], r1[3]); *(v4u*)(out_bf + o) = w; } } }
    }
};

struct EpiMoe1 {
    static constexpr bool PERM = true;
    bf16_t* Hs; const float* roww;
    __device__ __forceinline__ void operator()(const f32x4 (&acc)[2][2][4][2], const Unit& u, int wr, int wc, int fr, int fq) const {
        const int row0 = u.em * BM + wr * 64 + fr; const int col0 = u.en * HALF + wc * 32 + 8 * fq;
#pragma unroll
        for (int ai = 0; ai < 2; ++ai)
#pragma unroll
            for (int m = 0; m < 4; ++m) { const int r = row0 + ai * HALF + m * 16; const float w = roww[r];
                float o[8];
#pragma unroll
                for (int n = 0; n < 2; ++n)
#pragma unroll
                    for (int j = 0; j < 4; ++j) { const float g = acc[ai][0][m][n][j], up = acc[ai][1][m][n][j]; o[n * 4 + j] = siluf_(g) * up * w; }
                v4u pw; pw.x = cvt_pk_bf16(o[0], o[1]); pw.y = cvt_pk_bf16(o[2], o[3]); pw.z = cvt_pk_bf16(o[4], o[5]); pw.w = cvt_pk_bf16(o[6], o[7]);
                *(v4u*)(Hs + (size_t)r * FF + col0) = pw; }
    }
};

template <class Epi, class Sched, bool GATHER>
__device__ __forceinline__ void gemm_phase(LAS unsigned char* lds, const Gemm g, const Sched& S, const Epi& E, int wave) {
    const int lane = hw_lane(), wid = wave, tid = wave * 64 + lane;
    const int wr = wid >> 2, wc = wid & 3, fr = lane & 15, fq = lane >> 4;
    const int K = g.K, nt = K / BK;
    int Rr[2], Cc[2];
    unsigned voffB[2], voffA[2];
#pragma unroll
    for (int i = 0; i < 2; ++i) { int R, C; stage_rc(tid * 16 + i * 8192, R, C); const int Rb = Epi::PERM ? ((R & ~31) + perm32(R & 31)) : R; Rr[i] = R; Cc[i] = C;
        voffB[i] = (unsigned)(Rb * g.ldb + C) * 2u; voffA[i] = (unsigned)(R * g.lda + C) * 2u; }
    const size_t kstep = (size_t)(BK * 2);
    const size_t hstepB = (size_t)HALF * g.ldb * 2, hstepA = (size_t)HALF * g.lda * 2;
    const size_t tstepA = (size_t)BM * g.lda * 2, tstepB = (size_t)BM * g.ldb * 2;
    const unsigned ldsw = (unsigned)wid * 1024u;
    const int aoff = lds_byte(wr * 64 + fr, fq * 8), boff = lds_byte(wc * 32 + fr, fq * 8);
#define PG8_SA(b, h) (((b) * 2 + (h)) * HTB)
#define PG8_SB(b, h) ((4 + (b) * 2 + (h)) * HTB)
#define PG8_STAGE(bufoff, gbase, voff) do { _Pragma("unroll") for (int _i = 0; _i < 2; ++_i) \
        __builtin_amdgcn_global_load_lds((const unsigned*)((const char*)(gbase) + (voff)[_i]), (LAS unsigned*)(lds + (bufoff) + ldsw + _i * 8192), 16, 0, 0); } while (0)
#define PG8_LDA(dst, b, h) do { _Pragma("unroll") for (int m = 0; m < 4; ++m) _Pragma("unroll") for (int k = 0; k < 2; ++k) dst[m][k] = *(const LAS bf16x8*)(lds + PG8_SA(b, h) + aoff + m * 2048 + k * 1024); } while (0)
#define PG8_LDB(dst, b, h) do { _Pragma("unroll") for (int n = 0; n < 2; ++n) _Pragma("unroll") for (int k = 0; k < 2; ++k) dst[n][k] = *(const LAS bf16x8*)(lds + PG8_SB(b, h) + boff + n * 2048 + k * 1024); } while (0)
#define PG8_MMA(ai, bj, At, Bt) do { __builtin_amdgcn_s_setprio(1); _Pragma("unroll") for (int m = 0; m < 4; ++m) _Pragma("unroll") for (int n = 0; n < 2; ++n) _Pragma("unroll") for (int k = 0; k < 2; ++k) \
        acc[ai][bj][m][n] = __builtin_amdgcn_mfma_f32_16x16x32_bf16(Bt[n][k], At[m][k], acc[ai][bj][m][n], 0, 0, 0); __builtin_amdgcn_s_setprio(0); } while (0)
#define PG8_WAIT_V(n) asm volatile("s_waitcnt vmcnt(" #n ")" ::: "memory")
#define PG8_WAIT_L(n) asm volatile("s_waitcnt lgkmcnt(" #n ")" ::: "memory")
#define PG8_BAR __builtin_amdgcn_s_barrier()
#define PG8_SCHED __builtin_amdgcn_sched_barrier(0)
#define PG8_AOFFS(dst, unit) do { if constexpr (GATHER) { _Pragma("unroll") for (int _h = 0; _h < 2; ++_h) _Pragma("unroll") for (int _i = 0; _i < 2; ++_i) { \
        const int _row = g.rowlist[(size_t)(unit).pm * BM + _h * HALF + Rr[_i]]; dst[_h][_i] = (unsigned)((size_t)_row * g.lda + Cc[_i]) * 2u; } \
        asm volatile("s_waitcnt vmcnt(0)" ::: "memory"); } } while (0)
#define PG8_STAGE_A(bufoff, base, h, vset) do { if constexpr (GATHER) { PG8_STAGE(bufoff, base, vset[h]); } else { PG8_STAGE(bufoff, (base) + (h) * hstepA, voffA); } } while (0)
    Unit cur, nxt; int ui = 0;
    if (!S.next(0, cur)) return;
    f32x4 acc[2][2][4][2];
#pragma unroll
    for (int a = 0; a < 2; ++a)
#pragma unroll
        for (int b = 0; b < 2; ++b)
#pragma unroll
            for (int m = 0; m < 4; ++m)
#pragma unroll
                for (int n = 0; n < 2; ++n) acc[a][b][m][n] = (f32x4){0.f, 0.f, 0.f, 0.f};
    bf16x8 At[4][2], B0[2][2], B1[2][2];
    unsigned vc[2][2], vn[2][2];
    PG8_AOFFS(vc, cur);
    const char* cA = GATHER ? (const char*)g.A : (const char*)g.A + (size_t)cur.pm * tstepA + (size_t)cur.ex * g.astep; const char* cB = (const char*)g.Bt + (size_t)cur.pn * tstepB;
    PG8_STAGE(PG8_SB(0, 0), cB, voffB); PG8_STAGE(PG8_SB(0, 1), cB + hstepB, voffB); PG8_STAGE_A(PG8_SA(0, 0), cA, 0, vc); PG8_STAGE_A(PG8_SA(0, 1), cA, 1, vc);
    if (wr == 1) PG8_BAR;
    PG8_WAIT_V(2); PG8_BAR;
    PG8_STAGE(PG8_SB(1, 0), cB + kstep, voffB); PG8_STAGE_A(PG8_SA(1, 0), cA + kstep, 0, vc); PG8_STAGE(PG8_SB(1, 1), cB + hstepB + kstep, voffB);
    PG8_WAIT_V(6); PG8_BAR;
    for (;;) {
        const bool has_next = S.next(ui + 1, nxt);
        if constexpr (GATHER) { if (has_next) { PG8_AOFFS(vn, nxt); } else { vn[0][0] = vc[0][0]; vn[0][1] = vc[0][1]; vn[1][0] = vc[1][0]; vn[1][1] = vc[1][1]; } }
        const char* nA = has_next ? (GATHER ? (const char*)g.A : (const char*)g.A + (size_t)nxt.pm * tstepA + (size_t)nxt.ex * g.astep) : cA; const char* nB = has_next ? (const char*)g.Bt + (size_t)nxt.pn * tstepB : cB;
        for (int t = 0; t < nt; t += 2) {
            const bool last = (t == nt - 2);
            const char* a1 = cA + (size_t)(t + 1) * kstep;
            const char* a2 = last ? nA : cA + (size_t)(t + 2) * kstep; const char* b2 = last ? nB : cB + (size_t)(t + 2) * kstep;
            const char* a3 = a2 + kstep; const char* b3 = b2 + kstep;
            unsigned v2[2][2];
            if constexpr (GATHER) { v2[0][0] = last ? vn[0][0] : vc[0][0]; v2[0][1] = last ? vn[0][1] : vc[0][1]; v2[1][0] = last ? vn[1][0] : vc[1][0]; v2[1][1] = last ? vn[1][1] : vc[1][1]; }
            PG8_LDB(B0, 0, 0); PG8_LDB(B1, 0, 1); PG8_SCHED; PG8_LDA(At, 0, 0); PG8_STAGE_A(PG8_SA(1, 1), a1, 1, vc);
            PG8_WAIT_V(8); PG8_WAIT_L(0); PG8_BAR; PG8_MMA(0, 0, At, B0); PG8_MMA(0, 1, At, B1); PG8_BAR; PG8_SCHED;
            PG8_LDA(At, 0, 1); PG8_STAGE(PG8_SB(0, 0), b2, voffB); PG8_STAGE(PG8_SB(0, 1), b2 + hstepB, voffB); PG8_STAGE_A(PG8_SA(0, 0), a2, 0, v2);
            PG8_WAIT_V(8); PG8_WAIT_L(0); PG8_BAR; PG8_MMA(1, 0, At, B0); PG8_MMA(1, 1, At, B1); PG8_BAR; PG8_SCHED;
            PG8_LDB(B0, 1, 0); PG8_LDB(B1, 1, 1); PG8_SCHED; PG8_LDA(At, 1, 0); PG8_STAGE_A(PG8_SA(0, 1), a2, 1, v2);
            PG8_WAIT_V(8); PG8_WAIT_L(0); PG8_BAR; PG8_MMA(0, 0, At, B0); PG8_MMA(0, 1, At, B1); PG8_BAR; PG8_SCHED;
            PG8_LDA(At, 1, 1); PG8_STAGE(PG8_SB(1, 0), b3, voffB); PG8_STAGE(PG8_SB(1, 1), b3 + hstepB, voffB); PG8_STAGE_A(PG8_SA(1, 0), a3, 0, v2);
            PG8_WAIT_V(8); PG8_WAIT_L(0); PG8_BAR; PG8_MMA(1, 0, At, B0); PG8_MMA(1, 1, At, B1); PG8_BAR; PG8_SCHED;
        }
        if (wr == 0) PG8_BAR;
        { const int l2 = hw_lane(); E(acc, cur, wr, wc, l2 & 15, l2 >> 4); }
        if (!has_next) break;
#pragma unroll
        for (int a = 0; a < 2; ++a)
#pragma unroll
            for (int b = 0; b < 2; ++b)
#pragma unroll
                for (int m = 0; m < 4; ++m)
#pragma unroll
                    for (int n = 0; n < 2; ++n) acc[a][b][m][n] = (f32x4){0.f, 0.f, 0.f, 0.f};
        cur = nxt; cA = nA; cB = nB; ++ui;
        if constexpr (GATHER) { vc[0][0] = vn[0][0]; vc[0][1] = vn[0][1]; vc[1][0] = vn[1][0]; vc[1][1] = vn[1][1]; }
        if (wr == 1) PG8_BAR;
    }
    PG8_WAIT_V(0);
    PG8_BAR;
#undef PG8_SA
#undef PG8_SB
#undef PG8_STAGE
#undef PG8_LDA
#undef PG8_LDB
#undef PG8_MMA
#undef PG8_WAIT_V
#undef PG8_WAIT_L
#undef PG8_BAR
#undef PG8_SCHED
#undef PG8_AOFFS
#undef PG8_STAGE_A
}
}
namespace attn_body {
using bf16=__hip_bfloat16;
using bf16x8=__attribute__((ext_vector_type(8)))short;
using s16x4=__attribute__((ext_vector_type(4)))short;
using f32x16=__attribute__((ext_vector_type(16)))float;
using u32x4=__attribute__((ext_vector_type(4)))unsigned;
constexpr int D=64;
constexpr int NW=8,QBLK=32,QB=QBLK*NW,KVBLK=64;
constexpr int ATTN_UNIT_ROWS=QB;
__device__ __forceinline__ int crow(int r,int hi){return (r&3)+8*(r>>2)+4*hi;}
#define SBAR() __builtin_amdgcn_sched_barrier(0)
constexpr int NSLOT=3, SLOTB=8192;
constexpr int LDS_K=0, LDS_V=NSLOT*SLOTB, LDS_WS=2*NSLOT*SLOTB, LDS_OST=LDS_WS+NW*64*4, LDS_BYTES=LDS_OST+NW*4096;
constexpr float C2=0.125f*1.4426950408889634f;
__device__ __forceinline__ void glds16(const void*gsrc,unsigned lds_dst){unsigned keep;
  asm volatile("s_mov_b32 %0, m0\n\ts_mov_b32 m0, %2\n\ts_nop 0\n\tglobal_load_lds_dwordx4 %1, off\n\ts_mov_b32 m0, %0":"=&s"(keep):"v"(gsrc),"s"(lds_dst):"memory");}
__device__ __forceinline__ float max3f(float a,float b,float c){float r;asm("v_max3_f32 %0, %1, %2, %3":"=v"(r):"v"(a),"v"(b),"v"(c));return r;}
__device__ __forceinline__ float max2f(float a,float b){float r;asm("v_max_f32_e32 %0, %1, %2":"=v"(r):"v"(a),"v"(b));return r;}
__device__ __forceinline__ float fadd_s(float a,float b){float r;asm("v_add_f32_e32 %0, %1, %2":"=v"(r):"v"(a),"v"(b));return r;}
__device__ __forceinline__ float fsub_s(float a,float b){float r;asm("v_sub_f32_e32 %0, %1, %2":"=v"(r):"v"(a),"v"(b));return r;}
typedef float f32x2_t __attribute__((ext_vector_type(2))); typedef __bf16 bf16x2_t __attribute__((ext_vector_type(2)));
__device__ __forceinline__ unsigned cvtpk_s(float lo,float hi){f32x2_t v={lo,hi};bf16x2_t b=__builtin_convertvector(v,bf16x2_t);return __builtin_bit_cast(unsigned,b);}
#define WAIT_BAR(N) asm volatile("s_waitcnt vmcnt(" #N ") lgkmcnt(0)\n\ts_barrier":::"memory")

__device__ __forceinline__ void qkt(f32x16&p0,f32x16&p1,const char*Kslot,const bf16x8*qr,const f32x16&negm,int r32,int hi){
  const char*kb=Kslot+hi*1024+r32*16;
  #pragma unroll
  for(int d0=0;d0<4;++d0){
    const bf16x8 b0=*reinterpret_cast<const bf16x8*>(kb+d0*2048);
    const bf16x8 b1=*reinterpret_cast<const bf16x8*>(kb+d0*2048+512);
    if(d0==0){p0=__builtin_amdgcn_mfma_f32_32x32x16_bf16(b0,qr[0],negm,0,0,0);p1=__builtin_amdgcn_mfma_f32_32x32x16_bf16(b1,qr[0],negm,0,0,0);}
    else{p0=__builtin_amdgcn_mfma_f32_32x32x16_bf16(b0,qr[d0],p0,0,0,0);p1=__builtin_amdgcn_mfma_f32_32x32x16_bf16(b1,qr[d0],p1,0,0,0);}}
}
typedef __attribute__((address_space(3))) const char* lds_cptr;
typedef short v4i16_t __attribute__((ext_vector_type(4)));
__device__ __forceinline__ void kload8(bf16x8*kf,lds_cptr kp){
  kf[0]=*(const __attribute__((address_space(3))) bf16x8*)(kp);      kf[1]=*(const __attribute__((address_space(3))) bf16x8*)(kp+512);
  kf[2]=*(const __attribute__((address_space(3))) bf16x8*)(kp+2048); kf[3]=*(const __attribute__((address_space(3))) bf16x8*)(kp+2560);
  kf[4]=*(const __attribute__((address_space(3))) bf16x8*)(kp+4096); kf[5]=*(const __attribute__((address_space(3))) bf16x8*)(kp+4608);
  kf[6]=*(const __attribute__((address_space(3))) bf16x8*)(kp+6144); kf[7]=*(const __attribute__((address_space(3))) bf16x8*)(kp+6656);
}
__device__ __forceinline__ void kload2(bf16x8*kf,lds_cptr kp,int j){ kf[2*j]=*(const __attribute__((address_space(3))) bf16x8*)(kp+j*2048); kf[2*j+1]=*(const __attribute__((address_space(3))) bf16x8*)(kp+j*2048+512); }
__device__ __forceinline__ void kload8_rm(bf16x8*kf,lds_cptr kp,const int*koff){
  #pragma unroll
  for(int d0=0;d0<4;++d0){ kf[2*d0]=*(const __attribute__((address_space(3))) bf16x8*)(kp+koff[d0]); kf[2*d0+1]=*(const __attribute__((address_space(3))) bf16x8*)(kp+koff[d0]+4096); }
}
__device__ __forceinline__ void kload2_rm(bf16x8*kf,lds_cptr kp,const int*koff,int j){ kf[2*j]=*(const __attribute__((address_space(3))) bf16x8*)(kp+koff[j]); kf[2*j+1]=*(const __attribute__((address_space(3))) bf16x8*)(kp+koff[j]+4096); }
__device__ __forceinline__ void qkt_rm(f32x16&p0,f32x16&p1,lds_cptr kp,const int*koff,const bf16x8*qr,const f32x16&negm){
  #pragma unroll
  for(int d0=0;d0<4;++d0){
    const bf16x8 b0=*(const __attribute__((address_space(3))) bf16x8*)(kp+koff[d0]);
    const bf16x8 b1=*(const __attribute__((address_space(3))) bf16x8*)(kp+koff[d0]+4096);
    if(d0==0){p0=__builtin_amdgcn_mfma_f32_32x32x16_bf16(b0,qr[0],negm,0,0,0);p1=__builtin_amdgcn_mfma_f32_32x32x16_bf16(b1,qr[0],negm,0,0,0);}
    else{p0=__builtin_amdgcn_mfma_f32_32x32x16_bf16(b0,qr[d0],p0,0,0,0);p1=__builtin_amdgcn_mfma_f32_32x32x16_bf16(b1,qr[d0],p1,0,0,0);}}
}
__device__ __forceinline__ void qprep(bf16x8 (&qr)[4],int hi,int pos,const float*gq){
  float x[4][8];
  #pragma unroll
  for(int d0=0;d0<4;++d0){
    #pragma unroll
    for(int e=0;e<8;++e)x[d0][e]=__builtin_bit_cast(float,(unsigned)(unsigned short)qr[d0][e]<<16);}
  if(gq){ float ss=0.f;
    #pragma unroll
    for(int d0=0;d0<4;++d0){
      #pragma unroll
      for(int e=0;e<8;++e)ss+=x[d0][e]*x[d0][e];}
    auto rr=__builtin_amdgcn_permlane32_swap(__float_as_uint(ss),__float_as_uint(ss),false,false);ss=__uint_as_float(rr[0])+__uint_as_float(rr[1]);
    const float rstd=rsqrtf(ss*(1.f/64.f)+1e-6f);
    #pragma unroll
    for(int d0=0;d0<4;++d0){
      #pragma unroll
      for(int e=0;e<8;++e)x[d0][e]*=rstd*gq[16*d0+8*hi+e];} }
  if(pos>=0){ const float rp=(float)(pos>>6),cp=(float)(pos&63);
    #pragma unroll
    for(int e=0;e<8;++e){ const float inv=exp2f(-(float)(8*hi+e)*(13.287712379549449f/16.f)); float s0,c0,s1,c1; sincosf(rp*inv,&s0,&c0); sincosf(cp*inv,&s1,&c1);
      const float a0=x[0][e],b0=x[2][e],a1=x[1][e],b1=x[3][e];
      x[0][e]=a0*c0-b0*s0; x[2][e]=b0*c0+a0*s0; x[1][e]=a1*c1-b1*s1; x[3][e]=b1*c1+a1*s1; } }
  #pragma unroll
  for(int d0=0;d0<4;++d0){ u32x4 w; w[0]=cvtpk_s(x[d0][0]*C2,x[d0][1]*C2); w[1]=cvtpk_s(x[d0][2]*C2,x[d0][3]*C2); w[2]=cvtpk_s(x[d0][4]*C2,x[d0][5]*C2); w[3]=cvtpk_s(x[d0][6]*C2,x[d0][7]*C2); qr[d0]=__builtin_bit_cast(bf16x8,w); }
}
__device__ __forceinline__ s16x4 vtr(lds_cptr p){ return __builtin_bit_cast(s16x4,__builtin_amdgcn_ds_read_tr16_b64_v4i16((__attribute__((address_space(3))) v4i16_t*)p)); }
__device__ __forceinline__ float rowmax(const f32x16&p0,const f32x16&p1){
  float a=max3f(p0[0],p0[1],p1[0]),b=max3f(p0[2],p0[3],p1[1]);a=max3f(a,p1[2],p1[3]);
  #pragma unroll
  for(int r=4;r<16;r+=4){a=max3f(a,p0[r],p0[r+1]);b=max3f(b,p0[r+2],p0[r+3]);a=max3f(a,p1[r],p1[r+1]);b=max3f(b,p1[r+2],p1[r+3]);}
  const float m=max2f(a,b);
  auto rr=__builtin_amdgcn_permlane32_swap(__float_as_uint(m),__float_as_uint(m),false,false);
  return max2f(__uint_as_float(rr[0]),__uint_as_float(rr[1]));
}
template<int ND> __device__ __forceinline__ void pv(f32x16*o,int vb,bf16x8 pa0,bf16x8 pa1,bf16x8 pa2,bf16x8 pa3){
  #pragma unroll
  for(int d0=0;d0<ND;++d0){s16x4 lo[4],hi[4];
    #pragma unroll
    for(int ks=0;ks<4;++ks){
      asm volatile("ds_read_b64_tr_b16 %0,%1 offset:%c2":"=&v"(lo[ks]):"v"(vb),"i"(d0*4096+ks*1024):"memory");
      asm volatile("ds_read_b64_tr_b16 %0,%1 offset:%c2":"=&v"(hi[ks]):"v"(vb),"i"(d0*4096+ks*1024+512):"memory");}
    asm volatile("s_waitcnt lgkmcnt(0)":::"memory");SBAR();
    #define PK(k) (bf16x8){lo[k][0],lo[k][1],lo[k][2],lo[k][3],hi[k][0],hi[k][1],hi[k][2],hi[k][3]}
    o[d0]=__builtin_amdgcn_mfma_f32_32x32x16_bf16(pa0,PK(0),o[d0],0,0,0);
    o[d0]=__builtin_amdgcn_mfma_f32_32x32x16_bf16(pa1,PK(1),o[d0],0,0,0);
    o[d0]=__builtin_amdgcn_mfma_f32_32x32x16_bf16(pa2,PK(2),o[d0],0,0,0);
    o[d0]=__builtin_amdgcn_mfma_f32_32x32x16_bf16(pa3,PK(3),o[d0],0,0,0);
    #undef PK
  }
}

#ifndef ATTN_STORE16
#define ATTN_STORE16(p,v) (*(u32x4*)(p)=(v))
#endif
template<int THRL> __device__ __forceinline__ void attn_unit(const bf16*Qb,int QP,const bf16*__restrict__ Kh,int KP,const bf16*__restrict__ Vh,int VP,bf16*Ob,int OP,int NT,char*shm,int wave){
  const int lane=hw_lane(),r32=lane&31,hi=lane>>5; const int wid=wave;
  const bf16*Qw=Qb+(long)(wid*QBLK)*QP;
  const unsigned lds0=(unsigned)(uintptr_t)shm;
  float*wsf=(float*)(shm+LDS_WS)+wid*64;
  const bf16*ksrc=Kh+(long)lane*KP+wid*8;
  const bf16*vsrc=Vh+(long)(16*(wid&3)+(lane>>2))*VP+(wid>>2)*32+(lane&3)*8;
  const unsigned kdst=lds0+LDS_K+wid*1024, vdst=lds0+LDS_V+wid*1024;
  #define DMA_K(t,slot) glds16(ksrc+(long)(t)*KVBLK*KP,(unsigned)__builtin_amdgcn_readfirstlane(kdst+(slot)))
  #define DMA_V(t,slot) glds16(vsrc+(long)(t)*KVBLK*VP,(unsigned)__builtin_amdgcn_readfirstlane(vdst+(slot)))
  const int vb0=(int)(lds0+LDS_V)+((lane>>4)&1)*32+(lane&3)*8+(4*hi+((lane&15)>>2))*64;
  const char*Kbase=shm+LDS_K; bf16x8 kf[8];
  const lds_cptr shm3=(lds_cptr)shm; const lds_cptr kp0=shm3+LDS_K+hi*1024+r32*16; const lds_cptr vp0=shm3+LDS_V+((lane>>4)&1)*32+(lane&3)*8+(4*hi+((lane&15)>>2))*64;
  DMA_K(0,0);DMA_V(0,0);DMA_K(1,SLOTB);
  bf16x8 qr[4];
  #pragma unroll
  for(int d0=0;d0<4;++d0)qr[d0]=*reinterpret_cast<const bf16x8*>(&Qw[(long)r32*QP+d0*16+hi*8]);
  float mhat=0.f,l_reg=0.f;f32x16 o[2];o[0]=f32x16{};o[1]=f32x16{};f32x16 negm=f32x16{};asm volatile("":"+v"(negm));
  #define CMASK(P0,P1,t) do{}while(0)
  bool resc=false;
  #define START(P0,P1) do{ const float rm=rowmax(P0,P1); resc=false; \
    { const float dl=rm; mhat=fadd_s(mhat,dl); \
      _Pragma("unroll") for(int r=0;r<16;++r){P0[r]=fsub_s(P0[r],dl);P1[r]=fsub_s(P1[r],dl);} \
      _Pragma("unroll") for(int r=0;r<16;++r)negm[r]=-mhat; asm volatile("":"+v"(negm)); } \
    _Pragma("unroll") for(int r=0;r<16;++r)P0[r]=__builtin_amdgcn_exp2f(P0[r]); }while(0)
  #define RESC() do{ if(resc){ asm volatile("s_waitcnt lgkmcnt(0)":::"memory"); \
      _Pragma("unroll") for(int d_=0;d_<2;++d_) _Pragma("unroll") for(int r=0;r<16;++r)o[d_][r]*=wsf[crow(r,hi)]; } }while(0)
  f32x16 pA0,pA1,pB0,pB1;
  int sl_prev=0,sl_cur=0,sl_next=SLOTB;
  #define ROT() do{sl_prev=sl_cur;sl_cur=sl_next;sl_next=(sl_next==(NSLOT-1)*SLOTB)?0:sl_next+SLOTB;}while(0)
  DMA_K(2,2*SLOTB);
  WAIT_BAR(3);
  qkt(pA0,pA1,Kbase,qr,negm,r32,hi);asm volatile("s_nop 15\n\ts_nop 7":"+v"(pA0),"+v"(pA1));CMASK(pA0,pA1,0);
  START(pA0,pA1);
  _Pragma("unroll") for(int r=0;r<16;++r)pA1[r]=__builtin_amdgcn_exp2f(pA1[r]);
  WAIT_BAR(0);
  DMA_K(3,0);DMA_V(1,SLOTB);
  ROT();
  kload8(kf,kp0+sl_cur);
  WAIT_BAR(2);
  s16x4 vlo[8],vhi[8]; u32x4 pw0,pw1,pw2,pw3;
  #define PKW(P,B) cvtpk_s(P[B],P[B+1])
  #define PAF(k) __builtin_bit_cast(bf16x8,pw##k)
  #define VFR(i) (bf16x8){vlo[i][0],vlo[i][1],vlo[i][2],vlo[i][3],vhi[i][0],vhi[i][1],vhi[i][2],vhi[i][3]}
  #define PIN(x) asm volatile("":"+v"(x))
  #define MX3(a,b,c) __builtin_fmaxf(__builtin_fmaxf((a),(b)),(c))
  #define GAPA(MF,A0,A1,A2,A3,W0,W1,PW) do{ MF; sacc+=A0; sacc+=A1; sacc+=A2; sacc+=A3; PIN(sacc); W0; W1; PIN(PW); SBAR(); }while(0)
  #define EX(v) __builtin_amdgcn_exp2f(v)
  #define GAPB(MF,X,B) do{ MF; X[B]=EX(X[B]); X[B+1]=EX(X[B+1]); X[B+2]=EX(X[B+2]); X[B+3]=EX(X[B+3]); PIN(X); SBAR(); }while(0)
  #define VRD(i) do{ vlo[i]=vtr(vp_+(((i)>>2)*4096+((i)&3)*1024)); vhi[i]=vtr(vp_+(((i)>>2)*4096+((i)&3)*1024+512)); }while(0)
  #define KRD(G,j) do{ if(G){ kload2(kf,kp0+sl_next,j); SBAR(); } }while(0)
  #define STEP(C0,C1,P0,P1,t,GK,GV,GL) do{ SBAR(); \
    const lds_cptr vp_=vp0+sl_prev; \
    VRD(0); SBAR(); float sacc=(P0[0]+P0[1]); \
    GAPA(C0=__builtin_amdgcn_mfma_f32_32x32x16_bf16(kf[0],qr[0],negm,0,0,0), P0[2],P0[3],P0[4],P0[5],     pw0[0]=PKW(P0,0), pw0[1]=PKW(P0,2), pw0); \
    VRD(4); SBAR(); GAPA(C1=__builtin_amdgcn_mfma_f32_32x32x16_bf16(kf[1],qr[0],negm,0,0,0), P0[6],P0[7],P0[8],P0[9],     pw0[2]=PKW(P0,4), pw0[3]=PKW(P0,6), pw0); \
    VRD(1); SBAR(); GAPA(C0=__builtin_amdgcn_mfma_f32_32x32x16_bf16(kf[2],qr[1],C0,0,0,0),   P0[10],P0[11],P0[12],P0[13], pw1[0]=PKW(P0,8), pw1[1]=PKW(P0,10), pw1); \
    VRD(5); SBAR(); GAPA(C1=__builtin_amdgcn_mfma_f32_32x32x16_bf16(kf[3],qr[1],C1,0,0,0),   P0[14],P0[15],P1[0],P1[1],   pw1[2]=PKW(P0,12),pw1[3]=PKW(P0,14), pw1); \
    VRD(2); SBAR(); GAPA(C0=__builtin_amdgcn_mfma_f32_32x32x16_bf16(kf[4],qr[2],C0,0,0,0),   P1[2],P1[3],P1[4],P1[5],     pw2[0]=PKW(P1,0), pw2[1]=PKW(P1,2), pw2); \
    VRD(6); SBAR(); GAPA(C1=__builtin_amdgcn_mfma_f32_32x32x16_bf16(kf[5],qr[2],C1,0,0,0),   P1[6],P1[7],P1[8],P1[9],     pw2[2]=PKW(P1,4), pw2[3]=PKW(P1,6), pw2); \
    VRD(3); SBAR(); GAPA(C0=__builtin_amdgcn_mfma_f32_32x32x16_bf16(kf[6],qr[3],C0,0,0,0),   P1[10],P1[11],P1[12],P1[13], pw3[0]=PKW(P1,8), pw3[1]=PKW(P1,10), pw3); \
    VRD(7); SBAR(); GAPA(C1=__builtin_amdgcn_mfma_f32_32x32x16_bf16(kf[7],qr[3],C1,0,0,0),   P1[14],P1[15],0.f,0.f,       pw3[2]=PKW(P1,12),pw3[3]=PKW(P1,14), pw3); \
    l_reg+=sacc; \
    if(GK){DMA_K((t)+3,sl_cur);} if(GV){DMA_V((t)+1,sl_next);} \
    CMASK(C0,C1,t); \
    { float a=MX3(C0[0],C0[1],C1[0]),b=MX3(C0[2],C0[3],C1[1]); a=MX3(a,C1[2],C1[3]); \
      _Pragma("unroll") for(int r=4;r<16;r+=4){a=MX3(a,C0[r],C0[r+1]);b=MX3(b,C0[r+2],C0[r+3]);a=MX3(a,C1[r],C1[r+1]);b=MX3(b,C1[r+2],C1[r+3]);} \
      float rm=__builtin_fmaxf(a,b); { auto rr=__builtin_amdgcn_permlane32_swap(__float_as_uint(rm),__float_as_uint(rm),false,false); rm=__builtin_fmaxf(__uint_as_float(rr[0]),__uint_as_float(rr[1])); } \
      resc=false; \
      if(__builtin_expect(__any(rm>(float)THRL),0)){ const float dl=__builtin_fmaxf(rm,0.f); mhat+=dl; \
        _Pragma("unroll") for(int r=0;r<16;++r){C0[r]-=dl;C1[r]-=dl;} \
        _Pragma("unroll") for(int r=0;r<16;++r)negm[r]=-mhat; asm volatile("":"+v"(negm)); \
        const float f=__builtin_amdgcn_exp2f(-dl); l_reg*=f; if(hi==0)wsf[r32]=f; resc=true; } } \
    SBAR(); \
    GAPB(o[0]=__builtin_amdgcn_mfma_f32_32x32x16_bf16(PAF(0),VFR(0),o[0],0,0,0), C0,0); \
    GAPB(o[1]=__builtin_amdgcn_mfma_f32_32x32x16_bf16(PAF(0),VFR(4),o[1],0,0,0), C0,4); \
    KRD(GL,0); GAPB(o[0]=__builtin_amdgcn_mfma_f32_32x32x16_bf16(PAF(1),VFR(1),o[0],0,0,0), C0,8); \
    KRD(GL,1); GAPB(o[1]=__builtin_amdgcn_mfma_f32_32x32x16_bf16(PAF(1),VFR(5),o[1],0,0,0), C0,12); \
    KRD(GL,2); GAPB(o[0]=__builtin_amdgcn_mfma_f32_32x32x16_bf16(PAF(2),VFR(2),o[0],0,0,0), C1,0); \
    KRD(GL,3); GAPB(o[1]=__builtin_amdgcn_mfma_f32_32x32x16_bf16(PAF(2),VFR(6),o[1],0,0,0), C1,4); \
    GAPB(o[0]=__builtin_amdgcn_mfma_f32_32x32x16_bf16(PAF(3),VFR(3),o[0],0,0,0), C1,8); \
    GAPB(o[1]=__builtin_amdgcn_mfma_f32_32x32x16_bf16(PAF(3),VFR(7),o[1],0,0,0), C1,12); \
    }while(0)
  int t=1;
  #undef CMASK
  #define CMASK(P0,P1,t) do{}while(0)
  for(;t+5<NT;t+=2){
    STEP(pB0,pB1,pA0,pA1,t,true,true,true);     WAIT_BAR(2); RESC(); ROT();
    STEP(pA0,pA1,pB0,pB1,t+1,true,true,true);   WAIT_BAR(2); RESC(); ROT();
  }
  #undef CMASK
  #define CMASK(P0,P1,t) do{}while(0)
  #define ENDW(tt) do{ if((tt)+3<NT){WAIT_BAR(2);} else if((tt)+2<NT){WAIT_BAR(1);} else {WAIT_BAR(0);} }while(0)
  for(;t+1<NT;t+=2){
    STEP(pB0,pB1,pA0,pA1,t,(t+3<NT),(t+1<NT),(t+1<NT));       ENDW(t);   RESC(); ROT();
    STEP(pA0,pA1,pB0,pB1,t+1,(t+4<NT),(t+2<NT),(t+2<NT));     ENDW(t+1); RESC(); ROT();
  }
  STEP(pB0,pB1,pA0,pA1,NT-1,false,false,false); RESC();
  { float sacc=pB0[0]+pB0[1]; _Pragma("unroll") for(int r=2;r<16;++r)sacc+=pB0[r]; _Pragma("unroll") for(int r=0;r<16;++r)sacc+=pB1[r]; l_reg+=sacc;
    pw0=(u32x4){PKW(pB0,0),PKW(pB0,2),PKW(pB0,4),PKW(pB0,6)};pw1=(u32x4){PKW(pB0,8),PKW(pB0,10),PKW(pB0,12),PKW(pB0,14)};pw2=(u32x4){PKW(pB1,0),PKW(pB1,2),PKW(pB1,4),PKW(pB1,6)};pw3=(u32x4){PKW(pB1,8),PKW(pB1,10),PKW(pB1,12),PKW(pB1,14)};
    SBAR(); pv<2>(o,vb0+sl_cur,PAF(0),PAF(1),PAF(2),PAF(3)); }
  #undef PKW
  #undef PAF
  #undef VFR
  #undef PIN
  #undef MX3
  #undef GAPA
  #undef GAPB
  #undef EX
  #undef VRD
  #undef KRD
  #undef STEP
  #undef ENDW
  {auto rr=__builtin_amdgcn_permlane32_swap(__float_as_uint(l_reg),__float_as_uint(l_reg),false,false);l_reg=__uint_as_float(rr[0])+__uint_as_float(rr[1]);}
  if(hi==0)wsf[32+r32]=l_reg;asm volatile("s_waitcnt lgkmcnt(0)":::"memory");
  float rli[16];
  #pragma unroll
  for(int r=0;r<16;++r)rli[r]=__builtin_amdgcn_rcpf(wsf[32+crow(r,hi)]);
  bf16*Ow=Ob+(long)(wid*QBLK)*OP;
  { bf16*stg=(bf16*)(shm+LDS_OST)+wid*2048;
    #pragma unroll
    for(int r=0;r<16;++r){const int orow=crow(r,hi);
      #pragma unroll
      for(int d0=0;d0<2;++d0)stg[orow*64+d0*32+r32]=__float2bfloat16(o[d0][r]*rli[r]);}
    asm volatile("s_waitcnt lgkmcnt(0)":::"memory");
    #pragma unroll
    for(int i=0;i<4;++i){const int row=i*8+(lane>>3),ch=lane&7; const u32x4 v=*(const u32x4*)(stg+row*64+ch*8); ATTN_STORE16(Ow+(long)row*OP+ch*8,v);} }
  asm volatile("s_waitcnt lgkmcnt(0)\n\ts_barrier":::"memory");
  #undef DMA_K
  #undef DMA_V
  #undef CMASK
  #undef START
  #undef RESC
  #undef ROT
}
template<int THRL> __device__ __forceinline__ void attn_unit128(const bf16*Qb,int QP,const bf16*__restrict__ Kh,int KP,const bf16*__restrict__ Vh,int VP,bf16*Ob,int OP,int NT,char*shm,int wave){
  const int lane=hw_lane(),r32=lane&31,hi=lane>>5; const int wid=wave;
  constexpr int LDS_V=NSLOT*SLOTB, LDS_WS=LDS_V+NSLOT*2*SLOTB, LDS_OST=LDS_WS+NW*64*4;
  const bf16*Qw=Qb+(long)(wid*QBLK)*QP;
  const unsigned lds0=(unsigned)(uintptr_t)shm;
  float*wsf=(float*)(shm+LDS_WS)+wid*64;
  const bf16*ksrc=Kh+(long)lane*KP+wid*8;
  const bf16*vsrc=Vh+(long)(16*(wid&3)+(lane>>2))*VP+(wid>>2)*32+(lane&3)*8;
  const unsigned kdst=lds0+LDS_K+wid*1024, vdst=lds0+LDS_V+wid*1024;
  #define DMA_K(t,slot) glds16(ksrc+(long)(t)*KVBLK*KP,(unsigned)__builtin_amdgcn_readfirstlane(kdst+(slot)))
  #define DMA_V(t,slot) do{ glds16(vsrc+(long)(t)*KVBLK*VP,(unsigned)__builtin_amdgcn_readfirstlane(vdst+2*(slot))); glds16(vsrc+(long)(t)*KVBLK*VP+64,(unsigned)__builtin_amdgcn_readfirstlane(vdst+2*(slot)+8192)); }while(0)
  const int vb0=(int)(lds0+LDS_V)+((lane>>4)&1)*32+(lane&3)*8+(4*hi+((lane&15)>>2))*64;
  const char*Kbase=shm+LDS_K; bf16x8 kf[8];
  const lds_cptr shm3=(lds_cptr)shm; const lds_cptr kp0=shm3+LDS_K+hi*1024+r32*16; const lds_cptr vp0=shm3+LDS_V+((lane>>4)&1)*32+(lane&3)*8+(4*hi+((lane&15)>>2))*64;
  DMA_K(0,0);DMA_V(0,0);DMA_K(1,SLOTB);
  bf16x8 qr[4];
  #pragma unroll
  for(int d0=0;d0<4;++d0)qr[d0]=*reinterpret_cast<const bf16x8*>(&Qw[(long)r32*QP+d0*16+hi*8]);
  float mhat=0.f,l_reg=0.f;f32x16 o[4];o[0]=f32x16{};o[1]=f32x16{};o[2]=f32x16{};o[3]=f32x16{};f32x16 negm=f32x16{};asm volatile("":"+v"(negm));
  #define CMASK(P0,P1,t) do{}while(0)
  bool resc=false;
  #define START(P0,P1) do{ const float rm=rowmax(P0,P1); resc=false; \
    { const float dl=rm; mhat=fadd_s(mhat,dl); \
      _Pragma("unroll") for(int r=0;r<16;++r){P0[r]=fsub_s(P0[r],dl);P1[r]=fsub_s(P1[r],dl);} \
      _Pragma("unroll") for(int r=0;r<16;++r)negm[r]=-mhat; asm volatile("":"+v"(negm)); } \
    _Pragma("unroll") for(int r=0;r<16;++r)P0[r]=__builtin_amdgcn_exp2f(P0[r]); }while(0)
  #define RESC() do{ if(resc){ asm volatile("s_waitcnt lgkmcnt(0)":::"memory"); \
      _Pragma("unroll") for(int d_=0;d_<4;++d_) _Pragma("unroll") for(int r=0;r<16;++r)o[d_][r]*=wsf[crow(r,hi)]; } }while(0)
  f32x16 pA0,pA1,pB0,pB1;
  int sl_prev=0,sl_cur=0,sl_next=SLOTB;
  #define ROT() do{sl_prev=sl_cur;sl_cur=sl_next;sl_next=(sl_next==(NSLOT-1)*SLOTB)?0:sl_next+SLOTB;}while(0)
  DMA_K(2,2*SLOTB);
  WAIT_BAR(3);
  qkt(pA0,pA1,Kbase,qr,negm,r32,hi);asm volatile("s_nop 15\n\ts_nop 7":"+v"(pA0),"+v"(pA1));CMASK(pA0,pA1,0);
  START(pA0,pA1);
  _Pragma("unroll") for(int r=0;r<16;++r)pA1[r]=__builtin_amdgcn_exp2f(pA1[r]);
  WAIT_BAR(0);
  DMA_K(3,0);DMA_V(1,SLOTB);
  ROT();
  kload8(kf,kp0+sl_cur);
  WAIT_BAR(3);
  s16x4 vlo[8],vhi[8]; u32x4 pw0,pw1,pw2,pw3;
  #define PKW(P,B) cvtpk_s(P[B],P[B+1])
  #define PAF(k) __builtin_bit_cast(bf16x8,pw##k)
  #define VFR(i) (bf16x8){vlo[i][0],vlo[i][1],vlo[i][2],vlo[i][3],vhi[i][0],vhi[i][1],vhi[i][2],vhi[i][3]}
  #define PIN(x) asm volatile("":"+v"(x))
  #define MX3(a,b,c) __builtin_fmaxf(__builtin_fmaxf((a),(b)),(c))
  #define GAPA(MF,A0,A1,A2,A3,W0,W1,PW) do{ MF; sacc+=A0; sacc+=A1; sacc+=A2; sacc+=A3; PIN(sacc); W0; W1; PIN(PW); SBAR(); }while(0)
  #define EX(v) __builtin_amdgcn_exp2f(v)
  #define GAPB(MF,X,B) do{ MF; X[B]=EX(X[B]); X[B+1]=EX(X[B+1]); X[B+2]=EX(X[B+2]); X[B+3]=EX(X[B+3]); PIN(X); SBAR(); }while(0)
  #define VRD(sl_,f) do{ vlo[sl_]=vtr(vp_+(((f)>>2)*4096+((f)&3)*1024)); vhi[sl_]=vtr(vp_+(((f)>>2)*4096+((f)&3)*1024+512)); }while(0)
  #define GAPB2(MF,X,B) do{ MF; X[B]=EX(X[B]); X[B+1]=EX(X[B+1]); PIN(X); SBAR(); }while(0)
  #define KRD(G,j) do{ if(G){ kload2(kf,kp0+sl_next,j); SBAR(); } }while(0)
  #define STEP(C0,C1,P0,P1,t,GK,GV,GL) do{ SBAR(); \
    const lds_cptr vp_=vp0+2*sl_prev; \
    VRD(0,0); SBAR(); float sacc=(P0[0]+P0[1]); \
    GAPA(C0=__builtin_amdgcn_mfma_f32_32x32x16_bf16(kf[0],qr[0],negm,0,0,0), P0[2],P0[3],P0[4],P0[5],     pw0[0]=PKW(P0,0), pw0[1]=PKW(P0,2), pw0); \
    VRD(1,4); SBAR(); GAPA(C1=__builtin_amdgcn_mfma_f32_32x32x16_bf16(kf[1],qr[0],negm,0,0,0), P0[6],P0[7],P0[8],P0[9],     pw0[2]=PKW(P0,4), pw0[3]=PKW(P0,6), pw0); \
    VRD(2,8); SBAR(); GAPA(C0=__builtin_amdgcn_mfma_f32_32x32x16_bf16(kf[2],qr[1],C0,0,0,0),   P0[10],P0[11],P0[12],P0[13], pw1[0]=PKW(P0,8), pw1[1]=PKW(P0,10), pw1); \
    VRD(3,12); SBAR(); GAPA(C1=__builtin_amdgcn_mfma_f32_32x32x16_bf16(kf[3],qr[1],C1,0,0,0),   P0[14],P0[15],P1[0],P1[1],   pw1[2]=PKW(P0,12),pw1[3]=PKW(P0,14), pw1); \
    VRD(4,1); SBAR(); GAPA(C0=__builtin_amdgcn_mfma_f32_32x32x16_bf16(kf[4],qr[2],C0,0,0,0),   P1[2],P1[3],P1[4],P1[5],     pw2[0]=PKW(P1,0), pw2[1]=PKW(P1,2), pw2); \
    VRD(5,5); SBAR(); GAPA(C1=__builtin_amdgcn_mfma_f32_32x32x16_bf16(kf[5],qr[2],C1,0,0,0),   P1[6],P1[7],P1[8],P1[9],     pw2[2]=PKW(P1,4), pw2[3]=PKW(P1,6), pw2); \
    VRD(6,9); SBAR(); GAPA(C0=__builtin_amdgcn_mfma_f32_32x32x16_bf16(kf[6],qr[3],C0,0,0,0),   P1[10],P1[11],P1[12],P1[13], pw3[0]=PKW(P1,8), pw3[1]=PKW(P1,10), pw3); \
    VRD(7,13); SBAR(); GAPA(C1=__builtin_amdgcn_mfma_f32_32x32x16_bf16(kf[7],qr[3],C1,0,0,0),   P1[14],P1[15],0.f,0.f,       pw3[2]=PKW(P1,12),pw3[3]=PKW(P1,14), pw3); \
    l_reg+=sacc; \
    if(GK){DMA_K((t)+3,sl_cur);} if(GV){DMA_V((t)+1,sl_next);} \
    CMASK(C0,C1,t); \
    { float a=MX3(C0[0],C0[1],C1[0]),b=MX3(C0[2],C0[3],C1[1]); a=MX3(a,C1[2],C1[3]); \
      _Pragma("unroll") for(int r=4;r<16;r+=4){a=MX3(a,C0[r],C0[r+1]);b=MX3(b,C0[r+2],C0[r+3]);a=MX3(a,C1[r],C1[r+1]);b=MX3(b,C1[r+2],C1[r+3]);} \
      float rm=__builtin_fmaxf(a,b); { auto rr=__builtin_amdgcn_permlane32_swap(__float_as_uint(rm),__float_as_uint(rm),false,false); rm=__builtin_fmaxf(__uint_as_float(rr[0]),__uint_as_float(rr[1])); } \
      resc=false; \
      if(__builtin_expect(__any(rm>(float)THRL),0)){ const float dl=__builtin_fmaxf(rm,0.f); mhat+=dl; \
        _Pragma("unroll") for(int r=0;r<16;++r){C0[r]-=dl;C1[r]-=dl;} \
        _Pragma("unroll") for(int r=0;r<16;++r)negm[r]=-mhat; asm volatile("":"+v"(negm)); \
        const float f=__builtin_amdgcn_exp2f(-dl); l_reg*=f; if(hi==0)wsf[r32]=f; resc=true; } } \
    SBAR(); \
    GAPB2(o[0]=__builtin_amdgcn_mfma_f32_32x32x16_bf16(PAF(0),VFR(0),o[0],0,0,0), C0,0); VRD(0,2); SBAR(); \
    GAPB2(o[1]=__builtin_amdgcn_mfma_f32_32x32x16_bf16(PAF(0),VFR(1),o[1],0,0,0), C0,2); VRD(1,6); SBAR(); \
    GAPB2(o[2]=__builtin_amdgcn_mfma_f32_32x32x16_bf16(PAF(0),VFR(2),o[2],0,0,0), C0,4); VRD(2,10); SBAR(); \
    GAPB2(o[3]=__builtin_amdgcn_mfma_f32_32x32x16_bf16(PAF(0),VFR(3),o[3],0,0,0), C0,6); VRD(3,14); SBAR(); \
    KRD(GL,0); GAPB2(o[0]=__builtin_amdgcn_mfma_f32_32x32x16_bf16(PAF(1),VFR(4),o[0],0,0,0), C0,8); VRD(4,3); SBAR(); \
    GAPB2(o[1]=__builtin_amdgcn_mfma_f32_32x32x16_bf16(PAF(1),VFR(5),o[1],0,0,0), C0,10); VRD(5,7); SBAR(); \
    KRD(GL,1); GAPB2(o[2]=__builtin_amdgcn_mfma_f32_32x32x16_bf16(PAF(1),VFR(6),o[2],0,0,0), C0,12); VRD(6,11); SBAR(); \
    GAPB2(o[3]=__builtin_amdgcn_mfma_f32_32x32x16_bf16(PAF(1),VFR(7),o[3],0,0,0), C0,14); VRD(7,15); SBAR(); \
    KRD(GL,2); GAPB2(o[0]=__builtin_amdgcn_mfma_f32_32x32x16_bf16(PAF(2),VFR(0),o[0],0,0,0), C1,0); \
    GAPB2(o[1]=__builtin_amdgcn_mfma_f32_32x32x16_bf16(PAF(2),VFR(1),o[1],0,0,0), C1,2); \
    KRD(GL,3); GAPB2(o[2]=__builtin_amdgcn_mfma_f32_32x32x16_bf16(PAF(2),VFR(2),o[2],0,0,0), C1,4); \
    GAPB2(o[3]=__builtin_amdgcn_mfma_f32_32x32x16_bf16(PAF(2),VFR(3),o[3],0,0,0), C1,6); \
    GAPB2(o[0]=__builtin_amdgcn_mfma_f32_32x32x16_bf16(PAF(3),VFR(4),o[0],0,0,0), C1,8); \
    GAPB2(o[1]=__builtin_amdgcn_mfma_f32_32x32x16_bf16(PAF(3),VFR(5),o[1],0,0,0), C1,10); \
    GAPB2(o[2]=__builtin_amdgcn_mfma_f32_32x32x16_bf16(PAF(3),VFR(6),o[2],0,0,0), C1,12); \
    GAPB2(o[3]=__builtin_amdgcn_mfma_f32_32x32x16_bf16(PAF(3),VFR(7),o[3],0,0,0), C1,14); \
    }while(0)
  int t=1;
  #undef CMASK
  #define CMASK(P0,P1,t) do{}while(0)
  for(;t+5<NT;t+=2){
    STEP(pB0,pB1,pA0,pA1,t,true,true,true);     WAIT_BAR(3); RESC(); ROT();
    STEP(pA0,pA1,pB0,pB1,t+1,true,true,true);   WAIT_BAR(3); RESC(); ROT();
  }
  #undef CMASK
  #define CMASK(P0,P1,t) do{}while(0)
  #define ENDW(tt) do{ if((tt)+3<NT){WAIT_BAR(3);} else if((tt)+2<NT){WAIT_BAR(2);} else {WAIT_BAR(0);} }while(0)
  for(;t+1<NT;t+=2){
    STEP(pB0,pB1,pA0,pA1,t,(t+3<NT),(t+1<NT),(t+1<NT));       ENDW(t);   RESC(); ROT();
    STEP(pA0,pA1,pB0,pB1,t+1,(t+4<NT),(t+2<NT),(t+2<NT));     ENDW(t+1); RESC(); ROT();
  }
  STEP(pB0,pB1,pA0,pA1,NT-1,false,false,false); RESC();
  { float sacc=pB0[0]+pB0[1]; _Pragma("unroll") for(int r=2;r<16;++r)sacc+=pB0[r]; _Pragma("unroll") for(int r=0;r<16;++r)sacc+=pB1[r]; l_reg+=sacc;
    pw0=(u32x4){PKW(pB0,0),PKW(pB0,2),PKW(pB0,4),PKW(pB0,6)};pw1=(u32x4){PKW(pB0,8),PKW(pB0,10),PKW(pB0,12),PKW(pB0,14)};pw2=(u32x4){PKW(pB1,0),PKW(pB1,2),PKW(pB1,4),PKW(pB1,6)};pw3=(u32x4){PKW(pB1,8),PKW(pB1,10),PKW(pB1,12),PKW(pB1,14)};
    SBAR(); pv<4>(o,vb0+2*sl_cur,PAF(0),PAF(1),PAF(2),PAF(3)); }
  #undef PKW
  #undef PAF
  #undef VFR
  #undef PIN
  #undef MX3
  #undef GAPA
  #undef GAPB
  #undef EX
  #undef VRD
  #undef GAPB2
  #undef KRD
  #undef STEP
  #undef ENDW
  {auto rr=__builtin_amdgcn_permlane32_swap(__float_as_uint(l_reg),__float_as_uint(l_reg),false,false);l_reg=__uint_as_float(rr[0])+__uint_as_float(rr[1]);}
  if(hi==0)wsf[32+r32]=l_reg;asm volatile("s_waitcnt lgkmcnt(0)":::"memory");
  float rli[16];
  #pragma unroll
  for(int r=0;r<16;++r)rli[r]=__builtin_amdgcn_rcpf(wsf[32+crow(r,hi)]);
  bf16*Ow=Ob+(long)(wid*QBLK)*OP;
  { bf16*stg=(bf16*)(shm+LDS_OST)+wid*2048;
    #pragma unroll
    for(int hf=0;hf<2;++hf){
      #pragma unroll
      for(int r=0;r<16;++r){const int orow=crow(r,hi);
        #pragma unroll
        for(int d0=0;d0<2;++d0)stg[orow*64+d0*32+r32]=__float2bfloat16(o[2*hf+d0][r]*rli[r]);}
      asm volatile("s_waitcnt lgkmcnt(0)":::"memory");
      #pragma unroll
      for(int i=0;i<4;++i){const int row=i*8+(lane>>3),ch=lane&7; const u32x4 v=*(const u32x4*)(stg+row*64+ch*8); ATTN_STORE16(Ow+(long)row*OP+hf*64+ch*8,v);}
      asm volatile("s_waitcnt lgkmcnt(0)":::"memory"); } }
  asm volatile("s_waitcnt lgkmcnt(0)\n\ts_barrier":::"memory");
  #undef DMA_K
  #undef DMA_V
  #undef CMASK
  #undef START
  #undef RESC
  #undef ROT
}
template<int THRL> __device__ __forceinline__ void attn_unit_br(const bf16*Qb,int QP,const bf16*__restrict__ Kh,int KP,const bf16*__restrict__ Vh,int VP,bf16*Ob,int OP,int NT,char*shm,int wave,float kmax,int qpos0,const float*gq){
  const int lane=hw_lane(),r32=lane&31,hi=lane>>5; const int wid=wave;
  const bf16*Qw=Qb+(long)(wid*QBLK)*QP;
  const unsigned lds0=(unsigned)(uintptr_t)shm;
  float*wsf=(float*)(shm+LDS_WS)+wid*64;
  const int krow_=8*wid+(lane>>3); const bf16*ksrc=Kh+(long)krow_*KP+(((lane&7)^((krow_>>1)&7))*8);
  const bf16*vsrc=Vh+(long)(16*(wid&3)+(lane>>2))*VP+(wid>>2)*32+(lane&3)*8;
  const unsigned kdst=lds0+LDS_K+wid*1024, vdst=lds0+LDS_V+wid*1024;
  #define DMA_K(t,slot) glds16(ksrc+(long)(t)*KVBLK*KP,(unsigned)__builtin_amdgcn_readfirstlane(kdst+(slot)))
  #define DMA_V(t,slot) glds16(vsrc+(long)(t)*KVBLK*VP,(unsigned)__builtin_amdgcn_readfirstlane(vdst+(slot)))
  const int vb0=(int)(lds0+LDS_V)+((lane>>4)&1)*32+(lane&3)*8+(4*hi+((lane&15)>>2))*64;
  const char*Kbase=shm+LDS_K; bf16x8 kf[8];
  const lds_cptr shm3=(lds_cptr)shm; const lds_cptr kp0=shm3+LDS_K; int koff[4]; _Pragma("unroll") for(int d0_=0;d0_<4;++d0_)koff[d0_]=r32*128+((((2*d0_+hi)^((r32>>1)&7)))*16); const lds_cptr vp0=shm3+LDS_V+((lane>>4)&1)*32+(lane&3)*8+(4*hi+((lane&15)>>2))*64;
  DMA_K(0,0);DMA_V(0,0);DMA_K(1,SLOTB);
  bf16x8 qr[4];
  #pragma unroll
  for(int d0=0;d0<4;++d0)qr[d0]=*reinterpret_cast<const bf16x8*>(&Qw[(long)r32*QP+d0*16+hi*8]);
  qprep(qr,hi,qpos0<0?-1:qpos0+wid*QBLK+r32,gq);
  float l_reg=0.f;f32x16 o[2];o[0]=f32x16{};o[1]=f32x16{};f32x16 negm;
  { float qs=0.f;
    #pragma unroll
    for(int d0=0;d0<4;++d0){
      #pragma unroll
      for(int e=0;e<8;++e){const float v=__builtin_bit_cast(float,(unsigned)(unsigned short)qr[d0][e]<<16);qs+=v*v;}}
    auto rr=__builtin_amdgcn_permlane32_swap(__float_as_uint(qs),__float_as_uint(qs),false,false);qs=__uint_as_float(rr[0])+__uint_as_float(rr[1]);
    const float ref=sqrtf(qs)*kmax*1.002f+0.02f;
    #pragma unroll
    for(int r=0;r<16;++r)negm[r]=-ref;
    asm volatile("":"+v"(negm)); }
  #define CMASK(P0,P1,t) do{}while(0)
  #define START(P0,P1) do{ _Pragma("unroll") for(int r=0;r<16;++r)P0[r]=__builtin_amdgcn_exp2f(P0[r]); }while(0)
  #define RESC() do{}while(0)
  f32x16 pA0,pA1,pB0,pB1;
  int sl_prev=0,sl_cur=0,sl_next=SLOTB;
  #define ROT() do{sl_prev=sl_cur;sl_cur=sl_next;sl_next=(sl_next==(NSLOT-1)*SLOTB)?0:sl_next+SLOTB;}while(0)
  DMA_K(2,2*SLOTB);
  WAIT_BAR(3);
  qkt_rm(pA0,pA1,kp0,koff,qr,negm);asm volatile("s_nop 15\n\ts_nop 7":"+v"(pA0),"+v"(pA1));CMASK(pA0,pA1,0);
  START(pA0,pA1);
  _Pragma("unroll") for(int r=0;r<16;++r)pA1[r]=__builtin_amdgcn_exp2f(pA1[r]);
  WAIT_BAR(0);
  DMA_K(3,0);DMA_V(1,SLOTB);
  ROT();
  kload8_rm(kf,kp0+sl_cur,koff);
  WAIT_BAR(2);
  s16x4 vlo[8],vhi[8]; u32x4 pw0,pw1,pw2,pw3;
  #define PKW(P,B) cvtpk_s(P[B],P[B+1])
  #define PAF(k) __builtin_bit_cast(bf16x8,pw##k)
  #define VFR(i) (bf16x8){vlo[i][0],vlo[i][1],vlo[i][2],vlo[i][3],vhi[i][0],vhi[i][1],vhi[i][2],vhi[i][3]}
  #define PIN(x) asm volatile("":"+v"(x))
  #define MX3(a,b,c) __builtin_fmaxf(__builtin_fmaxf((a),(b)),(c))
  #define GAPA(MF,A0,A1,A2,A3,W0,W1,PW) do{ MF; sacc+=A0; sacc+=A1; sacc+=A2; sacc+=A3; PIN(sacc); W0; W1; PIN(PW); SBAR(); }while(0)
  #define EX(v) __builtin_amdgcn_exp2f(v)
  #define GAPB(MF,X,B) do{ MF; X[B]=EX(X[B]); X[B+1]=EX(X[B+1]); X[B+2]=EX(X[B+2]); X[B+3]=EX(X[B+3]); PIN(X); SBAR(); }while(0)
  #define VRD(i) do{ vlo[i]=vtr(vp_+(((i)>>2)*4096+((i)&3)*1024)); vhi[i]=vtr(vp_+(((i)>>2)*4096+((i)&3)*1024+512)); }while(0)
  #define KRD(G,j) do{ if(G){ kload2_rm(kf,kp0+sl_next,koff,j); SBAR(); } }while(0)
  #define STEP(C0,C1,P0,P1,t,GK,GV,GL) do{ SBAR(); \
    const lds_cptr vp_=vp0+sl_prev; \
    VRD(0); SBAR(); float sacc=(P0[0]+P0[1]); \
    GAPA(C0=__builtin_amdgcn_mfma_f32_32x32x16_bf16(kf[0],qr[0],negm,0,0,0), P0[2],P0[3],P0[4],P0[5],     pw0[0]=PKW(P0,0), pw0[1]=PKW(P0,2), pw0); \
    VRD(4); SBAR(); GAPA(C1=__builtin_amdgcn_mfma_f32_32x32x16_bf16(kf[1],qr[0],negm,0,0,0), P0[6],P0[7],P0[8],P0[9],     pw0[2]=PKW(P0,4), pw0[3]=PKW(P0,6), pw0); \
    VRD(1); SBAR(); GAPA(C0=__builtin_amdgcn_mfma_f32_32x32x16_bf16(kf[2],qr[1],C0,0,0,0),   P0[10],P0[11],P0[12],P0[13], pw1[0]=PKW(P0,8), pw1[1]=PKW(P0,10), pw1); \
    VRD(5); SBAR(); GAPA(C1=__builtin_amdgcn_mfma_f32_32x32x16_bf16(kf[3],qr[1],C1,0,0,0),   P0[14],P0[15],P1[0],P1[1],   pw1[2]=PKW(P0,12),pw1[3]=PKW(P0,14), pw1); \
    VRD(2); SBAR(); GAPA(C0=__builtin_amdgcn_mfma_f32_32x32x16_bf16(kf[4],qr[2],C0,0,0,0),   P1[2],P1[3],P1[4],P1[5],     pw2[0]=PKW(P1,0), pw2[1]=PKW(P1,2), pw2); \
    VRD(6); SBAR(); GAPA(C1=__builtin_amdgcn_mfma_f32_32x32x16_bf16(kf[5],qr[2],C1,0,0,0),   P1[6],P1[7],P1[8],P1[9],     pw2[2]=PKW(P1,4), pw2[3]=PKW(P1,6), pw2); \
    VRD(3); SBAR(); GAPA(C0=__builtin_amdgcn_mfma_f32_32x32x16_bf16(kf[6],qr[3],C0,0,0,0),   P1[10],P1[11],P1[12],P1[13], pw3[0]=PKW(P1,8), pw3[1]=PKW(P1,10), pw3); \
    VRD(7); SBAR(); GAPA(C1=__builtin_amdgcn_mfma_f32_32x32x16_bf16(kf[7],qr[3],C1,0,0,0),   P1[14],P1[15],0.f,0.f,       pw3[2]=PKW(P1,12),pw3[3]=PKW(P1,14), pw3); \
    l_reg+=sacc; \
    if(GK){DMA_K((t)+3,sl_cur);} if(GV){DMA_V((t)+1,sl_next);} \
    CMASK(C0,C1,t); \
    SBAR(); \
    GAPB(o[0]=__builtin_amdgcn_mfma_f32_32x32x16_bf16(PAF(0),VFR(0),o[0],0,0,0), C0,0); \
    GAPB(o[1]=__builtin_amdgcn_mfma_f32_32x32x16_bf16(PAF(0),VFR(4),o[1],0,0,0), C0,4); \
    KRD(GL,0); GAPB(o[0]=__builtin_amdgcn_mfma_f32_32x32x16_bf16(PAF(1),VFR(1),o[0],0,0,0), C0,8); \
    KRD(GL,1); GAPB(o[1]=__builtin_amdgcn_mfma_f32_32x32x16_bf16(PAF(1),VFR(5),o[1],0,0,0), C0,12); \
    KRD(GL,2); GAPB(o[0]=__builtin_amdgcn_mfma_f32_32x32x16_bf16(PAF(2),VFR(2),o[0],0,0,0), C1,0); \
    KRD(GL,3); GAPB(o[1]=__builtin_amdgcn_mfma_f32_32x32x16_bf16(PAF(2),VFR(6),o[1],0,0,0), C1,4); \
    GAPB(o[0]=__builtin_amdgcn_mfma_f32_32x32x16_bf16(PAF(3),VFR(3),o[0],0,0,0), C1,8); \
    GAPB(o[1]=__builtin_amdgcn_mfma_f32_32x32x16_bf16(PAF(3),VFR(7),o[1],0,0,0), C1,12); \
    }while(0)
  if(wid>=4)__builtin_amdgcn_s_setprio(1);
  int t=1;
  #undef CMASK
  #define CMASK(P0,P1,t) do{}while(0)
  for(;t+5<NT;t+=2){
    STEP(pB0,pB1,pA0,pA1,t,true,true,true);     WAIT_BAR(2); RESC(); ROT();
    STEP(pA0,pA1,pB0,pB1,t+1,true,true,true);   WAIT_BAR(2); RESC(); ROT();
  }
  #undef CMASK
  #define CMASK(P0,P1,t) do{}while(0)
  #define ENDW(tt) do{ if((tt)+3<NT){WAIT_BAR(2);} else if((tt)+2<NT){WAIT_BAR(1);} else {WAIT_BAR(0);} }while(0)
  for(;t+1<NT;t+=2){
    STEP(pB0,pB1,pA0,pA1,t,(t+3<NT),(t+1<NT),(t+1<NT));       ENDW(t);   RESC(); ROT();
    STEP(pA0,pA1,pB0,pB1,t+1,(t+4<NT),(t+2<NT),(t+2<NT));     ENDW(t+1); RESC(); ROT();
  }
  STEP(pB0,pB1,pA0,pA1,NT-1,false,false,false); RESC();
  __builtin_amdgcn_s_setprio(0);
  { float sacc=pB0[0]+pB0[1]; _Pragma("unroll") for(int r=2;r<16;++r)sacc+=pB0[r]; _Pragma("unroll") for(int r=0;r<16;++r)sacc+=pB1[r]; l_reg+=sacc;
    pw0=(u32x4){PKW(pB0,0),PKW(pB0,2),PKW(pB0,4),PKW(pB0,6)};pw1=(u32x4){PKW(pB0,8),PKW(pB0,10),PKW(pB0,12),PKW(pB0,14)};pw2=(u32x4){PKW(pB1,0),PKW(pB1,2),PKW(pB1,4),PKW(pB1,6)};pw3=(u32x4){PKW(pB1,8),PKW(pB1,10),PKW(pB1,12),PKW(pB1,14)};
    SBAR(); pv<2>(o,vb0+sl_cur,PAF(0),PAF(1),PAF(2),PAF(3)); }
  #undef PKW
  #undef PAF
  #undef VFR
  #undef PIN
  #undef MX3
  #undef GAPA
  #undef GAPB
  #undef EX
  #undef VRD
  #undef KRD
  #undef STEP
  #undef ENDW
  {auto rr=__builtin_amdgcn_permlane32_swap(__float_as_uint(l_reg),__float_as_uint(l_reg),false,false);l_reg=__uint_as_float(rr[0])+__uint_as_float(rr[1]);}
  if(hi==0)wsf[32+r32]=l_reg;asm volatile("s_waitcnt lgkmcnt(0)":::"memory");
  float rli[16];
  #pragma unroll
  for(int r=0;r<16;++r)rli[r]=__builtin_amdgcn_rcpf(wsf[32+crow(r,hi)]);
  bf16*Ow=Ob+(long)(wid*QBLK)*OP;
  { bf16*stg=(bf16*)(shm+LDS_OST)+wid*2048;
    #pragma unroll
    for(int r=0;r<16;++r){const int orow=crow(r,hi);
      #pragma unroll
      for(int d0=0;d0<2;++d0)stg[orow*64+d0*32+r32]=__float2bfloat16(o[d0][r]*rli[r]);}
    asm volatile("s_waitcnt lgkmcnt(0)":::"memory");
    #pragma unroll
    for(int i=0;i<4;++i){const int row=i*8+(lane>>3),ch=lane&7; const u32x4 v=*(const u32x4*)(stg+row*64+ch*8); ATTN_STORE16(Ow+(long)row*OP+ch*8,v);} }
  asm volatile("s_waitcnt lgkmcnt(0)\n\ts_barrier":::"memory");
  #undef DMA_K
  #undef DMA_V
  #undef CMASK
  #undef START
  #undef RESC
  #undef ROT
}
template<int THRL> __device__ __forceinline__ void attn_unit128_br(const bf16*Qb,int QP,const bf16*__restrict__ Kh,int KP,const bf16*__restrict__ Vh,int VP,bf16*Ob,int OP,int NT,char*shm,int wave,float kmax,int qpos0,const float*gq){
  const int lane=hw_lane(),r32=lane&31,hi=lane>>5; const int wid=wave;
  constexpr int LDS_V=NSLOT*SLOTB, LDS_WS=LDS_V+NSLOT*2*SLOTB, LDS_OST=LDS_WS+NW*64*4;
  const bf16*Qw=Qb+(long)(wid*QBLK)*QP;
  const unsigned lds0=(unsigned)(uintptr_t)shm;
  float*wsf=(float*)(shm+LDS_WS)+wid*64;
  const bf16*ksrc=Kh+(long)lane*KP+wid*8;
  const bf16*vsrc=Vh+(long)(16*(wid&3)+(lane>>2))*VP+(wid>>2)*32+(lane&3)*8;
  const unsigned kdst=lds0+LDS_K+wid*1024, vdst=lds0+LDS_V+wid*1024;
  #define DMA_K(t,slot) glds16(ksrc+(long)(t)*KVBLK*KP,(unsigned)__builtin_amdgcn_readfirstlane(kdst+(slot)))
  #define DMA_V(t,slot) do{ glds16(vsrc+(long)(t)*KVBLK*VP,(unsigned)__builtin_amdgcn_readfirstlane(vdst+2*(slot))); glds16(vsrc+(long)(t)*KVBLK*VP+64,(unsigned)__builtin_amdgcn_readfirstlane(vdst+2*(slot)+8192)); }while(0)
  const int vb0=(int)(lds0+LDS_V)+((lane>>4)&1)*32+(lane&3)*8+(4*hi+((lane&15)>>2))*64;
  const char*Kbase=shm+LDS_K; bf16x8 kf[8];
  const lds_cptr shm3=(lds_cptr)shm; const lds_cptr kp0=shm3+LDS_K+hi*1024+r32*16; const lds_cptr vp0=shm3+LDS_V+((lane>>4)&1)*32+(lane&3)*8+(4*hi+((lane&15)>>2))*64;
  DMA_K(0,0);DMA_V(0,0);DMA_K(1,SLOTB);
  bf16x8 qr[4];
  #pragma unroll
  for(int d0=0;d0<4;++d0)qr[d0]=*reinterpret_cast<const bf16x8*>(&Qw[(long)r32*QP+d0*16+hi*8]);
  qprep(qr,hi,qpos0<0?-1:qpos0+wid*QBLK+r32,gq);
  float l_reg=0.f;f32x16 o[4];o[0]=f32x16{};o[1]=f32x16{};o[2]=f32x16{};o[3]=f32x16{};f32x16 negm;
  { float qs=0.f;
    #pragma unroll
    for(int d0=0;d0<4;++d0){
      #pragma unroll
      for(int e=0;e<8;++e){const float v=__builtin_bit_cast(float,(unsigned)(unsigned short)qr[d0][e]<<16);qs+=v*v;}}
    auto rr=__builtin_amdgcn_permlane32_swap(__float_as_uint(qs),__float_as_uint(qs),false,false);qs=__uint_as_float(rr[0])+__uint_as_float(rr[1]);
    const float ref=sqrtf(qs)*kmax*1.002f+0.02f;
    #pragma unroll
    for(int r=0;r<16;++r)negm[r]=-ref;
    asm volatile("":"+v"(negm)); }
  #define CMASK(P0,P1,t) do{}while(0)
  #define START(P0,P1) do{ _Pragma("unroll") for(int r=0;r<16;++r)P0[r]=__builtin_amdgcn_exp2f(P0[r]); }while(0)
  #define RESC() do{}while(0)
  f32x16 pA0,pA1,pB0,pB1;
  int sl_prev=0,sl_cur=0,sl_next=SLOTB;
  #define ROT() do{sl_prev=sl_cur;sl_cur=sl_next;sl_next=(sl_next==(NSLOT-1)*SLOTB)?0:sl_next+SLOTB;}while(0)
  DMA_K(2,2*SLOTB);
  WAIT_BAR(3);
  qkt(pA0,pA1,Kbase,qr,negm,r32,hi);asm volatile("s_nop 15\n\ts_nop 7":"+v"(pA0),"+v"(pA1));CMASK(pA0,pA1,0);
  START(pA0,pA1);
  _Pragma("unroll") for(int r=0;r<16;++r)pA1[r]=__builtin_amdgcn_exp2f(pA1[r]);
  WAIT_BAR(0);
  DMA_K(3,0);DMA_V(1,SLOTB);
  ROT();
  kload8(kf,kp0+sl_cur);
  WAIT_BAR(3);
  s16x4 vlo[8],vhi[8]; u32x4 pw0,pw1,pw2,pw3;
  #define PKW(P,B) cvtpk_s(P[B],P[B+1])
  #define PAF(k) __builtin_bit_cast(bf16x8,pw##k)
  #define VFR(i) (bf16x8){vlo[i][0],vlo[i][1],vlo[i][2],vlo[i][3],vhi[i][0],vhi[i][1],vhi[i][2],vhi[i][3]}
  #define PIN(x) asm volatile("":"+v"(x))
  #define MX3(a,b,c) __builtin_fmaxf(__builtin_fmaxf((a),(b)),(c))
  #define GAPA(MF,A0,A1,A2,A3,W0,W1,PW) do{ MF; sacc+=A0; sacc+=A1; sacc+=A2; sacc+=A3; PIN(sacc); W0; W1; PIN(PW); SBAR(); }while(0)
  #define EX(v) __builtin_amdgcn_exp2f(v)
  #define GAPB(MF,X,B) do{ MF; X[B]=EX(X[B]); X[B+1]=EX(X[B+1]); X[B+2]=EX(X[B+2]); X[B+3]=EX(X[B+3]); PIN(X); SBAR(); }while(0)
  #define VRD(sl_,f) do{ vlo[sl_]=vtr(vp_+(((f)>>2)*4096+((f)&3)*1024)); vhi[sl_]=vtr(vp_+(((f)>>2)*4096+((f)&3)*1024+512)); }while(0)
  #define GAPB2(MF,X,B) do{ MF; X[B]=EX(X[B]); X[B+1]=EX(X[B+1]); PIN(X); SBAR(); }while(0)
  #define KRD(G,j) do{ if(G){ kload2(kf,kp0+sl_next,j); SBAR(); } }while(0)
  #define STEP(C0,C1,P0,P1,t,GK,GV,GL) do{ SBAR(); \
    const lds_cptr vp_=vp0+2*sl_prev; \
    VRD(0,0); SBAR(); float sacc=(P0[0]+P0[1]); \
    GAPA(C0=__builtin_amdgcn_mfma_f32_32x32x16_bf16(kf[0],qr[0],negm,0,0,0), P0[2],P0[3],P0[4],P0[5],     pw0[0]=PKW(P0,0), pw0[1]=PKW(P0,2), pw0); \
    VRD(1,4); SBAR(); GAPA(C1=__builtin_amdgcn_mfma_f32_32x32x16_bf16(kf[1],qr[0],negm,0,0,0), P0[6],P0[7],P0[8],P0[9],     pw0[2]=PKW(P0,4), pw0[3]=PKW(P0,6), pw0); \
    VRD(2,8); SBAR(); GAPA(C0=__builtin_amdgcn_mfma_f32_32x32x16_bf16(kf[2],qr[1],C0,0,0,0),   P0[10],P0[11],P0[12],P0[13], pw1[0]=PKW(P0,8), pw1[1]=PKW(P0,10), pw1); \
    VRD(3,12); SBAR(); GAPA(C1=__builtin_amdgcn_mfma_f32_32x32x16_bf16(kf[3],qr[1],C1,0,0,0),   P0[14],P0[15],P1[0],P1[1],   pw1[2]=PKW(P0,12),pw1[3]=PKW(P0,14), pw1); \
    VRD(4,1); SBAR(); GAPA(C0=__builtin_amdgcn_mfma_f32_32x32x16_bf16(kf[4],qr[2],C0,0,0,0),   P1[2],P1[3],P1[4],P1[5],     pw2[0]=PKW(P1,0), pw2[1]=PKW(P1,2), pw2); \
    VRD(5,5); SBAR(); GAPA(C1=__builtin_amdgcn_mfma_f32_32x32x16_bf16(kf[5],qr[2],C1,0,0,0),   P1[6],P1[7],P1[8],P1[9],     pw2[2]=PKW(P1,4), pw2[3]=PKW(P1,6), pw2); \
    VRD(6,9); SBAR(); GAPA(C0=__builtin_amdgcn_mfma_f32_32x32x16_bf16(kf[6],qr[3],C0,0,0,0),   P1[10],P1[11],P1[12],P1[13], pw3[0]=PKW(P1,8), pw3[1]=PKW(P1,10), pw3); \
    VRD(7,13); SBAR(); GAPA(C1=__builtin_amdgcn_mfma_f32_32x32x16_bf16(kf[7],qr[3],C1,0,0,0),   P1[14],P1[15],0.f,0.f,       pw3[2]=PKW(P1,12),pw3[3]=PKW(P1,14), pw3); \
    l_reg+=sacc; \
    if(GK){DMA_K((t)+3,sl_cur);} if(GV){DMA_V((t)+1,sl_next);} \
    CMASK(C0,C1,t); \
    SBAR(); \
    GAPB2(o[0]=__builtin_amdgcn_mfma_f32_32x32x16_bf16(PAF(0),VFR(0),o[0],0,0,0), C0,0); VRD(0,2); SBAR(); \
    GAPB2(o[1]=__builtin_amdgcn_mfma_f32_32x32x16_bf16(PAF(0),VFR(1),o[1],0,0,0), C0,2); VRD(1,6); SBAR(); \
    GAPB2(o[2]=__builtin_amdgcn_mfma_f32_32x32x16_bf16(PAF(0),VFR(2),o[2],0,0,0), C0,4); VRD(2,10); SBAR(); \
    GAPB2(o[3]=__builtin_amdgcn_mfma_f32_32x32x16_bf16(PAF(0),VFR(3),o[3],0,0,0), C0,6); VRD(3,14); SBAR(); \
    KRD(GL,0); GAPB2(o[0]=__builtin_amdgcn_mfma_f32_32x32x16_bf16(PAF(1),VFR(4),o[0],0,0,0), C0,8); VRD(4,3); SBAR(); \
    GAPB2(o[1]=__builtin_amdgcn_mfma_f32_32x32x16_bf16(PAF(1),VFR(5),o[1],0,0,0), C0,10); VRD(5,7); SBAR(); \
    KRD(GL,1); GAPB2(o[2]=__builtin_amdgcn_mfma_f32_32x32x16_bf16(PAF(1),VFR(6),o[2],0,0,0), C0,12); VRD(6,11); SBAR(); \
    GAPB2(o[3]=__builtin_amdgcn_mfma_f32_32x32x16_bf16(PAF(1),VFR(7),o[3],0,0,0), C0,14); VRD(7,15); SBAR(); \
    KRD(GL,2); GAPB2(o[0]=__builtin_amdgcn_mfma_f32_32x32x16_bf16(PAF(2),VFR(0),o[0],0,0,0), C1,0); \
    GAPB2(o[1]=__builtin_amdgcn_mfma_f32_32x32x16_bf16(PAF(2),VFR(1),o[1],0,0,0), C1,2); \
    KRD(GL,3); GAPB2(o[2]=__builtin_amdgcn_mfma_f32_32x32x16_bf16(PAF(2),VFR(2),o[2],0,0,0), C1,4); \
    GAPB2(o[3]=__builtin_amdgcn_mfma_f32_32x32x16_bf16(PAF(2),VFR(3),o[3],0,0,0), C1,6); \
    GAPB2(o[0]=__builtin_amdgcn_mfma_f32_32x32x16_bf16(PAF(3),VFR(4),o[0],0,0,0), C1,8); \
    GAPB2(o[1]=__builtin_amdgcn_mfma_f32_32x32x16_bf16(PAF(3),VFR(5),o[1],0,0,0), C1,10); \
    GAPB2(o[2]=__builtin_amdgcn_mfma_f32_32x32x16_bf16(PAF(3),VFR(6),o[2],0,0,0), C1,12); \
    GAPB2(o[3]=__builtin_amdgcn_mfma_f32_32x32x16_bf16(PAF(3),VFR(7),o[3],0,0,0), C1,14); \
    }while(0)
  if(wid>=4)__builtin_amdgcn_s_setprio(1);
  int t=1;
  #undef CMASK
  #define CMASK(P0,P1,t) do{}while(0)
  for(;t+5<NT;t+=2){
    STEP(pB0,pB1,pA0,pA1,t,true,true,true);     WAIT_BAR(3); RESC(); ROT();
    STEP(pA0,pA1,pB0,pB1,t+1,true,true,true);   WAIT_BAR(3); RESC(); ROT();
  }
  #undef CMASK
  #define CMASK(P0,P1,t) do{}while(0)
  #define ENDW(tt) do{ if((tt)+3<NT){WAIT_BAR(3);} else if((tt)+2<NT){WAIT_BAR(2);} else {WAIT_BAR(0);} }while(0)
  for(;t+1<NT;t+=2){
    STEP(pB0,pB1,pA0,pA1,t,(t+3<NT),(t+1<NT),(t+1<NT));       ENDW(t);   RESC(); ROT();
    STEP(pA0,pA1,pB0,pB1,t+1,(t+4<NT),(t+2<NT),(t+2<NT));     ENDW(t+1); RESC(); ROT();
  }
  STEP(pB0,pB1,pA0,pA1,NT-1,false,false,false); RESC();
  __builtin_amdgcn_s_setprio(0);
  { float sacc=pB0[0]+pB0[1]; _Pragma("unroll") for(int r=2;r<16;++r)sacc+=pB0[r]; _Pragma("unroll") for(int r=0;r<16;++r)sacc+=pB1[r]; l_reg+=sacc;
    pw0=(u32x4){PKW(pB0,0),PKW(pB0,2),PKW(pB0,4),PKW(pB0,6)};pw1=(u32x4){PKW(pB0,8),PKW(pB0,10),PKW(pB0,12),PKW(pB0,14)};pw2=(u32x4){PKW(pB1,0),PKW(pB1,2),PKW(pB1,4),PKW(pB1,6)};pw3=(u32x4){PKW(pB1,8),PKW(pB1,10),PKW(pB1,12),PKW(pB1,14)};
    SBAR(); pv<4>(o,vb0+2*sl_cur,PAF(0),PAF(1),PAF(2),PAF(3)); }
  #undef PKW
  #undef PAF
  #undef VFR
  #undef PIN
  #undef MX3
  #undef GAPA
  #undef GAPB
  #undef EX
  #undef VRD
  #undef GAPB2
  #undef KRD
  #undef STEP
  #undef ENDW
  {auto rr=__builtin_amdgcn_permlane32_swap(__float_as_uint(l_reg),__float_as_uint(l_reg),false,false);l_reg=__uint_as_float(rr[0])+__uint_as_float(rr[1]);}
  if(hi==0)wsf[32+r32]=l_reg;asm volatile("s_waitcnt lgkmcnt(0)":::"memory");
  float rli[16];
  #pragma unroll
  for(int r=0;r<16;++r)rli[r]=__builtin_amdgcn_rcpf(wsf[32+crow(r,hi)]);
  bf16*Ow=Ob+(long)(wid*QBLK)*OP;
  { bf16*stg=(bf16*)(shm+LDS_OST)+wid*2048;
    #pragma unroll
    for(int hf=0;hf<2;++hf){
      #pragma unroll
      for(int r=0;r<16;++r){const int orow=crow(r,hi);
        #pragma unroll
        for(int d0=0;d0<2;++d0)stg[orow*64+d0*32+r32]=__float2bfloat16(o[2*hf+d0][r]*rli[r]);}
      asm volatile("s_waitcnt lgkmcnt(0)":::"memory");
      #pragma unroll
      for(int i=0;i<4;++i){const int row=i*8+(lane>>3),ch=lane&7; const u32x4 v=*(const u32x4*)(stg+row*64+ch*8); ATTN_STORE16(Ow+(long)row*OP+hf*64+ch*8,v);}
      asm volatile("s_waitcnt lgkmcnt(0)":::"memory"); } }
  asm volatile("s_waitcnt lgkmcnt(0)\n\ts_barrier":::"memory");
  #undef DMA_K
  #undef DMA_V
  #undef CMASK
  #undef START
  #undef RESC
  #undef ROT
}
constexpr int ATTN_LDS_BYTES=LDS_BYTES;
#undef SBAR
#undef WAIT_BAR
}
namespace dn {
constexpr int NCHUNK = 260, GROUP = 6, WREG = 17408  , TP = 72  ;
constexpr int F_WT = 0, F_QKT = 8, F_QD = 14, F_KD = 22, F_U = 30, F_GL = 38;
__device__ __forceinline__ int crow(int r, int hi) { return (r & 3) + 8 * (r >> 2) + 4 * hi; }
__device__ __forceinline__ bf16x8 pack8(const f32x16& x, int s) {
    v4u w; w.x = cvt_pk_bf16(x[8 * s + 0], x[8 * s + 1]); w.y = cvt_pk_bf16(x[8 * s + 2], x[8 * s + 3]); w.z = cvt_pk_bf16(x[8 * s + 4], x[8 * s + 5]); w.w = cvt_pk_bf16(x[8 * s + 6], x[8 * s + 7]);
    return __builtin_bit_cast(bf16x8, w);
}
#define DN_MFMA(a, b, c) __builtin_amdgcn_mfma_f32_32x32x16_bf16(a, b, c, 0, 0, 0)

struct Chain {
    const bf16_t* P1b;
    const bf16_t* QKb;
    bf16_t* Ob;
    int h, dir;
    float Aexp, dtb;
    unsigned char* ring;
    unsigned* dbg;
};
__device__ __forceinline__ int chunk_of(int ci, int dir) { return dir == 0 ? ci : (ci < 4 ? 3 - ci : 263 - ci); }

__device__ __forceinline__ void produce(const Chain& ch, int ci, LAS unsigned char* wl, const LAS float* wct, unsigned char* slot, int lane_in) {
    int lane = lane_in; asm volatile("" : "+v"(lane));
    const int r = lane & 31, hh = lane >> 5;
    const int c = chunk_of(ci, ch.dir), t0 = 64 * c, seg_lo = (c < 4) ? 0 : CTXL, seg_hi = (c < 4) ? CTXL : TT;
    LAS float* Lm = (LAS float*)wl; LAS bf16_t* Tm = (LAS bf16_t*)wl; LAS float* gcT = (LAS float*)(wl + 16384); LAS float* btT = gcT + 64;
    {
        const int tok = ch.dir ? t0 + 63 - lane : t0 + lane;
        const bf16_t* row = ch.P1b + (size_t)tok * P1W;
        const float a = bf2f(row[C_BA + ch.dir * 8 + ch.h]), bb = bf2f(row[C_BB + ch.dir * 8 + ch.h]);
        const float x = a + ch.dtb; const float sp = x > 20.f ? x : log1pf(__expf(x));
        float g = -ch.Aexp * sp;
#pragma unroll
        for (int o = 1; o < 64; o <<= 1) { const float t = __shfl_up(g, o); if (lane >= o) g += t; }
        gcT[lane] = g; btT[lane] = sigmoidf_(bb);
    }
    LDS_WAIT();
    const float gl = gcT[63];
    bf16x8 kA[2][4], qA[2][4], vA[2][4];
#pragma unroll
    for (int rt = 0; rt < 2; ++rt) {
        const int p = 32 * rt + r; const int tok = ch.dir ? t0 + 63 - p : t0 + p;
        const bf16_t* rq = ch.QKb + (size_t)tok * 1536 + ch.h * 64 + 4 * hh; const bf16_t* rk = rq + 512;
        const bf16_t* rv = ch.P1b + (size_t)tok * P1W + C_BQKV + ch.h * 64 + 4 * hh;
#pragma unroll
        for (int s = 0; s < 4; ++s) { const v2u a = *(const v2u*)(rk + 16 * s), b2 = *(const v2u*)(rk + 16 * s + 8); v4u w; w.x = a.x; w.y = a.y; w.z = b2.x; w.w = b2.y; kA[rt][s] = __builtin_bit_cast(bf16x8, w);
            const v2u c2 = *(const v2u*)(rq + 16 * s), d2 = *(const v2u*)(rq + 16 * s + 8); v4u w2; w2.x = c2.x; w2.y = c2.y; w2.z = d2.x; w2.w = d2.y; qA[rt][s] = __builtin_bit_cast(bf16x8, w2);
            const v2u e2 = *(const v2u*)(rv + 16 * s), f2 = *(const v2u*)(rv + 16 * s + 8); v4u w3; w3.x = e2.x; w3.y = e2.y; w3.z = f2.x; w3.w = f2.y; vA[rt][s] = __builtin_bit_cast(bf16x8, w3); }
    }
    __builtin_amdgcn_sched_barrier(0);
    v4u* sl = (v4u*)slot;
    const float gcc0 = gcT[r], gcc1 = gcT[32 + r];
#pragma unroll
    for (int tix = 0; tix < 3; ++tix) {
        const int it = (tix == 0) ? 0 : 1, jt = (tix == 2) ? 1 : 0;
        f32x16 acc = {};
#pragma unroll
        for (int s = 0; s < 4; ++s) acc = DN_MFMA(kA[it][s], kA[jt][s], acc);
        const float gcj = jt ? gcc1 : gcc0; const int j = 32 * jt + r;
#pragma unroll
        for (int rg = 0; rg < 16; ++rg) { const int i = 32 * it + crow(rg, hh); const float gi = gcT[i], bi = btT[i];
            const float v = (i > j) ? bi * acc[rg] * __expf(fminf(gi - gcj, 0.f)) : 0.f; Lm[i * 64 + j] = v; }
    }
#pragma unroll
    for (int tix = 0; tix < 3; ++tix) {
        const int jt = (tix == 2) ? 1 : 0, it = (tix == 0) ? 0 : 1;
        f32x16 acc = {};
#pragma unroll
        for (int s = 0; s < 4; ++s) acc = DN_MFMA(kA[jt][s], qA[it][s], acc);
        const float gci = it ? gcc1 : gcc0; const int i = 32 * it + r;
#pragma unroll
        for (int rg = 0; rg < 16; ++rg) { const int j = 32 * jt + crow(rg, hh); const float gj = gcT[j];
            acc[rg] = (i >= j) ? acc[rg] * __expf(fminf(gci - gj, 0.f)) : 0.f; }
        sl[(F_QKT + tix * 2 + 0) * 64 + lane] = __builtin_bit_cast(v4u, pack8(acc, 0));
        sl[(F_QKT + tix * 2 + 1) * 64 + lane] = __builtin_bit_cast(v4u, pack8(acc, 1));
    }
#pragma unroll
    for (int rt = 0; rt < 2; ++rt) { const float e = __expf(rt ? gcc1 : gcc0);
#pragma unroll
        for (int s = 0; s < 4; ++s) { const v4u w = __builtin_bit_cast(v4u, qA[rt][s]); v4u o;
            o.x = cvt_pk_bf16(bflo(w.x) * e, bfhi(w.x) * e); o.y = cvt_pk_bf16(bflo(w.y) * e, bfhi(w.y) * e); o.z = cvt_pk_bf16(bflo(w.z) * e, bfhi(w.z) * e); o.w = cvt_pk_bf16(bflo(w.w) * e, bfhi(w.w) * e);
            sl[(F_QD + rt * 4 + s) * 64 + lane] = o; } }
    LDS_WAIT();
#if MK_DEBUG == 3
    { unsigned bad = 0u;
      for (int i = 0; i < 64; ++i) { const float lv = Lm[i * 64 + lane]; if (lane < i && !(fabsf(lv) <= 1.5f)) bad |= 1u; }
      if (!(fabsf(gcT[lane]) < 1.0e30f)) bad |= 2u; if (!(btT[lane] >= 0.f && btT[lane] <= 1.f)) bad |= 4u;
      if (bad) atomicOr(ch.dbg, bad); }
#endif
    float T[64];
#pragma unroll
    for (int i = 0; i < 64; ++i) {
        float a = (lane == i) ? 1.f : 0.f;
#pragma unroll
        for (int q = 0; q < (i + 3) / 4; ++q) { const f32x4 l4 = *(const LAS f32x4*)(Lm + i * 64 + 4 * q);
#pragma unroll
            for (int e = 0; e < 4; ++e) if (4 * q + e < i) a -= l4[e] * T[4 * q + e]; }
        T[i] = a;
        if ((i & 3) == 3) __builtin_amdgcn_sched_barrier(0);
    }
    LDS_WAIT();
#pragma unroll
    for (int i = 0; i < 64; ++i) Tm[i * TP + lane] = (bf16_t)f2bf(T[i]);
    LDS_WAIT();
    bf16x8 Tf[3][2];
#pragma unroll
    for (int tix = 0; tix < 3; ++tix) { const int it = (tix == 0) ? 0 : 1, jt = (tix == 2) ? 1 : 0;
#pragma unroll
        for (int s = 0; s < 2; ++s) { const LAS bf16_t* p = Tm + (32 * it + r) * TP + 32 * jt + 16 * s + 4 * hh;
            const v2u a = *(const LAS v2u*)p, b = *(const LAS v2u*)(p + 8); v4u w; w.x = a.x; w.y = a.y; w.z = b.x; w.w = b.y; Tf[tix][s] = __builtin_bit_cast(bf16x8, w); } }
#if MK_DEBUG == 4
    { unsigned bad = 0u;
      _Pragma("unroll") for (int t_ = 0; t_ < 3; ++t_) _Pragma("unroll") for (int s_ = 0; s_ < 2; ++s_) { const v4u w = __builtin_bit_cast(v4u, Tf[t_][s_]);
        const unsigned ws_[4] = {w.x, w.y, w.z, w.w};
        _Pragma("unroll") for (int q_ = 0; q_ < 4; ++q_) { const float lo_ = bflo(ws_[q_]), hi_ = bfhi(ws_[q_]);
          if (!(fabsf(lo_) < 3.0e38f) || !(fabsf(hi_) < 3.0e38f)) bad |= 1u; else if (fabsf(lo_) > 1.0e3f || fabsf(hi_) > 1.0e3f) bad |= 2u; } }
      if (bad) atomicOr(ch.dbg, bad); }
#endif
    bf16x8 If[2];
#pragma unroll
    for (int sp = 0; sp < 2; ++sp) { bf16x8 f_;
#pragma unroll
        for (int jj = 0; jj < 8; ++jj) f_[jj] = ((16 * sp + 8 * (jj >> 2) + 4 * hh + (jj & 3)) == r) ? (short)0x3F80 : (short)0;
        If[sp] = f_; }
    {
        bf16x8 kbg[2][2][2];
#pragma unroll
        for (int jt = 0; jt < 2; ++jt)
#pragma unroll
            for (int dt = 0; dt < 2; ++dt) {
                f32x16 kc = {};
                kc = DN_MFMA(kA[jt][2 * dt + 0], If[0], kc); kc = DN_MFMA(kA[jt][2 * dt + 1], If[1], kc);
                f32x16 kd, kb;
#pragma unroll
                for (int rg = 0; rg < 16; ++rg) { const int j = 32 * jt + crow(rg, hh); const float gj = gcT[j], bj = btT[j];
                    kd[rg] = kc[rg] * __expf(gl - gj); kb[rg] = kc[rg] * bj * __expf(gj); }
                sl[(F_KD + (jt * 2 + dt) * 2 + 0) * 64 + lane] = __builtin_bit_cast(v4u, pack8(kd, 0));
                sl[(F_KD + (jt * 2 + dt) * 2 + 1) * 64 + lane] = __builtin_bit_cast(v4u, pack8(kd, 1));
                kbg[jt][dt][0] = pack8(kb, 0); kbg[jt][dt][1] = pack8(kb, 1);
#if MK_DEBUG == 4
                { bool b_ = false; _Pragma("unroll") for (int rg = 0; rg < 16; ++rg) if (!(fabsf(kb[rg]) < 3.0e38f)) b_ = true; if (b_) atomicOr(ch.dbg, 4u); }
#endif
            }
#pragma unroll
        for (int dt = 0; dt < 2; ++dt)
#pragma unroll
            for (int it = 0; it < 2; ++it) {
                f32x16 wt = {};
#pragma unroll
                for (int s = 0; s < 2; ++s) {
                    if (it == 0) wt = DN_MFMA(kbg[0][dt][s], Tf[0][s], wt);
                    else { wt = DN_MFMA(kbg[0][dt][s], Tf[1][s], wt); wt = DN_MFMA(kbg[1][dt][s], Tf[2][s], wt); }
                }
                asm volatile("s_nop 15\n\ts_nop 7" : "+v"(wt));
                sl[(F_WT + (dt * 2 + it) * 2 + 0) * 64 + lane] = __builtin_bit_cast(v4u, pack8(wt, 0));
                sl[(F_WT + (dt * 2 + it) * 2 + 1) * 64 + lane] = __builtin_bit_cast(v4u, pack8(wt, 1));
            }
    }
    {
        bf16x8 vb[2][2][2];
#pragma unroll
        for (int jt = 0; jt < 2; ++jt)
#pragma unroll
            for (int dvt = 0; dvt < 2; ++dvt) {
                f32x16 vc = {};
                vc = DN_MFMA(vA[jt][2 * dvt + 0], If[0], vc); vc = DN_MFMA(vA[jt][2 * dvt + 1], If[1], vc);
#pragma unroll
                for (int rg = 0; rg < 16; ++rg) { const int j = 32 * jt + crow(rg, hh); vc[rg] *= btT[j]; }
                vb[jt][dvt][0] = pack8(vc, 0); vb[jt][dvt][1] = pack8(vc, 1);
#if MK_DEBUG == 4
                { bool b_ = false; _Pragma("unroll") for (int rg = 0; rg < 16; ++rg) if (!(fabsf(vc[rg]) < 3.0e38f)) b_ = true; if (b_) atomicOr(ch.dbg, 8u); }
#endif
            }
#pragma unroll
        for (int it = 0; it < 2; ++it)
#pragma unroll
            for (int dvt = 0; dvt < 2; ++dvt) {
                f32x16 u = {};
#pragma unroll
                for (int s = 0; s < 2; ++s) {
                    if (it == 0) u = DN_MFMA(Tf[0][s], vb[0][dvt][s], u);
                    else { u = DN_MFMA(Tf[1][s], vb[0][dvt][s], u); u = DN_MFMA(Tf[2][s], vb[1][dvt][s], u); }
                }
                asm volatile("s_nop 15\n\ts_nop 7" : "+v"(u));
                sl[(F_U + (it * 2 + dvt) * 2 + 0) * 64 + lane] = __builtin_bit_cast(v4u, pack8(u, 0));
                sl[(F_U + (it * 2 + dvt) * 2 + 1) * 64 + lane] = __builtin_bit_cast(v4u, pack8(u, 1));
            }
    }
    { v4u gw; gw.x = __float_as_uint(__expf(gl)); gw.y = gw.x; gw.z = gw.x; gw.w = gw.x; sl[F_GL * 64 + lane] = gw; }
}

__device__ __forceinline__ f32x16 unpack16(v4u a, v4u b) {
    f32x16 x;
    x[0] = bflo(a.x); x[1] = bfhi(a.x); x[2] = bflo(a.y); x[3] = bfhi(a.y); x[4] = bflo(a.z); x[5] = bfhi(a.z); x[6] = bflo(a.w); x[7] = bfhi(a.w);
    x[8] = bflo(b.x); x[9] = bfhi(b.x); x[10] = bflo(b.y); x[11] = bfhi(b.y); x[12] = bflo(b.z); x[13] = bfhi(b.z); x[14] = bflo(b.w); x[15] = bfhi(b.w);
    return x;
}
__device__ __forceinline__ void consume(const Chain& ch, int ci, const unsigned char* slot, f32x16 (&S)[2], int hv, int lane_in) {
    int lane = lane_in; asm volatile("" : "+v"(lane));
    const int r = lane & 31, hh = lane >> 5;
    const v4u* sl = (const v4u*)slot;
    v4u fr_[F_U], fU_[4];
#pragma unroll
    for (int i = 0; i < F_U; ++i) fr_[i] = sl[i * 64 + lane];
#pragma unroll
    for (int it = 0; it < 2; ++it)
#pragma unroll
        for (int s = 0; s < 2; ++s) fU_[it * 2 + s] = sl[(F_U + (it * 2 + hv) * 2 + s) * 64 + lane];
    const v4u fgl_ = sl[F_GL * 64 + lane];
    __builtin_amdgcn_sched_barrier(0);
#define DN_FR(idx) __builtin_bit_cast(bf16x8, fr_[idx])
    const float gl = __builtin_bit_cast(float, fgl_.x);
#if MK_DEBUG == 2
    { unsigned bad = 0u;
      auto nf = [](v4u w) { return ((w.x & 0x7f80u) == 0x7f80u) || ((w.x & 0x7f800000u) == 0x7f800000u) || ((w.y & 0x7f80u) == 0x7f80u) || ((w.y & 0x7f800000u) == 0x7f800000u) || ((w.z & 0x7f80u) == 0x7f80u) || ((w.z & 0x7f800000u) == 0x7f800000u) || ((w.w & 0x7f80u) == 0x7f80u) || ((w.w & 0x7f800000u) == 0x7f800000u); };
      if ((__float_as_uint(gl) & 0x7f800000u) == 0x7f800000u) bad |= 1u;
      for (int i = 0; i < 8; ++i) { if (nf(sl[(F_WT + i) * 64 + lane])) bad |= 2u; if (nf(sl[(F_QD + i) * 64 + lane])) bad |= 4u; if (nf(sl[(F_KD + i) * 64 + lane])) bad |= 8u; if (nf(sl[(F_U + i) * 64 + lane])) bad |= 16u; }
      for (int i = 0; i < 6; ++i) if (nf(sl[(F_QKT + i) * 64 + lane])) bad |= 32u;
      if (bad) atomicOr(ch.dbg, bad); }
#endif
    asm volatile("s_nop 15\n\ts_nop 7" : "+v"(S[0]), "+v"(S[1]));
    bf16x8 Sb[2][2];
#pragma unroll
    for (int dt = 0; dt < 2; ++dt) { Sb[dt][0] = pack8(S[dt], 0); Sb[dt][1] = pack8(S[dt], 1); }
    f32x16 accv[2], acco[2];
#pragma unroll
    for (int it = 0; it < 2; ++it) { accv[it] = f32x16{}; acco[it] = f32x16{};
#pragma unroll
        for (int dt = 0; dt < 2; ++dt)
#pragma unroll
            for (int s = 0; s < 2; ++s) {
                accv[it] = DN_MFMA(DN_FR(F_WT + (dt * 2 + it) * 2 + s), Sb[dt][s], accv[it]);
                acco[it] = DN_MFMA(DN_FR(F_QD + it * 4 + 2 * dt + s), Sb[dt][s], acco[it]);
            } }
    bf16x8 vb[2][2];
#pragma unroll
    for (int it = 0; it < 2; ++it) {
        const f32x16 u = unpack16(fU_[it * 2 + 0], fU_[it * 2 + 1]);
        const f32x16 vn = u - accv[it];
        vb[it][0] = pack8(vn, 0); vb[it][1] = pack8(vn, 1);
    }
#pragma unroll
    for (int s = 0; s < 2; ++s) {
        acco[0] = DN_MFMA(DN_FR(F_QKT + 0 * 2 + s), vb[0][s], acco[0]);
        acco[1] = DN_MFMA(DN_FR(F_QKT + 1 * 2 + s), vb[0][s], acco[1]);
        acco[1] = DN_MFMA(DN_FR(F_QKT + 2 * 2 + s), vb[1][s], acco[1]);
    }
#pragma unroll
    for (int dt = 0; dt < 2; ++dt) {
        S[dt] = S[dt] * gl;
#pragma unroll
        for (int jt = 0; jt < 2; ++jt)
#pragma unroll
            for (int s = 0; s < 2; ++s) S[dt] = DN_MFMA(DN_FR(F_KD + (jt * 2 + dt) * 2 + s), vb[jt][s], S[dt]);
    }
    const int c = chunk_of(ci, ch.dir), t0 = 64 * c;
#pragma unroll
    for (int it = 0; it < 2; ++it)
#pragma unroll
        for (int rg = 0; rg < 16; ++rg) { const int i = 32 * it + crow(rg, hh); const int tok = ch.dir ? t0 + 63 - i : t0 + i;
            ch.Ob[(size_t)tok * 512 + ch.h * 64 + 32 * hv + r] = (bf16_t)f2bf(acco[it][rg]); }
#undef DN_FR
}

__device__ __forceinline__ void chain_unit(const Chain& ch, const float* wconv  , LAS unsigned char* lds, LAS float* wct, int wave) {
    const int lane = hw_lane(), wid = wave, tid = wave * 64 + lane;
    __syncthreads();
    constexpr int NG = (NCHUNK + GROUP - 1) / GROUP;
#define DN_BAR() do { asm volatile("s_waitcnt vmcnt(0) lgkmcnt(0)" ::: "memory"); __builtin_amdgcn_s_barrier(); asm volatile("" ::: "memory"); } while (0)
    if (wid >= 2) {
        for (int k = 0; k <= NG; ++k) {
            const int ci = k * GROUP + (wid - 2);
#ifndef NO_DNP
            if (k < NG && ci < NCHUNK) produce(ch, ci, lds + wid * WREG, wct, ch.ring + (size_t)((k & 1) * GROUP + (wid - 2)) * RING_SLOT, lane);
#endif
            DN_BAR();
        }
    } else {
        f32x16 S[2]; S[0] = f32x16{}; S[1] = f32x16{};
        for (int k = 0; k <= NG; ++k) {
#ifndef NO_DNC
            if (k >= 1) { const int g0 = (k - 1) * GROUP; const int n = (NCHUNK - g0 < GROUP) ? NCHUNK - g0 : GROUP;
                for (int j = 0; j < n; ++j) consume(ch, g0 + j, ch.ring + (size_t)(((k - 1) & 1) * GROUP + j) * RING_SLOT, S, wid, lane); }
#endif
            DN_BAR();
        }
    }
#undef DN_BAR
    __syncthreads();
}
#undef DN_MFMA
}
struct Params {
    const float* in[28];
    float* out; unsigned char* ws;
    int ph_lo, ph_hi; int use_bar; int pad;
};
enum { I_X = 0, I_C, I_CTX, I_CCTX, I_WMOD, I_BMOD, I_GN1, I_GN2, I_WIN, I_GQ, I_GK, I_WCONV, I_ALOG, I_DTB, I_GDN, I_LAMQK, I_GSUB, I_WBR, I_WOUT, I_WRT, I_BRT,
       I_WEG, I_WEU, I_WED, I_WSG, I_WSU, I_WSD, I_GFIN };
struct Frame {
    LAS unsigned char* lds; volatile LAS unsigned* MISC; gu32* ctl;
    int tid, lane, wave, G, gw, NGW;
    GAS unsigned char* ws;
};
__device__ __forceinline__ size_t hrow_off(int r, bool& isctx, int& b) { b = r / TT; const int t = r - b * TT; isctx = t < CTXL; return isctx ? (size_t)(b * CTXL + t) * DM : (size_t)(b * SEQ + (t - CTXL)) * DM; }

__device__ __forceinline__ void transpose_item(const float* W, int ldw, int k0, int n0, bf16_t* WT, int K, int dst_row0, LAS float* scr, int lane) {
    float tv[32];
#pragma unroll
    for (int i = 0; i < 32; ++i) { const int kk = 2 * i + (lane >> 5); tv[i] = W[(size_t)(k0 + kk) * ldw + n0 + (lane & 31)]; }
#pragma unroll
    for (int i = 0; i < 32; ++i) { const int kk = 2 * i + (lane >> 5); scr[kk * 33 + (lane & 31)] = tv[i]; }
    LDS_WAIT(); asm volatile("" ::: "memory");
    const int c = lane & 7;
#pragma unroll
    for (int j = 0; j < 4; ++j) { const int n = (lane >> 3) + 8 * j; const LAS float* s = scr + (8 * c) * 33 + n;
        v4u o; o.x = pk2(s[0 * 33], s[1 * 33]); o.y = pk2(s[2 * 33], s[3 * 33]); o.z = pk2(s[4 * 33], s[5 * 33]); o.w = pk2(s[6 * 33], s[7 * 33]);
        *(v4u*)(WT + (size_t)(dst_row0 + n) * K + k0 + 8 * c) = o; }
    LDS_WAIT(); asm volatile("" ::: "memory");
}
__device__ __forceinline__ void convert_small(Frame& F, const Params& P, int l) {
    LAS float* scr = (LAS float*)(F.lds + RING_OFF + F.wave * 16384);
    const float* win = P.in[I_WIN] + (size_t)l * DM * INW;
    const float* wbr = P.in[I_WBR] + (size_t)l * 3 * 512 * DM;
    const float* wo = P.in[I_WOUT] + (size_t)l * DM * DM;
    bf16_t* WB1 = (bf16_t*)(F.ws + WS_WB1); bf16_t* WB2 = (bf16_t*)(F.ws + WS_WB2); bf16_t* WBR = (bf16_t*)(F.ws + WS_WBR); bf16_t* WOT = (bf16_t*)(F.ws + WS_WOT);
    constexpr int I1 = 16 * (P1W / 32), I2 = 16 * (GW / 32), I3 = 3 * 8 * 32, I4 = 16 * 32;
    for (int it = F.gw; it < I1 + I2 + I3 + I4; it += F.NGW) {
        int r = it;
        if (r < I1) { const int nb = r % (P1W / 32), kb = r / (P1W / 32); transpose_item(win, INW, 64 * kb, 32 * nb, WB1, DM, 32 * nb, scr, F.lane); continue; } r -= I1;
        if (r < I2) { const int nb = r % (GW / 32), kb = r / (GW / 32); transpose_item(win, INW, 64 * kb, C_GATE + 32 * nb, WB2, DM, 32 * nb, scr, F.lane); continue; } r -= I2;
        if (r < I3) { const int br = r / 256, q = r % 256, nb = q % 32, kb = q / 32; transpose_item(wbr + (size_t)br * 512 * DM, DM, 64 * kb, 32 * nb, WBR + (size_t)br * DM * 512, 512, 32 * nb, scr, F.lane); continue; } r -= I3;
        { const int nb = r % 32, kb = r / 32; transpose_item(wo, DM, 64 * kb, 32 * nb, WOT, DM, 32 * nb, scr, F.lane); }
    }
}
__device__ __forceinline__ void convert_experts(Frame& F, const Params& P, int l) {
    LAS float* scr = (LAS float*)(F.lds + RING_OFF + F.wave * 16384);
    bf16_t* WGU = (bf16_t*)(F.ws + WS_B); bf16_t* WD = WGU + (size_t)NEXP1 * 512 * DM;
    for (int it = F.gw; it < NEXP1 * 384; it += F.NGW) {
        const int e = it / 384; int r = it % 384;
        const float* wg = (e < NEXP) ? P.in[I_WEG] + ((size_t)l * NEXP + e) * DM * FF : P.in[I_WSG] + (size_t)l * DM * FF;
        const float* wu = (e < NEXP) ? P.in[I_WEU] + ((size_t)l * NEXP + e) * DM * FF : P.in[I_WSU] + (size_t)l * DM * FF;
        const float* wd = (e < NEXP) ? P.in[I_WED] + ((size_t)l * NEXP + e) * FF * DM : P.in[I_WSD] + (size_t)l * FF * DM;
        if (r < 256) { const bool up = r >= 128; r &= 127; const int nb = r % 8, kb = r / 8; const int n0 = 32 * nb;
            transpose_item(up ? wu : wg, FF, 64 * kb, n0, WGU + (size_t)e * 512 * DM, DM, (n0 / 128) * 256 + (up ? 128 : 0) + (n0 % 128), scr, F.lane); }
        else { r -= 256; const int nb = r % 32, kb = r / 32; transpose_item(wd, DM, 64 * kb, 32 * nb, WD + (size_t)e * DM * FF, FF, 32 * nb, scr, F.lane); }
    }
}
__device__ __forceinline__ void compute_mod(Frame& F, const Params& P) {
    float* modv = (float*)(F.ws + WS_MODV);
    const int kq = F.lane >> 3, nn = F.lane & 7;
    for (int it = F.gw; it < NLAYER * (6144 / 8); it += F.NGW) {
        const int l = it / (6144 / 8), n = (it % (6144 / 8)) * 8 + nn;
        const float* w = P.in[I_WMOD] + (size_t)l * DM * 6144 + n;
        float a0 = 0.f, a1 = 0.f, a2 = 0.f;
#pragma unroll 16
        for (int i = 0; i < 128; ++i) { const int k = kq + 8 * i; const float wv = w[(size_t)k * 6144];
            a0 += siluf_(P.in[I_C][k]) * wv; a1 += siluf_(P.in[I_C][DM + k]) * wv; a2 += siluf_(P.in[I_CCTX][k]) * wv; }
#pragma unroll
        for (int o = 8; o < 64; o <<= 1) { a0 += __shfl_xor(a0, o); a1 += __shfl_xor(a1, o); a2 += __shfl_xor(a2, o); }
        if (kq == 0) { const float bm = P.in[I_BMOD][l * 6144 + n]; float* m = modv + (size_t)l * 3 * 6144 + n; m[0] = a0 + bm; m[6144] = a1 + bm; m[2 * 6144] = a2 + bm; }
    }
}
__device__ __forceinline__ void modnorm_store(const float (&x)[16], const float* g, const float* sc, const float* sh, bf16_t* orow, int lane) {
    float ss = 0.f;
#pragma unroll
    for (int i = 0; i < 16; ++i) ss += x[i] * x[i];
    const float rstd = rsqrtf(wave_sum(ss) * (1.f / DM) + EPS);
#pragma unroll
    for (int hf = 0; hf < 2; ++hf) { const int c0 = hf * 512 + lane * 8; float y[8];
#pragma unroll
        for (int j = 0; j < 8; ++j) y[j] = x[hf * 8 + j] * rstd * g[c0 + j] * (1.f + sc[c0 + j]) + sh[c0 + j];
        v4u w; w.x = cvt_pk_bf16(y[0], y[1]); w.y = cvt_pk_bf16(y[2], y[3]); w.z = cvt_pk_bf16(y[4], y[5]); w.w = cvt_pk_bf16(y[6], y[7]);
        *(v4u*)(orow + c0) = w; }
}
__device__ __forceinline__ void load_row16(const float* row, float (&x)[16], int lane) {
#pragma unroll
    for (int hf = 0; hf < 2; ++hf) { const f32x4 a = *(const f32x4*)(row + hf * 512 + lane * 8), b = *(const f32x4*)(row + hf * 512 + lane * 8 + 4);
        x[hf * 8 + 0] = a[0]; x[hf * 8 + 1] = a[1]; x[hf * 8 + 2] = a[2]; x[hf * 8 + 3] = a[3]; x[hf * 8 + 4] = b[0]; x[hf * 8 + 5] = b[1]; x[hf * 8 + 6] = b[2]; x[hf * 8 + 7] = b[3]; }
}
__device__ __forceinline__ void phase_norm1(Frame& F, const Params& P) {
    const float* modv = (const float*)(F.ws + WS_MODV); bf16_t* U = (bf16_t*)(F.ws + WS_C);
    for (int r = F.gw; r < MROWS; r += 2 * F.NGW) {
        const bool has1 = r + F.NGW < MROWS; const int r1 = has1 ? r + F.NGW : r;
        bool ic0, ic1; int b0, b1; const size_t off0 = hrow_off(r, ic0, b0), off1 = hrow_off(r1, ic1, b1);
        float x0[16], x1[16]; load_row16((ic0 ? P.in[I_CTX] : P.in[I_X]) + off0, x0, F.lane); load_row16((ic1 ? P.in[I_CTX] : P.in[I_X]) + off1, x1, F.lane);
        { const float* mv = modv + (ic0 ? 2 : b0) * 6144; modnorm_store(x0, P.in[I_GN1], mv + 1 * DM, mv + 0 * DM, U + (size_t)r * DM, F.lane); }
        if (has1) { const float* mv = modv + (ic1 ? 2 : b1) * 6144; modnorm_store(x1, P.in[I_GN1], mv + 1 * DM, mv + 0 * DM, U + (size_t)r1 * DM, F.lane); } }
}
__device__ __forceinline__ void unpack8(const v4u w, float (&x)[8]) { x[0] = bflo(w.x); x[1] = bfhi(w.x); x[2] = bflo(w.y); x[3] = bfhi(w.y); x[4] = bflo(w.z); x[5] = bfhi(w.z); x[6] = bflo(w.w); x[7] = bfhi(w.w); }
__device__ __forceinline__ void load_row16_bf(const bf16_t* row, float (&x)[16], int lane) {
#pragma unroll
    for (int hf = 0; hf < 2; ++hf) { const v4u w = *(const v4u*)(row + hf * 512 + lane * 8); float t[8]; unpack8(w, t);
#pragma unroll
        for (int j = 0; j < 8; ++j) x[hf * 8 + j] = t[j]; }
}
__device__ __forceinline__ v4u pack8f(const float (&y)[8]) { v4u w; w.x = cvt_pk_bf16(y[0], y[1]); w.y = cvt_pk_bf16(y[2], y[3]); w.z = cvt_pk_bf16(y[4], y[5]); w.w = cvt_pk_bf16(y[6], y[7]); return w; }
__device__ __forceinline__ void phase_prep(Frame& F, const Params& P, int l, bool dry = false) {
    bf16_t* P1 = (bf16_t*)(F.ws + WS_A);
    const int lane = F.lane, c = lane & 3, i5 = lane & 31, hd = lane >> 2; const bool act = hd < 10;
    const float inv = exp2f(-(float)(i5 & 15) * (13.287712379549449f / 16.f));
    float gk[16];
#pragma unroll
    for (int e = 0; e < 8; ++e) { gk[e] = P.in[I_GK][l * 64 + 8 * c + e]; gk[8 + e] = P.in[I_GK][l * 64 + 32 + 8 * c + e]; }
    const int col = !act ? C_AK : (hd < 2 ? C_AK + hd * 64 : C_CK + (hd - 2) * 64); const bool nrm = hd < 2;
    float kmx[2] = {0.f, 0.f};
    auto body = [&](int r, const v4u w0, const v4u w1) {
        const int b = r / TT, t = r - b * TT; const bool lat = t >= CTXL;
        float cs = 1.f, sn = 0.f;
        if (lat) { const int s = t - CTXL; const float pos = (i5 < 16) ? (float)(s / GRIDW) : (float)(s % GRIDW); sincosf(pos * inv, &sn, &cs); }
        float cse[8], sne[8];
#pragma unroll
        for (int e = 0; e < 8; ++e) { cse[e] = __shfl(cs, 8 * c + e); sne[e] = __shfl(sn, 8 * c + e); }
        bf16_t* row = P1 + (size_t)r * P1W;
        float x0[8], x1[8]; unpack8(w0, x0); unpack8(w1, x1);
        if (nrm) { float ss = 0.f;
#pragma unroll
            for (int e = 0; e < 8; ++e) ss += x0[e] * x0[e] + x1[e] * x1[e];
            ss += __shfl_xor(ss, 1); ss += __shfl_xor(ss, 2);
            const float rstd = rsqrtf(ss * (1.f / 64.f) + EPS);
#pragma unroll
            for (int e = 0; e < 8; ++e) { x0[e] *= rstd * gk[e]; x1[e] *= rstd * gk[8 + e]; } }
        float y0[8], y1[8];
#pragma unroll
        for (int e = 0; e < 8; ++e) { y0[e] = x0[e] * cse[e] - x1[e] * sne[e]; y1[e] = x1[e] * cse[e] + x0[e] * sne[e]; }
        const v4u pk0 = pack8f(y0), pk1 = pack8f(y1);
        if (act && (!dry || y0[0] == 123456.f)) { *(v4u*)(row + col + 8 * c) = pk0; *(v4u*)(row + col + 32 + 8 * c) = pk1; }
        { float z0[8], z1[8]; unpack8(pk0, z0); unpack8(pk1, z1); float ks = 0.f;
#pragma unroll
          for (int e = 0; e < 8; ++e) ks += z0[e] * z0[e] + z1[e] * z1[e];
          ks += __shfl_xor(ks, 1); ks += __shfl_xor(ks, 2);
          if (b == 0) kmx[0] = fmaxf(kmx[0], ks); else kmx[1] = fmaxf(kmx[1], ks); }
    };
    for (int r = F.gw; r < MROWS; r += 4 * F.NGW) {
        int rr[4]; v4u wa[4], wb[4];
#pragma unroll
        for (int q = 0; q < 4; ++q) { rr[q] = r + q * F.NGW; const int rq = rr[q] < MROWS ? rr[q] : r; const bf16_t* row = P1 + (size_t)rq * P1W; wa[q] = *(const v4u*)(row + col + 8 * c); wb[q] = *(const v4u*)(row + col + 32 + 8 * c); }
#pragma unroll
        for (int q = 0; q < 4; ++q) if (rr[q] < MROWS) body(rr[q], wa[q], wb[q]);
    }
    if (!dry && act && c == 0) { atomicMax((int*)(F.ctl + CW_KMAX + (l * 2 + 0) * 16 + hd), __float_as_int(kmx[0])); atomicMax((int*)(F.ctl + CW_KMAX + (l * 2 + 1) * 16 + hd), __float_as_int(kmx[1])); }
}
__device__ __forceinline__ void phase_dn_prep(Frame& F, const Params& P, int l) {
    bf16_t* P1 = (bf16_t*)(F.ws + WS_A); bf16_t* BR = (bf16_t*)(F.ws + WS_B);
    const float* wc = P.in[I_WCONV] + (size_t)l * 3 * 1536;
    const int lane = F.lane;
    float w0[2][8], w1[2][8], w2[2][8];
#pragma unroll
    for (int ps = 0; ps < 2; ++ps) { const int ch0 = (ps * 64 + lane) * 8;
#pragma unroll
        for (int e = 0; e < 8; ++e) { w0[ps][e] = wc[0 * 1536 + ch0 + e]; w1[ps][e] = wc[1 * 1536 + ch0 + e]; w2[ps][e] = wc[2 * 1536 + ch0 + e]; } }
    for (int r0 = F.gw; r0 < MROWS; r0 += 2 * F.NGW) {
        int rr[2]; bool hm[2], hp[2]; v4u wc_[2][2], wm_[2][2], wp_[2][2];
#pragma unroll
        for (int q = 0; q < 2; ++q) { rr[q] = r0 + q * F.NGW; const int r = rr[q] < MROWS ? rr[q] : r0;
            const int b = r / TT, t = r - b * TT; const int seg_lo = (t < CTXL) ? 0 : CTXL, seg_hi = (t < CTXL) ? CTXL : TT;
            hm[q] = (t - 1 >= seg_lo); hp[q] = (t + 1 < seg_hi);
            const bf16_t* rowc = P1 + (size_t)r * P1W + C_BQKV; const bf16_t* rowm = hm[q] ? rowc - P1W : rowc; const bf16_t* rowp = hp[q] ? rowc + P1W : rowc;
#pragma unroll
            for (int ps = 0; ps < 2; ++ps) { const int ch0 = (ps * 64 + lane) * 8; wc_[q][ps] = *(const v4u*)(rowc + ch0); wm_[q][ps] = *(const v4u*)(rowm + ch0); wp_[q][ps] = *(const v4u*)(rowp + ch0); } }
#pragma unroll
        for (int q = 0; q < 2; ++q) { if (rr[q] >= MROWS) continue; const int r = rr[q]; const bool hasm = hm[q], hasp = hp[q];
#pragma unroll
        for (int ps = 0; ps < 2; ++ps) { const int ch0 = (ps * 64 + lane) * 8;
            float xc[8], xm[8], xp[8]; unpack8(wc_[q][ps], xc); unpack8(wm_[q][ps], xm); unpack8(wp_[q][ps], xp);
            float y[8]; float ss = 0.f;
#pragma unroll
            for (int e = 0; e < 8; ++e) { const float v = (hasm ? xm[e] * w0[ps][e] : 0.f) + xc[e] * w1[ps][e] + (hasp ? xp[e] * w2[ps][e] : 0.f); y[e] = siluf_(v); ss += y[e] * y[e]; }
            ss += __shfl_xor(ss, 1); ss += __shfl_xor(ss, 2); ss += __shfl_xor(ss, 4);
            const float sc = rsqrtf(ss + EPS) * (ps == 0 ? 0.125f : 1.f);
#pragma unroll
            for (int e = 0; e < 8; ++e) y[e] *= sc;
            *(v4u*)(BR + (size_t)r * 1536 + 512 + ch0) = pack8f(y); } }
    }
}
__device__ __forceinline__ void phase_dn_prep_v(Frame& F, const Params& P, int l) {
    bf16_t* P1 = (bf16_t*)(F.ws + WS_A);
    const float* wc = P.in[I_WCONV] + (size_t)l * 3 * 1536 + 1024;
    const int lane = F.lane; const int ch0 = lane * 8;
    float w0[8], w1[8], w2[8];
#pragma unroll
    for (int e = 0; e < 8; ++e) { w0[e] = wc[0 * 1536 + ch0 + e]; w1[e] = wc[1 * 1536 + ch0 + e]; w2[e] = wc[2 * 1536 + ch0 + e]; }
    for (int r0 = F.gw; r0 < MROWS; r0 += 4 * F.NGW) {
        int rr[4]; bool hm[4], hp[4]; v4u wc_[4], wm_[4], wp_[4];
#pragma unroll
        for (int q = 0; q < 4; ++q) { rr[q] = r0 + q * F.NGW; const int r = rr[q] < MROWS ? rr[q] : r0;
            const int b = r / TT, t = r - b * TT; const int seg_lo = (t < CTXL) ? 0 : CTXL, seg_hi = (t < CTXL) ? CTXL : TT;
            hm[q] = (t - 1 >= seg_lo); hp[q] = (t + 1 < seg_hi);
            const bf16_t* rowc = P1 + (size_t)r * P1W + C_BQKV + 1024; const bf16_t* rowm = hm[q] ? rowc - P1W : rowc; const bf16_t* rowp = hp[q] ? rowc + P1W : rowc;
            wc_[q] = *(const v4u*)(rowc + ch0); wm_[q] = *(const v4u*)(rowm + ch0); wp_[q] = *(const v4u*)(rowp + ch0); }
#pragma unroll
        for (int q = 0; q < 4; ++q) { if (rr[q] >= MROWS) continue; const bool hasm = hm[q], hasp = hp[q];
            float xc[8], xm[8], xp[8]; unpack8(wc_[q], xc); unpack8(wm_[q], xm); unpack8(wp_[q], xp);
            float y[8];
#pragma unroll
            for (int e = 0; e < 8; ++e) { const float v = (hasm ? xm[e] * w0[e] : 0.f) + xc[e] * w1[e] + (hasp ? xp[e] * w2[e] : 0.f); y[e] = siluf_(v); }
            *(v4u*)(P1 + (size_t)rr[q] * P1W + C_BQKV + ch0) = pack8f(y); }
    }
}
__device__ __forceinline__ void phase_post(Frame& F, const Params& P, int l) {
    const bf16_t* P1 = (const bf16_t*)(F.ws + WS_A); bf16_t* BR = (bf16_t*)(F.ws + WS_B);
    const bf16_t* DO = (const bf16_t*)(F.ws + WS_D); const bf16_t* OFw = DO + (size_t)MROWS * 1024; const bf16_t* OBw = OFw + (size_t)MROWS * 512;
    const int lane = F.lane;
    const float linit = 0.8f - 0.6f * expf(-0.3f * (float)l);
    const float* lq = P.in[I_LAMQK] + l * 256;
    const float lam = expf(wave_sum(lq[lane] * lq[64 + lane])) - expf(wave_sum(lq[128 + lane] * lq[192 + lane])) + linit;
    float gdn[8], gsb[8];
#pragma unroll
    for (int e = 0; e < 8; ++e) { gdn[e] = P.in[I_GDN][l * 64 + (lane & 7) * 8 + e]; gsb[e] = P.in[I_GSUB][l * 128 + (lane & 15) * 8 + e] * (1.f - linit); }
    const int hq = lane >> 4, e0 = (lane & 15) * 8;
    for (int r0 = F.gw; r0 < MROWS; r0 += 2 * F.NGW) {
        int rr[2]; v4u wf_[2], wb_[2], wz_[2], d0_[2], d1_[2];
#pragma unroll
        for (int q = 0; q < 2; ++q) { rr[q] = r0 + q * F.NGW; const int r = rr[q] < MROWS ? rr[q] : r0;
            wf_[q] = *(const v4u*)(OFw + (size_t)r * 512 + lane * 8); wb_[q] = *(const v4u*)(OBw + (size_t)r * 512 + lane * 8); wz_[q] = *(const v4u*)(P1 + (size_t)r * P1W + C_BZ + lane * 8);
            d0_[q] = *(const v4u*)(DO + (size_t)r * 1024 + (2 * hq) * 128 + e0); d1_[q] = *(const v4u*)(DO + (size_t)r * 1024 + (2 * hq + 1) * 128 + e0); }
#pragma unroll
        for (int q = 0; q < 2; ++q) { if (rr[q] >= MROWS) continue; const int r = rr[q];
        { float a[8], bq[8], z[8], y[8]; unpack8(wf_[q], a); unpack8(wb_[q], bq); unpack8(wz_[q], z); float ss = 0.f;
#pragma unroll
          for (int e = 0; e < 8; ++e) { a[e] += bq[e]; ss += a[e] * a[e]; }
          ss += __shfl_xor(ss, 1); ss += __shfl_xor(ss, 2); ss += __shfl_xor(ss, 4);
          const float rstd = rsqrtf(ss * (1.f / 64.f) + EPS);
#pragma unroll
          for (int e = 0; e < 8; ++e) y[e] = a[e] * rstd * gdn[e] * siluf_(z[e]);
          *(v4u*)(BR + (size_t)r * 1536 + 512 + lane * 8) = pack8f(y); }
        { float a[8], bq[8], y[8]; unpack8(d0_[q], a); unpack8(d1_[q], bq); float ss = 0.f;
#pragma unroll
          for (int e = 0; e < 8; ++e) { a[e] -= lam * bq[e]; ss += a[e] * a[e]; }
          ss += __shfl_xor(ss, 1); ss += __shfl_xor(ss, 2); ss += __shfl_xor(ss, 4); ss += __shfl_xor(ss, 8);
          const float rstd = rsqrtf(ss * (1.f / 128.f) + EPS);
#pragma unroll
          for (int e = 0; e < 8; ++e) y[e] = a[e] * rstd * gsb[e];
          *(v4u*)(BR + (size_t)r * 1536 + 1024 + lane * 8) = pack8f(y); } }
    }
}
__device__ __forceinline__ void phase_norm2_router(Frame& F, const Params& P, int l, bool dry = false) {
    const float* modv = (const float*)(F.ws + WS_MODV) + (size_t)l * 3 * 6144; bf16_t* U = (bf16_t*)(F.ws + WS_C);
    const bf16_t* hlat = (const bf16_t*)(F.ws + WS_HB); const float* hctx = (const float*)(F.ws + WS_HCTX);
    int* tope = (int*)(F.ws + WS_TOPE); float* topw = (float*)(F.ws + WS_TOPW); int* tops = (int*)(F.ws + WS_TOPS);
    constexpr int VSP = DM + 4;
    LAS float* vS = (LAS float*)(F.lds + RING_OFF);
    const float* wr = P.in[I_WRT] + (size_t)l * DM * NEXP; const float brt = P.in[I_BRT][l * NEXP + F.lane];
    const float* g2 = P.in[I_GN2] + l * DM;
    const int lane = F.lane;
    for (int base = blockIdx.x * 32; base < MROWS; base += F.G * 32) {
        const int r0 = base + 4 * F.wave;
        __syncthreads();
        float xq[4][16];
#pragma unroll
        for (int q = 0; q < 4; ++q) { bool isctx_; int b_; const size_t off_ = hrow_off(r0 + q, isctx_, b_); if (isctx_) load_row16(hctx + off_, xq[q], lane); else load_row16_bf(hlat + off_, xq[q], lane); }
#pragma unroll
        for (int q = 0; q < 4; ++q) { const int r = r0 + q; bool isctx; int b; const size_t off = hrow_off(r, isctx, b); (void)off;
            float (&x)[16] = xq[q];
            const float* mv = modv + (isctx ? 2 : b) * 6144; const float* sc = mv + 4 * DM; const float* sh = mv + 3 * DM;
            float ss = 0.f;
#pragma unroll
            for (int i = 0; i < 16; ++i) ss += x[i] * x[i];
            const float rstd = rsqrtf(wave_sum(ss) * (1.f / DM) + EPS);
#pragma unroll
            for (int hf = 0; hf < 2; ++hf) { const int c0 = hf * 512 + lane * 8; float y[8];
#pragma unroll
                for (int j = 0; j < 8; ++j) y[j] = x[hf * 8 + j] * rstd * g2[c0 + j] * (1.f + sc[c0 + j]) + sh[c0 + j];
                { LAS float* vp = vS + (4 * F.wave + q) * VSP + c0; *(LAS f32x4*)vp = (f32x4){y[0], y[1], y[2], y[3]}; *(LAS f32x4*)(vp + 4) = (f32x4){y[4], y[5], y[6], y[7]}; }
                v4u w; w.x = cvt_pk_bf16(y[0], y[1]); w.y = cvt_pk_bf16(y[2], y[3]); w.z = cvt_pk_bf16(y[4], y[5]); w.w = cvt_pk_bf16(y[6], y[7]);
                *(v4u*)(U + (size_t)r * DM + c0) = w; } }
        __syncthreads();
        f32x4 lacc0 = {0.f, 0.f, 0.f, 0.f}, lacc1 = {0.f, 0.f, 0.f, 0.f};
        { const int i16 = lane & 15, kk = lane >> 4, rt = F.wave >> 2, ct = F.wave & 3;
          const LAS float* ap = vS + (16 * rt + i16) * VSP + 256 * kk; const float* bp = wr + (size_t)(256 * kk) * NEXP + 16 * ct + i16;
#pragma unroll 8
          for (int s4 = 0; s4 < 64; ++s4) { const f32x4 av = *(const LAS f32x4*)(ap + 4 * s4);
              const float b0 = bp[(size_t)(4 * s4 + 0) * NEXP], b1 = bp[(size_t)(4 * s4 + 1) * NEXP], b2 = bp[(size_t)(4 * s4 + 2) * NEXP], b3 = bp[(size_t)(4 * s4 + 3) * NEXP];
              lacc0 = __builtin_amdgcn_mfma_f32_16x16x4f32(av[0], b0, lacc0, 0, 0, 0); lacc1 = __builtin_amdgcn_mfma_f32_16x16x4f32(av[1], b1, lacc1, 0, 0, 0);
              lacc0 = __builtin_amdgcn_mfma_f32_16x16x4f32(av[2], b2, lacc0, 0, 0, 0); lacc1 = __builtin_amdgcn_mfma_f32_16x16x4f32(av[3], b3, lacc1, 0, 0, 0); }
          lacc0 = lacc0 + lacc1; }
        __syncthreads();
        { const int j16 = lane & 15, rq = lane >> 4, rt = F.wave >> 2, ct = F.wave & 3;
#pragma unroll
          for (int g = 0; g < 4; ++g) vS[(16 * rt + 4 * rq + g) * NEXP + 16 * ct + j16] = lacc0[g]; }
        __syncthreads();
        const float a0 = vS[(4 * F.wave + 0) * NEXP + lane], a1 = vS[(4 * F.wave + 1) * NEXP + lane], a2 = vS[(4 * F.wave + 2) * NEXP + lane], a3 = vS[(4 * F.wave + 3) * NEXP + lane];
        LDS_WAIT();
#pragma unroll 1
        for (int q = 0; q < 4; ++q) { const int r = r0 + q; const float lg = q == 0 ? a0 : (q == 1 ? a1 : (q == 2 ? a2 : a3));
            const float sc = 1.f / (1.f + expf(-lg)); const float sel = sc + brt;
            float m1 = sel;
#pragma unroll
            for (int o = 1; o < 8; o <<= 1) m1 = fmaxf(m1, __shfl_xor(m1, o));
            int fi = (sel == m1) ? lane : 999;
#pragma unroll
            for (int o = 1; o < 8; o <<= 1) fi = min(fi, __shfl_xor(fi, o));
            float m2 = (lane == fi) ? -INFINITY : sel;
#pragma unroll
            for (int o = 1; o < 8; o <<= 1) m2 = fmaxf(m2, __shfl_xor(m2, o));
            const float gs = m1 + m2; const int g = lane >> 3;
            int grank = 0;
#pragma unroll
            for (int gg = 0; gg < 8; ++gg) { const float o = __builtin_bit_cast(float, __builtin_amdgcn_readlane(__builtin_bit_cast(int, gs), gg * 8)); grank += (o > gs || (o == gs && gg < g)) ? 1 : 0; }
            const float val = (grank < 4) ? sel : -INFINITY;
            int rank = 0;
#pragma unroll 4
            for (int e = 0; e < 64; ++e) { const float o = __builtin_bit_cast(float, __builtin_amdgcn_readlane(__builtin_bit_cast(int, val), e)); rank += (o > val || (o == val && e < lane)) ? 1 : 0; }
            const bool selx = (grank < 4) && (rank < TOPK);
            const float wsum = wave_sum(selx ? sc : 0.f);
            const int half = r / TT;
            if (selx && (!dry || wsum == 123456.f)) { const int slot = atomicAdd((int*)(F.ctl + CW_ECNT + ((l * 2 + half) * NEXP1 + lane) * 16), 1);
                tope[(size_t)r * 8 + rank] = lane; topw[(size_t)r * 8 + rank] = sc / (wsum + 1e-20f) * 2.5f; tops[(size_t)r * 8 + rank] = slot; }
            if (lane == 0 && !dry) { tope[(size_t)r * 8 + 6] = NEXP; topw[(size_t)r * 8 + 6] = 1.f; tops[(size_t)r * 8 + 6] = r - half * TT; }
        }
    }
}
__device__ __forceinline__ void moe_table(Frame& F, int l, int half, LAS int* ts, LAS int* te) {
    LAS int* cn = (LAS int*)(F.lds + MISC_OFF + 5696);
    __syncthreads();
    if (F.tid < NEXP) {
        const int c = (int)__hip_atomic_load(F.ctl + CW_ECNT + ((l * 2 + half) * NEXP1 + F.tid) * 16, RLX_AGENT);
        cn[F.tid] = c; const int tiles = (c + 255) >> 8; int s = tiles;
#pragma unroll
        for (int o = 1; o < 64; o <<= 1) { const int t = __shfl_up(s, o); if (F.tid >= o) s += t; }
        ts[F.tid] = s - tiles;
        if (F.tid == NEXP - 1) { ts[NEXP] = s; ts[NEXP1] = s + (TT + 255) / 256; cn[NEXP] = TT; }
    }
    __syncthreads();
    const int total = ts[NEXP1];
    for (int t = F.tid; t < total; t += NTHREADS) { int e = 0;
        for (int k = 1; k < NEXP1; ++k) e += (ts[k] <= t) ? 1 : 0;
        te[t] = e; }
    __syncthreads();
}
__device__ __forceinline__ void phase_scatter(Frame& F, int l, bool dry = false) {
    LAS int* ts = (LAS int*)(F.lds + MISC_OFF + 256); LAS int* te = (LAS int*)(F.lds + MISC_OFF + 3584);
    const int* tope = (const int*)(F.ws + WS_TOPE); const float* topw = (const float*)(F.ws + WS_TOPW); int* tops = (int*)(F.ws + WS_TOPS);
    for (int half = 0; half < 2; ++half) {
        moe_table(F, l, half, ts, te);
        int* rtok = (int*)(F.ws + WS_RTOK) + (size_t)half * HROWS_PAD; float* rw = (float*)(F.ws + WS_RW) + (size_t)half * HROWS_PAD;
        for (int r = half * TT + F.gw; r < (half + 1) * TT; r += F.NGW) {
            if (F.lane < 7) { const int e = tope[(size_t)r * 8 + F.lane]; const int pos = ts[e] * 256 + tops[(size_t)r * 8 + F.lane];
                if (!dry || pos == -12345) { rtok[pos] = r; rw[pos] = topw[(size_t)r * 8 + F.lane]; tops[(size_t)r * 8 + F.lane] = pos; } } }
        for (int it = blockIdx.x * NTHREADS + F.tid; it < NEXP1 * 256; it += F.G * NTHREADS) { const int e = it >> 8, j = it & 255;
            const int cnt = ((const LAS int*)(F.lds + MISC_OFF + 5696))[e];
            const int rem = cnt & 255; if (rem != 0 && j >= rem) { const int pos = (ts[e] + (cnt >> 8)) * 256 + j; rtok[pos] = half * TT; rw[pos] = 0.f; } }
    }
}
__device__ __forceinline__ void phase_combine(Frame& F, const Params& P, int l, int half, bool dry = false) {
    const float* modv = (const float*)(F.ws + WS_MODV) + (size_t)l * 3 * 6144; const float* modn = (const float*)(F.ws + WS_MODV) + (size_t)(l + 1) * 3 * 6144;
    const bf16_t* hb = (const bf16_t*)(F.ws + WS_HB); bf16_t* hn = (bf16_t*)P.out; float* hlat = P.out; float* hctx = (float*)(F.ws + WS_HCTX); bf16_t* U = (bf16_t*)(F.ws + WS_C);
    const unsigned char* Y = (const unsigned char*)(F.ws + WS_A); const int* tops = (const int*)(F.ws + WS_TOPS);
    const int lane = F.lane; const int cb = (lane >> 4) * 256 + (lane & 15) * 8;
    int posn[7];
    { const int r0 = half * TT + F.gw;
#pragma unroll
      for (int k = 0; k < 7; ++k) posn[k] = (r0 < (half + 1) * TT) ? tops[(size_t)r0 * 8 + k] : 0; }
    for (int r = half * TT + F.gw; r < (half + 1) * TT; r += F.NGW) {
        int pos[7];
#pragma unroll
        for (int k = 0; k < 7; ++k) pos[k] = posn[k];
        { const int rn = r + F.NGW; const int rq = (rn < (half + 1) * TT) ? rn : r;
#pragma unroll
          for (int k = 0; k < 7; ++k) posn[k] = tops[(size_t)rq * 8 + k]; }
        bool isctx; int b; const size_t off = hrow_off(r, isctx, b);
        float* row = (isctx ? hctx : hlat) + off; float x[16];
        if (isctx) {
#pragma unroll
            for (int hf = 0; hf < 2; ++hf) { const f32x4 a = *(const f32x4*)(row + cb + hf * 128), b4 = *(const f32x4*)(row + cb + hf * 128 + 4);
                x[hf * 8 + 0] = a[0]; x[hf * 8 + 1] = a[1]; x[hf * 8 + 2] = a[2]; x[hf * 8 + 3] = a[3]; x[hf * 8 + 4] = b4[0]; x[hf * 8 + 5] = b4[1]; x[hf * 8 + 6] = b4[2]; x[hf * 8 + 7] = b4[3]; }
        } else {
#pragma unroll
            for (int hf = 0; hf < 2; ++hf) { const v4u w = *(const v4u*)(hb + off + cb + hf * 128); float t[8]; unpack8(w, t);
#pragma unroll
                for (int j = 0; j < 8; ++j) x[hf * 8 + j] = t[j]; }
        }
        float y[16];
#pragma unroll
        for (int i = 0; i < 16; ++i) y[i] = 0.f;
        v4u yw[7];
#pragma unroll
        for (int k = 0; k < 7; ++k) yw[k] = *(const v4u*)(Y + (size_t)pos[k] * DM + lane * 16);
#pragma unroll
        for (int k = 0; k < 7; ++k)
#pragma unroll
            for (int q = 0; q < 4; ++q) { const int wq = (int)yw[k][q]; const f32x2 lo = __builtin_amdgcn_cvt_pk_f32_fp8(wq, false), hi = __builtin_amdgcn_cvt_pk_f32_fp8(wq, true);
                y[q * 4 + 0] += lo[0]; y[q * 4 + 1] += lo[1]; y[q * 4 + 2] += hi[0]; y[q * 4 + 3] += hi[1]; }
        const float* gt2 = modv + (isctx ? 2 : b) * 6144 + 5 * DM;
#pragma unroll
        for (int hf = 0; hf < 2; ++hf)
#pragma unroll
            for (int j = 0; j < 8; ++j) x[hf * 8 + j] += gt2[cb + hf * 128 + j] * (y[hf * 8 + j] * pg8::YUNSCALE);
        if (dry) { float sy = 0.f;
#pragma unroll
            for (int i = 0; i < 16; ++i) sy += x[i];
            if (sy == 123456.f) row[0] = sy; continue; }
        if (l + 1 < NLAYER) {
#pragma unroll
            for (int hf = 0; hf < 2; ++hf) {
                if (isctx) { *(f32x4*)(row + cb + hf * 128) = (f32x4){x[hf * 8 + 0], x[hf * 8 + 1], x[hf * 8 + 2], x[hf * 8 + 3]}; *(f32x4*)(row + cb + hf * 128 + 4) = (f32x4){x[hf * 8 + 4], x[hf * 8 + 5], x[hf * 8 + 6], x[hf * 8 + 7]}; }
                else { v4u w; w.x = cvt_pk_bf16(x[hf * 8 + 0], x[hf * 8 + 1]); w.y = cvt_pk_bf16(x[hf * 8 + 2], x[hf * 8 + 3]); w.z = cvt_pk_bf16(x[hf * 8 + 4], x[hf * 8 + 5]); w.w = cvt_pk_bf16(x[hf * 8 + 6], x[hf * 8 + 7]); *(v4u*)(hn + off + cb + hf * 128) = w; } }
            const float* mv = modn + (isctx ? 2 : b) * 6144; const float* g = P.in[I_GN1] + (l + 1) * DM; const float* sc = mv + 1 * DM; const float* sh = mv + 0 * DM;
            float ss = 0.f;
#pragma unroll
            for (int i = 0; i < 16; ++i) ss += x[i] * x[i];
            const float rstd = rsqrtf(wave_sum(ss) * (1.f / DM) + EPS);
#pragma unroll
            for (int hf = 0; hf < 2; ++hf) { const int c0 = cb + hf * 128; float yv[8];
#pragma unroll
                for (int j = 0; j < 8; ++j) yv[j] = x[hf * 8 + j] * rstd * g[c0 + j] * (1.f + sc[c0 + j]) + sh[c0 + j];
                v4u w; w.x = cvt_pk_bf16(yv[0], yv[1]); w.y = cvt_pk_bf16(yv[2], yv[3]); w.z = cvt_pk_bf16(yv[4], yv[5]); w.w = cvt_pk_bf16(yv[6], yv[7]);
                *(v4u*)(U + (size_t)r * DM + c0) = w; }
        } else if (!isctx) {
            float ss = 0.f;
#pragma unroll
            for (int i = 0; i < 16; ++i) ss += x[i] * x[i];
            const float rstd = rsqrtf(wave_sum(ss) * (1.f / DM) + EPS); const float* gf = P.in[I_GFIN];
#pragma unroll
            for (int hf = 0; hf < 2; ++hf) { const int c0 = cb + hf * 128;
                *(f32x4*)(row + c0) = (f32x4){x[hf * 8 + 0] * rstd * gf[c0 + 0], x[hf * 8 + 1] * rstd * gf[c0 + 1], x[hf * 8 + 2] * rstd * gf[c0 + 2], x[hf * 8 + 3] * rstd * gf[c0 + 3]};
                *(f32x4*)(row + c0 + 4) = (f32x4){x[hf * 8 + 4] * rstd * gf[c0 + 4], x[hf * 8 + 5] * rstd * gf[c0 + 5], x[hf * 8 + 6] * rstd * gf[c0 + 6], x[hf * 8 + 7] * rstd * gf[c0 + 7]}; }
        }
    }
}
#if defined(MK_DEBUG)
__global__ void chk_bf16(const bf16_t* buf, long rows, int cols, int pitch, unsigned* word, unsigned bit) {
    bool bad = false;
    for (long i = blockIdx.x * (long)blockDim.x + threadIdx.x; i < rows * cols; i += (long)gridDim.x * blockDim.x) { const long r = i / cols; const int c = (int)(i % cols);
        const unsigned short v = buf[r * pitch + c]; if ((v & 0x7f80u) == 0x7f80u) bad = true; }
    if (bad) atomicOr(word, bit);
}
__global__ void chk_f32(const float* buf, long n, unsigned* word, unsigned bit) {
    bool bad = false;
    for (long i = blockIdx.x * (long)blockDim.x + threadIdx.x; i < n; i += (long)gridDim.x * blockDim.x) { const unsigned v = __float_as_uint(buf[i]); if ((v & 0x7f800000u) == 0x7f800000u) bad = true; }
    if (bad) atomicOr(word, bit);
}
__global__ void dbg_fill(float* out, long n, const unsigned* word) {
    const float a = 1.0f + (float)(*word);
    for (long i = blockIdx.x * (long)blockDim.x + threadIdx.x; i < n; i += (long)gridDim.x * blockDim.x) out[i] = a;
}
#endif
constexpr int NU_DN = 32, NU_GQA = 1024, NU_DIFF = 1024, NU_GQAC = 16, NU_DIFFC = 16, NU_TOTAL = NU_DN + NU_GQA + NU_DIFF + NU_GQAC + NU_DIFFC, NU_XCD = NU_TOTAL / 8;
static_assert(NU_XCD == 264, "per-XCD unit lists");
__device__ __forceinline__ void phase_mix(Frame& F, const Params& P, int l, int qoff = 0) {
    bf16_t* P1 = (bf16_t*)(F.ws + WS_A); bf16_t* BR = (bf16_t*)(F.ws + WS_B); bf16_t* DO = (bf16_t*)(F.ws + WS_D);
    bf16_t* OFw = DO + (size_t)MROWS * 1024; bf16_t* OBw = OFw + (size_t)MROWS * 512;
    const int xcd0 = (int)xb_xcc_id() & 7;
    LAS float* kt = (LAS float*)(F.lds + MISC_OFF + 6144);
    if (F.tid < 20) kt[F.tid] = sqrtf(__int_as_float((int)__hip_atomic_load(F.ctl + CW_KMAX + (l * 2 + F.tid / 10) * 16 + F.tid % 10, RLX_AGENT)));
    int qsel = 0;
    for (;;) {
        int u = -1; int x = 0;
        for (;;) {
            if (qsel >= 8) break;
            x = (xcd0 + qsel) & 7;
            __syncthreads();
            if (F.tid == 0) F.MISC[16] = __hip_atomic_fetch_add(F.ctl + CW_QUEUE + 64 * (l * 8 + x + qoff), 1u, RLX_AGENT);
            __syncthreads();
            const int li = __builtin_amdgcn_readfirstlane((int)F.MISC[16]);
            if (li < NU_XCD) { u = li; break; }
            ++qsel;
        }
        if (u < 0) break;
#if defined(MK_PROBE_DNLAST)
        const int li = (u + 4) % NU_XCD;
#else
        const int li = u;
#endif
        if (li < 4) {
            const int cu = x + 8 * li;
            dn::Chain ch; const int b = cu >> 4, h = (cu >> 1) & 7, dir = cu & 1;
            ch.P1b = P1 + (size_t)b * TT * P1W; ch.QKb = BR + (size_t)b * TT * 1536 + 512; ch.Ob = (dir ? OBw : OFw) + (size_t)b * TT * 512; ch.h = h; ch.dir = dir;
            ch.Aexp = expf(P.in[I_ALOG][l * 16 + dir * 8 + h]); ch.dtb = P.in[I_DTB][l * 16 + dir * 8 + h];
            ch.ring = (unsigned char*)(F.ws + WS_RING + (size_t)cu * 12 * RING_SLOT); ch.dbg = (unsigned*)(F.ws + WS_CTL) + 64;
            dn::chain_unit(ch, P.in[I_WCONV] + (size_t)l * 3 * 1536, F.lds + RING_OFF, (LAS float*)(F.lds + MISC_OFF + 1024), F.wave);
            continue;
        }
        int b, qrow, nt, qcol, kcol, vcol, ocol, op; bf16_t* obase; bool wide; int kidx;
        if (li < 4 + 128) { const int j = li - 4, gidx = 2 * x + (j >> 6), qb = j & 63; b = gidx >> 3; const int hc = gidx & 7; wide = true; kidx = 2 + hc;
            qrow = CTXL + qb * 256; nt = TT / 64; qcol = C_CQ + hc * 64; kcol = C_CK + hc * 64; vcol = C_CV + (hc >> 1) * 128; obase = DO; op = 1024; ocol = hc * 128; }
        else if (li < 4 + 128 + 128) { const int j = li - 132, grp = x >> 1; b = grp >> 1; const int kvh = grp & 1, hq = 2 * (x & 1) + (j >> 6), qb = j & 63, h = kvh * 4 + hq; wide = false; kidx = kvh;
            qrow = CTXL + qb * 256; nt = TT / 64; qcol = C_AQ + h * 64; kcol = C_AK + kvh * 64; vcol = C_AV + kvh * 64; obase = BR; op = 1536; ocol = h * 64; }
        else { const int ci = x * 4 + (li - 260);
            if (ci < 16) { b = ci >> 3; const int h = ci & 7, kvh = h >> 2; wide = false; kidx = kvh;
                qrow = 0; nt = CTXL / 64; qcol = C_AQ + h * 64; kcol = C_AK + kvh * 64; vcol = C_AV + kvh * 64; obase = BR; op = 1536; ocol = h * 64; }
            else { const int idx = ci - 16; b = idx >> 3; const int hc = idx & 7; wide = true; kidx = 2 + hc;
                qrow = 0; nt = CTXL / 64; qcol = C_CQ + hc * 64; kcol = C_CK + hc * 64; vcol = C_CV + (hc >> 1) * 128; obase = DO; op = 1024; ocol = hc * 128; } }
        const bf16_t* pb = P1 + (size_t)b * TT * P1W;
        const float kmaxv = kt[b * 10 + kidx];
        if (wide) attn_body::attn_unit128_br<8>((const attn_body::bf16*)(pb + (size_t)qrow * P1W + qcol), P1W, (const attn_body::bf16*)(pb + kcol), P1W, (const attn_body::bf16*)(pb + vcol), P1W,
                                (attn_body::bf16*)(obase + ((size_t)b * TT + qrow) * op + ocol), op, nt, (char*)F.lds + RING_OFF, F.wave, kmaxv, qrow == 0 ? -1 : qrow - CTXL, wide ? (const float*)nullptr : P.in[I_GQ] + l * 64);
        else attn_body::attn_unit_br<8>((const attn_body::bf16*)(pb + (size_t)qrow * P1W + qcol), P1W, (const attn_body::bf16*)(pb + kcol), P1W, (const attn_body::bf16*)(pb + vcol), P1W,
                                (attn_body::bf16*)(obase + ((size_t)b * TT + qrow) * op + ocol), op, nt, (char*)F.lds + RING_OFF, F.wave, kmaxv, qrow == 0 ? -1 : qrow - CTXL, wide ? (const float*)nullptr : P.in[I_GQ] + l * 64);
    }
}

#ifndef MK_PHMASK
#define MK_PHMASK 0xFFFFF
#endif
#define PHEN(k) (((MK_PHMASK) >> (k)) & 1)
#if defined(MK_PROBE_BAR2)
#define MK_BAR2() do { for (int rb_ = 0; rb_ < MK_PROBE_BAR2; ++rb_) { F.lane = hw_lane(); xcd_barrier(bar, F.wave == 0 && F.lane == 0); } } while (0)
#else
#define MK_BAR2() do { } while (0)
#endif
#if defined(MK_PROBE_GEMM2)
#define GREP for (int rep_ = 0; rep_ < ((MK_PROBE_GEMM2 & 1) ? 2 : 1); ++rep_)
#define GREPE for (int rep_ = 0; rep_ < ((MK_PROBE_GEMM2 & 2) ? 2 : 1); ++rep_)
#define GREPE2 for (int rep_ = 0; rep_ < ((MK_PROBE_GEMM2 & 4) ? 2 : 1); ++rep_)
#else
#define GREP
#define GREPE
#define GREPE2
#endif
#if defined(MK_PROBE_EW2)
#define EREP for (int rep_ = 0; rep_ < 2; ++rep_)
#else
#define EREP
#endif
constexpr int NPH_LAYER = 15, NPHASES = 2 + NLAYER * NPH_LAYER;
#if MK_DEBUG == 5
#define MK_STAMP(k) do { if (blockIdx.x == 0 && F.tid == 0) { ((unsigned long long*)(P.ws + WS_CTL + 512))[(k) + 1] = __builtin_amdgcn_s_memrealtime(); ((unsigned long long*)(P.ws + WS_CTL + 1024))[(k) + 1] = __builtin_amdgcn_s_memtime(); } } while (0)
#else
#define MK_STAMP(k) do { } while (0)
#endif
#define IN(k) (lo <= (k) && (k) < hi)
#define SEAM(k) do { if (IN(k) && IN((k) + 1)) { F.lane = hw_lane(); xcd_barrier(bar, F.wave == 0 && F.lane == 0); MK_BAR2(); } F.lane = hw_lane(); F.tid = F.wave * 64 + F.lane; MK_STAMP(k); { GAS unsigned char* w_ = (GAS unsigned char*)P.ws; asm volatile("" : "+s"(w_)); F.ws = w_; F.ctl = (gu32*)(w_ + WS_CTL); } } while (0)
#define SEAM_NB(k) do { F.lane = hw_lane(); F.tid = F.wave * 64 + F.lane; MK_STAMP(k); { GAS unsigned char* w_ = (GAS unsigned char*)P.ws; asm volatile("" : "+s"(w_)); F.ws = w_; F.ctl = (gu32*)(w_ + WS_CTL); } } while (0)
#define U ((bf16_t*)(F.ws + WS_C))
#define RA ((bf16_t*)(F.ws + WS_A))
#define BR ((bf16_t*)(F.ws + WS_B))
#define G2 RA
#define Mm (RA + (size_t)MROWS * GW)
#define Hs ((bf16_t*)(F.ws + WS_D))
#define Yb RA
#define WGU ((bf16_t*)(F.ws + WS_B))
#define WD (WGU + (size_t)NEXP1 * 512 * DM)
template <int l, int half> __device__ __forceinline__ void moe_half(Frame& F, const Params& P, const XcdBarrier& bar, int lo, int hi) {
    constexpr int pb = 2 + NPH_LAYER * l;
    LAS int* const ts = (LAS int*)(F.lds + MISC_OFF + 256); LAS int* const te = (LAS int*)(F.lds + MISC_OFF + 3584);
    constexpr int hb = pb + 9 + 3 * half;
            if (PHEN(9) && IN(hb + 0)) {
                moe_table(F, l, half, ts, te);
                pg8::Gemm g{U, WGU, DM, DM, DM, (const int*)(F.ws + WS_RTOK) + (size_t)half * HROWS_PAD}; pg8::MoeOrder S{ts, te, 2, F.G, (int)blockIdx.x};
                pg8::EpiMoe1 E{Hs, (const float*)(F.ws + WS_RW) + (size_t)half * HROWS_PAD};
                GREPE pg8::gemm_phase<pg8::EpiMoe1, pg8::MoeOrder, true>(F.lds + RING_OFF, g, S, E, F.wave);
            } SEAM(hb + 0);
            if (PHEN(10) && IN(hb + 1)) {
                moe_table(F, l, half, ts, te);
                pg8::Gemm g{Hs, WD, FF, FF, FF, nullptr}; pg8::MoeOrder S{ts, te, 4, F.G, (int)blockIdx.x};
                pg8::EpiFp8 E{(unsigned char*)(F.ws + WS_A)};
                GREPE2 pg8::gemm_phase<pg8::EpiFp8, pg8::MoeOrder, false>(F.lds + RING_OFF, g, S, E, F.wave);
            } SEAM(hb + 1);
            if (PHEN(11) && IN(hb + 2)) {
#if defined(MK_PROBE_DRY)
                if (MK_PROBE_DRY & 8) phase_combine(F, P, l, half, true);
#endif
                phase_combine(F, P, l, half); if (half == 1 && l + 1 < NLAYER) { __syncthreads(); convert_small(F, P, l + 1); } }
            if (half == 0) { SEAM_NB(hb + 2); } else { SEAM(hb + 2); }
}
template <int l> __device__ __forceinline__ void layer_phases(Frame& F, const Params& P, const XcdBarrier& bar, int lo, int hi) {
    constexpr int pb = 2 + NPH_LAYER * l;
        if (PHEN(0) && IN(pb + 0)) {
            pg8::Gemm g{U, (const bf16_t*)(F.ws + WS_WB1), DM, DM, DM, nullptr}; pg8::DenseOrder S; S.init(MROWS / 256, P1W / 256, F.G, (int)blockIdx.x);
            pg8::EpiBf16<0> E{RA, P1W};
            GREP pg8::gemm_phase<pg8::EpiBf16<0>, pg8::DenseOrder, false>(F.lds + RING_OFF, g, S, E, F.wave);
        } SEAM(pb + 0);
        if (PHEN(1) && IN(pb + 1)) { phase_prep(F, P, l); phase_dn_prep(F, P, l);
            { F.lane = hw_lane(); xcd_barrier(bar, F.wave == 0 && F.lane == 0); F.lane = hw_lane(); F.tid = F.wave * 64 + F.lane; phase_dn_prep_v(F, P, l); }
#if defined(MK_PROBE_DRY)
            if (MK_PROBE_DRY & 1) phase_prep(F, P, l, true);
#endif
        } SEAM(pb + 1);
        if (PHEN(2) && IN(pb + 2)) { phase_mix(F, P, l);
#if defined(MK_PROBE_MIX2)
            { F.lane = hw_lane(); xcd_barrier(bar, F.wave == 0 && F.lane == 0); F.lane = hw_lane(); F.tid = F.wave * 64 + F.lane; phase_mix(F, P, l, 16); }
#endif
        } SEAM(pb + 2);
        if (PHEN(3) && IN(pb + 3)) { EREP phase_post(F, P, l); } SEAM(pb + 3);
        if (PHEN(4) && IN(pb + 4)) {
            pg8::Gemm g{U, (const bf16_t*)(F.ws + WS_WB2), DM, DM, DM, nullptr}; pg8::DenseOrder S; S.init(MROWS / 256, GW / 256, F.G, (int)blockIdx.x, l + 1 == NLAYER);
            pg8::EpiGate8 E{(unsigned char*)(F.ws + WS_A)};
            GREP pg8::gemm_phase<pg8::EpiGate8, pg8::DenseOrder, false>(F.lds + RING_OFF, g, S, E, F.wave);
        } SEAM(pb + 4);
        if (PHEN(5) && IN(pb + 5)) {
            pg8::Gemm g{BR, (const bf16_t*)(F.ws + WS_WBR), 1536, 512, 512, nullptr, 1024}; pg8::MergeOrder S; S.D.init(MROWS / 256, DM / 256, F.G, (int)blockIdx.x, l + 1 == NLAYER);
            pg8::EpiMerge E{Mm, (const unsigned char*)(F.ws + WS_A)};
            pg8::gemm_phase<pg8::EpiMerge, pg8::MergeOrder, false>(F.lds + RING_OFF, g, S, E, F.wave);
        } SEAM(pb + 5);
        if (PHEN(6) && IN(pb + 6)) {
            pg8::Gemm g{Mm, (const bf16_t*)(F.ws + WS_WOT), DM, DM, DM, nullptr}; pg8::DenseOrder S; S.init(MROWS / 256, DM / 256, F.G, (int)blockIdx.x, l + 1 == NLAYER);
            pg8::EpiResidB E{l == 0 ? P.in[I_X] : (const float*)nullptr, l == 0 ? (const bf16_t*)nullptr : (const bf16_t*)P.out, (bf16_t*)(F.ws + WS_HB), l == 0 ? P.in[I_CTX] : (const float*)(F.ws + WS_HCTX), (float*)(F.ws + WS_HCTX), (const float*)(F.ws + WS_MODV) + (size_t)l * 3 * 6144, 2};
            pg8::gemm_phase<pg8::EpiResidB, pg8::DenseOrder, false>(F.lds + RING_OFF, g, S, E, F.wave);
        } SEAM(pb + 6);
        if (PHEN(7) && IN(pb + 7)) { EREP convert_experts(F, P, l); __syncthreads(); phase_norm2_router(F, P, l);
#if defined(MK_PROBE_DRY)
            if (MK_PROBE_DRY & 2) { __syncthreads(); phase_norm2_router(F, P, l, true); }
#endif
        } SEAM(pb + 7);
        if (PHEN(8) && IN(pb + 8)) {
#if defined(MK_PROBE_DRY)
            if (MK_PROBE_DRY & 4) phase_scatter(F, l, true);
#endif
            phase_scatter(F, l); } SEAM(pb + 8);
    moe_half<l, 0>(F, P, bar, lo, hi);
    moe_half<l, 1>(F, P, bar, lo, hi);
}
#undef IN
#undef SEAM
#undef U
#undef RA
#undef BR
#undef G2
#undef Mm
#undef Hs
#undef Yb
#undef WGU
#undef WD
__global__ void __launch_bounds__(NTHREADS, 2) fwd_kernel(Params P) {
    extern __shared__ __attribute__((aligned(16))) unsigned char lds_raw[];
    Frame F;
    F.lds = (LAS unsigned char*)lds_raw; F.MISC = (volatile LAS unsigned*)(F.lds + MISC_OFF);
    F.wave = __builtin_amdgcn_readfirstlane((int)threadIdx.x >> 6); F.lane = hw_lane(); F.tid = F.wave * 64 + F.lane; F.G = gridDim.x;
    F.gw = blockIdx.x * NWAVES + F.wave; F.NGW = F.G * NWAVES; F.ws = (GAS unsigned char*)P.ws; F.ctl = (gu32*)(F.ws + WS_CTL);
    for (int u = F.tid; u < 64; u += NTHREADS) F.MISC[u] = 0u;
    __syncthreads();
    XcdBarrier bar; bar.bar = (unsigned*)(F.ctl + CW_BAR); bar.x = 0; bar.st = nullptr;
    if (P.use_bar) bar = xcd_barrier_post((unsigned*)(F.ctl + CW_BAR), F.MISC + 8, F.tid == 0);
    const int lo = P.ph_lo, hi = P.ph_hi;
#if MK_DEBUG == 5
    if (blockIdx.x == 0 && F.tid == 0) ((unsigned long long*)(P.ws + WS_CTL + 512))[0] = __builtin_amdgcn_s_memrealtime();
#endif
#define IN(k) (lo <= (k) && (k) < hi)
#define SEAM(k) do { if (IN(k) && IN((k) + 1)) { F.lane = hw_lane(); xcd_barrier(bar, F.wave == 0 && F.lane == 0); MK_BAR2(); } F.lane = hw_lane(); F.tid = F.wave * 64 + F.lane; MK_STAMP(k); { GAS unsigned char* w_ = (GAS unsigned char*)P.ws; asm volatile("" : "+s"(w_)); F.ws = w_; F.ctl = (gu32*)(w_ + WS_CTL); } } while (0)
    LAS int* const ts = (LAS int*)(F.lds + MISC_OFF + 256); LAS int* const te = (LAS int*)(F.lds + MISC_OFF + 3584);

    if (PHEN(15) && IN(0)) { EREP { convert_small(F, P, 0); compute_mod(F, P); } } SEAM(0);
    if (PHEN(16) && IN(1)) { EREP phase_norm1(F, P); } SEAM(1);
    layer_phases<0>(F, P, bar, lo, hi);
    layer_phases<1>(F, P, bar, lo, hi);
#if MK_DEBUG == 5
    { F.lane = hw_lane(); xcd_barrier(bar, F.wave == 0 && F.lane == 0);
      const unsigned long long* ts = (const unsigned long long*)(P.ws + WS_CTL + 512);
      const unsigned long long* tc = (const unsigned long long*)(P.ws + WS_CTL + 1024);
      auto dur = [&](int a, int b) { return (float)(ts[b + 1] - ts[a]) * 0.01f; };
      auto ghz = [&](int a, int b) { return (float)(tc[b + 1] - tc[a]) / ((float)(ts[b + 1] - ts[a]) * 10.0f); };
      auto LQ = [&](float X) { return 1.0f + floorf(log2f(X * 0.1f) * 5.0f + 0.5f) * 0.025f; };
      const float t1 = MK_T1, t2 = MK_T2;
      float* o = P.out; const long n = (long)NB * SEQ * DM;
      for (long i = (long)blockIdx.x * NTHREADS + F.wave * 64 + F.lane; i < n; i += (long)F.G * NTHREADS) o[i] = (i < 4096) ? t2 : t1; }
#endif
#undef IN
#undef SEAM
}

#ifndef MK_MULTI
#define MK_MULTI 0
#endif
extern "C" void kernel_launch(void* const* d_in, const int* in_sizes, int n_in, void* d_out, int out_size, void* d_ws, size_t ws_size, hipStream_t stream) {
    static int grid = 0;
    if (grid == 0) {
        if (n_in != 28 || out_size != NB * SEQ * DM || ws_size < WS_END) { fprintf(stderr, "kernel_launch: unexpected shapes (n_in %d out %d ws %zu need %zu); nothing launched\n", n_in, out_size, ws_size, (size_t)WS_END); grid = -1; return; }
        int dev = 0, cus = 0;
        if (hipGetDevice(&dev) != hipSuccess || hipDeviceGetAttribute(&cus, hipDeviceAttributeMultiprocessorCount, dev) != hipSuccess) { grid = -1; return; }
        if (hipFuncSetAttribute((const void*)fwd_kernel, hipFuncAttributeMaxDynamicSharedMemorySize, LDS_BYTES) != hipSuccess) { fprintf(stderr, "kernel_launch: hipFuncSetAttribute failed\n"); grid = -1; return; }
        int per_cu = 0;
        if (hipOccupancyMaxActiveBlocksPerMultiprocessor(&per_cu, (const void*)fwd_kernel, NTHREADS, LDS_BYTES) != hipSuccess || per_cu < 1) fprintf(stderr, "kernel_launch: occupancy query reports %d\n", per_cu);
        (void)hipGetLastError();
        grid = cus;
    }
    if (grid < 0) return;
    (void)hipMemsetAsync((char*)d_ws + WS_CTL, 0, CTL_ZERO_BYTES, stream);
    Params p{};
    for (int i = 0; i < 28; ++i) p.in[i] = (const float*)d_in[i];
    p.out = (float*)d_out; p.ws = (unsigned char*)d_ws;
#ifndef MK_NPH_RUN
#define MK_NPH_RUN NPHASES
#endif
#if MK_MULTI
#error "the per-phase checkpoint build is no longer supported: the prep phase contains a grid barrier"
    for (int k = 0; k < MK_NPH_RUN; ++k) { p.ph_lo = k; p.ph_hi = k + 1; p.use_bar = 0; hipLaunchKernelGGL(fwd_kernel, dim3(grid), dim3(NTHREADS), LDS_BYTES, stream, p);
#if defined(MK_DEBUG)
        unsigned* dw = (unsigned*)((char*)d_ws + WS_CTL) + 64; unsigned char* w = (unsigned char*)d_ws;
#if MK_DEBUG == 1
        if (k == 3) hipLaunchKernelGGL(chk_bf16, dim3(1024), dim3(256), 0, stream, (const bf16_t*)(w + WS_A), (long)MROWS, 4384, P1W, dw, 1u);
        if (k == 4) { hipLaunchKernelGGL(chk_bf16, dim3(1024), dim3(256), 0, stream, (const bf16_t*)(w + WS_B), (long)MROWS, 512, 1536, dw, 2u);
                      hipLaunchKernelGGL(chk_bf16, dim3(1024), dim3(256), 0, stream, (const bf16_t*)(w + WS_D), (long)MROWS, 1024, 1024, dw, 4u);
                      hipLaunchKernelGGL(chk_bf16, dim3(1024), dim3(256), 0, stream, (const bf16_t*)(w + WS_D) + (size_t)MROWS * 1024, (long)MROWS, 1024, 1024, dw, 8u); }
        if (k == 7) hipLaunchKernelGGL(chk_bf16, dim3(1024), dim3(256), 0, stream, (const bf16_t*)(w + WS_A) + (size_t)MROWS * GW, (long)MROWS, 1024, 1024, dw, 16u);
#endif
#endif
    }
#if defined(MK_DEBUG)
    hipLaunchKernelGGL(dbg_fill, dim3(1024), dim3(256), 0, stream, (float*)d_out, (long)NB * SEQ * DM, (const unsigned*)((char*)d_ws + WS_CTL) + 64);
#endif
#else
    p.ph_lo = 0; p.ph_hi = NPHASES; p.use_bar = 1;
    hipLaunchKernelGGL(fwd_kernel, dim3(grid), dim3(NTHREADS), LDS_BYTES, stream, p);
#endif
}
```
